# Optimizing an MI355X kernel written in HIP

```python
import math
import jax
import jax.numpy as jnp
from jax import lax
import numpy as np


D_MODEL = 1024
BATCH = 8
SEQ = 4096
DEPTH = 1

CHUNK = 64
PLE_DIM = 256
SB_HEADS = 8
SB_HEAD_DIM = 64
SB_WIDTH = SB_HEADS * SB_HEAD_DIM
SGU_GROUPS = 8
SGU_WIDTH = 512
SGU_GROUP_DIM = SGU_WIDTH // SGU_GROUPS
SGU_BLOCK = 128
QBLK = 128
N_EXPERTS = 32
TOP_K = 4
D_EXPERT = 1024
SWIGLU_ALPHA = 1.702
SWIGLU_LIMIT = 7.0
MOE_BLOCK = 128
EPS = 1e-6
SPLITS = (SB_WIDTH, SB_WIDTH, SB_WIDTH, SGU_WIDTH, SGU_WIDTH, D_MODEL, D_MODEL)
IN_COLS = sum(SPLITS)

kernel_name = 'hybrid_stickbreak_sgu_moe_block'


def rmsnorm(x, g):
    xf = x.astype(jnp.float32)
    y = xf * lax.rsqrt(jnp.mean(xf * xf, axis=-1, keepdims=True) + EPS)
    return (y * g.astype(jnp.float32)).astype(x.dtype)


def layernorm(x, g):
    xf = x.astype(jnp.float32)
    mu = jnp.mean(xf, axis=-1, keepdims=True)
    var = jnp.mean(jnp.square(xf - mu), axis=-1, keepdims=True)
    return ((xf - mu) * lax.rsqrt(var + EPS) * g.astype(jnp.float32)).astype(x.dtype)


def stick_breaking_attention(q, k, v):
    S = q.shape[2]
    scale = 1.0 / math.sqrt(q.shape[-1])
    outs = []
    for qb in range(S // QBLK):
        L = (qb + 1) * QBLK
        qi = q[:, :, qb * QBLK:L]
        z = jnp.einsum('bhtd,bhsd->bhts', qi, k[:, :, :L]).astype(jnp.float32) * scale
        t_pos = qb * QBLK + jnp.arange(QBLK)
        s_pos = jnp.arange(L)
        mask = s_pos[None, :] < t_pos[:, None]
        log_1mb = jnp.where(mask, jax.nn.log_sigmoid(-z), 0.0)
        rest = lax.cumsum(log_1mb, axis=3, reverse=True) - log_1mb
        w = jnp.where(mask, jnp.exp(jax.nn.log_sigmoid(z) + rest), 0.0)
        outs.append(jnp.einsum('bhts,bhsd->bhtd', w.astype(v.dtype), v[:, :, :L]))
    return jnp.concatenate(outs, axis=2)


def spatial_gating(u, vs, norm_g, w_s, b_s):
    B, S, _ = u.shape
    u = jax.nn.gelu(u)
    vs = layernorm(jax.nn.gelu(vs), norm_g)
    pos = jnp.arange(SGU_BLOCK)
    cmask = (pos[None, :] // CHUNK) <= (pos[:, None] // CHUNK)
    w_m = jnp.where(cmask[None], w_s, 0.0).astype(vs.dtype)
    vg = vs.reshape(B, S // SGU_BLOCK, SGU_BLOCK, SGU_GROUPS, SGU_GROUP_DIM)
    sv = jnp.einsum('gts,bnsgc->bntgc', w_m, vg) + b_s.T[None, None, :, :, None]
    return u * sv.reshape(B, S, SGU_WIDTH)


def token_mixer(a, w_in, w_out_a, w_out_b, w_out, sgu_norm, sgu_w, sgu_b):
    B, S, _ = a.shape
    zz = a @ w_in
    idx = list(np.cumsum(SPLITS)[:-1])
    q, k, v, u, vs, ga, gb = jnp.split(zz, idx, axis=-1)
    heads = lambda t: t.reshape(B, S, SB_HEADS, SB_HEAD_DIM).transpose(0, 2, 1, 3)
    o_a = stick_breaking_attention(heads(q), heads(k), heads(v))
    o_a = o_a.transpose(0, 2, 1, 3).reshape(B, S, SB_WIDTH)
    o_b = spatial_gating(u, vs, sgu_norm, sgu_w, sgu_b)
    merged = jax.nn.sigmoid(ga) * (o_a @ w_out_a) + jax.nn.sigmoid(gb) * (o_b @ w_out_b)
    return merged @ w_out


def moe(c, w_router, b_router, w1, b1, w2, b2):
    B, S, D = c.shape
    T = B * S
    cf = c.reshape(T, D)
    logits = (cf @ w_router + b_router).astype(jnp.float32)
    top_vals, top_idx = lax.top_k(logits, TOP_K)
    gates = jax.nn.softmax(top_vals, axis=-1).astype(c.dtype)
    e_flat = top_idx.reshape(-1)
    g_flat = gates.reshape(-1)
    tok_flat = jnp.repeat(jnp.arange(T), TOP_K)
    order = jnp.argsort(e_flat)
    e_sorted = e_flat[order]
    counts = jnp.bincount(e_flat, length=N_EXPERTS)
    offsets = jnp.cumsum(counts) - counts
    padded = ((counts + MOE_BLOCK - 1) // MOE_BLOCK) * MOE_BLOCK
    pad_end = jnp.cumsum(padded)
    pad_off = pad_end - padded
    rank = jnp.arange(T * TOP_K) - offsets[e_sorted]
    dest = pad_off[e_sorted] + rank
    n_blocks = -(-(T * TOP_K + N_EXPERTS * (MOE_BLOCK - 1)) // MOE_BLOCK)
    n_slots = n_blocks * MOE_BLOCK
    slot_tok = jnp.zeros((n_slots,), jnp.int32).at[dest].set(tok_flat[order].astype(jnp.int32))
    slot_gate = jnp.zeros((n_slots,), c.dtype).at[dest].set(g_flat[order])
    starts = jnp.arange(n_blocks) * MOE_BLOCK
    block_e = jnp.minimum(jnp.sum(starts[:, None] >= pad_end[None, :], axis=1), N_EXPERTS - 1)
    xs = cf[slot_tok].reshape(n_blocks, MOE_BLOCK, D)

    def expert_block(args):
        xb, e = args
        hh = xb @ w1[e] + b1[e]
        x_glu = jnp.minimum(hh[:, ::2], SWIGLU_LIMIT)
        x_lin = jnp.clip(hh[:, 1::2], -SWIGLU_LIMIT, SWIGLU_LIMIT)
        act = x_glu * jax.nn.sigmoid(SWIGLU_ALPHA * x_glu) * (x_lin + 1.0)
        return act @ w2[e] + b2[e]

    ys = lax.map(expert_block, (xs, block_e)).reshape(n_slots, D)
    out = jnp.zeros((T, D), c.dtype).at[slot_tok].add(ys * slot_gate[:, None])
    return out.reshape(B, S, D)


def setup_inputs(seed: int = 0) -> dict:
    key = jax.random.key(seed)
    ks = jax.random.split(key, 24)
    f32 = jnp.float32
    nrm = lambda k, shape, s: jax.random.normal(k, shape, f32) * s
    gain = lambda k, shape: 1.0 + 0.02 * jax.random.normal(k, shape, f32)
    return {
        'x': jax.random.normal(ks[0], (BATCH, SEQ, D_MODEL), f32),
        'p': jax.random.normal(ks[1], (DEPTH, BATCH, SEQ, PLE_DIM), f32),
        'g_mix': gain(ks[2], (DEPTH, D_MODEL)),
        'w_in': nrm(ks[3], (DEPTH, D_MODEL, IN_COLS), D_MODEL ** -0.5),
        'w_out_a': nrm(ks[4], (DEPTH, SB_WIDTH, D_MODEL), SB_WIDTH ** -0.5),
        'w_out_b': nrm(ks[5], (DEPTH, SGU_WIDTH, D_MODEL), SGU_WIDTH ** -0.5),
        'w_out': nrm(ks[6], (DEPTH, D_MODEL, D_MODEL), D_MODEL ** -0.5),
        'sgu_norm': gain(ks[7], (DEPTH, SGU_WIDTH)),
        'sgu_w': nrm(ks[8], (DEPTH, SGU_GROUPS, SGU_BLOCK, SGU_BLOCK), SGU_BLOCK ** -0.5),
        'sgu_b': 1.0 + 0.02 * jax.random.normal(ks[9], (DEPTH, SGU_GROUPS, SGU_BLOCK), f32),
        'g_moe': gain(ks[10], (DEPTH, D_MODEL)),
        'w_router': nrm(ks[11], (DEPTH, D_MODEL, N_EXPERTS), D_MODEL ** -0.5),
        'b_router': nrm(ks[12], (DEPTH, N_EXPERTS), 0.01),
        'w1': nrm(ks[13], (DEPTH, N_EXPERTS, D_MODEL, 2 * D_EXPERT), D_MODEL ** -0.5),
        'b1': nrm(ks[14], (DEPTH, N_EXPERTS, 2 * D_EXPERT), 0.02),
        'w2': nrm(ks[15], (DEPTH, N_EXPERTS, D_EXPERT, D_MODEL), D_EXPERT ** -0.5),
        'b2': nrm(ks[16], (DEPTH, N_EXPERTS, D_MODEL), 0.02),
        'g_ple': gain(ks[17], (DEPTH, D_MODEL)),
        'w_ple_gate': nrm(ks[18], (DEPTH, D_MODEL, D_MODEL), D_MODEL ** -0.5),
        'w_ple_proj': nrm(ks[19], (DEPTH, PLE_DIM, D_MODEL), PLE_DIM ** -0.5),
        'g_final': gain(ks[20], (D_MODEL,)),
    }


def reference(x, p, g_mix, w_in, w_out_a, w_out_b, w_out, sgu_norm, sgu_w, sgu_b,
              g_moe, w_router, b_router, w1, b1, w2, b2, g_ple, w_ple_gate, w_ple_proj, g_final):
    h = x
    for i in range(DEPTH):
        a = rmsnorm(h, g_mix[i])
        h = h + token_mixer(a, w_in[i], w_out_a[i], w_out_b[i], w_out[i],
                            sgu_norm[i], sgu_w[i], sgu_b[i])
        c = rmsnorm(h, g_moe[i])
        h = h + moe(c, w_router[i], b_router[i], w1[i], b1[i], w2[i], b2[i])
        pg = jax.nn.sigmoid(rmsnorm(h, g_ple[i]) @ w_ple_gate[i])
        h = h + pg * (p[i] @ w_ple_proj[i])
    return rmsnorm(h, g_final)
```

```cpp
#include <hip/hip_runtime.h>
#include <cstdio>
#include <cstdint>

#define GAS __attribute__((address_space(1)))
#define LAS __attribute__((address_space(3)))
typedef unsigned short bf16;
typedef short bf16x8 __attribute__((ext_vector_type(8)));
typedef float f32x4 __attribute__((ext_vector_type(4)));
typedef float f32x16 __attribute__((ext_vector_type(16)));
typedef unsigned u32x4 __attribute__((ext_vector_type(4)));
typedef unsigned u32x2 __attribute__((ext_vector_type(2)));

constexpr int BATCH = 8, SEQ = 4096, T = BATCH * SEQ, D = 1024, PLE = 256, NH = 8, HD = 64, NE = 32, DE = 1024, INC = 4608;
constexpr int ZQ = 0, ZK = 512, ZV = 1024, ZU = 1536, ZVS = 2048, ZGA = 2560, ZGB = 3584;
constexpr float EPS = 1e-6f;
constexpr float LOG2E = 1.4426950408889634f;
constexpr float QSCALE = 0.125f * LOG2E;
constexpr int LCAP = 32768;
constexpr int HROWS = 139264;

constexpr size_t MiB = 1u << 20;
constexpr size_t WS_CTL = 0, CTL_ZERO_BYTES = 1 * MiB;
constexpr size_t WS_WRHI = 1 * MiB, WS_WRLO = WS_WRHI + 65536, WS_SGUW = WS_WRLO + 65536;
constexpr size_t WS_RSTD1 = WS_SGUW + 262144, WS_RSTD2 = WS_RSTD1 + 131072;
constexpr size_t WS_WIN = 2 * MiB, WS_WAB = 11 * MiB, WS_WOUT = 13 * MiB, WS_WPG = 15 * MiB, WS_WPP = 17 * MiB;
constexpr size_t WS_TOKLIST = 18 * MiB, WS_SLOTREF = 22 * MiB, WS_GATE = WS_SLOTREF + 524288;
constexpr size_t WS_W1 = 28 * MiB, WS_W2 = 156 * MiB, WS_PBF = 220 * MiB, WS_PROJ = 236 * MiB, WS_H1 = 300 * MiB;
constexpr size_t WS_R1 = 364 * MiB;
constexpr size_t WS_ZZ = WS_R1, WS_HID = WS_R1, WS_H2 = WS_R1, WS_H3 = WS_R1 + 64 * MiB;
constexpr size_t WS_R2 = 652 * MiB;
constexpr size_t WS_ABF = WS_R2, WS_OAB = WS_R2 + 64 * MiB, WS_MERGED = WS_R2 + 128 * MiB, WS_YS = WS_R2;
constexpr size_t WS_END = 924 * MiB;
constexpr int CW_BAR = 4096, CW_CNT = 8192;

constexpr int LDS_BYTES = 147456;
constexpr int MISC_OFF = 139264;
constexpr int NWAVES = 8, NTHREADS = 512;

#define LDS_WAIT() asm volatile("s_waitcnt lgkmcnt(0)" ::: "memory")
__device__ __forceinline__ float bf2f(unsigned v) { return __uint_as_float(v << 16); }
__device__ __forceinline__ unsigned f2bf(float f) { unsigned u = __float_as_uint(f); return (u + 0x7fffu + ((u >> 16) & 1u)) >> 16; }
__device__ __forceinline__ unsigned pk2(float lo, float hi) { return f2bf(lo) | (f2bf(hi) << 16); }
__device__ __forceinline__ float wave_sum(float v) {
#pragma unroll
    for (int o = 1; o < 64; o <<= 1) v += __shfl_xor(v, o);
    return v;
}
__device__ __forceinline__ float wave_max(float v) {
#pragma unroll
    for (int o = 1; o < 64; o <<= 1) v = fmaxf(v, __shfl_xor(v, o));
    return v;
}
__device__ __forceinline__ float sigmoidf_(float x) { return 1.0f / (1.0f + __expf(-x)); }
__device__ __forceinline__ float gelu_tanh(float x) {
    const float u = 1.5957691216057308f * (x + 0.044715f * x * x * x);
    return x * sigmoidf_(u);
}
__device__ __forceinline__ int crow(int r, int hi) { return (r & 3) + 8 * (r >> 2) + 4 * hi; }
__device__ __forceinline__ void unpack8(const u32x4 w, float (&f)[8]) {
    f[0] = bf2f(w.x & 0xffffu); f[1] = bf2f(w.x >> 16); f[2] = bf2f(w.y & 0xffffu); f[3] = bf2f(w.y >> 16);
    f[4] = bf2f(w.z & 0xffffu); f[5] = bf2f(w.z >> 16); f[6] = bf2f(w.w & 0xffffu); f[7] = bf2f(w.w >> 16);
}

#define XB_TMO      128
#define XB_XCNT(j)  (256  + 64 * (j))
#define XB_XSUB(j)  (1280 + 64 * (j))
#define XB_XGEN(j)  (2304 + 64 * (j))
#define XB_TOP      3328
#define XB_TOPGEN   3392
#define XCD_BAR_WORDS 3456
#define XB_SPIN_CAP (1u << 23)
__device__ __forceinline__ unsigned xb_ld(unsigned* p)              { return __hip_atomic_load(p, __ATOMIC_RELAXED, __HIP_MEMORY_SCOPE_AGENT); }
__device__ __forceinline__ unsigned xb_add(unsigned* p, unsigned v) { return __hip_atomic_fetch_add(p, v, __ATOMIC_RELAXED, __HIP_MEMORY_SCOPE_AGENT); }
__device__ __forceinline__ unsigned xb_xcc_id() { return (unsigned)__builtin_amdgcn_s_getreg((3 << 11) | 20) & 0xFu; }
#define XB_SPIN(cond, bar) do { unsigned _sp = 0; while (cond) { __builtin_amdgcn_s_sleep(1); \
    if ((++_sp & 255u) == 0u) { if (xb_ld(&(bar)[XB_TMO])) break; if (_sp > XB_SPIN_CAP) { atomicAdd(&(bar)[XB_TMO], 1u); break; } } } } while (0)
struct XcdBarrier { unsigned* bar; unsigned x; volatile LAS unsigned* st; };
__device__ __forceinline__ XcdBarrier xcd_barrier_post(unsigned* bar, volatile LAS unsigned* st) {
    XcdBarrier b; b.bar = bar; b.x = xb_xcc_id(); b.st = st;
    if (threadIdx.x == 0) (void)xb_add(&bar[XB_XCNT(b.x)], 1u);
    return b;
}
__device__ __forceinline__ void xcd_barrier_complete(unsigned* bar, unsigned x, unsigned& nloc, unsigned& nx) {
    const unsigned G = gridDim.x * gridDim.y * gridDim.z;
    unsigned sum, cnt, mine, sp = 0u;
    for (;;) {
        sum = 0u; cnt = 0u; mine = 0u;
#pragma unroll
        for (unsigned j = 0; j < 16; ++j) { const unsigned c = xb_ld(&bar[XB_XCNT(j)]); sum += c; cnt += (c > 0u) ? 1u : 0u; mine = (j == x) ? c : mine; }
        if (sum == G) break;
        __builtin_amdgcn_s_sleep(1);
        if ((++sp & 255u) == 0u) { if (xb_ld(&bar[XB_TMO])) break; if (sp > XB_SPIN_CAP) { atomicAdd(&bar[XB_TMO], 1u); break; } }
    }
    nloc = mine > 0u ? mine : 1u; nx = cnt > 0u ? cnt : 1u;
}
__device__ __forceinline__ void xcd_barrier(const XcdBarrier& b) {
    asm volatile("s_waitcnt vmcnt(0)" ::: "memory");
    __syncthreads();
    if (threadIdx.x == 0) {
        unsigned* bar = b.bar;
        __builtin_amdgcn_s_waitcnt(0);
        unsigned nloc = b.st[0], nx = b.st[1];
        if (nloc == 0u) { xcd_barrier_complete(bar, b.x, nloc, nx); b.st[0] = nloc; b.st[1] = nx; }
        const unsigned old = xb_add(&bar[XB_XSUB(b.x)], 1u);
        const unsigned gen = old / nloc;
        if (old + 1u == (gen + 1u) * nloc) {
            __builtin_amdgcn_fence(__ATOMIC_RELEASE, "agent");
            asm volatile("s_waitcnt vmcnt(0)" ::: "memory");
            const unsigned og = xb_add(&bar[XB_TOP], 1u);
            const unsigned tg = og / nx;
            if (og + 1u == (tg + 1u) * nx) xb_add(&bar[XB_TOPGEN], 1u);
            else XB_SPIN(xb_ld(&bar[XB_TOPGEN]) == tg, bar);
            __builtin_amdgcn_fence(__ATOMIC_ACQUIRE, "agent");
            xb_add(&bar[XB_XGEN(b.x)], 1u);
            asm volatile("s_waitcnt vmcnt(0)" ::: "memory");
        } else {
            XB_SPIN(xb_ld(&bar[XB_XGEN(b.x)]) == gen, bar);
            __builtin_amdgcn_fence(__ATOMIC_ACQUIRE, "agent");
            asm volatile("s_waitcnt vmcnt(0)" ::: "memory");
        }
    }
    __syncthreads();
}

struct Frame {
    LAS unsigned char* lds;
    volatile LAS unsigned* MISC;
    unsigned* ctl;
    int tid, lane, wave, G;
    const float *x, *p, *g_mix, *w_in, *w_out_a, *w_out_b, *w_out, *sgu_norm, *sgu_w, *sgu_b, *g_moe, *w_router, *b_router, *w1, *b1, *w2, *b2, *g_ple, *w_ple_gate, *w_ple_proj, *g_final;
    float* out;
    bf16 *WRHI, *WRLO, *SGUW, *WIN, *WAB, *WOUT, *WPG, *WPP, *W1T, *W2T, *PBF, *PROJ, *H1, *ZZ, *HID, *H2, *H3, *ABF, *OAB, *MERGED, *YS;
    float *RSTD1, *RSTD2, *GATE;
    int *TOKLIST, *SLOTREF;
};

template <int NB>
__device__ __forceinline__ void smma(const bf16* ap, const bf16* const (&bp)[NB], int K, f32x16 (&acc)[NB]) {
    for (int k0 = 0; k0 < K; k0 += 16) {
        const bf16x8 a = *(const bf16x8*)(ap + k0);
#pragma unroll
        for (int nb = 0; nb < NB; ++nb) { const bf16x8 b = *(const bf16x8*)(bp[nb] + k0); acc[nb] = __builtin_amdgcn_mfma_f32_32x32x16_bf16(a, b, acc[nb], 0, 0, 0); }
    }
}

struct RowId { __device__ __forceinline__ int operator()(int n) const { return n; } };
struct RowW1 { __device__ __forceinline__ int operator()(int n) const { const int hid = n >> 1; return 256 * (hid >> 7) + (hid & 127) + 128 * (n & 1); } };
template <class RM>
__device__ __forceinline__ void tr_item(const float* W, int N, const float* gk, bf16* WT, int ldt, int koff, RM rm, LAS float* scr, int kb, int nb, int lane) {
    const int k0 = kb * 64, n0 = nb * 64;
#pragma unroll 4
    for (int i = 0; i < 16; ++i) {
        const int kk = 4 * i + (lane >> 4), n4 = (lane & 15) * 4;
        f32x4 v = *(const f32x4*)(W + (size_t)(k0 + kk) * N + n0 + n4);
        if (gk) v = v * gk[k0 + kk];
        LAS float* s = scr + kk * 65 + n4;
        s[0] = v.x; s[1] = v.y; s[2] = v.z; s[3] = v.w;
    }
    LDS_WAIT(); asm volatile("" ::: "memory");
    const int c = lane & 7;
#pragma unroll
    for (int j = 0; j < 8; ++j) {
        const int n = (lane >> 3) + 8 * j;
        const LAS float* s = scr + (8 * c) * 65 + n;
        u32x4 o; o.x = pk2(s[0 * 65], s[1 * 65]); o.y = pk2(s[2 * 65], s[3 * 65]); o.z = pk2(s[4 * 65], s[5 * 65]); o.w = pk2(s[6 * 65], s[7 * 65]);
        *(u32x4*)(WT + (size_t)rm(n0 + n) * ldt + koff + k0 + 8 * c) = o;
    }
    LDS_WAIT(); asm volatile("" ::: "memory");
}
__device__ __forceinline__ void p0_prologue(const Frame& F) {
    LAS float* scr = (LAS float*)(F.lds + F.wave * 16640);
    const int gw = blockIdx.x * NWAVES + F.wave, NGW = F.G * NWAVES;
    constexpr int I_IN = 16 * 72, I_A = 8 * 16, I_B = 8 * 16, I_O = 16 * 16, I_PG = 16 * 16, I_PP = 4 * 16, I_W1 = NE * 16 * 32, I_W2 = NE * 16 * 16;
    constexpr int NITEMS = I_IN + I_A + I_B + I_O + I_PG + I_PP + I_W1 + I_W2;
    for (int it = gw; it < NITEMS; it += NGW) {
        int r = it;
        if (r < I_IN) { tr_item(F.w_in, INC, nullptr, F.WIN, D, 0, RowId(), scr, r / 72, r % 72, F.lane); continue; } r -= I_IN;
        if (r < I_A) { tr_item(F.w_out_a, D, nullptr, F.WAB, D, 0, RowId(), scr, r / 16, r % 16, F.lane); continue; } r -= I_A;
        if (r < I_B) { tr_item(F.w_out_b, D, nullptr, F.WAB, D, 512, RowId(), scr, r / 16, r % 16, F.lane); continue; } r -= I_B;
        if (r < I_O) { tr_item(F.w_out, D, nullptr, F.WOUT, D, 0, RowId(), scr, r / 16, r % 16, F.lane); continue; } r -= I_O;
        if (r < I_PG) { tr_item(F.w_ple_gate, D, F.g_ple, F.WPG, D, 0, RowId(), scr, r / 16, r % 16, F.lane); continue; } r -= I_PG;
        if (r < I_PP) { tr_item(F.w_ple_proj, D, nullptr, F.WPP, PLE, 0, RowId(), scr, r / 16, r % 16, F.lane); continue; } r -= I_PP;
        if (r < I_W1) { const int e = r / 512, q = r % 512; tr_item(F.w1 + (size_t)e * D * 2 * DE, 2 * DE, F.g_moe, F.W1T + (size_t)e * 2 * DE * D, D, 0, RowW1(), scr, q / 32, q % 32, F.lane); continue; } r -= I_W1;
        { const int e = r / 256, q = r % 256; tr_item(F.w2 + (size_t)e * DE * D, D, nullptr, F.W2T + (size_t)e * D * DE, DE, 0, RowId(), scr, q / 16, q % 16, F.lane); }
    }
    for (int m = gw; m < T; m += NGW) {
        const f32x4* xr = (const f32x4*)(F.x + (size_t)m * D) + F.lane;
        f32x4 v[4]; float s = 0.f;
#pragma unroll
        for (int j = 0; j < 4; ++j) { v[j] = xr[64 * j]; s += (v[j].x * v[j].x + v[j].y * v[j].y) + (v[j].z * v[j].z + v[j].w * v[j].w); }
        const float rstd = rsqrtf(wave_sum(s) * (1.f / D) + EPS);
        unsigned long long* o8 = (unsigned long long*)(F.ABF + (size_t)m * D) + F.lane;
#pragma unroll
        for (int j = 0; j < 4; ++j) { const f32x4 g = ((const f32x4*)F.g_mix)[F.lane + 64 * j];
            o8[64 * j] = (unsigned long long)pk2(v[j].x * rstd * g.x, v[j].y * rstd * g.y) | ((unsigned long long)pk2(v[j].z * rstd * g.z, v[j].w * rstd * g.w) << 32); }
    }
    for (int m = gw; m < T; m += NGW) {
        const f32x4 v = ((const f32x4*)(F.p + (size_t)m * PLE))[F.lane];
        ((unsigned long long*)(F.PBF + (size_t)m * PLE))[F.lane] = (unsigned long long)pk2(v.x, v.y) | ((unsigned long long)pk2(v.z, v.w) << 32);
    }
    const int gt = blockIdx.x * NTHREADS + F.tid, NGT = F.G * NTHREADS;
    for (int i = gt; i < NE * D; i += NGT) { const int e = i / D, k = i % D; const float v = F.w_router[k * NE + e] * F.g_moe[k]; const unsigned h = f2bf(v); F.WRHI[i] = (bf16)h; F.WRLO[i] = (bf16)f2bf(v - bf2f(h)); }
    for (int i = gt; i < 8 * 128 * 128; i += NGT) { const int t = (i >> 7) & 127, s = i & 127; F.SGUW[i] = (bf16)(((s >> 6) <= (t >> 6)) ? f2bf(F.sgu_w[i]) : 0u); }
}

__device__ __forceinline__ void p1_inproj(const Frame& F) {
    const int gw = blockIdx.x * NWAVES + F.wave, NGW = F.G * NWAVES, r32 = F.lane & 31, hi = F.lane >> 5;
    for (int tile = gw; tile < (T / 32) * (INC / 128); tile += NGW) {
        const int mb = tile / (INC / 128), cg = tile % (INC / 128), m0 = mb * 32, n0 = cg * 128;
        const bf16* ap = F.ABF + (size_t)(m0 + r32) * D + 8 * hi;
        const bf16* bp[4];
#pragma unroll
        for (int nb = 0; nb < 4; ++nb) bp[nb] = F.WIN + (size_t)(n0 + 32 * nb + r32) * D + 8 * hi;
        f32x16 acc[4];
#pragma unroll
        for (int nb = 0; nb < 4; ++nb) acc[nb] = f32x16{};
        smma<4>(ap, bp, D, acc);
        const int kind = (n0 < ZK) ? 0 : (n0 < ZU) ? 1 : (n0 < ZGA) ? 2 : 3;
#pragma unroll
        for (int nb = 0; nb < 4; ++nb)
#pragma unroll
            for (int r = 0; r < 16; ++r) {
                float v = acc[nb][r];
                if (kind == 0) v *= QSCALE; else if (kind == 2) v = gelu_tanh(v); else if (kind == 3) v = sigmoidf_(v);
                F.ZZ[(size_t)(m0 + crow(r, hi)) * INC + n0 + 32 * nb + r32] = (bf16)f2bf(v);
            }
    }
    for (int tile = gw; tile < (T / 32) * (D / 128); tile += NGW) {
        const int mb = tile / (D / 128), cg = tile % (D / 128), m0 = mb * 32, n0 = cg * 128;
        const bf16* ap = F.PBF + (size_t)(m0 + r32) * PLE + 8 * hi;
        const bf16* bp[4];
#pragma unroll
        for (int nb = 0; nb < 4; ++nb) bp[nb] = F.WPP + (size_t)(n0 + 32 * nb + r32) * PLE + 8 * hi;
        f32x16 acc[4];
#pragma unroll
        for (int nb = 0; nb < 4; ++nb) acc[nb] = f32x16{};
        smma<4>(ap, bp, PLE, acc);
#pragma unroll
        for (int nb = 0; nb < 4; ++nb)
#pragma unroll
            for (int r = 0; r < 16; ++r) F.PROJ[(size_t)(m0 + crow(r, hi)) * D + n0 + 32 * nb + r32] = (bf16)f2bf(acc[nb][r]);
    }
}

template <bool EARLY>
__device__ __forceinline__ void p2_attn_scalar(const Frame& F) {
    LAS u32x4* Kt = (LAS u32x4*)F.lds;
    LAS u32x4* Vt = Kt + 512;
    for (int pr = blockIdx.x; pr < 256; pr += F.G) {
        for (int half = 0; half < 2; ++half) {
            const int bh = pr >> 2, tb = half == 0 ? (pr & 3) : 7 - (pr & 3), b = bh / NH, h = bh % NH;
            const int t = tb * 512 + F.tid;
            const size_t row = (size_t)b * SEQ + t;
            float q[64], o[64];
            { const u32x4* qp = (const u32x4*)(F.ZZ + row * INC + ZQ + h * HD);
#pragma unroll
              for (int c = 0; c < 8; ++c) { float f[8]; unpack8(qp[c], f);
#pragma unroll
                  for (int j = 0; j < 8; ++j) q[8 * c + j] = f[j]; } }
#pragma unroll
            for (int d = 0; d < 64; ++d) o[d] = 0.f;
            float carry = 1.f;
            for (int kt = tb * 8 + 7; kt >= 0; --kt) {
                __syncthreads();
                { const int kr = F.tid >> 3, c = F.tid & 7; const size_t krow = ((size_t)b * SEQ + kt * 64 + kr) * INC + h * HD + 8 * c;
                  Kt[F.tid] = *(const u32x4*)(F.ZZ + krow + ZK); Vt[F.tid] = *(const u32x4*)(F.ZZ + krow + ZV); }
                __syncthreads();
                for (int sl = 63; sl >= 0; --sl) {
                    const int s = kt * 64 + sl;
                    if (s < t) {
                        float z = 0.f;
#pragma unroll
                        for (int c = 0; c < 8; ++c) { float f[8]; unpack8(Kt[sl * 8 + c], f);
#pragma unroll
                            for (int j = 0; j < 8; ++j) z += q[8 * c + j] * f[j]; }
                        z = fminf(z, 100.f);
                        const float e = exp2f(z), r = 1.0f / (1.0f + e);
                        carry *= r;
                        const float w = e * carry;
#pragma unroll
                        for (int c = 0; c < 8; ++c) { float f[8]; unpack8(Vt[sl * 8 + c], f);
#pragma unroll
                            for (int j = 0; j < 8; ++j) o[8 * c + j] += w * f[j]; }
                    }
                }
            }
            u32x4* op = (u32x4*)(F.OAB + row * D + h * HD);
#pragma unroll
            for (int c = 0; c < 8; ++c) { u32x4 w; w.x = pk2(o[8 * c], o[8 * c + 1]); w.y = pk2(o[8 * c + 2], o[8 * c + 3]); w.z = pk2(o[8 * c + 4], o[8 * c + 5]); w.w = pk2(o[8 * c + 6], o[8 * c + 7]); op[c] = w; }
        }
    }
    __syncthreads();
}
__device__ __forceinline__ void p2_sgu_simple(const Frame& F) {
    LAS bf16* vsn = (LAS bf16*)F.lds;
    for (int unit = blockIdx.x; unit < T / 128; unit += F.G) {
        const int row0 = unit * 128;
        for (int i = 0; i < 16; ++i) {
            const int rl = F.wave * 16 + i;
            const u32x4 w = *(const u32x4*)(F.ZZ + (size_t)(row0 + rl) * INC + ZVS + 8 * F.lane);
            float f[8]; unpack8(w, f);
            float s = 0.f;
#pragma unroll
            for (int j = 0; j < 8; ++j) s += f[j];
            const float mean = wave_sum(s) * (1.f / 512.f);
            float s2 = 0.f;
#pragma unroll
            for (int j = 0; j < 8; ++j) { f[j] -= mean; s2 += f[j] * f[j]; }
            const float rstd = rsqrtf(wave_sum(s2) * (1.f / 512.f) + EPS);
            const f32x4 g0 = *(const f32x4*)(F.sgu_norm + 8 * F.lane), g1 = *(const f32x4*)(F.sgu_norm + 8 * F.lane + 4);
            u32x4 o; o.x = pk2(f[0] * rstd * g0.x, f[1] * rstd * g0.y); o.y = pk2(f[2] * rstd * g0.z, f[3] * rstd * g0.w);
            o.z = pk2(f[4] * rstd * g1.x, f[5] * rstd * g1.y); o.w = pk2(f[6] * rstd * g1.z, f[7] * rstd * g1.w);
            *(LAS u32x4*)(vsn + rl * 512 + 8 * F.lane) = o;
        }
        __syncthreads();
        const int ch = F.tid, g = ch >> 6;
        for (int tl = 0; tl < 128; ++tl) {
            const bf16* wrow = F.SGUW + (g * 128 + tl) * 128;
            float a = 0.f;
            for (int s = 0; s < 128; ++s) a += bf2f(wrow[s]) * bf2f(vsn[s * 512 + ch]);
            const float sv = a + F.sgu_b[g * 128 + tl];
            const float u = bf2f(F.ZZ[(size_t)(row0 + tl) * INC + ZU + ch]);
            F.OAB[(size_t)(row0 + tl) * D + 512 + ch] = (bf16)f2bf(u * sv);
        }
        __syncthreads();
    }
}

__device__ __forceinline__ void p3_merge(const Frame& F) {
    const int gw = blockIdx.x * NWAVES + F.wave, NGW = F.G * NWAVES, r32 = F.lane & 31, hi = F.lane >> 5;
    for (int tile = gw; tile < (T / 32) * (D / 128); tile += NGW) {
        const int mb = tile / (D / 128), cg = tile % (D / 128), m0 = mb * 32, n0 = cg * 128;
        const bf16* ap = F.OAB + (size_t)(m0 + r32) * D + 8 * hi;
        const bf16* bp[4];
#pragma unroll
        for (int nb = 0; nb < 4; ++nb) bp[nb] = F.WAB + (size_t)(n0 + 32 * nb + r32) * D + 8 * hi;
        f32x16 acca[4], accb[4];
#pragma unroll
        for (int nb = 0; nb < 4; ++nb) { acca[nb] = f32x16{}; accb[nb] = f32x16{}; }
        smma<4>(ap, bp, 512, acca);
        const bf16* ap2 = ap + 512; const bf16* bp2[4];
#pragma unroll
        for (int nb = 0; nb < 4; ++nb) bp2[nb] = bp[nb] + 512;
        smma<4>(ap2, bp2, 512, accb);
#pragma unroll
        for (int nb = 0; nb < 4; ++nb)
#pragma unroll
            for (int r = 0; r < 16; ++r) {
                const size_t row = m0 + crow(r, hi); const int col = n0 + 32 * nb + r32;
                const float sga = bf2f(F.ZZ[row * INC + ZGA + col]), sgb = bf2f(F.ZZ[row * INC + ZGB + col]);
                F.MERGED[row * D + col] = (bf16)f2bf(sga * acca[nb][r] + sgb * accb[nb][r]);
            }
    }
}
__device__ __forceinline__ void p4_out(const Frame& F) {
    const int gw = blockIdx.x * NWAVES + F.wave, NGW = F.G * NWAVES, r32 = F.lane & 31, hi = F.lane >> 5;
    for (int tile = gw; tile < (T / 32) * (D / 128); tile += NGW) {
        const int mb = tile / (D / 128), cg = tile % (D / 128), m0 = mb * 32, n0 = cg * 128;
        const bf16* ap = F.MERGED + (size_t)(m0 + r32) * D + 8 * hi;
        const bf16* bp[4];
#pragma unroll
        for (int nb = 0; nb < 4; ++nb) bp[nb] = F.WOUT + (size_t)(n0 + 32 * nb + r32) * D + 8 * hi;
        f32x16 acc[4];
#pragma unroll
        for (int nb = 0; nb < 4; ++nb) acc[nb] = f32x16{};
        smma<4>(ap, bp, D, acc);
#pragma unroll
        for (int nb = 0; nb < 4; ++nb)
#pragma unroll
            for (int r = 0; r < 16; ++r) {
                const size_t row = m0 + crow(r, hi); const int col = n0 + 32 * nb + r32;
                F.H1[row * D + col] = (bf16)f2bf(F.x[row * D + col] + acc[nb][r]);
            }
    }
}
__device__ __forceinline__ void p5_router(const Frame& F) {
    LAS unsigned* hist = (LAS unsigned*)F.lds;
    LAS unsigned* base = hist + 32;
    LAS unsigned* lsel = hist + 64;
    LAS float* lgate = (LAS float*)(hist + 64 + 512);
    const int e = F.lane & 31, half = F.lane >> 5;
    for (int chunk = blockIdx.x; chunk < T / 128; chunk += F.G) {
        if (F.tid < 32) hist[F.tid] = 0u;
        __syncthreads();
        for (int i = 0; i < 16; ++i) {
            const int tl = F.wave * 16 + i, t = chunk * 128 + tl;
            const bf16* hp = F.H1 + (size_t)t * D + half * 512;
            const bf16* whi = F.WRHI + e * D + half * 512;
            const bf16* wlo = F.WRLO + e * D + half * 512;
            float dot = 0.f, ss = 0.f;
            for (int k = 0; k < 512; k += 8) {
                float hf[8], a[8], c[8];
                unpack8(*(const u32x4*)(hp + k), hf); unpack8(*(const u32x4*)(whi + k), a); unpack8(*(const u32x4*)(wlo + k), c);
#pragma unroll
                for (int j = 0; j < 8; ++j) { dot += hf[j] * (a[j] + c[j]); ss += hf[j] * hf[j]; }
            }
            dot += __shfl_xor(dot, 32); ss += __shfl_xor(ss, 32);
            const float rstd = rsqrtf(ss * (1.f / D) + EPS);
            float logit = rstd * dot + F.b_router[e];
            float val[4]; int sel[4];
#pragma unroll
            for (int r = 0; r < 4; ++r) {
                const float m = wave_max(logit);
                const unsigned long long bal = __ballot(logit == m);
                const int le = (int)(__ffsll((long long)bal) - 1) & 31;
                val[r] = m; sel[r] = le;
                if (e == le) logit = -INFINITY;
            }
            float ex[4], sum = 0.f;
#pragma unroll
            for (int r = 0; r < 4; ++r) { ex[r] = __expf(val[r] - val[0]); sum += ex[r]; }
            if (F.lane == 0) {
                F.RSTD1[t] = rstd;
#pragma unroll
                for (int r = 0; r < 4; ++r) { const unsigned loc = atomicAdd((unsigned*)&hist[sel[r]], 1u); lsel[tl * 4 + r] = (unsigned)sel[r] | (loc << 8); lgate[tl * 4 + r] = ex[r] / sum; }
            }
        }
        __syncthreads();
        if (F.tid < 32) { const unsigned n = hist[F.tid]; base[F.tid] = n ? __hip_atomic_fetch_add(F.ctl + CW_CNT + 64 * F.tid, n, __ATOMIC_RELAXED, __HIP_MEMORY_SCOPE_AGENT) : 0u; }
        __syncthreads();
        { const int tl = F.tid >> 2, r = F.tid & 3, t = chunk * 128 + tl; const unsigned s = lsel[tl * 4 + r]; const int ee = s & 255; const unsigned rank = base[ee] + (s >> 8);
          F.TOKLIST[ee * LCAP + rank] = t; F.SLOTREF[t * 4 + r] = (ee << 16) | rank; F.GATE[t * 4 + r] = lgate[tl * 4 + r]; }
        __syncthreads();
    }
}
struct MoeTab { LAS int* cnt; LAS int* toff; LAS int* p32; };
__device__ __forceinline__ MoeTab moe_tables(const Frame& F) {
    MoeTab M; M.cnt = (LAS int*)(F.lds + MISC_OFF + 512); M.toff = M.cnt + 32; M.p32 = M.toff + 33;
    __syncthreads();
    if (F.tid == 0) { int a = 0, c = 0;
        for (int e = 0; e < NE; ++e) { const int n = (int)__hip_atomic_load(F.ctl + CW_CNT + 64 * e, __ATOMIC_RELAXED, __HIP_MEMORY_SCOPE_AGENT); M.cnt[e] = n; M.toff[e] = a; M.p32[e] = c; a += (n + 255) >> 8; c += (n + 31) >> 5; }
        M.toff[NE] = a; M.p32[NE] = c; }
    __syncthreads();
    return M;
}
__device__ __forceinline__ void p6_moe1(const Frame& F) {
    const MoeTab M = moe_tables(F);
    const int gw = blockIdx.x * NWAVES + F.wave, NGW = F.G * NWAVES, r32 = F.lane & 31, hi = F.lane >> 5;
    const int ntiles = M.p32[NE] * 32;
    for (int tile = gw; tile < ntiles; tile += NGW) {
        const int blk = tile >> 5, hb = tile & 31;
        int e = 0; while (M.p32[e + 1] <= blk) ++e;
        const int sb = blk - M.p32[e], cnt = M.cnt[e];
        const int rank = sb * 32 + r32;
        const int tok = F.TOKLIST[e * LCAP + (rank < cnt ? rank : cnt - 1)];
        const bf16* ap = F.H1 + (size_t)tok * D + 8 * hi;
        const int hidb = hb * 32 + r32;
        const bf16* bp[2];
        bp[0] = F.W1T + ((size_t)e * 2048 + 256 * (hidb >> 7) + (hidb & 127)) * D + 8 * hi; bp[1] = bp[0] + 128 * D;
        f32x16 acc[2]; acc[0] = f32x16{}; acc[1] = f32x16{};
        smma<2>(ap, bp, D, acc);
        const float rs_l = F.RSTD1[tok];
        const float bg = F.b1[e * 2048 + 2 * hidb], bl = F.b1[e * 2048 + 2 * hidb + 1];
#pragma unroll
        for (int r = 0; r < 16; ++r) {
            const int rr = crow(r, hi), rk = sb * 32 + rr;
            const float rs = __shfl(rs_l, rr);
            float gl = rs * acc[0][r] + bg, li = rs * acc[1][r] + bl;
            gl = fminf(gl, 7.f); li = fminf(fmaxf(li, -7.f), 7.f);
            const float act = gl * sigmoidf_(1.702f * gl) * (li + 1.f);
            if (rk < cnt) F.HID[((size_t)256 * M.toff[e] + rk) * DE + hidb] = (bf16)f2bf(act);
        }
    }
}
__device__ __forceinline__ void p7_moe2(const Frame& F) {
    const MoeTab M = moe_tables(F);
    const int gw = blockIdx.x * NWAVES + F.wave, NGW = F.G * NWAVES, r32 = F.lane & 31, hi = F.lane >> 5;
    const int ntiles = M.p32[NE] * 8;
    for (int tile = gw; tile < ntiles; tile += NGW) {
        const int blk = tile >> 3, cg = tile & 7;
        int e = 0; while (M.p32[e + 1] <= blk) ++e;
        const int sb = blk - M.p32[e], cnt = M.cnt[e];
        const size_t rowb = (size_t)256 * M.toff[e] + sb * 32;
        const bf16* ap = F.HID + (rowb + r32) * DE + 8 * hi;
        const bf16* bp[4];
#pragma unroll
        for (int nb = 0; nb < 4; ++nb) bp[nb] = F.W2T + ((size_t)e * D + cg * 128 + 32 * nb + r32) * DE + 8 * hi;
        f32x16 acc[4];
#pragma unroll
        for (int nb = 0; nb < 4; ++nb) acc[nb] = f32x16{};
        smma<4>(ap, bp, DE, acc);
#pragma unroll
        for (int nb = 0; nb < 4; ++nb) { const int col = cg * 128 + 32 * nb + r32; const float bb = F.b2[e * D + col];
#pragma unroll
            for (int r = 0; r < 16; ++r) { const int rr = crow(r, hi); if (sb * 32 + rr < cnt) F.YS[(rowb + rr) * D + col] = (bf16)f2bf(acc[nb][r] + bb); } }
    }
}
__device__ __forceinline__ void p8_combine(const Frame& F) {
    const MoeTab M = moe_tables(F);
    const int gw = blockIdx.x * NWAVES + F.wave, NGW = F.G * NWAVES;
    for (int t = gw; t < T; t += NGW) {
        size_t yrow[4]; float gk[4];
#pragma unroll
        for (int k = 0; k < 4; ++k) { const int sr = F.SLOTREF[t * 4 + k]; yrow[k] = (size_t)256 * M.toff[sr >> 16] + (sr & 0xffff); gk[k] = F.GATE[t * 4 + k]; }
        float ss = 0.f;
#pragma unroll
        for (int j = 0; j < 2; ++j) {
            const int col = 8 * F.lane + 512 * j;
            float a[8]; unpack8(*(const u32x4*)(F.H1 + (size_t)t * D + col), a);
#pragma unroll
            for (int k = 0; k < 4; ++k) { float y[8]; unpack8(*(const u32x4*)(F.YS + yrow[k] * D + col), y);
#pragma unroll
                for (int q = 0; q < 8; ++q) a[q] += gk[k] * y[q]; }
            u32x4 o; o.x = pk2(a[0], a[1]); o.y = pk2(a[2], a[3]); o.z = pk2(a[4], a[5]); o.w = pk2(a[6], a[7]);
            *(u32x4*)(F.H2 + (size_t)t * D + col) = o;
            float b[8]; unpack8(o, b);
#pragma unroll
            for (int q = 0; q < 8; ++q) ss += b[q] * b[q];
        }
        ss = wave_sum(ss);
        if (F.lane == 0) F.RSTD2[t] = rsqrtf(ss * (1.f / D) + EPS);
    }
}
__device__ __forceinline__ void p9_ple(const Frame& F) {
    const int gw = blockIdx.x * NWAVES + F.wave, NGW = F.G * NWAVES, r32 = F.lane & 31, hi = F.lane >> 5;
    for (int tile = gw; tile < (T / 32) * (D / 128); tile += NGW) {
        const int mb = tile / (D / 128), cg = tile % (D / 128), m0 = mb * 32, n0 = cg * 128;
        const bf16* ap = F.H2 + (size_t)(m0 + r32) * D + 8 * hi;
        const bf16* bp[4];
#pragma unroll
        for (int nb = 0; nb < 4; ++nb) bp[nb] = F.WPG + (size_t)(n0 + 32 * nb + r32) * D + 8 * hi;
        f32x16 acc[4];
#pragma unroll
        for (int nb = 0; nb < 4; ++nb) acc[nb] = f32x16{};
        smma<4>(ap, bp, D, acc);
#pragma unroll
        for (int r = 0; r < 16; ++r) {
            const size_t row = m0 + crow(r, hi); const float rs = F.RSTD2[row];
#pragma unroll
            for (int nb = 0; nb < 4; ++nb) { const int col = n0 + 32 * nb + r32;
                const float pg = sigmoidf_(rs * acc[nb][r]);
                F.H3[row * D + col] = (bf16)f2bf(bf2f(F.H2[row * D + col]) + pg * bf2f(F.PROJ[row * D + col])); }
        }
    }
}
__device__ __forceinline__ void p10_final(const Frame& F) {
    const int gw = blockIdx.x * NWAVES + F.wave, NGW = F.G * NWAVES;
    for (int t = gw; t < T; t += NGW) {
        float a[2][8]; float ss = 0.f;
#pragma unroll
        for (int j = 0; j < 2; ++j) { unpack8(*(const u32x4*)(F.H3 + (size_t)t * D + 8 * F.lane + 512 * j), a[j]);
#pragma unroll
            for (int q = 0; q < 8; ++q) ss += a[j][q] * a[j][q]; }
        const float rstd = rsqrtf(wave_sum(ss) * (1.f / D) + EPS);
#pragma unroll
        for (int j = 0; j < 2; ++j) { const int col = 8 * F.lane + 512 * j;
            const f32x4 g0 = *(const f32x4*)(F.g_final + col), g1 = *(const f32x4*)(F.g_final + col + 4);
            f32x4 o0, o1; o0.x = a[j][0] * rstd * g0.x; o0.y = a[j][1] * rstd * g0.y; o0.z = a[j][2] * rstd * g0.z; o0.w = a[j][3] * rstd * g0.w;
            o1.x = a[j][4] * rstd * g1.x; o1.y = a[j][5] * rstd * g1.y; o1.z = a[j][6] * rstd * g1.z; o1.w = a[j][7] * rstd * g1.w;
            *(f32x4*)(F.out + (size_t)t * D + col) = o0; *(f32x4*)(F.out + (size_t)t * D + col + 4) = o1; }
    }
}

struct Args { const float* in[21]; float* out; unsigned char* ws; int ph_lo, ph_hi; };
__global__ void __launch_bounds__(NTHREADS, 2) fwd(Args args) {
    extern __shared__ __attribute__((aligned(16))) unsigned char lds[];
    Frame F;
    F.lds = (LAS unsigned char*)lds; F.MISC = (volatile LAS unsigned*)(F.lds + MISC_OFF);
    F.tid = threadIdx.x; F.lane = F.tid & 63; F.wave = __builtin_amdgcn_readfirstlane(F.tid >> 6); F.G = gridDim.x;
    unsigned char* ws = args.ws;
    F.ctl = (unsigned*)(ws + WS_CTL);
    F.x = args.in[0]; F.p = args.in[1]; F.g_mix = args.in[2]; F.w_in = args.in[3]; F.w_out_a = args.in[4]; F.w_out_b = args.in[5]; F.w_out = args.in[6];
    F.sgu_norm = args.in[7]; F.sgu_w = args.in[8]; F.sgu_b = args.in[9]; F.g_moe = args.in[10]; F.w_router = args.in[11]; F.b_router = args.in[12];
    F.w1 = args.in[13]; F.b1 = args.in[14]; F.w2 = args.in[15]; F.b2 = args.in[16]; F.g_ple = args.in[17]; F.w_ple_gate = args.in[18]; F.w_ple_proj = args.in[19]; F.g_final = args.in[20];
    F.out = args.out;
    F.WRHI = (bf16*)(ws + WS_WRHI); F.WRLO = (bf16*)(ws + WS_WRLO); F.SGUW = (bf16*)(ws + WS_SGUW); F.WIN = (bf16*)(ws + WS_WIN); F.WAB = (bf16*)(ws + WS_WAB);
    F.WOUT = (bf16*)(ws + WS_WOUT); F.WPG = (bf16*)(ws + WS_WPG); F.WPP = (bf16*)(ws + WS_WPP); F.W1T = (bf16*)(ws + WS_W1); F.W2T = (bf16*)(ws + WS_W2);
    F.PBF = (bf16*)(ws + WS_PBF); F.PROJ = (bf16*)(ws + WS_PROJ); F.H1 = (bf16*)(ws + WS_H1); F.ZZ = (bf16*)(ws + WS_ZZ); F.HID = (bf16*)(ws + WS_HID);
    F.H2 = (bf16*)(ws + WS_H2); F.H3 = (bf16*)(ws + WS_H3); F.ABF = (bf16*)(ws + WS_ABF); F.OAB = (bf16*)(ws + WS_OAB); F.MERGED = (bf16*)(ws + WS_MERGED); F.YS = (bf16*)(ws + WS_YS);
    F.RSTD1 = (float*)(ws + WS_RSTD1); F.RSTD2 = (float*)(ws + WS_RSTD2); F.GATE = (float*)(ws + WS_GATE);
    F.TOKLIST = (int*)(ws + WS_TOKLIST); F.SLOTREF = (int*)(ws + WS_SLOTREF);
    for (int u = F.tid; u < (LDS_BYTES - MISC_OFF) / 4; u += NTHREADS) ((LAS unsigned*)(F.lds + MISC_OFF))[u] = 0u;
    __syncthreads();
    XcdBarrier bar = xcd_barrier_post(F.ctl + CW_BAR, F.MISC + 8);
    const int lo = args.ph_lo, hi = args.ph_hi;
#define IN(k) (lo <= (k) && (k) < hi)
#define SEAM(k) do { if (IN(k) && IN((k) + 1)) xcd_barrier(bar); } while (0)
    if (IN(0)) { p0_prologue(F); } SEAM(0);
    if (IN(1)) { p1_inproj(F); } SEAM(1);
    if (IN(2)) { p2_attn_scalar<false>(F); p2_sgu_simple(F); } SEAM(2);
    if (IN(3)) { p3_merge(F); } SEAM(3);
    if (IN(4)) { p4_out(F); } SEAM(4);
    if (IN(5)) { p5_router(F); } SEAM(5);
    if (IN(6)) { p6_moe1(F); } SEAM(6);
    if (IN(7)) { p7_moe2(F); } SEAM(7);
    if (IN(8)) { p8_combine(F); } SEAM(8);
    if (IN(9)) { p9_ple(F); } SEAM(9);
    if (IN(10)) { p10_final(F); }
#undef IN
#undef SEAM
}

extern "C" void kernel_launch(void* const* d_in, const int* in_sizes, int n_in, void* d_out, int out_size, void* d_ws, size_t ws_size, hipStream_t stream) {
    static int grid = 0;
    if (grid == 0) {
        if (n_in != 21 || out_size != T * D || ws_size < WS_END) { fprintf(stderr, "kernel_launch: unexpected shapes (n_in %d out %d ws %zu)\n", n_in, out_size, ws_size); grid = -1; return; }
        int dev = 0, cus = 0;
        if (hipGetDevice(&dev) != hipSuccess || hipDeviceGetAttribute(&cus, hipDeviceAttributeMultiprocessorCount, dev) != hipSuccess) { grid = -1; return; }
        if (hipFuncSetAttribute((const void*)fwd, hipFuncAttributeMaxDynamicSharedMemorySize, LDS_BYTES) != hipSuccess) { fprintf(stderr, "kernel_launch: hipFuncSetAttribute failed\n"); grid = -1; return; }
        int per_cu = 0;
        if (hipOccupancyMaxActiveBlocksPerMultiprocessor(&per_cu, (const void*)fwd, NTHREADS, LDS_BYTES) != hipSuccess || per_cu < 1) fprintf(stderr, "kernel_launch: occupancy query says %d\n", per_cu);
        (void)hipGetLastError();
        grid = cus;
    }
    if (grid < 0) return;
    (void)hipMemsetAsync((char*)d_ws + WS_CTL, 0, CTL_ZERO_BYTES, stream);
    Args a{};
    for (int i = 0; i < 21; ++i) a.in[i] = (const float*)d_in[i];
    a.out = (float*)d_out; a.ws = (unsigned char*)d_ws; a.ph_lo = 0; a.ph_hi = 11;
    hipLaunchKernelGGL(fwd, dim3(grid), dim3(NTHREADS), LDS_BYTES, stream, a);
}
```

```cpp
#include <hip/hip_runtime.h>
#include <cstdio>
#include <cstdint>

#define GAS __attribute__((address_space(1)))
#define LAS __attribute__((address_space(3)))
typedef unsigned short bf16;
typedef short bf16x8 __attribute__((ext_vector_type(8)));
typedef float f32x4 __attribute__((ext_vector_type(4)));
typedef float f32x16 __attribute__((ext_vector_type(16)));
typedef unsigned u32x4 __attribute__((ext_vector_type(4)));
typedef unsigned u32x2 __attribute__((ext_vector_type(2)));

#ifndef OPT_P1
#define OPT_P1 1
#endif
#ifndef OPT_P3
#define OPT_P3 1
#endif
#ifndef OPT_P4
#define OPT_P4 1
#endif
#ifndef OPT_P6
#define OPT_P6 1
#endif
#ifndef OPT_P7
#define OPT_P7 1
#endif
#ifndef OPT_ATT
#define OPT_ATT 1
#endif
#ifndef OPT_SGU
#define OPT_SGU 1
#endif
#ifndef ATT_EARLY
#define ATT_EARLY true
#endif
#ifndef OPT_P5
#define OPT_P5 1
#endif
#ifndef OPT_P9
#define OPT_P9 1
#endif
constexpr int BATCH = 8, SEQ = 4096, T = BATCH * SEQ, D = 1024, PLE = 256, NH = 8, HD = 64, NE = 32, DE = 1024, INC = 4608;
constexpr int ZQ = 0, ZK = 512, ZV = 1024, ZU = 1536, ZVS = 2048, ZGA = 2560, ZGB = 3584;
constexpr float EPS = 1e-6f;
constexpr float LOG2E = 1.4426950408889634f;
constexpr float QSCALE = 0.125f * LOG2E;
constexpr int LCAP = 32768;
constexpr int HROWS = 139264;

constexpr size_t MiB = 1u << 20;
constexpr size_t WS_CTL = 0, CTL_ZERO_BYTES = 1 * MiB;
constexpr size_t WS_WRHI = 1 * MiB, WS_WRLO = WS_WRHI + 65536, WS_SGUW = WS_WRLO + 65536;
constexpr size_t WS_RSTD1 = WS_SGUW + 262144, WS_RSTD2 = WS_RSTD1 + 131072;
constexpr size_t WS_WIN = 2 * MiB, WS_WAB = 11 * MiB, WS_WOUT = 13 * MiB, WS_WPG = 15 * MiB, WS_WPP = 17 * MiB;
constexpr size_t WS_TOKLIST = 18 * MiB, WS_SLOTREF = 22 * MiB, WS_GATE = WS_SLOTREF + 524288;
constexpr size_t WS_W1 = 28 * MiB, WS_W2 = 156 * MiB, WS_PBF = 220 * MiB, WS_PROJ = 236 * MiB, WS_H1 = 300 * MiB;
constexpr size_t WS_R1 = 364 * MiB;
constexpr size_t WS_ZZ = WS_R1, WS_HID = WS_R1, WS_H2 = WS_R1, WS_H3 = WS_R1 + 64 * MiB;
constexpr size_t WS_R2 = 652 * MiB;
constexpr size_t WS_ABF = WS_R2, WS_OAB = WS_R2 + 64 * MiB, WS_MERGED = WS_R2 + 128 * MiB, WS_YS = WS_R2;
constexpr size_t WS_END = 924 * MiB;
constexpr int CW_BAR = 4096, CW_CNT = 8192;

constexpr int STAGE_OFF = 0, TAB_OFF = 131072, MISC_OFF = 151552;
constexpr int LDS_BYTES = 152576;
constexpr int NWAVES = 8, NTHREADS = 512;

#define LDS_WAIT() asm volatile("s_waitcnt lgkmcnt(0)" ::: "memory")
__device__ __forceinline__ float bf2f(unsigned v) { return __uint_as_float(v << 16); }
__device__ __forceinline__ unsigned f2bf(float f) { unsigned u = __float_as_uint(f); return (u + 0x7fffu + ((u >> 16) & 1u)) >> 16; }
__device__ __forceinline__ unsigned pk2(float lo, float hi) { return f2bf(lo) | (f2bf(hi) << 16); }
__device__ __forceinline__ float wave_sum(float v) {
#pragma unroll
    for (int o = 1; o < 64; o <<= 1) v += __shfl_xor(v, o);
    return v;
}
__device__ __forceinline__ float wave_max(float v) {
#pragma unroll
    for (int o = 1; o < 64; o <<= 1) v = fmaxf(v, __shfl_xor(v, o));
    return v;
}
__device__ __forceinline__ float sigmoidf_(float x) { return 1.0f / (1.0f + __expf(-x)); }
__device__ __forceinline__ float gelu_tanh(float x) {
    const float u = 1.5957691216057308f * (x + 0.044715f * x * x * x);
    return x * sigmoidf_(u);
}
__device__ __forceinline__ int crow(int r, int hi) { return (r & 3) + 8 * (r >> 2) + 4 * hi; }
__device__ __forceinline__ void unpack8(const u32x4 w, float (&f)[8]) {
    f[0] = bf2f(w.x & 0xffffu); f[1] = bf2f(w.x >> 16); f[2] = bf2f(w.y & 0xffffu); f[3] = bf2f(w.y >> 16);
    f[4] = bf2f(w.z & 0xffffu); f[5] = bf2f(w.z >> 16); f[6] = bf2f(w.w & 0xffffu); f[7] = bf2f(w.w >> 16);
}

#define XB_TMO      128
#define XB_XCNT(j)  (256  + 64 * (j))
#define XB_XSUB(j)  (1280 + 64 * (j))
#define XB_XGEN(j)  (2304 + 64 * (j))
#define XB_TOP      3328
#define XB_TOPGEN   3392
#define XCD_BAR_WORDS 3456
#define XB_SPIN_CAP (1u << 23)
__device__ __forceinline__ unsigned xb_ld(unsigned* p)              { return __hip_atomic_load(p, __ATOMIC_RELAXED, __HIP_MEMORY_SCOPE_AGENT); }
__device__ __forceinline__ unsigned xb_add(unsigned* p, unsigned v) { return __hip_atomic_fetch_add(p, v, __ATOMIC_RELAXED, __HIP_MEMORY_SCOPE_AGENT); }
__device__ __forceinline__ unsigned xb_xcc_id() { return (unsigned)__builtin_amdgcn_s_getreg((3 << 11) | 20) & 0xFu; }
#define XB_SPIN(cond, bar) do { unsigned _sp = 0; while (cond) { __builtin_amdgcn_s_sleep(1); \
    if ((++_sp & 255u) == 0u) { if (xb_ld(&(bar)[XB_TMO])) break; if (_sp > XB_SPIN_CAP) { atomicAdd(&(bar)[XB_TMO], 1u); break; } } } } while (0)
struct XcdBarrier { unsigned* bar; unsigned x; volatile LAS unsigned* st; };
__device__ __forceinline__ XcdBarrier xcd_barrier_post(unsigned* bar, volatile LAS unsigned* st) {
    XcdBarrier b; b.bar = bar; b.x = xb_xcc_id(); b.st = st;
    if (threadIdx.x == 0) (void)xb_add(&bar[XB_XCNT(b.x)], 1u);
    return b;
}
__device__ __forceinline__ void xcd_barrier_complete(unsigned* bar, unsigned x, unsigned& nloc, unsigned& nx) {
    const unsigned G = gridDim.x * gridDim.y * gridDim.z;
    unsigned sum, cnt, mine, sp = 0u;
    for (;;) {
        sum = 0u; cnt = 0u; mine = 0u;
#pragma unroll
        for (unsigned j = 0; j < 16; ++j) { const unsigned c = xb_ld(&bar[XB_XCNT(j)]); sum += c; cnt += (c > 0u) ? 1u : 0u; mine = (j == x) ? c : mine; }
        if (sum == G) break;
        __builtin_amdgcn_s_sleep(1);
        if ((++sp & 255u) == 0u) { if (xb_ld(&bar[XB_TMO])) break; if (sp > XB_SPIN_CAP) { atomicAdd(&bar[XB_TMO], 1u); break; } }
    }
    nloc = mine > 0u ? mine : 1u; nx = cnt > 0u ? cnt : 1u;
}
__device__ __forceinline__ void xcd_barrier(const XcdBarrier& b) {
    asm volatile("s_waitcnt vmcnt(0)" ::: "memory");
    __syncthreads();
    if (threadIdx.x == 0) {
        unsigned* bar = b.bar;
        __builtin_amdgcn_s_waitcnt(0);
        unsigned nloc = b.st[0], nx = b.st[1];
        if (nloc == 0u) { xcd_barrier_complete(bar, b.x, nloc, nx); b.st[0] = nloc; b.st[1] = nx; }
        const unsigned old = xb_add(&bar[XB_XSUB(b.x)], 1u);
        const unsigned gen = old / nloc;
        if (old + 1u == (gen + 1u) * nloc) {
            __builtin_amdgcn_fence(__ATOMIC_RELEASE, "agent");
            asm volatile("s_waitcnt vmcnt(0)" ::: "memory");
            const unsigned og = xb_add(&bar[XB_TOP], 1u);
            const unsigned tg = og / nx;
            if (og + 1u == (tg + 1u) * nx) xb_add(&bar[XB_TOPGEN], 1u);
            else XB_SPIN(xb_ld(&bar[XB_TOPGEN]) == tg, bar);
            __builtin_amdgcn_fence(__ATOMIC_ACQUIRE, "agent");
            xb_add(&bar[XB_XGEN(b.x)], 1u);
            asm volatile("s_waitcnt vmcnt(0)" ::: "memory");
        } else {
            XB_SPIN(xb_ld(&bar[XB_XGEN(b.x)]) == gen, bar);
            __builtin_amdgcn_fence(__ATOMIC_ACQUIRE, "agent");
            asm volatile("s_waitcnt vmcnt(0)" ::: "memory");
        }
    }
    __syncthreads();
}

struct Frame {
    LAS unsigned char* lds;
    volatile LAS unsigned* MISC;
    unsigned* ctl;
    int tid, lane, wave, G;
    const float *x, *p, *g_mix, *w_in, *w_out_a, *w_out_b, *w_out, *sgu_norm, *sgu_w, *sgu_b, *g_moe, *w_router, *b_router, *w1, *b1, *w2, *b2, *g_ple, *w_ple_gate, *w_ple_proj, *g_final;
    float* out;
    bf16 *WRHI, *WRLO, *SGUW, *WIN, *WAB, *WOUT, *WPG, *WPP, *W1T, *W2T, *PBF, *PROJ, *H1, *ZZ, *HID, *H2, *H3, *ABF, *OAB, *MERGED, *YS;
    float *RSTD1, *RSTD2, *GATE;
    int *TOKLIST, *SLOTREF;
};

template <int NB>
__device__ __forceinline__ void smma(const bf16* ap, const bf16* const (&bp)[NB], int K, f32x16 (&acc)[NB]) {
    for (int k0 = 0; k0 < K; k0 += 16) {
        const bf16x8 a = *(const bf16x8*)(ap + k0);
#pragma unroll
        for (int nb = 0; nb < NB; ++nb) { const bf16x8 b = *(const bf16x8*)(bp[nb] + k0); acc[nb] = __builtin_amdgcn_mfma_f32_32x32x16_bf16(a, b, acc[nb], 0, 0, 0); }
    }
}

struct RowId { __device__ __forceinline__ int operator()(int n) const { return n; } };
struct RowW1 { __device__ __forceinline__ int operator()(int n) const { const int hid = n >> 1; return 256 * (hid >> 7) + (hid & 127) + 128 * (n & 1); } };
template <class RM>
__device__ __forceinline__ void tr_item(const float* W, int N, const float* gk, bf16* WT, int ldt, int koff, RM rm, LAS float* scr, int kb, int nb, int lane, float sc = 1.0f) {
    const int k0 = kb * 64, n0 = nb * 64;
#pragma unroll 4
    for (int i = 0; i < 16; ++i) {
        const int kk = 4 * i + (lane >> 4), n4 = (lane & 15) * 4;
        f32x4 v = *(const f32x4*)(W + (size_t)(k0 + kk) * N + n0 + n4);
        if (gk) v = v * gk[k0 + kk];
        v = v * sc;
        LAS float* s = scr + kk * 65 + n4;
        s[0] = v.x; s[1] = v.y; s[2] = v.z; s[3] = v.w;
    }
    LDS_WAIT(); asm volatile("" ::: "memory");
    const int c = lane & 7;
#pragma unroll
    for (int j = 0; j < 8; ++j) {
        const int n = (lane >> 3) + 8 * j;
        const LAS float* s = scr + (8 * c) * 65 + n;
        u32x4 o; o.x = pk2(s[0 * 65], s[1 * 65]); o.y = pk2(s[2 * 65], s[3 * 65]); o.z = pk2(s[4 * 65], s[5 * 65]); o.w = pk2(s[6 * 65], s[7 * 65]);
        *(u32x4*)(WT + (size_t)rm(n0 + n) * ldt + koff + k0 + 8 * c) = o;
    }
    LDS_WAIT(); asm volatile("" ::: "memory");
}
__device__ __forceinline__ void p0_prologue(const Frame& F) {
    LAS float* scr = (LAS float*)(F.lds + F.wave * 16640);
    const int gw = blockIdx.x * NWAVES + F.wave, NGW = F.G * NWAVES;
    constexpr int I_IN = 16 * 72, I_A = 8 * 16, I_B = 8 * 16, I_O = 16 * 16, I_PG = 16 * 16, I_PP = 4 * 16, I_W1 = NE * 16 * 32, I_W2 = NE * 16 * 16;
    constexpr int NITEMS = I_IN + I_A + I_B + I_O + I_PG + I_PP + I_W1 + I_W2;
    for (int it = gw; it < NITEMS; it += NGW) {
        int r = it;
        if (r < I_IN) { tr_item(F.w_in, INC, nullptr, F.WIN, D, 0, RowId(), scr, r / 72, r % 72, F.lane, (r % 72) < 8 ? QSCALE : 1.0f); continue; } r -= I_IN;
        if (r < I_A) { tr_item(F.w_out_a, D, nullptr, F.WAB, D, 0, RowId(), scr, r / 16, r % 16, F.lane); continue; } r -= I_A;
        if (r < I_B) { tr_item(F.w_out_b, D, nullptr, F.WAB, D, 512, RowId(), scr, r / 16, r % 16, F.lane); continue; } r -= I_B;
        if (r < I_O) { tr_item(F.w_out, D, nullptr, F.WOUT, D, 0, RowId(), scr, r / 16, r % 16, F.lane); continue; } r -= I_O;
        if (r < I_PG) { tr_item(F.w_ple_gate, D, F.g_ple, F.WPG, D, 0, RowId(), scr, r / 16, r % 16, F.lane); continue; } r -= I_PG;
        if (r < I_PP) { tr_item(F.w_ple_proj, D, nullptr, F.WPP, PLE, 0, RowId(), scr, r / 16, r % 16, F.lane); continue; } r -= I_PP;
        if (r < I_W1) { const int e = r / 512, q = r % 512; tr_item(F.w1 + (size_t)e * D * 2 * DE, 2 * DE, F.g_moe, F.W1T + (size_t)e * 2 * DE * D, D, 0, RowW1(), scr, q / 32, q % 32, F.lane); continue; } r -= I_W1;
        { const int e = r / 256, q = r % 256; tr_item(F.w2 + (size_t)e * DE * D, D, nullptr, F.W2T + (size_t)e * D * DE, DE, 0, RowId(), scr, q / 16, q % 16, F.lane); }
    }
    for (int m = gw; m < T; m += NGW) {
        const f32x4* xr = (const f32x4*)(F.x + (size_t)m * D) + F.lane;
        f32x4 v[4]; float s = 0.f;
#pragma unroll
        for (int j = 0; j < 4; ++j) { v[j] = xr[64 * j]; s += (v[j].x * v[j].x + v[j].y * v[j].y) + (v[j].z * v[j].z + v[j].w * v[j].w); }
        const float rstd = rsqrtf(wave_sum(s) * (1.f / D) + EPS);
        unsigned long long* o8 = (unsigned long long*)(F.ABF + (size_t)m * D) + F.lane;
#pragma unroll
        for (int j = 0; j < 4; ++j) { const f32x4 g = ((const f32x4*)F.g_mix)[F.lane + 64 * j];
            o8[64 * j] = (unsigned long long)pk2(v[j].x * rstd * g.x, v[j].y * rstd * g.y) | ((unsigned long long)pk2(v[j].z * rstd * g.z, v[j].w * rstd * g.w) << 32); }
    }
    for (int m = gw; m < T; m += NGW) {
        const f32x4 v = ((const f32x4*)(F.p + (size_t)m * PLE))[F.lane];
        ((unsigned long long*)(F.PBF + (size_t)m * PLE))[F.lane] = (unsigned long long)pk2(v.x, v.y) | ((unsigned long long)pk2(v.z, v.w) << 32);
    }
    const int gt = blockIdx.x * NTHREADS + F.tid, NGT = F.G * NTHREADS;
    for (int i = gt; i < NE * D; i += NGT) { const int e = i / D, k = i % D; const float v = F.w_router[k * NE + e] * F.g_moe[k]; const unsigned h = f2bf(v); F.WRHI[i] = (bf16)h; F.WRLO[i] = (bf16)f2bf(v - bf2f(h)); }
    for (int i = gt; i < 8 * 128 * 128; i += NGT) { const int t = (i >> 7) & 127, s = i & 127; F.SGUW[i] = (bf16)(((s >> 6) <= (t >> 6)) ? f2bf(F.sgu_w[i]) : 0u); }
}

__device__ __forceinline__ void p1_inproj(const Frame& F) {
    const int gw = blockIdx.x * NWAVES + F.wave, NGW = F.G * NWAVES, r32 = F.lane & 31, hi = F.lane >> 5;
    for (int tile = gw; tile < (T / 32) * (INC / 128); tile += NGW) {
        const int mb = tile / (INC / 128), cg = tile % (INC / 128), m0 = mb * 32, n0 = cg * 128;
        const bf16* ap = F.ABF + (size_t)(m0 + r32) * D + 8 * hi;
        const bf16* bp[4];
#pragma unroll
        for (int nb = 0; nb < 4; ++nb) bp[nb] = F.WIN + (size_t)(n0 + 32 * nb + r32) * D + 8 * hi;
        f32x16 acc[4];
#pragma unroll
        for (int nb = 0; nb < 4; ++nb) acc[nb] = f32x16{};
        smma<4>(ap, bp, D, acc);
        const int kind = (n0 < ZK) ? 0 : (n0 < ZU) ? 1 : (n0 < ZGA) ? 2 : 3;
#pragma unroll
        for (int nb = 0; nb < 4; ++nb)
#pragma unroll
            for (int r = 0; r < 16; ++r) {
                float v = acc[nb][r];
                if (kind == 2) v = gelu_tanh(v); else if (kind == 3) v = sigmoidf_(v);
                F.ZZ[(size_t)(m0 + crow(r, hi)) * INC + n0 + 32 * nb + r32] = (bf16)f2bf(v);
            }
    }
    for (int tile = gw; tile < (T / 32) * (D / 128); tile += NGW) {
        const int mb = tile / (D / 128), cg = tile % (D / 128), m0 = mb * 32, n0 = cg * 128;
        const bf16* ap = F.PBF + (size_t)(m0 + r32) * PLE + 8 * hi;
        const bf16* bp[4];
#pragma unroll
        for (int nb = 0; nb < 4; ++nb) bp[nb] = F.WPP + (size_t)(n0 + 32 * nb + r32) * PLE + 8 * hi;
        f32x16 acc[4];
#pragma unroll
        for (int nb = 0; nb < 4; ++nb) acc[nb] = f32x16{};
        smma<4>(ap, bp, PLE, acc);
#pragma unroll
        for (int nb = 0; nb < 4; ++nb)
#pragma unroll
            for (int r = 0; r < 16; ++r) F.PROJ[(size_t)(m0 + crow(r, hi)) * D + n0 + 32 * nb + r32] = (bf16)f2bf(acc[nb][r]);
    }
}

template <bool EARLY>
__device__ __forceinline__ void p2_attn_scalar(const Frame& F) {
    LAS u32x4* Kt = (LAS u32x4*)F.lds;
    LAS u32x4* Vt = Kt + 512;
    for (int pr = blockIdx.x; pr < 256; pr += F.G) {
        for (int half = 0; half < 2; ++half) {
            const int bh = pr >> 2, tb = half == 0 ? (pr & 3) : 7 - (pr & 3), b = bh / NH, h = bh % NH;
            const int t = tb * 512 + F.tid;
            const size_t row = (size_t)b * SEQ + t;
            float q[64], o[64];
            { const u32x4* qp = (const u32x4*)(F.ZZ + row * INC + ZQ + h * HD);
#pragma unroll
              for (int c = 0; c < 8; ++c) { float f[8]; unpack8(qp[c], f);
#pragma unroll
                  for (int j = 0; j < 8; ++j) q[8 * c + j] = f[j]; } }
#pragma unroll
            for (int d = 0; d < 64; ++d) o[d] = 0.f;
            float carry = 1.f;
            for (int kt = tb * 8 + 7; kt >= 0; --kt) {
                __syncthreads();
                { const int kr = F.tid >> 3, c = F.tid & 7; const size_t krow = ((size_t)b * SEQ + kt * 64 + kr) * INC + h * HD + 8 * c;
                  Kt[F.tid] = *(const u32x4*)(F.ZZ + krow + ZK); Vt[F.tid] = *(const u32x4*)(F.ZZ + krow + ZV); }
                __syncthreads();
                for (int sl = 63; sl >= 0; --sl) {
                    const int s = kt * 64 + sl;
                    if (s < t) {
                        float z = 0.f;
#pragma unroll
                        for (int c = 0; c < 8; ++c) { float f[8]; unpack8(Kt[sl * 8 + c], f);
#pragma unroll
                            for (int j = 0; j < 8; ++j) z += q[8 * c + j] * f[j]; }
                        z = fminf(z, 100.f);
                        const float e = exp2f(z), r = 1.0f / (1.0f + e);
                        carry *= r;
                        const float w = e * carry;
#pragma unroll
                        for (int c = 0; c < 8; ++c) { float f[8]; unpack8(Vt[sl * 8 + c], f);
#pragma unroll
                            for (int j = 0; j < 8; ++j) o[8 * c + j] += w * f[j]; }
                    }
                }
            }
            u32x4* op = (u32x4*)(F.OAB + row * D + h * HD);
#pragma unroll
            for (int c = 0; c < 8; ++c) { u32x4 w; w.x = pk2(o[8 * c], o[8 * c + 1]); w.y = pk2(o[8 * c + 2], o[8 * c + 3]); w.z = pk2(o[8 * c + 4], o[8 * c + 5]); w.w = pk2(o[8 * c + 6], o[8 * c + 7]); op[c] = w; }
        }
    }
    __syncthreads();
}
__device__ __forceinline__ void p2_sgu_simple(const Frame& F) {
    LAS bf16* vsn = (LAS bf16*)F.lds;
    for (int unit = blockIdx.x; unit < T / 128; unit += F.G) {
        const int row0 = unit * 128;
        for (int i = 0; i < 16; ++i) {
            const int rl = F.wave * 16 + i;
            const u32x4 w = *(const u32x4*)(F.ZZ + (size_t)(row0 + rl) * INC + ZVS + 8 * F.lane);
            float f[8]; unpack8(w, f);
            float s = 0.f;
#pragma unroll
            for (int j = 0; j < 8; ++j) s += f[j];
            const float mean = wave_sum(s) * (1.f / 512.f);
            float s2 = 0.f;
#pragma unroll
            for (int j = 0; j < 8; ++j) { f[j] -= mean; s2 += f[j] * f[j]; }
            const float rstd = rsqrtf(wave_sum(s2) * (1.f / 512.f) + EPS);
            const f32x4 g0 = *(const f32x4*)(F.sgu_norm + 8 * F.lane), g1 = *(const f32x4*)(F.sgu_norm + 8 * F.lane + 4);
            u32x4 o; o.x = pk2(f[0] * rstd * g0.x, f[1] * rstd * g0.y); o.y = pk2(f[2] * rstd * g0.z, f[3] * rstd * g0.w);
            o.z = pk2(f[4] * rstd * g1.x, f[5] * rstd * g1.y); o.w = pk2(f[6] * rstd * g1.z, f[7] * rstd * g1.w);
            *(LAS u32x4*)(vsn + rl * 512 + 8 * F.lane) = o;
        }
        __syncthreads();
        const int ch = F.tid, g = ch >> 6;
        for (int tl = 0; tl < 128; ++tl) {
            const bf16* wrow = F.SGUW + (g * 128 + tl) * 128;
            float a = 0.f;
            for (int s = 0; s < 128; ++s) a += bf2f(wrow[s]) * bf2f(vsn[s * 512 + ch]);
            const float sv = a + F.sgu_b[g * 128 + tl];
            const float u = bf2f(F.ZZ[(size_t)(row0 + tl) * INC + ZU + ch]);
            F.OAB[(size_t)(row0 + tl) * D + 512 + ch] = (bf16)f2bf(u * sv);
        }
        __syncthreads();
    }
}

__device__ __forceinline__ void p3_merge(const Frame& F) {
    const int gw = blockIdx.x * NWAVES + F.wave, NGW = F.G * NWAVES, r32 = F.lane & 31, hi = F.lane >> 5;
    for (int tile = gw; tile < (T / 32) * (D / 128); tile += NGW) {
        const int mb = tile / (D / 128), cg = tile % (D / 128), m0 = mb * 32, n0 = cg * 128;
        const bf16* ap = F.OAB + (size_t)(m0 + r32) * D + 8 * hi;
        const bf16* bp[4];
#pragma unroll
        for (int nb = 0; nb < 4; ++nb) bp[nb] = F.WAB + (size_t)(n0 + 32 * nb + r32) * D + 8 * hi;
        f32x16 acca[4], accb[4];
#pragma unroll
        for (int nb = 0; nb < 4; ++nb) { acca[nb] = f32x16{}; accb[nb] = f32x16{}; }
        smma<4>(ap, bp, 512, acca);
        const bf16* ap2 = ap + 512; const bf16* bp2[4];
#pragma unroll
        for (int nb = 0; nb < 4; ++nb) bp2[nb] = bp[nb] + 512;
        smma<4>(ap2, bp2, 512, accb);
#pragma unroll
        for (int nb = 0; nb < 4; ++nb)
#pragma unroll
            for (int r = 0; r < 16; ++r) {
                const size_t row = m0 + crow(r, hi); const int col = n0 + 32 * nb + r32;
                const float sga = bf2f(F.ZZ[row * INC + ZGA + col]), sgb = bf2f(F.ZZ[row * INC + ZGB + col]);
                F.MERGED[row * D + col] = (bf16)f2bf(sga * acca[nb][r] + sgb * accb[nb][r]);
            }
    }
}
__device__ __forceinline__ void p4_out(const Frame& F) {
    const int gw = blockIdx.x * NWAVES + F.wave, NGW = F.G * NWAVES, r32 = F.lane & 31, hi = F.lane >> 5;
    for (int tile = gw; tile < (T / 32) * (D / 128); tile += NGW) {
        const int mb = tile / (D / 128), cg = tile % (D / 128), m0 = mb * 32, n0 = cg * 128;
        const bf16* ap = F.MERGED + (size_t)(m0 + r32) * D + 8 * hi;
        const bf16* bp[4];
#pragma unroll
        for (int nb = 0; nb < 4; ++nb) bp[nb] = F.WOUT + (size_t)(n0 + 32 * nb + r32) * D + 8 * hi;
        f32x16 acc[4];
#pragma unroll
        for (int nb = 0; nb < 4; ++nb) acc[nb] = f32x16{};
        smma<4>(ap, bp, D, acc);
#pragma unroll
        for (int nb = 0; nb < 4; ++nb)
#pragma unroll
            for (int r = 0; r < 16; ++r) {
                const size_t row = m0 + crow(r, hi); const int col = n0 + 32 * nb + r32;
                F.H1[row * D + col] = (bf16)f2bf(F.x[row * D + col] + acc[nb][r]);
            }
    }
}
__device__ __forceinline__ void p5_router(const Frame& F) {
    LAS unsigned* hist = (LAS unsigned*)F.lds;
    LAS unsigned* base = hist + 32;
    LAS unsigned* lsel = hist + 64;
    LAS float* lgate = (LAS float*)(hist + 64 + 512);
    const int e = F.lane & 31, half = F.lane >> 5;
    for (int chunk = blockIdx.x; chunk < T / 128; chunk += F.G) {
        if (F.tid < 32) hist[F.tid] = 0u;
        __syncthreads();
        for (int i = 0; i < 16; ++i) {
            const int tl = F.wave * 16 + i, t = chunk * 128 + tl;
            const bf16* hp = F.H1 + (size_t)t * D + half * 512;
            const bf16* whi = F.WRHI + e * D + half * 512;
            const bf16* wlo = F.WRLO + e * D + half * 512;
            float dot = 0.f, ss = 0.f;
            for (int k = 0; k < 512; k += 8) {
                float hf[8], a[8], c[8];
                unpack8(*(const u32x4*)(hp + k), hf); unpack8(*(const u32x4*)(whi + k), a); unpack8(*(const u32x4*)(wlo + k), c);
#pragma unroll
                for (int j = 0; j < 8; ++j) { dot += hf[j] * (a[j] + c[j]); ss += hf[j] * hf[j]; }
            }
            dot += __shfl_xor(dot, 32); ss += __shfl_xor(ss, 32);
            const float rstd = rsqrtf(ss * (1.f / D) + EPS);
            float logit = rstd * dot + F.b_router[e];
            float val[4]; int sel[4];
#pragma unroll
            for (int r = 0; r < 4; ++r) {
                const float m = wave_max(logit);
                const unsigned long long bal = __ballot(logit == m);
                const int le = (int)(__ffsll((long long)bal) - 1) & 31;
                val[r] = m; sel[r] = le;
                if (e == le) logit = -INFINITY;
            }
            float ex[4], sum = 0.f;
#pragma unroll
            for (int r = 0; r < 4; ++r) { ex[r] = __expf(val[r] - val[0]); sum += ex[r]; }
            { const u32x4* hr = (const u32x4*)(F.H1 + (size_t)t * D); u32x4* cr = (u32x4*)(F.ABF + (size_t)t * D);
#pragma unroll
              for (int j = 0; j < 2; ++j) { float f[8]; unpack8(hr[F.lane + 64 * j], f); u32x4 o; o.x = pk2(f[0] * rstd, f[1] * rstd); o.y = pk2(f[2] * rstd, f[3] * rstd); o.z = pk2(f[4] * rstd, f[5] * rstd); o.w = pk2(f[6] * rstd, f[7] * rstd); cr[F.lane + 64 * j] = o; } }
            if (F.lane == 0) {
                F.RSTD1[t] = rstd;
#pragma unroll
                for (int r = 0; r < 4; ++r) { const unsigned loc = atomicAdd((unsigned*)&hist[sel[r]], 1u); lsel[tl * 4 + r] = (unsigned)sel[r] | (loc << 8); lgate[tl * 4 + r] = ex[r] / sum; }
            }
        }
        __syncthreads();
        if (F.tid < 32) { const unsigned n = hist[F.tid]; base[F.tid] = n ? __hip_atomic_fetch_add(F.ctl + CW_CNT + 64 * F.tid, n, __ATOMIC_RELAXED, __HIP_MEMORY_SCOPE_AGENT) : 0u; }
        __syncthreads();
        { const int tl = F.tid >> 2, r = F.tid & 3, t = chunk * 128 + tl; const unsigned s = lsel[tl * 4 + r]; const int ee = s & 255; const unsigned rank = base[ee] + (s >> 8);
          F.TOKLIST[ee * LCAP + rank] = t; F.SLOTREF[t * 4 + r] = (ee << 16) | rank; F.GATE[t * 4 + r] = lgate[tl * 4 + r]; }
        __syncthreads();
    }
}
struct MoeTab { LAS int* cnt; LAS int* toff; LAS int* p32; };
__device__ __forceinline__ MoeTab moe_tables(const Frame& F) {
    MoeTab M; M.cnt = (LAS int*)(F.lds + MISC_OFF + 128); M.toff = M.cnt + 32; M.p32 = M.toff + 33;
    __syncthreads();
    if (F.tid == 0) { int a = 0, c = 0;
        for (int e = 0; e < NE; ++e) { const int n = (int)__hip_atomic_load(F.ctl + CW_CNT + 64 * e, __ATOMIC_RELAXED, __HIP_MEMORY_SCOPE_AGENT); M.cnt[e] = n; M.toff[e] = a; M.p32[e] = c; a += (n + 255) >> 8; c += (n + 31) >> 5; }
        M.toff[NE] = a; M.p32[NE] = c; }
    __syncthreads();
    return M;
}
__device__ __forceinline__ void p6_moe1(const Frame& F) {
    const MoeTab M = moe_tables(F);
    const int gw = blockIdx.x * NWAVES + F.wave, NGW = F.G * NWAVES, r32 = F.lane & 31, hi = F.lane >> 5;
    const int ntiles = M.p32[NE] * 32;
    for (int tile = gw; tile < ntiles; tile += NGW) {
        const int blk = tile >> 5, hb = tile & 31;
        int e = 0; while (M.p32[e + 1] <= blk) ++e;
        const int sb = blk - M.p32[e], cnt = M.cnt[e];
        const int rank = sb * 32 + r32;
        const int tok = F.TOKLIST[e * LCAP + (rank < cnt ? rank : cnt - 1)];
        const bf16* ap = F.ABF + (size_t)tok * D + 8 * hi;
        const int hidb = hb * 32 + r32;
        const bf16* bp[2];
        bp[0] = F.W1T + ((size_t)e * 2048 + 256 * (hidb >> 7) + (hidb & 127)) * D + 8 * hi; bp[1] = bp[0] + 128 * D;
        f32x16 acc[2]; acc[0] = f32x16{}; acc[1] = f32x16{};
        smma<2>(ap, bp, D, acc);
        const float bg = F.b1[e * 2048 + 2 * hidb], bl = F.b1[e * 2048 + 2 * hidb + 1];
#pragma unroll
        for (int r = 0; r < 16; ++r) {
            const int rr = crow(r, hi), rk = sb * 32 + rr;
            float gl = acc[0][r] + bg, li = acc[1][r] + bl;
            gl = fminf(gl, 7.f); li = fminf(fmaxf(li, -7.f), 7.f);
            const float act = gl * sigmoidf_(1.702f * gl) * (li + 1.f);
            if (rk < cnt) F.HID[((size_t)256 * M.toff[e] + rk) * DE + hidb] = (bf16)f2bf(act);
        }
    }
}
__device__ __forceinline__ void p7_moe2(const Frame& F) {
    const MoeTab M = moe_tables(F);
    const int gw = blockIdx.x * NWAVES + F.wave, NGW = F.G * NWAVES, r32 = F.lane & 31, hi = F.lane >> 5;
    const int ntiles = M.p32[NE] * 8;
    for (int tile = gw; tile < ntiles; tile += NGW) {
        const int blk = tile >> 3, cg = tile & 7;
        int e = 0; while (M.p32[e + 1] <= blk) ++e;
        const int sb = blk - M.p32[e], cnt = M.cnt[e];
        const size_t rowb = (size_t)256 * M.toff[e] + sb * 32;
        const bf16* ap = F.HID + (rowb + r32) * DE + 8 * hi;
        const bf16* bp[4];
#pragma unroll
        for (int nb = 0; nb < 4; ++nb) bp[nb] = F.W2T + ((size_t)e * D + cg * 128 + 32 * nb + r32) * DE + 8 * hi;
        f32x16 acc[4];
#pragma unroll
        for (int nb = 0; nb < 4; ++nb) acc[nb] = f32x16{};
        smma<4>(ap, bp, DE, acc);
#pragma unroll
        for (int nb = 0; nb < 4; ++nb) { const int col = cg * 128 + 32 * nb + r32; const float bb = F.b2[e * D + col];
#pragma unroll
            for (int r = 0; r < 16; ++r) { const int rr = crow(r, hi); if (sb * 32 + rr < cnt) F.YS[(rowb + rr) * D + col] = (bf16)f2bf(acc[nb][r] + bb); } }
    }
}
__device__ __forceinline__ void p8_combine(const Frame& F) {
    const MoeTab M = moe_tables(F);
    const int gw = blockIdx.x * NWAVES + F.wave, NGW = F.G * NWAVES;
    for (int t = gw; t < T; t += NGW) {
        size_t yrow[4]; float gk[4];
#pragma unroll
        for (int k = 0; k < 4; ++k) { const int sr = F.SLOTREF[t * 4 + k]; yrow[k] = (size_t)256 * M.toff[sr >> 16] + (sr & 0xffff); gk[k] = F.GATE[t * 4 + k]; }
        float ss = 0.f;
#pragma unroll
        for (int j = 0; j < 2; ++j) {
            const int col = 8 * F.lane + 512 * j;
            float a[8]; unpack8(*(const u32x4*)(F.H1 + (size_t)t * D + col), a);
#pragma unroll
            for (int k = 0; k < 4; ++k) { float y[8]; unpack8(*(const u32x4*)(F.YS + yrow[k] * D + col), y);
#pragma unroll
                for (int q = 0; q < 8; ++q) a[q] += gk[k] * y[q]; }
            u32x4 o; o.x = pk2(a[0], a[1]); o.y = pk2(a[2], a[3]); o.z = pk2(a[4], a[5]); o.w = pk2(a[6], a[7]);
            *(u32x4*)(F.H2 + (size_t)t * D + col) = o;
            float b[8]; unpack8(o, b);
#pragma unroll
            for (int q = 0; q < 8; ++q) ss += b[q] * b[q];
        }
        ss = wave_sum(ss);
        if (F.lane == 0) F.RSTD2[t] = rsqrtf(ss * (1.f / D) + EPS);
    }
}
__device__ __forceinline__ void p9_ple(const Frame& F) {
    const int gw = blockIdx.x * NWAVES + F.wave, NGW = F.G * NWAVES, r32 = F.lane & 31, hi = F.lane >> 5;
    for (int tile = gw; tile < (T / 32) * (D / 128); tile += NGW) {
        const int mb = tile / (D / 128), cg = tile % (D / 128), m0 = mb * 32, n0 = cg * 128;
        const bf16* ap = F.H2 + (size_t)(m0 + r32) * D + 8 * hi;
        const bf16* bp[4];
#pragma unroll
        for (int nb = 0; nb < 4; ++nb) bp[nb] = F.WPG + (size_t)(n0 + 32 * nb + r32) * D + 8 * hi;
        f32x16 acc[4];
#pragma unroll
        for (int nb = 0; nb < 4; ++nb) acc[nb] = f32x16{};
        smma<4>(ap, bp, D, acc);
#pragma unroll
        for (int r = 0; r < 16; ++r) {
            const size_t row = m0 + crow(r, hi); const float rs = F.RSTD2[row];
#pragma unroll
            for (int nb = 0; nb < 4; ++nb) { const int col = n0 + 32 * nb + r32;
                const float pg = sigmoidf_(rs * acc[nb][r]);
                F.H3[row * D + col] = (bf16)f2bf(bf2f(F.H2[row * D + col]) + pg * bf2f(F.PROJ[row * D + col])); }
        }
    }
}
__device__ __forceinline__ void p10_final(const Frame& F) {
    const int gw = blockIdx.x * NWAVES + F.wave, NGW = F.G * NWAVES;
    for (int t = gw; t < T; t += NGW) {
        float a[2][8]; float ss = 0.f;
#pragma unroll
        for (int j = 0; j < 2; ++j) { unpack8(*(const u32x4*)(F.H3 + (size_t)t * D + 8 * F.lane + 512 * j), a[j]);
#pragma unroll
            for (int q = 0; q < 8; ++q) ss += a[j][q] * a[j][q]; }
        const float rstd = rsqrtf(wave_sum(ss) * (1.f / D) + EPS);
#pragma unroll
        for (int j = 0; j < 2; ++j) { const int col = 8 * F.lane + 512 * j;
            const f32x4 g0 = *(const f32x4*)(F.g_final + col), g1 = *(const f32x4*)(F.g_final + col + 4);
            f32x4 o0, o1; o0.x = a[j][0] * rstd * g0.x; o0.y = a[j][1] * rstd * g0.y; o0.z = a[j][2] * rstd * g0.z; o0.w = a[j][3] * rstd * g0.w;
            o1.x = a[j][4] * rstd * g1.x; o1.y = a[j][5] * rstd * g1.y; o1.z = a[j][6] * rstd * g1.z; o1.w = a[j][7] * rstd * g1.w;
            *(f32x4*)(F.out + (size_t)t * D + col) = o0; *(f32x4*)(F.out + (size_t)t * D + col + 4) = o1; }
    }
}


namespace pg {
constexpr int BM = 256, BK = 64, HALF = 128, HTB = HALF * BK * 2, STAGE_BYTES = 8 * HTB, NXCD = 8, WGM = 8;
__device__ __forceinline__ int lds_byte(int r, int c) { const int st = (r >> 4) * 2 + (c >> 5), rr = r & 15, cc = c & 31, ob = rr * 64 + cc * 2; return st * 1024 + (ob ^ (((ob >> 9) & 1) << 5)); }
__device__ __forceinline__ void stage_rc(int b, int& R, int& C) { const int st = b / 1024, sb = b % 1024, swz = sb ^ (((sb >> 9) & 1) << 5); R = (st >> 1) * 16 + swz / 64; C = (st & 1) * 32 + (swz % 64) / 2; }
__device__ __forceinline__ int perm32(int rho) { const int n = rho >> 4, i = rho & 15; return 8 * (i >> 2) + 4 * n + (i & 3); }
struct Unit { int arow, brow, kofs, x0, x1, x2; };
__device__ __forceinline__ unsigned cvt_pk_bf16(float lo, float hi) { unsigned r; asm volatile("v_cvt_pk_bf16_f32 %0, %1, %2" : "=v"(r) : "v"(lo), "v"(hi)); return r; }
typedef f32x4 Acc[2][2][4][2];

struct DenseMap { static constexpr bool GATHER = false; int lda; __device__ __forceinline__ unsigned rowoff(const Unit&, int r) const { return (unsigned)r * (unsigned)lda * 2u; }
    __device__ __forceinline__ size_t base(const Unit& u) const { return (size_t)u.arow * lda * 2; } };
template <int SPLIT>
struct DenseOrder {
    int nM, nN, nwg, G, c, khalf;
    __device__ __forceinline__ void init(int M, int N, int G_, int c_, int khalf_ = 0) { nM = M / BM; nN = N / BM; nwg = nM * nN; G = G_; c = c_; khalf = khalf_; }
    __device__ __forceinline__ bool next(int i, Unit& u) const {
        const int j = SPLIT ? (i >> 1) : i;
        const long L = (long)j * G + c; if (L >= nwg) return false;
        int wgid = (int)L; { const int q = nwg / NXCD, r = nwg % NXCD, xcd = wgid % NXCD, off = wgid / NXCD; wgid = (xcd < r ? xcd * (q + 1) : r * (q + 1) + (xcd - r) * q) + off; }
        const int nig = WGM * nN, gid = wgid / nig, fm = gid * WGM, gsz = (nM - fm) < WGM ? (nM - fm) : WGM;
        const int pm = fm + ((wgid % nig) % gsz), pn = (wgid % nig) / gsz;
        u.arow = pm * BM; u.brow = pn * BM; u.x0 = pm; u.x1 = pn; u.x2 = SPLIT ? (i & 1) : 0; u.kofs = SPLIT ? (i & 1) * khalf : 0; return true;
    }
};

template <class Epi, class Sched, class AMap, bool ALIGN_EPI>
__device__ __forceinline__ void gemm_run(LAS unsigned char* lds, const bf16* A, const bf16* Bt, const int ldb, const int nt, const Sched& S, const Epi& E, const AMap& AM) {
    const int tid = threadIdx.x, wid = __builtin_amdgcn_readfirstlane(tid >> 6), lane = tid & 63, wr = wid >> 2, wc = wid & 3, fr = lane & 15, fq = lane >> 4;
    int RA[2]; unsigned CA2[2], voffB[2];
#pragma unroll
    for (int i = 0; i < 2; ++i) { int R, C; stage_rc(tid * 16 + i * 8192, R, C); RA[i] = R; CA2[i] = (unsigned)C * 2u; const int Rb = (R & ~31) + perm32(R & 31); voffB[i] = (unsigned)(Rb * ldb + C) * 2u; }
    const size_t kstep = (size_t)(BK * 2);
    const size_t hstepB = (size_t)HALF * ldb * 2;
    const unsigned ldsw = (unsigned)wid * 1024u;
    const int aoff = lds_byte(wr * 64 + fr, fq * 8), boff = lds_byte(wc * 32 + fr, fq * 8);
#define PG_SA(b, h) (((b) * 2 + (h)) * HTB)
#define PG_SB(b, h) ((4 + (b) * 2 + (h)) * HTB)
#define PG_STAGE(bufoff, gbase, voff) do { _Pragma("unroll") for (int _i = 0; _i < 2; ++_i) \
        __builtin_amdgcn_global_load_lds((const unsigned*)((const char*)(gbase) + (voff)[_i]), (LAS unsigned*)(lds + (bufoff) + ldsw + _i * 8192), 16, 0, 0); } while (0)
#define PG_LDA(dst, b, h) do { _Pragma("unroll") for (int m = 0; m < 4; ++m) _Pragma("unroll") for (int k = 0; k < 2; ++k) dst[m][k] = *(const LAS bf16x8*)(lds + PG_SA(b, h) + aoff + m * 2048 + k * 1024); } while (0)
#define PG_LDB(dst, b, h) do { _Pragma("unroll") for (int n = 0; n < 2; ++n) _Pragma("unroll") for (int k = 0; k < 2; ++k) dst[n][k] = *(const LAS bf16x8*)(lds + PG_SB(b, h) + boff + n * 2048 + k * 1024); } while (0)
#define PG_MMA(ai, bj, At, Bt_) do { __builtin_amdgcn_s_setprio(1); _Pragma("unroll") for (int m = 0; m < 4; ++m) _Pragma("unroll") for (int n = 0; n < 2; ++n) _Pragma("unroll") for (int k = 0; k < 2; ++k) \
        acc[ai][bj][m][n] = __builtin_amdgcn_mfma_f32_16x16x32_bf16(Bt_[n][k], At[m][k], acc[ai][bj][m][n], 0, 0, 0); __builtin_amdgcn_s_setprio(0); } while (0)
#define PG_WAIT_V(n) asm volatile("s_waitcnt vmcnt(" #n ")" ::: "memory")
#define PG_WAIT_L(n) asm volatile("s_waitcnt lgkmcnt(" #n ")" ::: "memory")
#define PG_BAR __builtin_amdgcn_s_barrier()
#define PG_SCHED __builtin_amdgcn_sched_barrier(0)
#define PG_ZERO() do { _Pragma("unroll") for (int a = 0; a < 2; ++a) _Pragma("unroll") for (int b = 0; b < 2; ++b) _Pragma("unroll") for (int m = 0; m < 4; ++m) _Pragma("unroll") for (int n = 0; n < 2; ++n) acc[a][b][m][n] = (f32x4){0.f, 0.f, 0.f, 0.f}; } while (0)
#define PG_MKVA(u, va) do { _Pragma("unroll") for (int h = 0; h < 2; ++h) _Pragma("unroll") for (int i = 0; i < 2; ++i) va[h][i] = AM.rowoff(u, h * HALF + RA[i]) + CA2[i]; } while (0)
    Unit cur, nxt; int ui = 0;
    if (!S.next(0, cur)) return;
    Acc acc; PG_ZERO();
    bf16x8 At[4][2], B0[2][2], B1[2][2];
    unsigned voffA[2]; unsigned vaC[2][2], vaN[2][2];
    const size_t hstepA = AMap::GATHER ? 0 : (size_t)AM.rowoff(cur, HALF);
    if constexpr (AMap::GATHER) { PG_MKVA(cur, vaC); } else {
#pragma unroll
        for (int i = 0; i < 2; ++i) voffA[i] = AM.rowoff(cur, RA[i]) + CA2[i]; }
#define PG_STAGE_A(bufoff, ptr, h, useNext) do { if constexpr (AMap::GATHER) { unsigned _v[2] = {(useNext) ? vaN[h][0] : vaC[h][0], (useNext) ? vaN[h][1] : vaC[h][1]}; PG_STAGE(bufoff, ptr, _v); } \
        else { PG_STAGE(bufoff, (ptr) + (h) * hstepA, voffA); } } while (0)
    const char* cA = (const char*)A + (size_t)cur.kofs * 2 + AM.base(cur); const char* cB = (const char*)Bt + ((size_t)cur.brow * ldb + cur.kofs) * 2;
    PG_STAGE(PG_SB(0, 0), cB, voffB); PG_STAGE(PG_SB(0, 1), cB + hstepB, voffB); PG_STAGE_A(PG_SA(0, 0), cA, 0, false); PG_STAGE_A(PG_SA(0, 1), cA, 1, false);
    if (wr == 1) PG_BAR;
    PG_WAIT_V(2); PG_BAR;
    PG_STAGE(PG_SB(1, 0), cB + kstep, voffB); PG_STAGE_A(PG_SA(1, 0), cA + kstep, 0, false); PG_STAGE(PG_SB(1, 1), cB + hstepB + kstep, voffB);
    PG_WAIT_V(6); PG_BAR;
    for (;;) {
        const bool has_next = S.next(ui + 1, nxt);
        const char* nA = cA; const char* nB = cB;
        if (has_next) { if constexpr (AMap::GATHER) { PG_MKVA(nxt, vaN); } nA = (const char*)A + (size_t)nxt.kofs * 2 + AM.base(nxt); nB = (const char*)Bt + ((size_t)nxt.brow * ldb + nxt.kofs) * 2; }
        else if constexpr (AMap::GATHER) {
#pragma unroll
            for (int h = 0; h < 2; ++h)
#pragma unroll
                for (int i = 0; i < 2; ++i) vaN[h][i] = vaC[h][i]; }
#pragma unroll 1
        for (int t = 0; t < nt; t += 2) {
            const bool last = (t == nt - 2);
            const char* a1 = cA + (size_t)(t + 1) * kstep;
            const char* a2 = last ? nA : cA + (size_t)(t + 2) * kstep; const char* b2 = last ? nB : cB + (size_t)(t + 2) * kstep;
            const char* a3 = a2 + kstep; const char* b3 = b2 + kstep;
            PG_LDB(B0, 0, 0); PG_LDB(B1, 0, 1); PG_SCHED; PG_LDA(At, 0, 0); PG_STAGE_A(PG_SA(1, 1), a1, 1, false);
            PG_WAIT_V(8); PG_WAIT_L(0); PG_BAR; PG_MMA(0, 0, At, B0); PG_MMA(0, 1, At, B1); PG_BAR; PG_SCHED;
            PG_LDA(At, 0, 1); PG_STAGE(PG_SB(0, 0), b2, voffB); PG_STAGE(PG_SB(0, 1), b2 + hstepB, voffB); PG_STAGE_A(PG_SA(0, 0), a2, 0, last);
            PG_WAIT_V(8); PG_WAIT_L(0); PG_BAR; PG_MMA(1, 0, At, B0); PG_MMA(1, 1, At, B1); PG_BAR; PG_SCHED;
            PG_LDB(B0, 1, 0); PG_LDB(B1, 1, 1); PG_SCHED; PG_LDA(At, 1, 0); PG_STAGE_A(PG_SA(0, 1), a2, 1, last);
            PG_WAIT_V(8); PG_WAIT_L(0); PG_BAR; PG_MMA(0, 0, At, B0); PG_MMA(0, 1, At, B1); PG_BAR; PG_SCHED;
            PG_LDA(At, 1, 1); PG_STAGE(PG_SB(1, 0), b3, voffB); PG_STAGE(PG_SB(1, 1), b3 + hstepB, voffB); PG_STAGE_A(PG_SA(1, 0), a3, 0, last);
            PG_WAIT_V(8); PG_WAIT_L(0); PG_BAR; PG_MMA(1, 0, At, B0); PG_MMA(1, 1, At, B1); PG_BAR; PG_SCHED;
        }
        if constexpr (ALIGN_EPI) { if (wr == 0) PG_BAR; }
        E(acc, cur, wr, wc, fr, fq);
        if (!has_next) break;
        if (!E.keep(cur)) PG_ZERO();
        cur = nxt; cA = nA; cB = nB; ++ui;
        if constexpr (AMap::GATHER) {
#pragma unroll
            for (int h = 0; h < 2; ++h)
#pragma unroll
                for (int i = 0; i < 2; ++i) vaC[h][i] = vaN[h][i]; }
        if constexpr (ALIGN_EPI) { if (wr == 1) PG_BAR; }
    }
    PG_WAIT_V(0);
    if constexpr (!ALIGN_EPI) { if (wr == 0) PG_BAR; }
    PG_BAR;
#undef PG_SA
#undef PG_SB
#undef PG_STAGE
#undef PG_LDA
#undef PG_LDB
#undef PG_MMA
#undef PG_WAIT_V
#undef PG_WAIT_L
#undef PG_BAR
#undef PG_SCHED
#undef PG_ZERO
#undef PG_MKVA
#undef PG_STAGE_A
}

__device__ __forceinline__ float sigm(float x) { return __builtin_amdgcn_rcpf(1.0f + __builtin_amdgcn_exp2f(-LOG2E * x)); }
__device__ __forceinline__ float gelu_t(float x) { const float u = 1.5957691216057308f * (x + 0.044715f * x * x * x); return x * sigm(u); }
__device__ __forceinline__ float act_k(float x, float c1, float c3, bool plain, bool mulx) { const float s = sigm(x * (c1 + c3 * x * x)); const float y = mulx ? x * s : s; return plain ? x : y; }
__device__ __forceinline__ void store_act(const Acc& acc, bf16* base, int ldc, int kind) {
    const bool plain = kind == 1, mulx = kind == 2; const float c1 = kind == 2 ? 1.5957691216057308f : 1.0f, c3 = kind == 2 ? 1.5957691216057308f * 0.044715f : 0.0f;
#pragma unroll
    for (int ai = 0; ai < 2; ++ai)
#pragma unroll
        for (int m = 0; m < 4; ++m) { bf16* rowp = base + (size_t)(ai * HALF + m * 16) * ldc;
#pragma unroll
            for (int bj = 0; bj < 2; ++bj) { const f32x4 v0 = acc[ai][bj][m][0], v1 = acc[ai][bj][m][1];
                u32x4 w; w.x = cvt_pk_bf16(act_k(v0[0], c1, c3, plain, mulx), act_k(v0[1], c1, c3, plain, mulx)); w.y = cvt_pk_bf16(act_k(v0[2], c1, c3, plain, mulx), act_k(v0[3], c1, c3, plain, mulx));
                w.z = cvt_pk_bf16(act_k(v1[0], c1, c3, plain, mulx), act_k(v1[1], c1, c3, plain, mulx)); w.w = cvt_pk_bf16(act_k(v1[2], c1, c3, plain, mulx), act_k(v1[3], c1, c3, plain, mulx));
                *(u32x4*)(rowp + bj * HALF) = w; }
            asm volatile("" ::: "memory"); }
}
__device__ __forceinline__ void store_plain(const Acc& acc, bf16* base, int ldc) {
#pragma unroll
    for (int ai = 0; ai < 2; ++ai)
#pragma unroll
        for (int m = 0; m < 4; ++m) { bf16* rowp = base + (size_t)(ai * HALF + m * 16) * ldc;
#pragma unroll
            for (int bj = 0; bj < 2; ++bj) { const f32x4 v0 = acc[ai][bj][m][0], v1 = acc[ai][bj][m][1];
                u32x4 w; w.x = cvt_pk_bf16(v0[0], v0[1]); w.y = cvt_pk_bf16(v0[2], v0[3]); w.z = cvt_pk_bf16(v1[0], v1[1]); w.w = cvt_pk_bf16(v1[2], v1[3]);
                *(u32x4*)(rowp + bj * HALF) = w; } }
}
struct EpiInproj {
    bf16* ZZ;
    __device__ __forceinline__ bool keep(const Unit&) const { return false; }
    __device__ __forceinline__ void operator()(const Acc& acc, const Unit& u, int wr, int wc, int fr, int fq) const {
        bf16* base = ZZ + (size_t)(u.arow + wr * 64 + fr) * INC + u.brow + wc * 32 + 8 * fq;
        const int n0 = u.brow;
        if (n0 < ZU) store_plain(acc, base, INC); else store_act(acc, base, INC, n0 < ZGA ? 2 : 3);
    }
};
struct EpiPlain {
    bf16* O; int ldc;
    __device__ __forceinline__ bool keep(const Unit&) const { return false; }
    __device__ __forceinline__ void operator()(const Acc& acc, const Unit& u, int wr, int wc, int fr, int fq) const {
        store_plain(acc, O + (size_t)(u.arow + wr * 64 + fr) * ldc + u.brow + wc * 32 + 8 * fq, ldc);
    }
};
struct EpiMerge {
    const bf16* ZZ; bf16* O;
    __device__ __forceinline__ bool keep(const Unit& u) const { return u.x2 == 0; }
    __device__ __forceinline__ void operator()(Acc& acc, const Unit& u, int wr, int wc, int fr, int fq) const {
        const int row0 = u.arow + wr * 64 + fr, col0 = u.brow + wc * 32 + 8 * fq;
#pragma unroll
        for (int ai = 0; ai < 2; ++ai)
#pragma unroll
            for (int m = 0; m < 4; ++m) { const size_t row = row0 + ai * HALF + m * 16;
#pragma unroll
                for (int bj = 0; bj < 2; ++bj) { const int col = col0 + bj * HALF;
                    float gb[8]; unpack8(*(const u32x4*)(ZZ + row * INC + ZGB + col), gb);
#pragma unroll
                    for (int q = 0; q < 8; ++q) gb[q] = fmaxf(gb[q], 1e-30f);
                    if (u.x2 == 0) { float ga[8]; unpack8(*(const u32x4*)(ZZ + row * INC + ZGA + col), ga);
#pragma unroll
                        for (int q = 0; q < 8; ++q) acc[ai][bj][m][q >> 2][q & 3] *= ga[q] * __builtin_amdgcn_rcpf(gb[q]); }
                    else { const f32x4 v0 = acc[ai][bj][m][0], v1 = acc[ai][bj][m][1];
                        u32x4 w; w.x = cvt_pk_bf16(v0[0] * gb[0], v0[1] * gb[1]); w.y = cvt_pk_bf16(v0[2] * gb[2], v0[3] * gb[3]); w.z = cvt_pk_bf16(v1[0] * gb[4], v1[1] * gb[5]); w.w = cvt_pk_bf16(v1[2] * gb[6], v1[3] * gb[7]);
                        *(u32x4*)(O + row * D + col) = w; } }
                asm volatile("" ::: "memory"); }
    }
};
struct EpiOut {
    const float* x; bf16* O;
    __device__ __forceinline__ bool keep(const Unit&) const { return false; }
    __device__ __forceinline__ void operator()(const Acc& acc, const Unit& u, int wr, int wc, int fr, int fq) const {
        const int row0 = u.arow + wr * 64 + fr, col0 = u.brow + wc * 32 + 8 * fq;
#pragma unroll
        for (int ai = 0; ai < 2; ++ai)
#pragma unroll
            for (int m = 0; m < 4; ++m) { const size_t row = row0 + ai * HALF + m * 16;
#pragma unroll
                for (int bj = 0; bj < 2; ++bj) { const int col = col0 + bj * HALF;
                    const f32x4 x0 = *(const f32x4*)(x + row * D + col), x1 = *(const f32x4*)(x + row * D + col + 4);
                    const f32x4 v0 = acc[ai][bj][m][0] + x0, v1 = acc[ai][bj][m][1] + x1;
                    u32x4 w; w.x = cvt_pk_bf16(v0[0], v0[1]); w.y = cvt_pk_bf16(v0[2], v0[3]); w.z = cvt_pk_bf16(v1[0], v1[1]); w.w = cvt_pk_bf16(v1[2], v1[3]);
                    *(u32x4*)(O + row * D + col) = w; }
                asm volatile("" ::: "memory"); }
    }
};
struct EpiPle {
    const bf16* H2; const bf16* PROJ; const float* RSTD2; bf16* O;
    __device__ __forceinline__ bool keep(const Unit&) const { return false; }
    __device__ __forceinline__ void operator()(const Acc& acc, const Unit& u, int wr, int wc, int fr, int fq) const {
        const int row0 = u.arow + wr * 64 + fr, col0 = u.brow + wc * 32 + 8 * fq;
#pragma unroll
        for (int ai = 0; ai < 2; ++ai)
#pragma unroll
            for (int m = 0; m < 4; ++m) { const size_t row = row0 + ai * HALF + m * 16; const float rs = RSTD2[row];
#pragma unroll
                for (int bj = 0; bj < 2; ++bj) { const int col = col0 + bj * HALF;
                    float h[8], pj[8]; unpack8(*(const u32x4*)(H2 + row * D + col), h); unpack8(*(const u32x4*)(PROJ + row * D + col), pj);
                    float o[8];
#pragma unroll
                    for (int q = 0; q < 8; ++q) o[q] = h[q] + sigm(rs * acc[ai][bj][m][q >> 2][q & 3]) * pj[q];
                    u32x4 w; w.x = cvt_pk_bf16(o[0], o[1]); w.y = cvt_pk_bf16(o[2], o[3]); w.z = cvt_pk_bf16(o[4], o[5]); w.w = cvt_pk_bf16(o[6], o[7]);
                    *(u32x4*)(O + row * D + col) = w; }
                asm volatile("" ::: "memory"); }
    }
};
}

__device__ __forceinline__ void p1_fast(const Frame& F) {
    { pg::DenseOrder<0> S; S.init(T, INC, F.G, (int)blockIdx.x); pg::EpiInproj E{F.ZZ}; pg::DenseMap AM{D};
      pg::gemm_run<pg::EpiInproj, pg::DenseOrder<0>, pg::DenseMap, true>(F.lds + STAGE_OFF, F.ABF, F.WIN, D, D / 64, S, E, AM); }
    { pg::DenseOrder<0> S; S.init(T, D, F.G, (int)blockIdx.x); pg::EpiPlain E{F.PROJ, D}; pg::DenseMap AM{PLE};
      pg::gemm_run<pg::EpiPlain, pg::DenseOrder<0>, pg::DenseMap, true>(F.lds + STAGE_OFF, F.PBF, F.WPP, PLE, PLE / 64, S, E, AM); }
}
__device__ __forceinline__ void p3_fast(const Frame& F) {
    pg::DenseOrder<1> S; S.init(T, D, F.G, (int)blockIdx.x, 512); pg::EpiMerge E{F.ZZ, F.MERGED}; pg::DenseMap AM{D};
    pg::gemm_run<pg::EpiMerge, pg::DenseOrder<1>, pg::DenseMap, true>(F.lds + STAGE_OFF, F.OAB, F.WAB, D, 512 / 64, S, E, AM);
}
__device__ __forceinline__ void p4_fast(const Frame& F) {
    pg::DenseOrder<0> S; S.init(T, D, F.G, (int)blockIdx.x); pg::EpiOut E{F.x, F.H1}; pg::DenseMap AM{D};
    pg::gemm_run<pg::EpiOut, pg::DenseOrder<0>, pg::DenseMap, true>(F.lds + STAGE_OFF, F.MERGED, F.WOUT, D, D / 64, S, E, AM);
}
__device__ __forceinline__ void p9_fast(const Frame& F) {
    pg::DenseOrder<0> S; S.init(T, D, F.G, (int)blockIdx.x); pg::EpiPle E{F.H2, F.PROJ, F.RSTD2, F.H3}; pg::DenseMap AM{D};
    pg::gemm_run<pg::EpiPle, pg::DenseOrder<0>, pg::DenseMap, true>(F.lds + STAGE_OFF, F.H2, F.WPG, D, D / 64, S, E, AM);
}


namespace pg {
template <int MT, int NT, int NROWS_B>
struct MoeOrder {
    LAS const int* cnt; LAS const int* toff; int c;
    __device__ __forceinline__ bool next(int i, Unit& u) const {
        const int x = c & 7, cl = c >> 3, sb = i * 8 + x, mtg = MT * sb + cl / NT, pn = cl % NT;
        if (mtg >= toff[NE]) return false;
        int e = 0; while (toff[e + 1] <= mtg) ++e;
        u.arow = 256 * mtg; u.brow = e * NROWS_B + 256 * pn; u.kofs = 0; u.x0 = e; u.x1 = cnt[e] - 256 * (mtg - toff[e]); u.x2 = i; return true;
    }
};
struct GatherMap { static constexpr bool GATHER = true; LAS const unsigned* tab;
    __device__ __forceinline__ unsigned rowoff(const Unit& u, int r) const { return tab[u.x2 * 256 + r]; }
    __device__ __forceinline__ size_t base(const Unit&) const { return 0; } };
struct EpiSwiglu {
    bf16* HID; const float* b1;
    __device__ __forceinline__ bool keep(const Unit&) const { return false; }
    __device__ __forceinline__ void operator()(const Acc& acc, const Unit& u, int wr, int wc, int fr, int fq) const {
        const int e = u.x0, valid = u.x1, pn = (u.brow & 2047) >> 8, hid0 = 128 * pn + 32 * wc + 8 * fq;
        const f32x4* bp = (const f32x4*)(b1 + e * 2048 + 2 * hid0);
        const f32x4 f0 = bp[0], f1 = bp[1], f2 = bp[2], f3 = bp[3];
        const float bg[8] = {f0[0], f0[2], f1[0], f1[2], f2[0], f2[2], f3[0], f3[2]}, bl[8] = {f0[1], f0[3], f1[1], f1[3], f2[1], f2[3], f3[1], f3[3]};
#pragma unroll
        for (int ai = 0; ai < 2; ++ai)
#pragma unroll
            for (int m = 0; m < 4; ++m) { const int rl = ai * HALF + wr * 64 + m * 16 + fr;
                float o[8];
#pragma unroll
                for (int q = 0; q < 8; ++q) { float g = acc[ai][0][m][q >> 2][q & 3] + bg[q], l = acc[ai][1][m][q >> 2][q & 3] + bl[q];
                    g = fminf(g, 7.f); l = fminf(fmaxf(l, -7.f), 7.f); o[q] = g * sigm(1.702f * g) * (l + 1.f); }
                u32x4 w; w.x = cvt_pk_bf16(o[0], o[1]); w.y = cvt_pk_bf16(o[2], o[3]); w.z = cvt_pk_bf16(o[4], o[5]); w.w = cvt_pk_bf16(o[6], o[7]);
                if (rl < valid) *(u32x4*)(HID + (size_t)(u.arow + rl) * DE + hid0) = w; }
    }
};
struct EpiBias2 {
    bf16* YS; const float* b2;
    __device__ __forceinline__ bool keep(const Unit&) const { return false; }
    __device__ __forceinline__ void operator()(const Acc& acc, const Unit& u, int wr, int wc, int fr, int fq) const {
        const int e = u.x0, valid = u.x1, col0 = (u.brow & 1023) + 32 * wc + 8 * fq;
        f32x4 bb[2][2];
#pragma unroll
        for (int bj = 0; bj < 2; ++bj)
#pragma unroll
            for (int n = 0; n < 2; ++n) bb[bj][n] = *(const f32x4*)(b2 + e * D + col0 + bj * HALF + 4 * n);
#pragma unroll
        for (int ai = 0; ai < 2; ++ai)
#pragma unroll
            for (int m = 0; m < 4; ++m) { const int rl = ai * HALF + wr * 64 + m * 16 + fr;
#pragma unroll
                for (int bj = 0; bj < 2; ++bj) { const f32x4 v0 = acc[ai][bj][m][0] + bb[bj][0], v1 = acc[ai][bj][m][1] + bb[bj][1];
                    u32x4 w; w.x = cvt_pk_bf16(v0[0], v0[1]); w.y = cvt_pk_bf16(v0[2], v0[3]); w.z = cvt_pk_bf16(v1[0], v1[1]); w.w = cvt_pk_bf16(v1[2], v1[3]);
                    if (rl < valid) *(u32x4*)(YS + (size_t)(u.arow + rl) * D + col0 + bj * HALF) = w; } }
    }
};
}
__device__ __forceinline__ void p6_fast(const Frame& F) {
    const MoeTab M = moe_tables(F);
    pg::MoeOrder<4, 8, 2048> S{M.cnt, M.toff, (int)blockIdx.x};
    LAS unsigned* tab = (LAS unsigned*)(F.lds + TAB_OFF);
    { pg::Unit u;
      for (int i = 0; i < 20 && S.next(i, u); ++i) { const int e = u.x0, cnt = M.cnt[e], rk0 = cnt - u.x1;
          if (F.tid < 256) { const int rk = rk0 + F.tid; tab[i * 256 + F.tid] = (unsigned)F.TOKLIST[e * LCAP + (rk < cnt ? rk : cnt - 1)] * (unsigned)(D * 2); } } }
    __syncthreads();
    pg::EpiSwiglu E{F.HID, F.b1}; pg::GatherMap AM{tab};
    pg::gemm_run<pg::EpiSwiglu, pg::MoeOrder<4, 8, 2048>, pg::GatherMap, true>(F.lds + STAGE_OFF, F.ABF, F.W1T, D, D / 64, S, E, AM);
}
__device__ __forceinline__ void p7_fast(const Frame& F) {
    const MoeTab M = moe_tables(F);
    pg::MoeOrder<8, 4, 1024> S{M.cnt, M.toff, (int)blockIdx.x};
    pg::EpiBias2 E{F.YS, F.b2}; pg::DenseMap AM{DE};
    pg::gemm_run<pg::EpiBias2, pg::MoeOrder<8, 4, 1024>, pg::DenseMap, true>(F.lds + STAGE_OFF, F.HID, F.W2T, DE, DE / 64, S, E, AM);
}


typedef short s16x4 __attribute__((ext_vector_type(4)));
__device__ __forceinline__ s16x4 vtr(LAS const unsigned char* p) { return __builtin_bit_cast(s16x4, __builtin_amdgcn_ds_read_tr16_b64_v4i16((LAS s16x4*)p)); }
__device__ __forceinline__ bf16x8 cat8(s16x4 a, s16x4 b) { return (bf16x8){a[0], a[1], a[2], a[3], b[0], b[1], b[2], b[3]}; }
template <bool EARLY>
__device__ __forceinline__ void p2_attn_fast(const Frame& F) {
    const int lane = F.lane, r32 = lane & 31, hi = lane >> 5;
    LAS unsigned char* vl = F.lds + F.wave * 4096;
    LAS const unsigned char* vrd = vl + (4 * hi + ((lane & 15) >> 2)) * 64 + ((lane >> 4) & 1) * 32 + (lane & 3) * 8;
    const int gw = blockIdx.x * NWAVES + F.wave, NGW = F.G * NWAVES;
    for (int item = gw; item < BATCH * NH * (SEQ / 32); item += NGW) {
        const int qi = item >> 6, bh = item & 63, b = bh >> 3, h = bh & 7;
        const size_t rowbase = (size_t)b * SEQ;
        bf16x8 qf[4];
        { const bf16* qp = F.ZZ + (rowbase + 32 * qi + r32) * INC + ZQ + h * HD + 8 * hi;
#pragma unroll
          for (int d0 = 0; d0 < 4; ++d0) qf[d0] = *(const bf16x8*)(qp + 16 * d0); }
        f32x16 o[2]; o[0] = f32x16{}; o[1] = f32x16{};
        float carry = 1.0f;
        bf16x8 kn[4]; u32x4 vn[4];
#define ATT_LOAD(j) do { const bf16* kp = F.ZZ + (rowbase + 32 * (j) + r32) * INC + ZK + h * HD + 8 * hi; \
            _Pragma("unroll") for (int d0 = 0; d0 < 4; ++d0) kn[d0] = *(const bf16x8*)(kp + 16 * d0); \
            _Pragma("unroll") for (int i = 0; i < 4; ++i) { const int L = i * 64 + lane; \
                vn[i] = *(const u32x4*)(F.ZZ + (rowbase + 32 * (j) + ((L >> 2) & 31)) * INC + ZV + h * HD + (L >> 7) * 32 + (L & 3) * 8); } } while (0)
        ATT_LOAD(qi);
        for (int j = qi; j >= 0; --j) {
            bf16x8 kf[4];
#pragma unroll
            for (int d0 = 0; d0 < 4; ++d0) kf[d0] = kn[d0];
#pragma unroll
            for (int i = 0; i < 4; ++i) *(LAS u32x4*)(vl + (i * 64 + lane) * 16) = vn[i];
            if (j > 0) ATT_LOAD(j - 1);
            f32x16 p = f32x16{};
#pragma unroll
            for (int d0 = 0; d0 < 4; ++d0) p = __builtin_amdgcn_mfma_f32_32x32x16_bf16(kf[d0], qf[d0], p, 0, 0, 0);
            float e[16], sfx[16];
#pragma unroll
            for (int r = 0; r < 16; ++r) { const float z = fminf(p[r], 100.f); e[r] = __builtin_amdgcn_exp2f(z); sfx[r] = __builtin_amdgcn_rcpf(1.0f + e[r]); }
            if (j == qi) {
#pragma unroll
                for (int r = 0; r < 16; ++r) { const bool ok = crow(r, hi) < r32; e[r] = ok ? e[r] : 0.f; sfx[r] = ok ? sfx[r] : 1.f; }
            }
            float TL[4], TH[4];
#pragma unroll
            for (int g = 0; g < 4; ++g) {
                sfx[4 * g + 2] *= sfx[4 * g + 3]; sfx[4 * g + 1] *= sfx[4 * g + 2]; sfx[4 * g] *= sfx[4 * g + 1];
                const auto rr = __builtin_amdgcn_permlane32_swap(__float_as_uint(sfx[4 * g]), __float_as_uint(sfx[4 * g]), false, false);
                TL[g] = __uint_as_float(rr[0]); TH[g] = __uint_as_float(rr[1]); }
            float R[8];
            R[7] = carry; R[6] = R[7] * TH[3]; R[5] = R[6] * TL[3]; R[4] = R[5] * TH[2]; R[3] = R[4] * TL[2]; R[2] = R[3] * TH[1]; R[1] = R[2] * TL[1]; R[0] = R[1] * TH[0]; carry = R[0] * TL[0];
            unsigned pw[8];
#pragma unroll
            for (int g = 0; g < 4; ++g) { const float off = hi ? R[2 * g + 1] : R[2 * g];
                const float w0 = e[4 * g] * (off * sfx[4 * g]), w1 = e[4 * g + 1] * (off * sfx[4 * g + 1]), w2 = e[4 * g + 2] * (off * sfx[4 * g + 2]), w3 = e[4 * g + 3] * (off * sfx[4 * g + 3]);
                pw[2 * g] = pg::cvt_pk_bf16(w0, w1); pw[2 * g + 1] = pg::cvt_pk_bf16(w2, w3); }
            const bf16x8 pa0 = __builtin_bit_cast(bf16x8, (u32x4){pw[0], pw[1], pw[2], pw[3]}), pa1 = __builtin_bit_cast(bf16x8, (u32x4){pw[4], pw[5], pw[6], pw[7]});
            asm volatile("s_waitcnt lgkmcnt(0)" ::: "memory");
#pragma unroll
            for (int d0 = 0; d0 < 2; ++d0) {
                const s16x4 a0 = vtr(vrd + d0 * 2048), a1 = vtr(vrd + d0 * 2048 + 512), b0 = vtr(vrd + d0 * 2048 + 1024), b1 = vtr(vrd + d0 * 2048 + 1536);
                o[d0] = __builtin_amdgcn_mfma_f32_32x32x16_bf16(pa0, cat8(a0, a1), o[d0], 0, 0, 0);
                o[d0] = __builtin_amdgcn_mfma_f32_32x32x16_bf16(pa1, cat8(b0, b1), o[d0], 0, 0, 0);
            }
            asm volatile("s_waitcnt lgkmcnt(0)" ::: "memory");
            if (EARLY && __all(carry == 0.f)) break;
        }
#undef ATT_LOAD
        bf16* op = F.OAB + (rowbase + 32 * qi) * D + h * HD + r32;
#pragma unroll
        for (int d0 = 0; d0 < 2; ++d0)
#pragma unroll
            for (int r = 0; r < 16; ++r) op[(size_t)crow(r, hi) * D + 32 * d0] = (bf16)f2bf(o[d0][r]);
    }
}
__device__ __forceinline__ void p2_sgu_fast(const Frame& F) {
    const int lane = F.lane, r32 = lane & 31, hi = lane >> 5, g = F.wave;
    for (int unit = blockIdx.x; unit < T / 128; unit += F.G) {
        const int row0 = unit * 128;
        __syncthreads();
        for (int i = 0; i < 16; ++i) {
            const int rl = g * 16 + i;
            const u32x4 w = *(const u32x4*)(F.ZZ + (size_t)(row0 + rl) * INC + ZVS + 8 * lane);
            float f[8]; unpack8(w, f);
            float s = 0.f;
#pragma unroll
            for (int j = 0; j < 8; ++j) s += f[j];
            const float mean = wave_sum(s) * (1.f / 512.f);
            float s2 = 0.f;
#pragma unroll
            for (int j = 0; j < 8; ++j) { f[j] -= mean; s2 += f[j] * f[j]; }
            const float rstd = rsqrtf(wave_sum(s2) * (1.f / 512.f) + EPS);
            const f32x4 g0 = *(const f32x4*)(F.sgu_norm + 8 * lane), g1 = *(const f32x4*)(F.sgu_norm + 8 * lane + 4);
            u32x4 o; o.x = pk2(f[0] * rstd * g0.x, f[1] * rstd * g0.y); o.y = pk2(f[2] * rstd * g0.z, f[3] * rstd * g0.w);
            o.z = pk2(f[4] * rstd * g1.x, f[5] * rstd * g1.y); o.w = pk2(f[6] * rstd * g1.z, f[7] * rstd * g1.w);
            *(LAS u32x4*)(F.lds + (lane >> 2) * 8192 + rl * 64 + (lane & 3) * 16) = o;
        }
        __syncthreads();
        LAS const unsigned char* vrd = F.lds + (2 * g) * 8192 + (8 * hi + ((lane & 15) >> 2)) * 64 + ((lane >> 4) & 1) * 32 + (lane & 3) * 8;
        for (int mt = 0; mt < 4; ++mt) {
            f32x16 acc[2]; acc[0] = f32x16{}; acc[1] = f32x16{};
            const bf16* ap = F.SGUW + ((size_t)g * 128 + 32 * mt + r32) * 128 + 8 * hi;
            const int nks = (mt < 2) ? 4 : 8;
            for (int ks = 0; ks < nks; ++ks) {
                const bf16x8 a = *(const bf16x8*)(ap + 16 * ks);
#pragma unroll
                for (int nt = 0; nt < 2; ++nt) {
                    const s16x4 b0 = vtr(vrd + nt * 8192 + ks * 1024), b1 = vtr(vrd + nt * 8192 + ks * 1024 + 256);
                    acc[nt] = __builtin_amdgcn_mfma_f32_32x32x16_bf16(a, cat8(b0, b1), acc[nt], 0, 0, 0);
                }
            }
#pragma unroll
            for (int r = 0; r < 16; ++r) { const int tl = 32 * mt + crow(r, hi); const float bs = F.sgu_b[g * 128 + tl];
#pragma unroll
                for (int nt = 0; nt < 2; ++nt) { const int ch = 64 * g + 32 * nt + r32;
                    const float u = bf2f(F.ZZ[(size_t)(row0 + tl) * INC + ZU + ch]);
                    F.OAB[(size_t)(row0 + tl) * D + 512 + ch] = (bf16)f2bf(u * (acc[nt][r] + bs)); } }
        }
    }
    __syncthreads();
}


__device__ __forceinline__ void p5_fast(const Frame& F) {
    LAS unsigned* hist = (LAS unsigned*)F.lds;
    LAS unsigned* base = hist + 32;
    LAS unsigned* lsel = hist + 64;
    LAS float* lgate = (LAS float*)(hist + 64 + 512);
    LAS float* rsv = lgate + 512;
    LAS float* part = (LAS float*)(F.lds + 8192);
    const int lane = F.lane, r32 = lane & 31, hi = lane >> 5, wg4 = F.wave & 3, kh = F.wave >> 2;
    for (int chunk = blockIdx.x; chunk < T / 128; chunk += F.G) {
        if (F.tid < 32) hist[F.tid] = 0u;
        const int t0 = chunk * 128 + wg4 * 32;
        const bf16* hp = F.H1 + (size_t)(t0 + r32) * D + kh * 512 + 8 * hi;
        const bf16* whp = F.WRHI + r32 * D + kh * 512 + 8 * hi;
        const bf16* wlp = F.WRLO + r32 * D + kh * 512 + 8 * hi;
        f32x16 acc = f32x16{}; float ss = 0.f;
#pragma unroll 4
        for (int k0 = 0; k0 < 512; k0 += 16) {
            const u32x4 hb = *(const u32x4*)(hp + k0);
            const bf16x8 ah = *(const bf16x8*)(whp + k0), al = *(const bf16x8*)(wlp + k0);
            const bf16x8 bb = __builtin_bit_cast(bf16x8, hb);
            acc = __builtin_amdgcn_mfma_f32_32x32x16_bf16(ah, bb, acc, 0, 0, 0);
            acc = __builtin_amdgcn_mfma_f32_32x32x16_bf16(al, bb, acc, 0, 0, 0);
#pragma unroll
            for (int q = 0; q < 4; ++q) { const float lo = __uint_as_float(hb[q] << 16), hh = __uint_as_float(hb[q] & 0xffff0000u); ss += lo * lo + hh * hh; }
        }
        { const auto rr = __builtin_amdgcn_permlane32_swap(__float_as_uint(ss), __float_as_uint(ss), false, false); ss = __uint_as_float(rr[0]) + __uint_as_float(rr[1]); }
        if (kh == 1) {
#pragma unroll
            for (int r = 0; r < 16; ++r) part[(wg4 * 17 + r) * 64 + lane] = acc[r];
            part[(wg4 * 17 + 16) * 64 + lane] = ss;
        }
        __syncthreads();
        if (kh == 0) {
            ss += part[(wg4 * 17 + 16) * 64 + lane];
            const float rstd = rsqrtf(ss * (1.f / D) + EPS);
            float v[16];
#pragma unroll
            for (int r = 0; r < 16; ++r) v[r] = rstd * (acc[r] + part[(wg4 * 17 + r) * 64 + lane]) + F.b_router[crow(r, hi)];
            float cv[8]; int ce[8];
#pragma unroll
            for (int k = 0; k < 4; ++k) {
                float m = v[0];
#pragma unroll
                for (int r = 1; r < 16; ++r) m = fmaxf(m, v[r]);
                int idx = 15;
#pragma unroll
                for (int r = 14; r >= 0; --r) idx = (v[r] == m) ? r : idx;
                cv[k] = m; ce[k] = (idx & 3) + 8 * (idx >> 2) + 4 * hi;
#pragma unroll
                for (int r = 0; r < 16; ++r) v[r] = (r == idx) ? -INFINITY : v[r];
            }
#pragma unroll
            for (int k = 0; k < 4; ++k) {
                const auto rv = __builtin_amdgcn_permlane32_swap(__float_as_uint(cv[k]), __float_as_uint(cv[k]), false, false);
                const auto re = __builtin_amdgcn_permlane32_swap((unsigned)ce[k], (unsigned)ce[k], false, false);
                cv[4 + k] = __uint_as_float(hi ? rv[0] : rv[1]); ce[4 + k] = (int)(hi ? re[0] : re[1]);
            }
            float tv[4]; int te[4];
#pragma unroll
            for (int k = 0; k < 4; ++k) {
                float bv = cv[0]; int be = ce[0];
#pragma unroll
                for (int c = 1; c < 8; ++c) { const bool better = (cv[c] > bv) || (cv[c] == bv && ce[c] < be); bv = better ? cv[c] : bv; be = better ? ce[c] : be; }
                tv[k] = bv; te[k] = be;
#pragma unroll
                for (int c = 0; c < 8; ++c) cv[c] = (ce[c] == be) ? -INFINITY : cv[c];
            }
            float ex[4], sum = 0.f;
#pragma unroll
            for (int k = 0; k < 4; ++k) { ex[k] = __expf(tv[k] - tv[0]); sum += ex[k]; }
            if (hi == 0) { const int tl = wg4 * 32 + r32; rsv[tl] = rstd;
#pragma unroll
                for (int k = 0; k < 4; ++k) { const unsigned loc = atomicAdd((unsigned*)&hist[te[k]], 1u); lsel[tl * 4 + k] = (unsigned)te[k] | (loc << 8); lgate[tl * 4 + k] = ex[k] / sum; } }
        }
        __syncthreads();
        if (F.tid < 32) { const unsigned n = hist[F.tid]; base[F.tid] = n ? __hip_atomic_fetch_add(F.ctl + CW_CNT + 64 * F.tid, n, __ATOMIC_RELAXED, __HIP_MEMORY_SCOPE_AGENT) : 0u; }
        __syncthreads();
        { const int tl = F.tid >> 2, r = F.tid & 3, t = chunk * 128 + tl; const unsigned sl = lsel[tl * 4 + r]; const int ee = sl & 255; const unsigned rank = base[ee] + (sl >> 8);
          F.TOKLIST[ee * LCAP + rank] = t; F.SLOTREF[t * 4 + r] = (ee << 16) | rank; F.GATE[t * 4 + r] = lgate[tl * 4 + r]; }
        for (int i = 0; i < 16; ++i) {
            const int tl = F.wave * 16 + i, t = chunk * 128 + tl; const float rstd = rsv[tl];
            const u32x4* hr = (const u32x4*)(F.H1 + (size_t)t * D); u32x4* cr = (u32x4*)(F.ABF + (size_t)t * D);
#pragma unroll
            for (int j = 0; j < 2; ++j) { float f[8]; unpack8(hr[lane + 64 * j], f); u32x4 o; o.x = pk2(f[0] * rstd, f[1] * rstd); o.y = pk2(f[2] * rstd, f[3] * rstd); o.z = pk2(f[4] * rstd, f[5] * rstd); o.w = pk2(f[6] * rstd, f[7] * rstd); cr[lane + 64 * j] = o; }
        }
        __syncthreads();
    }
}

struct Args { const float* in[21]; float* out; unsigned char* ws; int ph_lo, ph_hi; };
__global__ void __launch_bounds__(NTHREADS, 2) fwd(Args args) {
    extern __shared__ __attribute__((aligned(16))) unsigned char lds[];
    Frame F;
    F.lds = (LAS unsigned char*)lds; F.MISC = (volatile LAS unsigned*)(F.lds + MISC_OFF);
    F.tid = threadIdx.x; F.lane = F.tid & 63; F.wave = __builtin_amdgcn_readfirstlane(F.tid >> 6); F.G = gridDim.x;
    unsigned char* ws = args.ws;
    F.ctl = (unsigned*)(ws + WS_CTL);
    F.x = args.in[0]; F.p = args.in[1]; F.g_mix = args.in[2]; F.w_in = args.in[3]; F.w_out_a = args.in[4]; F.w_out_b = args.in[5]; F.w_out = args.in[6];
    F.sgu_norm = args.in[7]; F.sgu_w = args.in[8]; F.sgu_b = args.in[9]; F.g_moe = args.in[10]; F.w_router = args.in[11]; F.b_router = args.in[12];
    F.w1 = args.in[13]; F.b1 = args.in[14]; F.w2 = args.in[15]; F.b2 = args.in[16]; F.g_ple = args.in[17]; F.w_ple_gate = args.in[18]; F.w_ple_proj = args.in[19]; F.g_final = args.in[20];
    F.out = args.out;
    F.WRHI = (bf16*)(ws + WS_WRHI); F.WRLO = (bf16*)(ws + WS_WRLO); F.SGUW = (bf16*)(ws + WS_SGUW); F.WIN = (bf16*)(ws + WS_WIN); F.WAB = (bf16*)(ws + WS_WAB);
    F.WOUT = (bf16*)(ws + WS_WOUT); F.WPG = (bf16*)(ws + WS_WPG); F.WPP = (bf16*)(ws + WS_WPP); F.W1T = (bf16*)(ws + WS_W1); F.W2T = (bf16*)(ws + WS_W2);
    F.PBF = (bf16*)(ws + WS_PBF); F.PROJ = (bf16*)(ws + WS_PROJ); F.H1 = (bf16*)(ws + WS_H1); F.ZZ = (bf16*)(ws + WS_ZZ); F.HID = (bf16*)(ws + WS_HID);
    F.H2 = (bf16*)(ws + WS_H2); F.H3 = (bf16*)(ws + WS_H3); F.ABF = (bf16*)(ws + WS_ABF); F.OAB = (bf16*)(ws + WS_OAB); F.MERGED = (bf16*)(ws + WS_MERGED); F.YS = (bf16*)(ws + WS_YS);
    F.RSTD1 = (float*)(ws + WS_RSTD1); F.RSTD2 = (float*)(ws + WS_RSTD2); F.GATE = (float*)(ws + WS_GATE);
    F.TOKLIST = (int*)(ws + WS_TOKLIST); F.SLOTREF = (int*)(ws + WS_SLOTREF);
    for (int u = F.tid; u < (LDS_BYTES - MISC_OFF) / 4; u += NTHREADS) ((LAS unsigned*)(F.lds + MISC_OFF))[u] = 0u;
    __syncthreads();
    XcdBarrier bar = xcd_barrier_post(F.ctl + CW_BAR, F.MISC + 8);
    const int lo = args.ph_lo, hi = args.ph_hi;
#define IN(k) (lo <= (k) && (k) < hi)
#define SEAM(k) do { if (IN(k) && IN((k) + 1)) xcd_barrier(bar); } while (0)
    if (IN(0)) { p0_prologue(F); } SEAM(0);
    if (IN(1)) { if (OPT_P1) p1_fast(F); else p1_inproj(F); } SEAM(1);
    if (IN(2)) { if (OPT_SGU) p2_sgu_fast(F); else p2_sgu_simple(F); if (OPT_ATT) p2_attn_fast<ATT_EARLY>(F); else p2_attn_scalar<false>(F); } SEAM(2);
    if (IN(3)) { if (OPT_P3) p3_fast(F); else p3_merge(F); } SEAM(3);
    if (IN(4)) { if (OPT_P4) p4_fast(F); else p4_out(F); } SEAM(4);
    if (IN(5)) { if (OPT_P5) p5_fast(F); else p5_router(F); } SEAM(5);
    if (IN(6)) { if (OPT_P6) p6_fast(F); else p6_moe1(F); } SEAM(6);
    if (IN(7)) { if (OPT_P7) p7_fast(F); else p7_moe2(F); } SEAM(7);
    if (IN(8)) { p8_combine(F); } SEAM(8);
    if (IN(9)) { if (OPT_P9) p9_fast(F); else p9_ple(F); } SEAM(9);
    if (IN(10)) { p10_final(F); }
#undef IN
#undef SEAM
}

extern "C" void kernel_launch(void* const* d_in, const int* in_sizes, int n_in, void* d_out, int out_size, void* d_ws, size_t ws_size, hipStream_t stream) {
    static int grid = 0;
    if (grid == 0) {
        if (n_in != 21 || out_size != T * D || ws_size < WS_END) { fprintf(stderr, "kernel_launch: unexpected shapes (n_in %d out %d ws %zu)\n", n_in, out_size, ws_size); grid = -1; return; }
        int dev = 0, cus = 0;
        if (hipGetDevice(&dev) != hipSuccess || hipDeviceGetAttribute(&cus, hipDeviceAttributeMultiprocessorCount, dev) != hipSuccess) { grid = -1; return; }
        if (hipFuncSetAttribute((const void*)fwd, hipFuncAttributeMaxDynamicSharedMemorySize, LDS_BYTES) != hipSuccess) { fprintf(stderr, "kernel_launch: hipFuncSetAttribute failed\n"); grid = -1; return; }
        int per_cu = 0;
        if (hipOccupancyMaxActiveBlocksPerMultiprocessor(&per_cu, (const void*)fwd, NTHREADS, LDS_BYTES) != hipSuccess || per_cu < 1) fprintf(stderr, "kernel_launch: occupancy query says %d\n", per_cu);
        (void)hipGetLastError();
        if (cus < 256) { fprintf(stderr, "kernel_launch: needs >= 256 CUs, found %d\n", cus); grid = -1; return; }
        grid = 256;
    }
    if (grid < 0) return;
    (void)hipMemsetAsync((char*)d_ws + WS_CTL, 0, CTL_ZERO_BYTES, stream);
    Args a{};
    for (int i = 0; i < 21; ++i) a.in[i] = (const float*)d_in[i];
    a.out = (float*)d_out; a.ws = (unsigned char*)d_ws; a.ph_lo = 0; a.ph_hi = 11;
    hipLaunchKernelGGL(fwd, dim3(grid), dim3(NTHREADS), LDS_BYTES, stream, a);
}
```

```cpp
#include <hip/hip_runtime.h>
#include <cstdio>
#include <cstdint>

#define GAS __attribute__((address_space(1)))
#define LAS __attribute__((address_space(3)))
typedef unsigned short bf16;
typedef short bf16x8 __attribute__((ext_vector_type(8)));
typedef float f32x4 __attribute__((ext_vector_type(4)));
typedef float f32x16 __attribute__((ext_vector_type(16)));
typedef unsigned u32x4 __attribute__((ext_vector_type(4)));
typedef unsigned u32x2 __attribute__((ext_vector_type(2)));

#ifndef OPT_P1
#define OPT_P1 1
#endif
#ifndef OPT_P3
#define OPT_P3 1
#endif
#ifndef OPT_P4
#define OPT_P4 1
#endif
#ifndef OPT_P6
#define OPT_P6 1
#endif
#ifndef OPT_P7
#define OPT_P7 1
#endif
#ifndef OPT_ATT
#define OPT_ATT 1
#endif
#ifndef OPT_SGU
#define OPT_SGU 1
#endif
#ifndef ATT_EARLY
#define ATT_EARLY true
#endif
#ifndef OPT_P5
#define OPT_P5 1
#endif
#ifndef OPT_P9
#define OPT_P9 1
#endif
constexpr int BATCH = 8, SEQ = 4096, T = BATCH * SEQ, D = 1024, PLE = 256, NH = 8, HD = 64, NE = 32, DE = 1024, INC = 4608;
constexpr int ZQ = 0, ZK = 512, ZV = 1024, ZU = 1536, ZVS = 2048, ZGA = 2560, ZGB = 3584;
constexpr float EPS = 1e-6f;
constexpr float LOG2E = 1.4426950408889634f;
constexpr float QSCALE = 0.125f * LOG2E;
constexpr int LCAP = 32768;
constexpr int HROWS = 139264;

constexpr size_t MiB = 1u << 20;
constexpr size_t WS_CTL = 0, CTL_ZERO_BYTES = 1 * MiB;
constexpr size_t WS_WRHI = 1 * MiB, WS_WRLO = WS_WRHI + 65536, WS_SGUW = WS_WRLO + 65536;
constexpr size_t WS_RSTD1 = WS_SGUW + 262144, WS_RSTD2 = WS_RSTD1 + 131072;
constexpr size_t WS_WIN = 2 * MiB, WS_WAB = 11 * MiB, WS_WOUT = 13 * MiB, WS_WPG = 15 * MiB, WS_WPP = 17 * MiB;
constexpr size_t WS_TOKLIST = 18 * MiB, WS_SLOTREF = 22 * MiB, WS_GATE = WS_SLOTREF + 524288;
constexpr size_t WS_W1 = 28 * MiB, WS_W2 = 156 * MiB, WS_PBF = 220 * MiB, WS_PROJ = 236 * MiB, WS_H1 = 300 * MiB;
constexpr size_t WS_R1 = 364 * MiB;
constexpr size_t WS_ZZ = WS_R1, WS_HID = WS_R1, WS_H2 = WS_R1, WS_H3 = WS_R1 + 64 * MiB;
constexpr size_t WS_R2 = 652 * MiB;
constexpr size_t WS_ABF = WS_R2, WS_OAB = WS_R2 + 64 * MiB, WS_MERGED = WS_R2 + 128 * MiB, WS_YS = WS_R2;
constexpr size_t WS_END = 924 * MiB;
constexpr int CW_BAR = 4096, CW_CNT = 8192;

constexpr int STAGE_OFF = 0, TAB_OFF = 131072, BIAS_OFF = 149504, MISC_OFF = 151552;
constexpr int LDS_BYTES = 152576;
constexpr int NWAVES = 8, NTHREADS = 512;

#define LDS_WAIT() asm volatile("s_waitcnt lgkmcnt(0)" ::: "memory")
__device__ __forceinline__ float bf2f(unsigned v) { return __uint_as_float(v << 16); }
__device__ __forceinline__ unsigned f2bf(float f) { unsigned u = __float_as_uint(f); return (u + 0x7fffu + ((u >> 16) & 1u)) >> 16; }
__device__ __forceinline__ unsigned pk2(float lo, float hi) { return f2bf(lo) | (f2bf(hi) << 16); }
__device__ __forceinline__ float wave_sum(float v) {
#pragma unroll
    for (int o = 1; o < 64; o <<= 1) v += __shfl_xor(v, o);
    return v;
}
__device__ __forceinline__ float wave_max(float v) {
#pragma unroll
    for (int o = 1; o < 64; o <<= 1) v = fmaxf(v, __shfl_xor(v, o));
    return v;
}
__device__ __forceinline__ float sigmoidf_(float x) { return 1.0f / (1.0f + __expf(-x)); }
__device__ __forceinline__ float gelu_tanh(float x) {
    const float u = 1.5957691216057308f * (x + 0.044715f * x * x * x);
    return x * sigmoidf_(u);
}
__device__ __forceinline__ int crow(int r, int hi) { return (r & 3) + 8 * (r >> 2) + 4 * hi; }
__device__ __forceinline__ void unpack8(const u32x4 w, float (&f)[8]) {
    f[0] = bf2f(w.x & 0xffffu); f[1] = bf2f(w.x >> 16); f[2] = bf2f(w.y & 0xffffu); f[3] = bf2f(w.y >> 16);
    f[4] = bf2f(w.z & 0xffffu); f[5] = bf2f(w.z >> 16); f[6] = bf2f(w.w & 0xffffu); f[7] = bf2f(w.w >> 16);
}

#define XB_TMO      128
#define XB_XCNT(j)  (256  + 64 * (j))
#define XB_XSUB(j)  (1280 + 64 * (j))
#define XB_XGEN(j)  (2304 + 64 * (j))
#define XB_TOP      3328
#define XB_TOPGEN   3392
#define XCD_BAR_WORDS 3456
#define XB_SPIN_CAP (1u << 23)
__device__ __forceinline__ unsigned xb_ld(unsigned* p)              { return __hip_atomic_load(p, __ATOMIC_RELAXED, __HIP_MEMORY_SCOPE_AGENT); }
__device__ __forceinline__ unsigned xb_add(unsigned* p, unsigned v) { return __hip_atomic_fetch_add(p, v, __ATOMIC_RELAXED, __HIP_MEMORY_SCOPE_AGENT); }
__device__ __forceinline__ unsigned xb_xcc_id() { return (unsigned)__builtin_amdgcn_s_getreg((3 << 11) | 20) & 0xFu; }
#define XB_SPIN(cond, bar) do { unsigned _sp = 0; while (cond) { __builtin_amdgcn_s_sleep(1); \
    if ((++_sp & 255u) == 0u) { if (xb_ld(&(bar)[XB_TMO])) break; if (_sp > XB_SPIN_CAP) { atomicAdd(&(bar)[XB_TMO], 1u); break; } } } } while (0)
struct XcdBarrier { unsigned* bar; unsigned x; volatile LAS unsigned* st; };
__device__ __forceinline__ XcdBarrier xcd_barrier_post(unsigned* bar, volatile LAS unsigned* st) {
    XcdBarrier b; b.bar = bar; b.x = xb_xcc_id(); b.st = st;
    if (threadIdx.x == 0) (void)xb_add(&bar[XB_XCNT(b.x)], 1u);
    return b;
}
__device__ __forceinline__ void xcd_barrier_complete(unsigned* bar, unsigned x, unsigned& nloc, unsigned& nx) {
    const unsigned G = gridDim.x * gridDim.y * gridDim.z;
    unsigned sum, cnt, mine, sp = 0u;
    for (;;) {
        sum = 0u; cnt = 0u; mine = 0u;
#pragma unroll
        for (unsigned j = 0; j < 16; ++j) { const unsigned c = xb_ld(&bar[XB_XCNT(j)]); sum += c; cnt += (c > 0u) ? 1u : 0u; mine = (j == x) ? c : mine; }
        if (sum == G) break;
        __builtin_amdgcn_s_sleep(1);
        if ((++sp & 255u) == 0u) { if (xb_ld(&bar[XB_TMO])) break; if (sp > XB_SPIN_CAP) { atomicAdd(&bar[XB_TMO], 1u); break; } }
    }
    nloc = mine > 0u ? mine : 1u; nx = cnt > 0u ? cnt : 1u;
}
__device__ __forceinline__ void xcd_barrier(const XcdBarrier& b) {
    asm volatile("s_waitcnt vmcnt(0)" ::: "memory");
    __syncthreads();
    if (threadIdx.x == 0) {
        unsigned* bar = b.bar;
        __builtin_amdgcn_s_waitcnt(0);
        unsigned nloc = b.st[0], nx = b.st[1];
        if (nloc == 0u) { xcd_barrier_complete(bar, b.x, nloc, nx); b.st[0] = nloc; b.st[1] = nx; }
        const unsigned old = xb_add(&bar[XB_XSUB(b.x)], 1u);
        const unsigned gen = old / nloc;
        if (old + 1u == (gen + 1u) * nloc) {
            __builtin_amdgcn_fence(__ATOMIC_RELEASE, "agent");
            asm volatile("s_waitcnt vmcnt(0)" ::: "memory");
            const unsigned og = xb_add(&bar[XB_TOP], 1u);
            const unsigned tg = og / nx;
            if (og + 1u == (tg + 1u) * nx) xb_add(&bar[XB_TOPGEN], 1u);
            else XB_SPIN(xb_ld(&bar[XB_TOPGEN]) == tg, bar);
            __builtin_amdgcn_fence(__ATOMIC_ACQUIRE, "agent");
            xb_add(&bar[XB_XGEN(b.x)], 1u);
            asm volatile("s_waitcnt vmcnt(0)" ::: "memory");
        } else {
            XB_SPIN(xb_ld(&bar[XB_XGEN(b.x)]) == gen, bar);
            __builtin_amdgcn_fence(__ATOMIC_ACQUIRE, "agent");
            asm volatile("s_waitcnt vmcnt(0)" ::: "memory");
        }
    }
    __syncthreads();
}

struct Frame {
    LAS unsigned char* lds;
    volatile LAS unsigned* MISC;
    unsigned* ctl;
    int tid, lane, wave, G;
    const float *x, *p, *g_mix, *w_in, *w_out_a, *w_out_b, *w_out, *sgu_norm, *sgu_w, *sgu_b, *g_moe, *w_router, *b_router, *w1, *b1, *w2, *b2, *g_ple, *w_ple_gate, *w_ple_proj, *g_final;
    float* out;
    bf16 *WRHI, *WRLO, *SGUW, *WIN, *WAB, *WOUT, *WPG, *WPP, *W1T, *W2T, *PBF, *PROJ, *H1, *ZZ, *HID, *H2, *H3, *ABF, *OAB, *MERGED, *YS;
    float *RSTD1, *RSTD2, *GATE;
    int *TOKLIST, *SLOTREF;
};

template <int NB>
__device__ __forceinline__ void smma(const bf16* ap, const bf16* const (&bp)[NB], int K, f32x16 (&acc)[NB]) {
    for (int k0 = 0; k0 < K; k0 += 16) {
        const bf16x8 a = *(const bf16x8*)(ap + k0);
#pragma unroll
        for (int nb = 0; nb < NB; ++nb) { const bf16x8 b = *(const bf16x8*)(bp[nb] + k0); acc[nb] = __builtin_amdgcn_mfma_f32_32x32x16_bf16(a, b, acc[nb], 0, 0, 0); }
    }
}

struct RowId { __device__ __forceinline__ int operator()(int n) const { return n; } };
struct RowW1 { __device__ __forceinline__ int operator()(int n) const { const int hid = n >> 1; return 256 * (hid >> 7) + (hid & 127) + 128 * (n & 1); } };
template <class RM>
__device__ __forceinline__ void tr_item(const float* W, int N, const float* gk, bf16* WT, int ldt, int koff, RM rm, LAS float* scr, int kb, int nb, int lane, float sc = 1.0f) {
    const int k0 = kb * 64, n0 = nb * 64;
    f32x4 v[16];
#pragma unroll
    for (int i = 0; i < 16; ++i) v[i] = __builtin_nontemporal_load((const f32x4*)(W + (size_t)(k0 + 4 * i + (lane >> 4)) * N + n0 + (lane & 15) * 4));
#pragma unroll
    for (int i = 0; i < 16; ++i) {
        const int kk = 4 * i + (lane >> 4), n4 = (lane & 15) * 4;
        f32x4 x = v[i] * sc;
        if (gk) x = x * gk[k0 + kk];
        LAS float* s = scr + kk * 65 + n4;
        s[0] = x.x; s[1] = x.y; s[2] = x.z; s[3] = x.w;
    }
    LDS_WAIT(); asm volatile("" ::: "memory");
    const int c = lane & 7;
#pragma unroll
    for (int j = 0; j < 8; ++j) {
        const int n = (lane >> 3) + 8 * j;
        const LAS float* s = scr + (8 * c) * 65 + n;
        u32x4 o; o.x = pk2(s[0 * 65], s[1 * 65]); o.y = pk2(s[2 * 65], s[3 * 65]); o.z = pk2(s[4 * 65], s[5 * 65]); o.w = pk2(s[6 * 65], s[7 * 65]);
        *(u32x4*)(WT + (size_t)rm(n0 + n) * ldt + koff + k0 + 8 * c) = o;
    }
    LDS_WAIT(); asm volatile("" ::: "memory");
}
__device__ __forceinline__ void p0_prologue(const Frame& F) {
    LAS float* scr = (LAS float*)(F.lds + F.wave * 16640);
    const int gw = blockIdx.x * NWAVES + F.wave, NGW = F.G * NWAVES;
    constexpr int I_IN = 16 * 72, I_A = 8 * 16, I_B = 8 * 16, I_O = 16 * 16, I_PG = 16 * 16, I_PP = 4 * 16, I_W1 = NE * 16 * 32, I_W2 = NE * 16 * 16;
    constexpr int NITEMS = I_IN + I_A + I_B + I_O + I_PG + I_PP + I_W1 + I_W2;
    for (int it = gw; it < NITEMS; it += NGW) {
        int r = it;
        if (r < I_IN) { tr_item(F.w_in, INC, nullptr, F.WIN, D, 0, RowId(), scr, r / 72, r % 72, F.lane, (r % 72) < 8 ? QSCALE : 1.0f); continue; } r -= I_IN;
        if (r < I_A) { tr_item(F.w_out_a, D, nullptr, F.WAB, D, 0, RowId(), scr, r / 16, r % 16, F.lane); continue; } r -= I_A;
        if (r < I_B) { tr_item(F.w_out_b, D, nullptr, F.WAB, D, 512, RowId(), scr, r / 16, r % 16, F.lane); continue; } r -= I_B;
        if (r < I_O) { tr_item(F.w_out, D, nullptr, F.WOUT, D, 0, RowId(), scr, r / 16, r % 16, F.lane); continue; } r -= I_O;
        if (r < I_PG) { tr_item(F.w_ple_gate, D, F.g_ple, F.WPG, D, 0, RowId(), scr, r / 16, r % 16, F.lane); continue; } r -= I_PG;
        if (r < I_PP) { tr_item(F.w_ple_proj, D, nullptr, F.WPP, PLE, 0, RowId(), scr, r / 16, r % 16, F.lane); continue; } r -= I_PP;
        if (r < I_W1) { const int e = r / 512, q = r % 512; tr_item(F.w1 + (size_t)e * D * 2 * DE, 2 * DE, F.g_moe, F.W1T + (size_t)e * 2 * DE * D, D, 0, RowW1(), scr, q / 32, q % 32, F.lane); continue; } r -= I_W1;
        { const int e = r / 256, q = r % 256; tr_item(F.w2 + (size_t)e * DE * D, D, nullptr, F.W2T + (size_t)e * D * DE, DE, 0, RowId(), scr, q / 16, q % 16, F.lane); }
    }
    for (int m0 = 2 * gw; m0 < T; m0 += 2 * NGW) {
        f32x4 v[2][4];
#pragma unroll
        for (int u = 0; u < 2; ++u) { const f32x4* xr = (const f32x4*)(F.x + (size_t)(m0 + u) * D) + F.lane;
#pragma unroll
            for (int j = 0; j < 4; ++j) v[u][j] = __builtin_nontemporal_load(xr + 64 * j); }
#pragma unroll
        for (int u = 0; u < 2; ++u) { float s = 0.f;
#pragma unroll
            for (int j = 0; j < 4; ++j) s += (v[u][j].x * v[u][j].x + v[u][j].y * v[u][j].y) + (v[u][j].z * v[u][j].z + v[u][j].w * v[u][j].w);
            const float rstd = rsqrtf(wave_sum(s) * (1.f / D) + EPS);
            unsigned long long* o8 = (unsigned long long*)(F.ABF + (size_t)(m0 + u) * D) + F.lane;
#pragma unroll
            for (int j = 0; j < 4; ++j) { const f32x4 g = ((const f32x4*)F.g_mix)[F.lane + 64 * j];
                o8[64 * j] = (unsigned long long)pk2(v[u][j].x * rstd * g.x, v[u][j].y * rstd * g.y) | ((unsigned long long)pk2(v[u][j].z * rstd * g.z, v[u][j].w * rstd * g.w) << 32); } }
    }
    for (int m0 = 4 * gw; m0 < T; m0 += 4 * NGW) {
        f32x4 v[4];
#pragma unroll
        for (int u = 0; u < 4; ++u) v[u] = __builtin_nontemporal_load((const f32x4*)(F.p + (size_t)(m0 + u) * PLE) + F.lane);
#pragma unroll
        for (int u = 0; u < 4; ++u) ((unsigned long long*)(F.PBF + (size_t)(m0 + u) * PLE))[F.lane] = (unsigned long long)pk2(v[u].x, v[u].y) | ((unsigned long long)pk2(v[u].z, v[u].w) << 32);
    }
    const int gt = blockIdx.x * NTHREADS + F.tid, NGT = F.G * NTHREADS;
    for (int i = gt; i < NE * D; i += NGT) { const int e = i / D, k = i % D; const float v = F.w_router[k * NE + e] * F.g_moe[k]; const unsigned h = f2bf(v); F.WRHI[i] = (bf16)h; F.WRLO[i] = (bf16)f2bf(v - bf2f(h)); }
    for (int i = gt; i < 8 * 128 * 128; i += NGT) { const int t = (i >> 7) & 127, s = i & 127; F.SGUW[i] = (bf16)(((s >> 6) <= (t >> 6)) ? f2bf(F.sgu_w[i]) : 0u); }
}

__device__ __forceinline__ void p1_inproj(const Frame& F) {
    const int gw = blockIdx.x * NWAVES + F.wave, NGW = F.G * NWAVES, r32 = F.lane & 31, hi = F.lane >> 5;
    for (int tile = gw; tile < (T / 32) * (INC / 128); tile += NGW) {
        const int mb = tile / (INC / 128), cg = tile % (INC / 128), m0 = mb * 32, n0 = cg * 128;
        const bf16* ap = F.ABF + (size_t)(m0 + r32) * D + 8 * hi;
        const bf16* bp[4];
#pragma unroll
        for (int nb = 0; nb < 4; ++nb) bp[nb] = F.WIN + (size_t)(n0 + 32 * nb + r32) * D + 8 * hi;
        f32x16 acc[4];
#pragma unroll
        for (int nb = 0; nb < 4; ++nb) acc[nb] = f32x16{};
        smma<4>(ap, bp, D, acc);
        const int kind = (n0 < ZK) ? 0 : (n0 < ZU) ? 1 : (n0 < ZGA) ? 2 : 3;
#pragma unroll
        for (int nb = 0; nb < 4; ++nb)
#pragma unroll
            for (int r = 0; r < 16; ++r) {
                float v = acc[nb][r];
                if (kind == 2) v = gelu_tanh(v); else if (kind == 3) v = sigmoidf_(v);
                F.ZZ[(size_t)(m0 + crow(r, hi)) * INC + n0 + 32 * nb + r32] = (bf16)f2bf(v);
            }
    }
    for (int tile = gw; tile < (T / 32) * (D / 128); tile += NGW) {
        const int mb = tile / (D / 128), cg = tile % (D / 128), m0 = mb * 32, n0 = cg * 128;
        const bf16* ap = F.PBF + (size_t)(m0 + r32) * PLE + 8 * hi;
        const bf16* bp[4];
#pragma unroll
        for (int nb = 0; nb < 4; ++nb) bp[nb] = F.WPP + (size_t)(n0 + 32 * nb + r32) * PLE + 8 * hi;
        f32x16 acc[4];
#pragma unroll
        for (int nb = 0; nb < 4; ++nb) acc[nb] = f32x16{};
        smma<4>(ap, bp, PLE, acc);
#pragma unroll
        for (int nb = 0; nb < 4; ++nb)
#pragma unroll
            for (int r = 0; r < 16; ++r) F.PROJ[(size_t)(m0 + crow(r, hi)) * D + n0 + 32 * nb + r32] = (bf16)f2bf(acc[nb][r]);
    }
}

template <bool EARLY>
__device__ __forceinline__ void p2_attn_scalar(const Frame& F) {
    LAS u32x4* Kt = (LAS u32x4*)F.lds;
    LAS u32x4* Vt = Kt + 512;
    for (int pr = blockIdx.x; pr < 256; pr += F.G) {
        for (int half = 0; half < 2; ++half) {
            const int bh = pr >> 2, tb = half == 0 ? (pr & 3) : 7 - (pr & 3), b = bh / NH, h = bh % NH;
            const int t = tb * 512 + F.tid;
            const size_t row = (size_t)b * SEQ + t;
            float q[64], o[64];
            { const u32x4* qp = (const u32x4*)(F.ZZ + row * INC + ZQ + h * HD);
#pragma unroll
              for (int c = 0; c < 8; ++c) { float f[8]; unpack8(qp[c], f);
#pragma unroll
                  for (int j = 0; j < 8; ++j) q[8 * c + j] = f[j]; } }
#pragma unroll
            for (int d = 0; d < 64; ++d) o[d] = 0.f;
            float carry = 1.f;
            for (int kt = tb * 8 + 7; kt >= 0; --kt) {
                __syncthreads();
                { const int kr = F.tid >> 3, c = F.tid & 7; const size_t krow = ((size_t)b * SEQ + kt * 64 + kr) * INC + h * HD + 8 * c;
                  Kt[F.tid] = *(const u32x4*)(F.ZZ + krow + ZK); Vt[F.tid] = *(const u32x4*)(F.ZZ + krow + ZV); }
                __syncthreads();
                for (int sl = 63; sl >= 0; --sl) {
                    const int s = kt * 64 + sl;
                    if (s < t) {
                        float z = 0.f;
#pragma unroll
                        for (int c = 0; c < 8; ++c) { float f[8]; unpack8(Kt[sl * 8 + c], f);
#pragma unroll
                            for (int j = 0; j < 8; ++j) z += q[8 * c + j] * f[j]; }
                        z = fminf(z, 100.f);
                        const float e = exp2f(z), r = 1.0f / (1.0f + e);
                        carry *= r;
                        const float w = e * carry;
#pragma unroll
                        for (int c = 0; c < 8; ++c) { float f[8]; unpack8(Vt[sl * 8 + c], f);
#pragma unroll
                            for (int j = 0; j < 8; ++j) o[8 * c + j] += w * f[j]; }
                    }
                }
            }
            u32x4* op = (u32x4*)(F.OAB + row * D + h * HD);
#pragma unroll
            for (int c = 0; c < 8; ++c) { u32x4 w; w.x = pk2(o[8 * c], o[8 * c + 1]); w.y = pk2(o[8 * c + 2], o[8 * c + 3]); w.z = pk2(o[8 * c + 4], o[8 * c + 5]); w.w = pk2(o[8 * c + 6], o[8 * c + 7]); op[c] = w; }
        }
    }
    __syncthreads();
}
__device__ __forceinline__ void p2_sgu_simple(const Frame& F) {
    LAS bf16* vsn = (LAS bf16*)F.lds;
    for (int unit = blockIdx.x; unit < T / 128; unit += F.G) {
        const int row0 = unit * 128;
        for (int i = 0; i < 16; ++i) {
            const int rl = F.wave * 16 + i;
            const u32x4 w = *(const u32x4*)(F.ZZ + (size_t)(row0 + rl) * INC + ZVS + 8 * F.lane);
            float f[8]; unpack8(w, f);
            float s = 0.f;
#pragma unroll
            for (int j = 0; j < 8; ++j) s += f[j];
            const float mean = wave_sum(s) * (1.f / 512.f);
            float s2 = 0.f;
#pragma unroll
            for (int j = 0; j < 8; ++j) { f[j] -= mean; s2 += f[j] * f[j]; }
            const float rstd = rsqrtf(wave_sum(s2) * (1.f / 512.f) + EPS);
            const f32x4 g0 = *(const f32x4*)(F.sgu_norm + 8 * F.lane), g1 = *(const f32x4*)(F.sgu_norm + 8 * F.lane + 4);
            u32x4 o; o.x = pk2(f[0] * rstd * g0.x, f[1] * rstd * g0.y); o.y = pk2(f[2] * rstd * g0.z, f[3] * rstd * g0.w);
            o.z = pk2(f[4] * rstd * g1.x, f[5] * rstd * g1.y); o.w = pk2(f[6] * rstd * g1.z, f[7] * rstd * g1.w);
            *(LAS u32x4*)(vsn + rl * 512 + 8 * F.lane) = o;
        }
        __syncthreads();
        const int ch = F.tid, g = ch >> 6;
        for (int tl = 0; tl < 128; ++tl) {
            const bf16* wrow = F.SGUW + (g * 128 + tl) * 128;
            float a = 0.f;
            for (int s = 0; s < 128; ++s) a += bf2f(wrow[s]) * bf2f(vsn[s * 512 + ch]);
            const float sv = a + F.sgu_b[g * 128 + tl];
            const float u = bf2f(F.ZZ[(size_t)(row0 + tl) * INC + ZU + ch]);
            F.OAB[(size_t)(row0 + tl) * D + 512 + ch] = (bf16)f2bf(u * sv);
        }
        __syncthreads();
    }
}

__device__ __forceinline__ void p3_merge(const Frame& F) {
    const int gw = blockIdx.x * NWAVES + F.wave, NGW = F.G * NWAVES, r32 = F.lane & 31, hi = F.lane >> 5;
    for (int tile = gw; tile < (T / 32) * (D / 128); tile += NGW) {
        const int mb = tile / (D / 128), cg = tile % (D / 128), m0 = mb * 32, n0 = cg * 128;
        const bf16* ap = F.OAB + (size_t)(m0 + r32) * D + 8 * hi;
        const bf16* bp[4];
#pragma unroll
        for (int nb = 0; nb < 4; ++nb) bp[nb] = F.WAB + (size_t)(n0 + 32 * nb + r32) * D + 8 * hi;
        f32x16 acca[4], accb[4];
#pragma unroll
        for (int nb = 0; nb < 4; ++nb) { acca[nb] = f32x16{}; accb[nb] = f32x16{}; }
        smma<4>(ap, bp, 512, acca);
        const bf16* ap2 = ap + 512; const bf16* bp2[4];
#pragma unroll
        for (int nb = 0; nb < 4; ++nb) bp2[nb] = bp[nb] + 512;
        smma<4>(ap2, bp2, 512, accb);
#pragma unroll
        for (int nb = 0; nb < 4; ++nb)
#pragma unroll
            for (int r = 0; r < 16; ++r) {
                const size_t row = m0 + crow(r, hi); const int col = n0 + 32 * nb + r32;
                const float sga = bf2f(F.ZZ[row * INC + ZGA + col]), sgb = bf2f(F.ZZ[row * INC + ZGB + col]);
                F.MERGED[row * D + col] = (bf16)f2bf(sga * acca[nb][r] + sgb * accb[nb][r]);
            }
    }
}
__device__ __forceinline__ void p4_out(const Frame& F) {
    const int gw = blockIdx.x * NWAVES + F.wave, NGW = F.G * NWAVES, r32 = F.lane & 31, hi = F.lane >> 5;
    for (int tile = gw; tile < (T / 32) * (D / 128); tile += NGW) {
        const int mb = tile / (D / 128), cg = tile % (D / 128), m0 = mb * 32, n0 = cg * 128;
        const bf16* ap = F.MERGED + (size_t)(m0 + r32) * D + 8 * hi;
        const bf16* bp[4];
#pragma unroll
        for (int nb = 0; nb < 4; ++nb) bp[nb] = F.WOUT + (size_t)(n0 + 32 * nb + r32) * D + 8 * hi;
        f32x16 acc[4];
#pragma unroll
        for (int nb = 0; nb < 4; ++nb) acc[nb] = f32x16{};
        smma<4>(ap, bp, D, acc);
#pragma unroll
        for (int nb = 0; nb < 4; ++nb)
#pragma unroll
            for (int r = 0; r < 16; ++r) {
                const size_t row = m0 + crow(r, hi); const int col = n0 + 32 * nb + r32;
                F.H1[row * D + col] = (bf16)f2bf(F.x[row * D + col] + acc[nb][r]);
            }
    }
}
__device__ __forceinline__ void p5_router(const Frame& F) {
    LAS unsigned* hist = (LAS unsigned*)F.lds;
    LAS unsigned* base = hist + 32;
    LAS unsigned* lsel = hist + 64;
    LAS float* lgate = (LAS float*)(hist + 64 + 512);
    const int e = F.lane & 31, half = F.lane >> 5;
    for (int chunk = blockIdx.x; chunk < T / 128; chunk += F.G) {
        if (F.tid < 32) hist[F.tid] = 0u;
        __syncthreads();
        for (int i = 0; i < 16; ++i) {
            const int tl = F.wave * 16 + i, t = chunk * 128 + tl;
            const bf16* hp = F.H1 + (size_t)t * D + half * 512;
            const bf16* whi = F.WRHI + e * D + half * 512;
            const bf16* wlo = F.WRLO + e * D + half * 512;
            float dot = 0.f, ss = 0.f;
            for (int k = 0; k < 512; k += 8) {
                float hf[8], a[8], c[8];
                unpack8(*(const u32x4*)(hp + k), hf); unpack8(*(const u32x4*)(whi + k), a); unpack8(*(const u32x4*)(wlo + k), c);
#pragma unroll
                for (int j = 0; j < 8; ++j) { dot += hf[j] * (a[j] + c[j]); ss += hf[j] * hf[j]; }
            }
            dot += __shfl_xor(dot, 32); ss += __shfl_xor(ss, 32);
            const float rstd = rsqrtf(ss * (1.f / D) + EPS);
            float logit = rstd * dot + F.b_router[e];
            float val[4]; int sel[4];
#pragma unroll
            for (int r = 0; r < 4; ++r) {
                const float m = wave_max(logit);
                const unsigned long long bal = __ballot(logit == m);
                const int le = (int)(__ffsll((long long)bal) - 1) & 31;
                val[r] = m; sel[r] = le;
                if (e == le) logit = -INFINITY;
            }
            float ex[4], sum = 0.f;
#pragma unroll
            for (int r = 0; r < 4; ++r) { ex[r] = __expf(val[r] - val[0]); sum += ex[r]; }
            { const u32x4* hr = (const u32x4*)(F.H1 + (size_t)t * D); u32x4* cr = (u32x4*)(F.ABF + (size_t)t * D);
#pragma unroll
              for (int j = 0; j < 2; ++j) { float f[8]; unpack8(hr[F.lane + 64 * j], f); u32x4 o; o.x = pk2(f[0] * rstd, f[1] * rstd); o.y = pk2(f[2] * rstd, f[3] * rstd); o.z = pk2(f[4] * rstd, f[5] * rstd); o.w = pk2(f[6] * rstd, f[7] * rstd); cr[F.lane + 64 * j] = o; } }
            if (F.lane == 0) {
                F.RSTD1[t] = rstd;
#pragma unroll
                for (int r = 0; r < 4; ++r) { const unsigned loc = atomicAdd((unsigned*)&hist[sel[r]], 1u); lsel[tl * 4 + r] = (unsigned)sel[r] | (loc << 8); lgate[tl * 4 + r] = ex[r] / sum; }
            }
        }
        __syncthreads();
        if (F.tid < 32) { const unsigned n = hist[F.tid]; base[F.tid] = n ? __hip_atomic_fetch_add(F.ctl + CW_CNT + 64 * F.tid, n, __ATOMIC_RELAXED, __HIP_MEMORY_SCOPE_AGENT) : 0u; }
        __syncthreads();
        { const int tl = F.tid >> 2, r = F.tid & 3, t = chunk * 128 + tl; const unsigned s = lsel[tl * 4 + r]; const int ee = s & 255; const unsigned rank = base[ee] + (s >> 8);
          F.TOKLIST[ee * LCAP + rank] = t; F.SLOTREF[t * 4 + r] = (ee << 16) | rank; F.GATE[t * 4 + r] = lgate[tl * 4 + r]; }
        __syncthreads();
    }
}
struct MoeTab { LAS int* cnt; LAS int* toff; LAS int* p32; };
__device__ __forceinline__ MoeTab moe_tables(const Frame& F) {
    MoeTab M; M.cnt = (LAS int*)(F.lds + MISC_OFF + 128); M.toff = M.cnt + 32; M.p32 = M.toff + 33;
    __syncthreads();
    if (F.tid == 0) { int a = 0, c = 0;
        for (int e = 0; e < NE; ++e) { const int n = (int)__hip_atomic_load(F.ctl + CW_CNT + 64 * e, __ATOMIC_RELAXED, __HIP_MEMORY_SCOPE_AGENT); M.cnt[e] = n; M.toff[e] = a; M.p32[e] = c; a += (n + 255) >> 8; c += (n + 31) >> 5; }
        M.toff[NE] = a; M.p32[NE] = c; }
    __syncthreads();
    return M;
}
__device__ __forceinline__ void p6_moe1(const Frame& F) {
    const MoeTab M = moe_tables(F);
    const int gw = blockIdx.x * NWAVES + F.wave, NGW = F.G * NWAVES, r32 = F.lane & 31, hi = F.lane >> 5;
    const int ntiles = M.p32[NE] * 32;
    for (int tile = gw; tile < ntiles; tile += NGW) {
        const int blk = tile >> 5, hb = tile & 31;
        int e = 0; while (M.p32[e + 1] <= blk) ++e;
        const int sb = blk - M.p32[e], cnt = M.cnt[e];
        const int rank = sb * 32 + r32;
        const int tok = F.TOKLIST[e * LCAP + (rank < cnt ? rank : cnt - 1)];
        const bf16* ap = F.ABF + (size_t)tok * D + 8 * hi;
        const int hidb = hb * 32 + r32;
        const bf16* bp[2];
        bp[0] = F.W1T + ((size_t)e * 2048 + 256 * (hidb >> 7) + (hidb & 127)) * D + 8 * hi; bp[1] = bp[0] + 128 * D;
        f32x16 acc[2]; acc[0] = f32x16{}; acc[1] = f32x16{};
        smma<2>(ap, bp, D, acc);
        const float bg = F.b1[e * 2048 + 2 * hidb], bl = F.b1[e * 2048 + 2 * hidb + 1];
#pragma unroll
        for (int r = 0; r < 16; ++r) {
            const int rr = crow(r, hi), rk = sb * 32 + rr;
            float gl = acc[0][r] + bg, li = acc[1][r] + bl;
            gl = fminf(gl, 7.f); li = fminf(fmaxf(li, -7.f), 7.f);
            const float act = gl * sigmoidf_(1.702f * gl) * (li + 1.f);
            if (rk < cnt) F.HID[((size_t)256 * M.toff[e] + rk) * DE + hidb] = (bf16)f2bf(act);
        }
    }
}
__device__ __forceinline__ void p7_moe2(const Frame& F) {
    const MoeTab M = moe_tables(F);
    const int gw = blockIdx.x * NWAVES + F.wave, NGW = F.G * NWAVES, r32 = F.lane & 31, hi = F.lane >> 5;
    const int ntiles = M.p32[NE] * 8;
    for (int tile = gw; tile < ntiles; tile += NGW) {
        const int blk = tile >> 3, cg = tile & 7;
        int e = 0; while (M.p32[e + 1] <= blk) ++e;
        const int sb = blk - M.p32[e], cnt = M.cnt[e];
        const size_t rowb = (size_t)256 * M.toff[e] + sb * 32;
        const bf16* ap = F.HID + (rowb + r32) * DE + 8 * hi;
        const bf16* bp[4];
#pragma unroll
        for (int nb = 0; nb < 4; ++nb) bp[nb] = F.W2T + ((size_t)e * D + cg * 128 + 32 * nb + r32) * DE + 8 * hi;
        f32x16 acc[4];
#pragma unroll
        for (int nb = 0; nb < 4; ++nb) acc[nb] = f32x16{};
        smma<4>(ap, bp, DE, acc);
#pragma unroll
        for (int nb = 0; nb < 4; ++nb) { const int col = cg * 128 + 32 * nb + r32; const float bb = F.b2[e * D + col];
#pragma unroll
            for (int r = 0; r < 16; ++r) { const int rr = crow(r, hi); if (sb * 32 + rr < cnt) F.YS[(rowb + rr) * D + col] = (bf16)f2bf(acc[nb][r] + bb); } }
    }
}
__device__ __forceinline__ void p8_combine(const Frame& F) {
    const MoeTab M = moe_tables(F);
    const int gw = blockIdx.x * NWAVES + F.wave, NGW = F.G * NWAVES;
    for (int t0 = 2 * gw; t0 < T; t0 += 2 * NGW) {
        size_t yrow[2][4]; float gk[2][4];
#pragma unroll
        for (int u = 0; u < 2; ++u)
#pragma unroll
            for (int k = 0; k < 4; ++k) { const int sr = F.SLOTREF[(t0 + u) * 4 + k]; yrow[u][k] = (size_t)256 * M.toff[sr >> 16] + (sr & 0xffff); gk[u][k] = F.GATE[(t0 + u) * 4 + k]; }
        u32x4 hv[2][2], yv[2][2][4];
#pragma unroll
        for (int u = 0; u < 2; ++u)
#pragma unroll
            for (int j = 0; j < 2; ++j) { const int col = 8 * F.lane + 512 * j; hv[u][j] = *(const u32x4*)(F.H1 + (size_t)(t0 + u) * D + col);
#pragma unroll
                for (int k = 0; k < 4; ++k) yv[u][j][k] = *(const u32x4*)(F.YS + yrow[u][k] * D + col); }
#pragma unroll
        for (int u = 0; u < 2; ++u) {
            float ss = 0.f;
#pragma unroll
            for (int j = 0; j < 2; ++j) {
                float a[8]; unpack8(hv[u][j], a);
#pragma unroll
                for (int k = 0; k < 4; ++k) { float y[8]; unpack8(yv[u][j][k], y);
#pragma unroll
                    for (int q = 0; q < 8; ++q) a[q] += gk[u][k] * y[q]; }
                u32x4 o; o.x = pk2(a[0], a[1]); o.y = pk2(a[2], a[3]); o.z = pk2(a[4], a[5]); o.w = pk2(a[6], a[7]);
                *(u32x4*)(F.H2 + (size_t)(t0 + u) * D + 8 * F.lane + 512 * j) = o;
                float b[8]; unpack8(o, b);
#pragma unroll
                for (int q = 0; q < 8; ++q) ss += b[q] * b[q];
            }
            ss = wave_sum(ss);
            if (F.lane == 0) F.RSTD2[t0 + u] = rsqrtf(ss * (1.f / D) + EPS);
        }
    }
}
__device__ __forceinline__ void p9_ple(const Frame& F) {
    const int gw = blockIdx.x * NWAVES + F.wave, NGW = F.G * NWAVES, r32 = F.lane & 31, hi = F.lane >> 5;
    for (int tile = gw; tile < (T / 32) * (D / 128); tile += NGW) {
        const int mb = tile / (D / 128), cg = tile % (D / 128), m0 = mb * 32, n0 = cg * 128;
        const bf16* ap = F.H2 + (size_t)(m0 + r32) * D + 8 * hi;
        const bf16* bp[4];
#pragma unroll
        for (int nb = 0; nb < 4; ++nb) bp[nb] = F.WPG + (size_t)(n0 + 32 * nb + r32) * D + 8 * hi;
        f32x16 acc[4];
#pragma unroll
        for (int nb = 0; nb < 4; ++nb) acc[nb] = f32x16{};
        smma<4>(ap, bp, D, acc);
#pragma unroll
        for (int r = 0; r < 16; ++r) {
            const size_t row = m0 + crow(r, hi); const float rs = F.RSTD2[row];
#pragma unroll
            for (int nb = 0; nb < 4; ++nb) { const int col = n0 + 32 * nb + r32;
                const float pg = sigmoidf_(rs * acc[nb][r]);
                F.H3[row * D + col] = (bf16)f2bf(bf2f(F.H2[row * D + col]) + pg * bf2f(F.PROJ[row * D + col])); }
        }
    }
}
__device__ __forceinline__ void p10_final(const Frame& F) {
    const int gw = blockIdx.x * NWAVES + F.wave, NGW = F.G * NWAVES;
    for (int t = gw; t < T; t += NGW) {
        float a[2][8]; float ss = 0.f;
#pragma unroll
        for (int j = 0; j < 2; ++j) { unpack8(*(const u32x4*)(F.H3 + (size_t)t * D + 8 * F.lane + 512 * j), a[j]);
#pragma unroll
            for (int q = 0; q < 8; ++q) ss += a[j][q] * a[j][q]; }
        const float rstd = rsqrtf(wave_sum(ss) * (1.f / D) + EPS);
#pragma unroll
        for (int j = 0; j < 2; ++j) { const int col = 8 * F.lane + 512 * j;
            const f32x4 g0 = *(const f32x4*)(F.g_final + col), g1 = *(const f32x4*)(F.g_final + col + 4);
            f32x4 o0, o1; o0.x = a[j][0] * rstd * g0.x; o0.y = a[j][1] * rstd * g0.y; o0.z = a[j][2] * rstd * g0.z; o0.w = a[j][3] * rstd * g0.w;
            o1.x = a[j][4] * rstd * g1.x; o1.y = a[j][5] * rstd * g1.y; o1.z = a[j][6] * rstd * g1.z; o1.w = a[j][7] * rstd * g1.w;
            *(f32x4*)(F.out + (size_t)t * D + col) = o0; *(f32x4*)(F.out + (size_t)t * D + col + 4) = o1; }
    }
}


namespace pg {
constexpr int BM = 256, BK = 64, HALF = 128, HTB = HALF * BK * 2, STAGE_BYTES = 8 * HTB, NXCD = 8, WGM = 8;
__device__ __forceinline__ int lds_byte(int r, int c) { const int st = (r >> 4) * 2 + (c >> 5), rr = r & 15, cc = c & 31, ob = rr * 64 + cc * 2; return st * 1024 + (ob ^ (((ob >> 9) & 1) << 5)); }
__device__ __forceinline__ void stage_rc(int b, int& R, int& C) { const int st = b / 1024, sb = b % 1024, swz = sb ^ (((sb >> 9) & 1) << 5); R = (st >> 1) * 16 + swz / 64; C = (st & 1) * 32 + (swz % 64) / 2; }
__device__ __forceinline__ int perm32(int rho) { const int n = rho >> 4, i = rho & 15; return 8 * (i >> 2) + 4 * n + (i & 3); }
struct Unit { int arow, brow, kofs, x0, x1, x2; };
__device__ __forceinline__ unsigned cvt_pk_bf16(float lo, float hi) { unsigned r; asm volatile("v_cvt_pk_bf16_f32 %0, %1, %2" : "=v"(r) : "v"(lo), "v"(hi)); return r; }
typedef f32x4 Acc[2][2][4][2];

struct DenseMap { static constexpr bool GATHER = false; int lda; __device__ __forceinline__ unsigned rowoff(const Unit&, int r) const { return (unsigned)r * (unsigned)lda * 2u; }
    __device__ __forceinline__ size_t base(const Unit& u) const { return (size_t)u.arow * lda * 2; } };
template <int SPLIT>
struct DenseOrder {
    int nM, nN, nwg, G, c, khalf;
    __device__ __forceinline__ void init(int M, int N, int G_, int c_, int khalf_ = 0) { nM = M / BM; nN = N / BM; nwg = nM * nN; G = G_; c = c_; khalf = khalf_; }
    __device__ __forceinline__ bool next(int i, Unit& u) const {
        const int j = SPLIT ? (i >> 1) : i;
        const long L = (long)j * G + c; if (L >= nwg) return false;
        int wgid = (int)L; { const int q = nwg / NXCD, r = nwg % NXCD, xcd = wgid % NXCD, off = wgid / NXCD; wgid = (xcd < r ? xcd * (q + 1) : r * (q + 1) + (xcd - r) * q) + off; }
        const int nig = WGM * nN, gid = wgid / nig, fm = gid * WGM, gsz = (nM - fm) < WGM ? (nM - fm) : WGM;
        const int pm = fm + ((wgid % nig) % gsz), pn = (wgid % nig) / gsz;
        u.arow = pm * BM; u.brow = pn * BM; u.x0 = pm; u.x1 = pn; u.x2 = SPLIT ? (i & 1) : 0; u.kofs = SPLIT ? (i & 1) * khalf : 0; return true;
    }
};

template <class Epi, class Sched, class AMap, bool ALIGN_EPI>
__device__ __forceinline__ void gemm_run(LAS unsigned char* lds, const bf16* A, const bf16* Bt, const int ldb, const int nt, const Sched& S, const Epi& E, const AMap& AM) {
    const int tid = threadIdx.x, wid = __builtin_amdgcn_readfirstlane(tid >> 6), lane = tid & 63, wr = wid >> 2, wc = wid & 3, fr = lane & 15, fq = lane >> 4;
    int RA[2]; unsigned CA2[2], voffB[2];
#pragma unroll
    for (int i = 0; i < 2; ++i) { int R, C; stage_rc(tid * 16 + i * 8192, R, C); RA[i] = R; CA2[i] = (unsigned)C * 2u; const int Rb = (R & ~31) + perm32(R & 31); voffB[i] = (unsigned)(Rb * ldb + C) * 2u; }
    const size_t kstep = (size_t)(BK * 2);
    const size_t hstepB = (size_t)HALF * ldb * 2;
    const unsigned ldsw = (unsigned)wid * 1024u;
    const int aoff = lds_byte(wr * 64 + fr, fq * 8), boff = lds_byte(wc * 32 + fr, fq * 8);
#define PG_SA(b, h) (((b) * 2 + (h)) * HTB)
#define PG_SB(b, h) ((4 + (b) * 2 + (h)) * HTB)
#define PG_STAGE(bufoff, gbase, voff) do { _Pragma("unroll") for (int _i = 0; _i < 2; ++_i) \
        __builtin_amdgcn_global_load_lds((const unsigned*)((const char*)(gbase) + (voff)[_i]), (LAS unsigned*)(lds + (bufoff) + ldsw + _i * 8192), 16, 0, 0); } while (0)
#define PG_LDA(dst, b, h) do { _Pragma("unroll") for (int m = 0; m < 4; ++m) _Pragma("unroll") for (int k = 0; k < 2; ++k) dst[m][k] = *(const LAS bf16x8*)(lds + PG_SA(b, h) + aoff + m * 2048 + k * 1024); } while (0)
#define PG_LDB(dst, b, h) do { _Pragma("unroll") for (int n = 0; n < 2; ++n) _Pragma("unroll") for (int k = 0; k < 2; ++k) dst[n][k] = *(const LAS bf16x8*)(lds + PG_SB(b, h) + boff + n * 2048 + k * 1024); } while (0)
#define PG_MMA(ai, bj, At, Bt_) do { __builtin_amdgcn_s_setprio(1); _Pragma("unroll") for (int m = 0; m < 4; ++m) _Pragma("unroll") for (int n = 0; n < 2; ++n) _Pragma("unroll") for (int k = 0; k < 2; ++k) \
        acc[ai][bj][m][n] = __builtin_amdgcn_mfma_f32_16x16x32_bf16(Bt_[n][k], At[m][k], acc[ai][bj][m][n], 0, 0, 0); __builtin_amdgcn_s_setprio(0); } while (0)
#define PG_WAIT_V(n) asm volatile("s_waitcnt vmcnt(" #n ")" ::: "memory")
#define PG_WAIT_L(n) asm volatile("s_waitcnt lgkmcnt(" #n ")" ::: "memory")
#define PG_BAR __builtin_amdgcn_s_barrier()
#define PG_SCHED __builtin_amdgcn_sched_barrier(0)
#define PG_ZERO() do { _Pragma("unroll") for (int a = 0; a < 2; ++a) _Pragma("unroll") for (int b = 0; b < 2; ++b) _Pragma("unroll") for (int m = 0; m < 4; ++m) _Pragma("unroll") for (int n = 0; n < 2; ++n) acc[a][b][m][n] = (f32x4){0.f, 0.f, 0.f, 0.f}; } while (0)
#define PG_MKVA(u, va) do { _Pragma("unroll") for (int h = 0; h < 2; ++h) _Pragma("unroll") for (int i = 0; i < 2; ++i) va[h][i] = AM.rowoff(u, h * HALF + RA[i]) + CA2[i]; } while (0)
    Unit cur, nxt; int ui = 0;
    if (!S.next(0, cur)) return;
    Acc acc; PG_ZERO();
    bf16x8 At[4][2], B0[2][2], B1[2][2];
    unsigned voffA[2]; unsigned vaC[2][2], vaN[2][2];
    const size_t hstepA = AMap::GATHER ? 0 : (size_t)AM.rowoff(cur, HALF);
    if constexpr (AMap::GATHER) { PG_MKVA(cur, vaC); } else {
#pragma unroll
        for (int i = 0; i < 2; ++i) voffA[i] = AM.rowoff(cur, RA[i]) + CA2[i]; }
#define PG_STAGE_A(bufoff, ptr, h, useNext) do { if constexpr (AMap::GATHER) { unsigned _v[2] = {(useNext) ? vaN[h][0] : vaC[h][0], (useNext) ? vaN[h][1] : vaC[h][1]}; PG_STAGE(bufoff, ptr, _v); } \
        else { PG_STAGE(bufoff, (ptr) + (h) * hstepA, voffA); } } while (0)
    const char* cA = (const char*)A + (size_t)cur.kofs * 2 + AM.base(cur); const char* cB = (const char*)Bt + ((size_t)cur.brow * ldb + cur.kofs) * 2;
    PG_STAGE(PG_SB(0, 0), cB, voffB); PG_STAGE(PG_SB(0, 1), cB + hstepB, voffB); PG_STAGE_A(PG_SA(0, 0), cA, 0, false); PG_STAGE_A(PG_SA(0, 1), cA, 1, false);
    if (wr == 1) PG_BAR;
    PG_WAIT_V(2); PG_BAR;
    PG_STAGE(PG_SB(1, 0), cB + kstep, voffB); PG_STAGE_A(PG_SA(1, 0), cA + kstep, 0, false); PG_STAGE(PG_SB(1, 1), cB + hstepB + kstep, voffB);
    PG_WAIT_V(6); PG_BAR;
    for (;;) {
        const bool has_next = S.next(ui + 1, nxt);
        const char* nA = cA; const char* nB = cB;
        if (has_next) { if constexpr (AMap::GATHER) { PG_MKVA(nxt, vaN); } nA = (const char*)A + (size_t)nxt.kofs * 2 + AM.base(nxt); nB = (const char*)Bt + ((size_t)nxt.brow * ldb + nxt.kofs) * 2; }
        else if constexpr (AMap::GATHER) {
#pragma unroll
            for (int h = 0; h < 2; ++h)
#pragma unroll
                for (int i = 0; i < 2; ++i) vaN[h][i] = vaC[h][i]; }
        E.prefetch(cur, ui, wid, lane);
#pragma unroll 1
        for (int t = 0; t < nt; t += 2) {
            const bool last = (t == nt - 2);
            const char* a1 = cA + (size_t)(t + 1) * kstep;
            const char* a2 = last ? nA : cA + (size_t)(t + 2) * kstep; const char* b2 = last ? nB : cB + (size_t)(t + 2) * kstep;
            const char* a3 = a2 + kstep; const char* b3 = b2 + kstep;
            PG_LDB(B0, 0, 0); PG_LDB(B1, 0, 1); PG_SCHED; PG_LDA(At, 0, 0); PG_STAGE_A(PG_SA(1, 1), a1, 1, false);
            PG_WAIT_V(8); PG_WAIT_L(0); PG_BAR; PG_MMA(0, 0, At, B0); PG_MMA(0, 1, At, B1); PG_BAR; PG_SCHED;
            PG_LDA(At, 0, 1); PG_STAGE(PG_SB(0, 0), b2, voffB); PG_STAGE(PG_SB(0, 1), b2 + hstepB, voffB); PG_STAGE_A(PG_SA(0, 0), a2, 0, last);
            PG_WAIT_V(8); PG_WAIT_L(0); PG_BAR; PG_MMA(1, 0, At, B0); PG_MMA(1, 1, At, B1); PG_BAR; PG_SCHED;
            PG_LDB(B0, 1, 0); PG_LDB(B1, 1, 1); PG_SCHED; PG_LDA(At, 1, 0); PG_STAGE_A(PG_SA(0, 1), a2, 1, last);
            PG_WAIT_V(8); PG_WAIT_L(0); PG_BAR; PG_MMA(0, 0, At, B0); PG_MMA(0, 1, At, B1); PG_BAR; PG_SCHED;
            PG_LDA(At, 1, 1); PG_STAGE(PG_SB(1, 0), b3, voffB); PG_STAGE(PG_SB(1, 1), b3 + hstepB, voffB); PG_STAGE_A(PG_SA(1, 0), a3, 0, last);
            PG_WAIT_V(8); PG_WAIT_L(0); PG_BAR; PG_MMA(1, 0, At, B0); PG_MMA(1, 1, At, B1); PG_BAR; PG_SCHED;
        }
        if constexpr (ALIGN_EPI) { if (wr == 0) PG_BAR; }
        E(acc, cur, ui, wr, wc, fr, fq);
        if (!has_next) break;
        if (!E.keep(cur)) PG_ZERO();
        cur = nxt; cA = nA; cB = nB; ++ui;
        if constexpr (AMap::GATHER) {
#pragma unroll
            for (int h = 0; h < 2; ++h)
#pragma unroll
                for (int i = 0; i < 2; ++i) vaC[h][i] = vaN[h][i]; }
        if constexpr (ALIGN_EPI) { if (wr == 1) PG_BAR; }
    }
    PG_WAIT_V(0);
    if constexpr (!ALIGN_EPI) { if (wr == 0) PG_BAR; }
    PG_BAR;
#undef PG_SA
#undef PG_SB
#undef PG_STAGE
#undef PG_LDA
#undef PG_LDB
#undef PG_MMA
#undef PG_WAIT_V
#undef PG_WAIT_L
#undef PG_BAR
#undef PG_SCHED
#undef PG_ZERO
#undef PG_MKVA
#undef PG_STAGE_A
}

__device__ __forceinline__ float sigm(float x) { return __builtin_amdgcn_rcpf(1.0f + __builtin_amdgcn_exp2f(-LOG2E * x)); }
__device__ __forceinline__ float gelu_t(float x) { const float u = 1.5957691216057308f * (x + 0.044715f * x * x * x); return x * sigm(u); }
__device__ __forceinline__ float act_k(float x, float c1, float c3, bool plain, bool mulx) { const float s = sigm(x * (c1 + c3 * x * x)); const float y = mulx ? x * s : s; return plain ? x : y; }
__device__ __forceinline__ void store_act(const Acc& acc, bf16* base, int ldc, int kind) {
    const bool plain = kind == 1, mulx = kind == 2; const float c1 = kind == 2 ? 1.5957691216057308f : 1.0f, c3 = kind == 2 ? 1.5957691216057308f * 0.044715f : 0.0f;
#pragma unroll
    for (int ai = 0; ai < 2; ++ai)
#pragma unroll
        for (int m = 0; m < 4; ++m) { bf16* rowp = base + (size_t)(ai * HALF + m * 16) * ldc;
#pragma unroll
            for (int bj = 0; bj < 2; ++bj) { const f32x4 v0 = acc[ai][bj][m][0], v1 = acc[ai][bj][m][1];
                u32x4 w; w.x = cvt_pk_bf16(act_k(v0[0], c1, c3, plain, mulx), act_k(v0[1], c1, c3, plain, mulx)); w.y = cvt_pk_bf16(act_k(v0[2], c1, c3, plain, mulx), act_k(v0[3], c1, c3, plain, mulx));
                w.z = cvt_pk_bf16(act_k(v1[0], c1, c3, plain, mulx), act_k(v1[1], c1, c3, plain, mulx)); w.w = cvt_pk_bf16(act_k(v1[2], c1, c3, plain, mulx), act_k(v1[3], c1, c3, plain, mulx));
                *(u32x4*)(rowp + bj * HALF) = w; }
            asm volatile("" ::: "memory"); }
}
__device__ __forceinline__ void store_plain(const Acc& acc, bf16* base, int ldc) {
#pragma unroll
    for (int ai = 0; ai < 2; ++ai)
#pragma unroll
        for (int m = 0; m < 4; ++m) { bf16* rowp = base + (size_t)(ai * HALF + m * 16) * ldc;
#pragma unroll
            for (int bj = 0; bj < 2; ++bj) { const f32x4 v0 = acc[ai][bj][m][0], v1 = acc[ai][bj][m][1];
                u32x4 w; w.x = cvt_pk_bf16(v0[0], v0[1]); w.y = cvt_pk_bf16(v0[2], v0[3]); w.z = cvt_pk_bf16(v1[0], v1[1]); w.w = cvt_pk_bf16(v1[2], v1[3]);
                *(u32x4*)(rowp + bj * HALF) = w; } }
}
struct EpiInproj {
    bf16* ZZ;
    __device__ __forceinline__ bool keep(const Unit&) const { return false; }
    __device__ __forceinline__ void prefetch(const Unit&, int, int, int) const {}
    __device__ __forceinline__ void operator()(const Acc& acc, const Unit& u, int ui, int wr, int wc, int fr, int fq) const {
        bf16* base = ZZ + (size_t)(u.arow + wr * 64 + fr) * INC + u.brow + wc * 32 + 8 * fq;
        const int n0 = u.brow;
        if (n0 < ZU) store_plain(acc, base, INC); else store_act(acc, base, INC, n0 < ZGA ? 2 : 3);
    }
};
struct EpiPlain {
    bf16* O; int ldc;
    __device__ __forceinline__ bool keep(const Unit&) const { return false; }
    __device__ __forceinline__ void prefetch(const Unit&, int, int, int) const {}
    __device__ __forceinline__ void operator()(const Acc& acc, const Unit& u, int ui, int wr, int wc, int fr, int fq) const {
        store_plain(acc, O + (size_t)(u.arow + wr * 64 + fr) * ldc + u.brow + wc * 32 + 8 * fq, ldc);
    }
};
struct EpiMerge {
    const bf16* ZZ; bf16* O;
    __device__ __forceinline__ bool keep(const Unit& u) const { return u.x2 == 0; }
    __device__ __forceinline__ void prefetch(const Unit&, int, int, int) const {}
    __device__ __forceinline__ void operator()(Acc& acc, const Unit& u, int ui, int wr, int wc, int fr, int fq) const {
        const int row0 = u.arow + wr * 64 + fr, col0 = u.brow + wc * 32 + 8 * fq;
#pragma unroll
        for (int ai = 0; ai < 2; ++ai)
#pragma unroll
            for (int m = 0; m < 4; ++m) { const size_t row = row0 + ai * HALF + m * 16;
#pragma unroll
                for (int bj = 0; bj < 2; ++bj) { const int col = col0 + bj * HALF;
                    float gb[8]; unpack8(*(const u32x4*)(ZZ + row * INC + ZGB + col), gb);
#pragma unroll
                    for (int q = 0; q < 8; ++q) gb[q] = fmaxf(gb[q], 1e-30f);
                    if (u.x2 == 0) { float ga[8]; unpack8(*(const u32x4*)(ZZ + row * INC + ZGA + col), ga);
#pragma unroll
                        for (int q = 0; q < 8; ++q) acc[ai][bj][m][q >> 2][q & 3] *= ga[q] * __builtin_amdgcn_rcpf(gb[q]); }
                    else { const f32x4 v0 = acc[ai][bj][m][0], v1 = acc[ai][bj][m][1];
                        u32x4 w; w.x = cvt_pk_bf16(v0[0] * gb[0], v0[1] * gb[1]); w.y = cvt_pk_bf16(v0[2] * gb[2], v0[3] * gb[3]); w.z = cvt_pk_bf16(v1[0] * gb[4], v1[1] * gb[5]); w.w = cvt_pk_bf16(v1[2] * gb[6], v1[3] * gb[7]);
                        *(u32x4*)(O + row * D + col) = w; } }
                asm volatile("" ::: "memory"); }
    }
};
struct EpiOut {
    const float* x; bf16* O;
    __device__ __forceinline__ bool keep(const Unit&) const { return false; }
    __device__ __forceinline__ void prefetch(const Unit&, int, int, int) const {}
    __device__ __forceinline__ void operator()(const Acc& acc, const Unit& u, int ui, int wr, int wc, int fr, int fq) const {
        const int row0 = u.arow + wr * 64 + fr, col0 = u.brow + wc * 32 + 8 * fq;
#pragma unroll
        for (int ai = 0; ai < 2; ++ai)
#pragma unroll
            for (int m = 0; m < 4; ++m) { const size_t row = row0 + ai * HALF + m * 16;
#pragma unroll
                for (int bj = 0; bj < 2; ++bj) { const int col = col0 + bj * HALF;
                    const f32x4 x0 = *(const f32x4*)(x + row * D + col), x1 = *(const f32x4*)(x + row * D + col + 4);
                    const f32x4 v0 = acc[ai][bj][m][0] + x0, v1 = acc[ai][bj][m][1] + x1;
                    u32x4 w; w.x = cvt_pk_bf16(v0[0], v0[1]); w.y = cvt_pk_bf16(v0[2], v0[3]); w.z = cvt_pk_bf16(v1[0], v1[1]); w.w = cvt_pk_bf16(v1[2], v1[3]);
                    *(u32x4*)(O + row * D + col) = w; }
                asm volatile("" ::: "memory"); }
    }
};
struct EpiPle {
    const bf16* H2; const bf16* PROJ; const float* RSTD2; bf16* O;
    __device__ __forceinline__ bool keep(const Unit&) const { return false; }
    __device__ __forceinline__ void prefetch(const Unit&, int, int, int) const {}
    __device__ __forceinline__ void operator()(const Acc& acc, const Unit& u, int ui, int wr, int wc, int fr, int fq) const {
        const int row0 = u.arow + wr * 64 + fr, col0 = u.brow + wc * 32 + 8 * fq;
#pragma unroll
        for (int ai = 0; ai < 2; ++ai)
#pragma unroll
            for (int m = 0; m < 4; ++m) { const size_t row = row0 + ai * HALF + m * 16; const float rs = RSTD2[row];
#pragma unroll
                for (int bj = 0; bj < 2; ++bj) { const int col = col0 + bj * HALF;
                    float h[8], pj[8]; unpack8(*(const u32x4*)(H2 + row * D + col), h); unpack8(*(const u32x4*)(PROJ + row * D + col), pj);
                    float o[8];
#pragma unroll
                    for (int q = 0; q < 8; ++q) o[q] = h[q] + sigm(rs * acc[ai][bj][m][q >> 2][q & 3]) * pj[q];
                    u32x4 w; w.x = cvt_pk_bf16(o[0], o[1]); w.y = cvt_pk_bf16(o[2], o[3]); w.z = cvt_pk_bf16(o[4], o[5]); w.w = cvt_pk_bf16(o[6], o[7]);
                    *(u32x4*)(O + row * D + col) = w; }
                asm volatile("" ::: "memory"); }
    }
};
}

#ifndef STAG_US
#define STAG_US 0
#endif
__device__ __forceinline__ void stagger(int group) {
    if (STAG_US > 0 && group > 0) { const unsigned long long t0 = __builtin_amdgcn_s_memrealtime(), dt = (unsigned long long)(group * STAG_US * 100);
        while (__builtin_amdgcn_s_memrealtime() - t0 < dt) __builtin_amdgcn_s_sleep(8); }
}
__device__ __forceinline__ void p1_fast(const Frame& F) {
    stagger((blockIdx.x >> 3) & 3);
    { pg::DenseOrder<0> S; S.init(T, INC, F.G, (int)blockIdx.x); pg::EpiInproj E{F.ZZ}; pg::DenseMap AM{D};
      pg::gemm_run<pg::EpiInproj, pg::DenseOrder<0>, pg::DenseMap, true>(F.lds + STAGE_OFF, F.ABF, F.WIN, D, D / 64, S, E, AM); }
    { pg::DenseOrder<0> S; S.init(T, D, F.G, (int)blockIdx.x); pg::EpiPlain E{F.PROJ, D}; pg::DenseMap AM{PLE};
      pg::gemm_run<pg::EpiPlain, pg::DenseOrder<0>, pg::DenseMap, true>(F.lds + STAGE_OFF, F.PBF, F.WPP, PLE, PLE / 64, S, E, AM); }
}
__device__ __forceinline__ void p3_fast(const Frame& F) {
    pg::DenseOrder<1> S; S.init(T, D, F.G, (int)blockIdx.x, 512); pg::EpiMerge E{F.ZZ, F.MERGED}; pg::DenseMap AM{D};
    pg::gemm_run<pg::EpiMerge, pg::DenseOrder<1>, pg::DenseMap, true>(F.lds + STAGE_OFF, F.OAB, F.WAB, D, 512 / 64, S, E, AM);
}
__device__ __forceinline__ void p4_fast(const Frame& F) {
    pg::DenseOrder<0> S; S.init(T, D, F.G, (int)blockIdx.x); pg::EpiOut E{F.x, F.H1}; pg::DenseMap AM{D};
    pg::gemm_run<pg::EpiOut, pg::DenseOrder<0>, pg::DenseMap, true>(F.lds + STAGE_OFF, F.MERGED, F.WOUT, D, D / 64, S, E, AM);
}
__device__ __forceinline__ void p9_fast(const Frame& F) {
    pg::DenseOrder<0> S; S.init(T, D, F.G, (int)blockIdx.x); pg::EpiPle E{F.H2, F.PROJ, F.RSTD2, F.H3}; pg::DenseMap AM{D};
    pg::gemm_run<pg::EpiPle, pg::DenseOrder<0>, pg::DenseMap, true>(F.lds + STAGE_OFF, F.H2, F.WPG, D, D / 64, S, E, AM);
}


namespace pg {
template <int MT, int NT, int NROWS_B>
struct MoeOrder {
    LAS const int* cnt; LAS const int* toff; int c;
    __device__ __forceinline__ bool next(int i, Unit& u) const {
        const int x = c & 7, cl = c >> 3, sb = i * 8 + x, mtg = MT * sb + cl / NT, pn = cl % NT;
        if (mtg >= toff[NE]) return false;
        int e = 0; while (toff[e + 1] <= mtg) ++e;
        u.arow = 256 * mtg; u.brow = e * NROWS_B + 256 * pn; u.kofs = 0; u.x0 = e; u.x1 = cnt[e] - 256 * (mtg - toff[e]); u.x2 = i; return true;
    }
};
struct GatherMap { static constexpr bool GATHER = true; LAS const unsigned* tab;
    __device__ __forceinline__ unsigned rowoff(const Unit& u, int r) const { return tab[u.x2 * 256 + r]; }
    __device__ __forceinline__ size_t base(const Unit&) const { return 0; } };
struct EpiSwiglu {
    bf16* HID; const float* b1; LAS unsigned char* lds;
    __device__ __forceinline__ bool keep(const Unit&) const { return false; }
    __device__ __forceinline__ void prefetch(const Unit& u, int ui, int wid, int lane) const {
        if (wid == 0) __builtin_amdgcn_global_load_lds((const unsigned*)(b1 + u.x0 * 2048 + ((u.brow & 2047) >> 8) * 256 + lane * 4), (LAS unsigned*)(lds + BIAS_OFF + (ui & 1) * 1024), 16, 0, 0); }
    __device__ __forceinline__ void operator()(const Acc& acc, const Unit& u, int ui, int wr, int wc, int fr, int fq) const {
        const int e = u.x0, valid = u.x1, pn = (u.brow & 2047) >> 8, hid0 = 128 * pn + 32 * wc + 8 * fq;
        const LAS f32x4* bp = (const LAS f32x4*)(lds + BIAS_OFF + (ui & 1) * 1024 + (32 * wc + 8 * fq) * 8);
        const f32x4 f0 = bp[0], f1 = bp[1], f2 = bp[2], f3 = bp[3];
        const float bg[8] = {f0[0], f0[2], f1[0], f1[2], f2[0], f2[2], f3[0], f3[2]}, bl[8] = {f0[1], f0[3], f1[1], f1[3], f2[1], f2[3], f3[1], f3[3]};
#pragma unroll
        for (int ai = 0; ai < 2; ++ai)
#pragma unroll
            for (int m = 0; m < 4; ++m) { const int rl = ai * HALF + wr * 64 + m * 16 + fr;
                float o[8];
#pragma unroll
                for (int q = 0; q < 8; ++q) { float g = acc[ai][0][m][q >> 2][q & 3] + bg[q], l = acc[ai][1][m][q >> 2][q & 3] + bl[q];
                    g = fminf(g, 7.f); l = fminf(fmaxf(l, -7.f), 7.f); o[q] = g * sigm(1.702f * g) * (l + 1.f); }
                u32x4 w; w.x = cvt_pk_bf16(o[0], o[1]); w.y = cvt_pk_bf16(o[2], o[3]); w.z = cvt_pk_bf16(o[4], o[5]); w.w = cvt_pk_bf16(o[6], o[7]);
                if (rl < valid) *(u32x4*)(HID + (size_t)(u.arow + rl) * DE + hid0) = w; }
    }
};
struct EpiBias2 {
    bf16* YS; const float* b2; LAS unsigned char* lds;
    __device__ __forceinline__ bool keep(const Unit&) const { return false; }
    __device__ __forceinline__ void prefetch(const Unit& u, int ui, int wid, int lane) const {
        if (wid == 0) __builtin_amdgcn_global_load_lds((const unsigned*)(b2 + u.x0 * D + (u.brow & 1023) + lane * 4), (LAS unsigned*)(lds + BIAS_OFF + (ui & 1) * 1024), 16, 0, 0); }
    __device__ __forceinline__ void operator()(const Acc& acc, const Unit& u, int ui, int wr, int wc, int fr, int fq) const {
        const int valid = u.x1, col0 = (u.brow & 1023) + 32 * wc + 8 * fq;
        f32x4 bb[2][2];
#pragma unroll
        for (int bj = 0; bj < 2; ++bj)
#pragma unroll
            for (int n = 0; n < 2; ++n) bb[bj][n] = *(const LAS f32x4*)(lds + BIAS_OFF + (ui & 1) * 1024 + (32 * wc + 8 * fq + bj * HALF + 4 * n) * 4);
#pragma unroll
        for (int ai = 0; ai < 2; ++ai)
#pragma unroll
            for (int m = 0; m < 4; ++m) { const int rl = ai * HALF + wr * 64 + m * 16 + fr;
#pragma unroll
                for (int bj = 0; bj < 2; ++bj) { const f32x4 v0 = acc[ai][bj][m][0] + bb[bj][0], v1 = acc[ai][bj][m][1] + bb[bj][1];
                    u32x4 w; w.x = cvt_pk_bf16(v0[0], v0[1]); w.y = cvt_pk_bf16(v0[2], v0[3]); w.z = cvt_pk_bf16(v1[0], v1[1]); w.w = cvt_pk_bf16(v1[2], v1[3]);
                    if (rl < valid) *(u32x4*)(YS + (size_t)(u.arow + rl) * D + col0 + bj * HALF) = w; } }
    }
};
}
__device__ __forceinline__ void p6_fast(const Frame& F) {
    const MoeTab M = moe_tables(F);
    pg::MoeOrder<4, 8, 2048> S{M.cnt, M.toff, (int)blockIdx.x};
    LAS unsigned* tab = (LAS unsigned*)(F.lds + TAB_OFF);
    { pg::Unit u;
      for (int i = 0; i < 18 && S.next(i, u); ++i) { const int e = u.x0, cnt = M.cnt[e], rk0 = cnt - u.x1;
          if (F.tid < 256) { const int rk = rk0 + F.tid; tab[i * 256 + F.tid] = (unsigned)F.TOKLIST[e * LCAP + (rk < cnt ? rk : cnt - 1)] * (unsigned)(D * 2); } } }
    __syncthreads();
    stagger((blockIdx.x >> 3) & 3);
    pg::EpiSwiglu E{F.HID, F.b1, F.lds}; pg::GatherMap AM{tab};
    pg::gemm_run<pg::EpiSwiglu, pg::MoeOrder<4, 8, 2048>, pg::GatherMap, true>(F.lds + STAGE_OFF, F.ABF, F.W1T, D, D / 64, S, E, AM);
}
__device__ __forceinline__ void p7_fast(const Frame& F) {
    const MoeTab M = moe_tables(F);
    pg::MoeOrder<8, 4, 1024> S{M.cnt, M.toff, (int)blockIdx.x};
    stagger((blockIdx.x >> 3) & 3);
    pg::EpiBias2 E{F.YS, F.b2, F.lds}; pg::DenseMap AM{DE};
    pg::gemm_run<pg::EpiBias2, pg::MoeOrder<8, 4, 1024>, pg::DenseMap, true>(F.lds + STAGE_OFF, F.HID, F.W2T, DE, DE / 64, S, E, AM);
}


typedef short s16x4 __attribute__((ext_vector_type(4)));
__device__ __forceinline__ s16x4 vtr(LAS const unsigned char* p) { return __builtin_bit_cast(s16x4, __builtin_amdgcn_ds_read_tr16_b64_v4i16((LAS s16x4*)p)); }
__device__ __forceinline__ bf16x8 cat8(s16x4 a, s16x4 b) { return (bf16x8){a[0], a[1], a[2], a[3], b[0], b[1], b[2], b[3]}; }
template <bool EARLY>
__device__ __forceinline__ void p2_attn_fast(const Frame& F) {
    const int lane = F.lane, r32 = lane & 31, hi = lane >> 5;
    LAS unsigned char* vl = F.lds + F.wave * 4096;
    LAS const unsigned char* vrd = vl + (4 * hi + ((lane & 15) >> 2)) * 64 + ((lane >> 4) & 1) * 32 + (lane & 3) * 8;
    const int gw = blockIdx.x * NWAVES + F.wave, NGW = F.G * NWAVES;
    for (int item = gw; item < BATCH * NH * (SEQ / 32); item += NGW) {
        const int qi = item >> 6, bh = item & 63, b = bh >> 3, h = bh & 7;
        const size_t rowbase = (size_t)b * SEQ;
        bf16x8 qf[4];
        { const bf16* qp = F.ZZ + (rowbase + 32 * qi + r32) * INC + ZQ + h * HD + 8 * hi;
#pragma unroll
          for (int d0 = 0; d0 < 4; ++d0) qf[d0] = *(const bf16x8*)(qp + 16 * d0); }
        f32x16 o[2]; o[0] = f32x16{}; o[1] = f32x16{};
        float carry = 1.0f;
        bf16x8 kn[4]; u32x4 vn[4];
#define ATT_LOAD(j) do { const bf16* kp = F.ZZ + (rowbase + 32 * (j) + r32) * INC + ZK + h * HD + 8 * hi; \
            _Pragma("unroll") for (int d0 = 0; d0 < 4; ++d0) kn[d0] = *(const bf16x8*)(kp + 16 * d0); \
            _Pragma("unroll") for (int i = 0; i < 4; ++i) { const int L = i * 64 + lane; \
                vn[i] = *(const u32x4*)(F.ZZ + (rowbase + 32 * (j) + ((L >> 2) & 31)) * INC + ZV + h * HD + (L >> 7) * 32 + (L & 3) * 8); } } while (0)
        ATT_LOAD(qi);
        for (int j = qi; j >= 0; --j) {
            bf16x8 kf[4];
#pragma unroll
            for (int d0 = 0; d0 < 4; ++d0) kf[d0] = kn[d0];
#pragma unroll
            for (int i = 0; i < 4; ++i) *(LAS u32x4*)(vl + (i * 64 + lane) * 16) = vn[i];
            if (j > 0) ATT_LOAD(j - 1);
            f32x16 p = f32x16{};
#pragma unroll
            for (int d0 = 0; d0 < 4; ++d0) p = __builtin_amdgcn_mfma_f32_32x32x16_bf16(kf[d0], qf[d0], p, 0, 0, 0);
            float e[16], sfx[16];
#pragma unroll
            for (int r = 0; r < 16; ++r) { const float z = fminf(p[r], 100.f); e[r] = __builtin_amdgcn_exp2f(z); sfx[r] = __builtin_amdgcn_rcpf(1.0f + e[r]); }
            if (j == qi) {
#pragma unroll
                for (int r = 0; r < 16; ++r) { const bool ok = crow(r, hi) < r32; e[r] = ok ? e[r] : 0.f; sfx[r] = ok ? sfx[r] : 1.f; }
            }
            float TL[4], TH[4];
#pragma unroll
            for (int g = 0; g < 4; ++g) {
                sfx[4 * g + 2] *= sfx[4 * g + 3]; sfx[4 * g + 1] *= sfx[4 * g + 2]; sfx[4 * g] *= sfx[4 * g + 1];
                const auto rr = __builtin_amdgcn_permlane32_swap(__float_as_uint(sfx[4 * g]), __float_as_uint(sfx[4 * g]), false, false);
                TL[g] = __uint_as_float(rr[0]); TH[g] = __uint_as_float(rr[1]); }
            float R[8];
            R[7] = carry; R[6] = R[7] * TH[3]; R[5] = R[6] * TL[3]; R[4] = R[5] * TH[2]; R[3] = R[4] * TL[2]; R[2] = R[3] * TH[1]; R[1] = R[2] * TL[1]; R[0] = R[1] * TH[0]; carry = R[0] * TL[0];
            unsigned pw[8];
#pragma unroll
            for (int g = 0; g < 4; ++g) { const float off = hi ? R[2 * g + 1] : R[2 * g];
                const float w0 = e[4 * g] * (off * sfx[4 * g]), w1 = e[4 * g + 1] * (off * sfx[4 * g + 1]), w2 = e[4 * g + 2] * (off * sfx[4 * g + 2]), w3 = e[4 * g + 3] * (off * sfx[4 * g + 3]);
                pw[2 * g] = pg::cvt_pk_bf16(w0, w1); pw[2 * g + 1] = pg::cvt_pk_bf16(w2, w3); }
            const bf16x8 pa0 = __builtin_bit_cast(bf16x8, (u32x4){pw[0], pw[1], pw[2], pw[3]}), pa1 = __builtin_bit_cast(bf16x8, (u32x4){pw[4], pw[5], pw[6], pw[7]});
            asm volatile("s_waitcnt lgkmcnt(0)" ::: "memory");
#pragma unroll
            for (int d0 = 0; d0 < 2; ++d0) {
                const s16x4 a0 = vtr(vrd + d0 * 2048), a1 = vtr(vrd + d0 * 2048 + 512), b0 = vtr(vrd + d0 * 2048 + 1024), b1 = vtr(vrd + d0 * 2048 + 1536);
                o[d0] = __builtin_amdgcn_mfma_f32_32x32x16_bf16(pa0, cat8(a0, a1), o[d0], 0, 0, 0);
                o[d0] = __builtin_amdgcn_mfma_f32_32x32x16_bf16(pa1, cat8(b0, b1), o[d0], 0, 0, 0);
            }
            asm volatile("s_waitcnt lgkmcnt(0)" ::: "memory");
            if (EARLY && __all(carry == 0.f)) break;
        }
#undef ATT_LOAD
        bf16* op = F.OAB + (rowbase + 32 * qi) * D + h * HD + r32;
#pragma unroll
        for (int d0 = 0; d0 < 2; ++d0)
#pragma unroll
            for (int r = 0; r < 16; ++r) op[(size_t)crow(r, hi) * D + 32 * d0] = (bf16)f2bf(o[d0][r]);
    }
}
__device__ __forceinline__ void p2_sgu_fast(const Frame& F) {
    const int lane = F.lane, r32 = lane & 31, hi = lane >> 5, g = F.wave;
    for (int unit = blockIdx.x; unit < T / 128; unit += F.G) {
        const int row0 = unit * 128;
        __syncthreads();
        for (int i = 0; i < 16; ++i) {
            const int rl = g * 16 + i;
            const u32x4 w = *(const u32x4*)(F.ZZ + (size_t)(row0 + rl) * INC + ZVS + 8 * lane);
            float f[8]; unpack8(w, f);
            float s = 0.f;
#pragma unroll
            for (int j = 0; j < 8; ++j) s += f[j];
            const float mean = wave_sum(s) * (1.f / 512.f);
            float s2 = 0.f;
#pragma unroll
            for (int j = 0; j < 8; ++j) { f[j] -= mean; s2 += f[j] * f[j]; }
            const float rstd = rsqrtf(wave_sum(s2) * (1.f / 512.f) + EPS);
            const f32x4 g0 = *(const f32x4*)(F.sgu_norm + 8 * lane), g1 = *(const f32x4*)(F.sgu_norm + 8 * lane + 4);
            u32x4 o; o.x = pk2(f[0] * rstd * g0.x, f[1] * rstd * g0.y); o.y = pk2(f[2] * rstd * g0.z, f[3] * rstd * g0.w);
            o.z = pk2(f[4] * rstd * g1.x, f[5] * rstd * g1.y); o.w = pk2(f[6] * rstd * g1.z, f[7] * rstd * g1.w);
            *(LAS u32x4*)(F.lds + (lane >> 2) * 8192 + rl * 64 + (lane & 3) * 16) = o;
        }
        __syncthreads();
        LAS const unsigned char* vrd = F.lds + (2 * g) * 8192 + (8 * hi + ((lane & 15) >> 2)) * 64 + ((lane >> 4) & 1) * 32 + (lane & 3) * 8;
        for (int mt = 0; mt < 4; ++mt) {
            f32x16 acc[2]; acc[0] = f32x16{}; acc[1] = f32x16{};
            const bf16* ap = F.SGUW + ((size_t)g * 128 + 32 * mt + r32) * 128 + 8 * hi;
            const int nks = (mt < 2) ? 4 : 8;
            for (int ks = 0; ks < nks; ++ks) {
                const bf16x8 a = *(const bf16x8*)(ap + 16 * ks);
#pragma unroll
                for (int nt = 0; nt < 2; ++nt) {
                    const s16x4 b0 = vtr(vrd + nt * 8192 + ks * 1024), b1 = vtr(vrd + nt * 8192 + ks * 1024 + 256);
                    acc[nt] = __builtin_amdgcn_mfma_f32_32x32x16_bf16(a, cat8(b0, b1), acc[nt], 0, 0, 0);
                }
            }
#pragma unroll
            for (int r = 0; r < 16; ++r) { const int tl = 32 * mt + crow(r, hi); const float bs = F.sgu_b[g * 128 + tl];
#pragma unroll
                for (int nt = 0; nt < 2; ++nt) { const int ch = 64 * g + 32 * nt + r32;
                    const float u = bf2f(F.ZZ[(size_t)(row0 + tl) * INC + ZU + ch]);
                    F.OAB[(size_t)(row0 + tl) * D + 512 + ch] = (bf16)f2bf(u * (acc[nt][r] + bs)); } }
        }
    }
    __syncthreads();
}


__device__ __forceinline__ void p5_fast(const Frame& F) {
    LAS unsigned* hist = (LAS unsigned*)F.lds;
    LAS unsigned* base = hist + 32;
    LAS unsigned* lsel = hist + 64;
    LAS float* lgate = (LAS float*)(hist + 64 + 512);
    LAS float* rsv = lgate + 512;
    LAS float* part = (LAS float*)(F.lds + 8192);
    const int lane = F.lane, r32 = lane & 31, hi = lane >> 5, wg4 = F.wave & 3, kh = F.wave >> 2;
    for (int chunk = blockIdx.x; chunk < T / 128; chunk += F.G) {
        if (F.tid < 32) hist[F.tid] = 0u;
        const int t0 = chunk * 128 + wg4 * 32;
        const bf16* hp = F.H1 + (size_t)(t0 + r32) * D + kh * 512 + 8 * hi;
        const bf16* whp = F.WRHI + r32 * D + kh * 512 + 8 * hi;
        const bf16* wlp = F.WRLO + r32 * D + kh * 512 + 8 * hi;
        f32x16 acc = f32x16{}; float ss = 0.f;
#pragma unroll 4
        for (int k0 = 0; k0 < 512; k0 += 16) {
            const u32x4 hb = *(const u32x4*)(hp + k0);
            const bf16x8 ah = *(const bf16x8*)(whp + k0), al = *(const bf16x8*)(wlp + k0);
            const bf16x8 bb = __builtin_bit_cast(bf16x8, hb);
            acc = __builtin_amdgcn_mfma_f32_32x32x16_bf16(ah, bb, acc, 0, 0, 0);
            acc = __builtin_amdgcn_mfma_f32_32x32x16_bf16(al, bb, acc, 0, 0, 0);
#pragma unroll
            for (int q = 0; q < 4; ++q) { const float lo = __uint_as_float(hb[q] << 16), hh = __uint_as_float(hb[q] & 0xffff0000u); ss += lo * lo + hh * hh; }
        }
        { const auto rr = __builtin_amdgcn_permlane32_swap(__float_as_uint(ss), __float_as_uint(ss), false, false); ss = __uint_as_float(rr[0]) + __uint_as_float(rr[1]); }
        if (kh == 1) {
#pragma unroll
            for (int r = 0; r < 16; ++r) part[(wg4 * 17 + r) * 64 + lane] = acc[r];
            part[(wg4 * 17 + 16) * 64 + lane] = ss;
        }
        __syncthreads();
        if (kh == 0) {
            ss += part[(wg4 * 17 + 16) * 64 + lane];
            const float rstd = rsqrtf(ss * (1.f / D) + EPS);
            float v[16];
#pragma unroll
            for (int r = 0; r < 16; ++r) v[r] = rstd * (acc[r] + part[(wg4 * 17 + r) * 64 + lane]) + F.b_router[crow(r, hi)];
            float cv[8]; int ce[8];
#pragma unroll
            for (int k = 0; k < 4; ++k) {
                float m = v[0];
#pragma unroll
                for (int r = 1; r < 16; ++r) m = fmaxf(m, v[r]);
                int idx = 15;
#pragma unroll
                for (int r = 14; r >= 0; --r) idx = (v[r] == m) ? r : idx;
                cv[k] = m; ce[k] = (idx & 3) + 8 * (idx >> 2) + 4 * hi;
#pragma unroll
                for (int r = 0; r < 16; ++r) v[r] = (r == idx) ? -INFINITY : v[r];
            }
#pragma unroll
            for (int k = 0; k < 4; ++k) {
                const auto rv = __builtin_amdgcn_permlane32_swap(__float_as_uint(cv[k]), __float_as_uint(cv[k]), false, false);
                const auto re = __builtin_amdgcn_permlane32_swap((unsigned)ce[k], (unsigned)ce[k], false, false);
                cv[4 + k] = __uint_as_float(hi ? rv[0] : rv[1]); ce[4 + k] = (int)(hi ? re[0] : re[1]);
            }
            float tv[4]; int te[4];
#pragma unroll
            for (int k = 0; k < 4; ++k) {
                float bv = cv[0]; int be = ce[0];
#pragma unroll
                for (int c = 1; c < 8; ++c) { const bool better = (cv[c] > bv) || (cv[c] == bv && ce[c] < be); bv = better ? cv[c] : bv; be = better ? ce[c] : be; }
                tv[k] = bv; te[k] = be;
#pragma unroll
                for (int c = 0; c < 8; ++c) cv[c] = (ce[c] == be) ? -INFINITY : cv[c];
            }
            float ex[4], sum = 0.f;
#pragma unroll
            for (int k = 0; k < 4; ++k) { ex[k] = __expf(tv[k] - tv[0]); sum += ex[k]; }
            if (hi == 0) { const int tl = wg4 * 32 + r32; rsv[tl] = rstd;
#pragma unroll
                for (int k = 0; k < 4; ++k) { const unsigned loc = atomicAdd((unsigned*)&hist[te[k]], 1u); lsel[tl * 4 + k] = (unsigned)te[k] | (loc << 8); lgate[tl * 4 + k] = ex[k] / sum; } }
        }
        __syncthreads();
        if (F.tid < 32) { const unsigned n = hist[F.tid]; base[F.tid] = n ? __hip_atomic_fetch_add(F.ctl + CW_CNT + 64 * F.tid, n, __ATOMIC_RELAXED, __HIP_MEMORY_SCOPE_AGENT) : 0u; }
        __syncthreads();
        { const int tl = F.tid >> 2, r = F.tid & 3, t = chunk * 128 + tl; const unsigned sl = lsel[tl * 4 + r]; const int ee = sl & 255; const unsigned rank = base[ee] + (sl >> 8);
          F.TOKLIST[ee * LCAP + rank] = t; F.SLOTREF[t * 4 + r] = (ee << 16) | rank; F.GATE[t * 4 + r] = lgate[tl * 4 + r]; }
        for (int i = 0; i < 16; ++i) {
            const int tl = F.wave * 16 + i, t = chunk * 128 + tl; const float rstd = rsv[tl];
            const u32x4* hr = (const u32x4*)(F.H1 + (size_t)t * D); u32x4* cr = (u32x4*)(F.ABF + (size_t)t * D);
#pragma unroll
            for (int j = 0; j < 2; ++j) { float f[8]; unpack8(hr[lane + 64 * j], f); u32x4 o; o.x = pk2(f[0] * rstd, f[1] * rstd); o.y = pk2(f[2] * rstd, f[3] * rstd); o.z = pk2(f[4] * rstd, f[5] * rstd); o.w = pk2(f[6] * rstd, f[7] * rstd); cr[lane + 64 * j] = o; }
        }
        __syncthreads();
    }
}

struct Args { const float* in[21]; float* out; unsigned char* ws; int ph_lo, ph_hi; };
__global__ void __launch_bounds__(NTHREADS, 2) fwd(Args args) {
    extern __shared__ __attribute__((aligned(16))) unsigned char lds[];
    Frame F;
    F.lds = (LAS unsigned char*)lds; F.MISC = (volatile LAS unsigned*)(F.lds + MISC_OFF);
    F.tid = threadIdx.x; F.lane = F.tid & 63; F.wave = __builtin_amdgcn_readfirstlane(F.tid >> 6); F.G = gridDim.x;
    unsigned char* ws = args.ws;
    F.ctl = (unsigned*)(ws + WS_CTL);
    F.x = args.in[0]; F.p = args.in[1]; F.g_mix = args.in[2]; F.w_in = args.in[3]; F.w_out_a = args.in[4]; F.w_out_b = args.in[5]; F.w_out = args.in[6];
    F.sgu_norm = args.in[7]; F.sgu_w = args.in[8]; F.sgu_b = args.in[9]; F.g_moe = args.in[10]; F.w_router = args.in[11]; F.b_router = args.in[12];
    F.w1 = args.in[13]; F.b1 = args.in[14]; F.w2 = args.in[15]; F.b2 = args.in[16]; F.g_ple = args.in[17]; F.w_ple_gate = args.in[18]; F.w_ple_proj = args.in[19]; F.g_final = args.in[20];
    F.out = args.out;
    F.WRHI = (bf16*)(ws + WS_WRHI); F.WRLO = (bf16*)(ws + WS_WRLO); F.SGUW = (bf16*)(ws + WS_SGUW); F.WIN = (bf16*)(ws + WS_WIN); F.WAB = (bf16*)(ws + WS_WAB);
    F.WOUT = (bf16*)(ws + WS_WOUT); F.WPG = (bf16*)(ws + WS_WPG); F.WPP = (bf16*)(ws + WS_WPP); F.W1T = (bf16*)(ws + WS_W1); F.W2T = (bf16*)(ws + WS_W2);
    F.PBF = (bf16*)(ws + WS_PBF); F.PROJ = (bf16*)(ws + WS_PROJ); F.H1 = (bf16*)(ws + WS_H1); F.ZZ = (bf16*)(ws + WS_ZZ); F.HID = (bf16*)(ws + WS_HID);
    F.H2 = (bf16*)(ws + WS_H2); F.H3 = (bf16*)(ws + WS_H3); F.ABF = (bf16*)(ws + WS_ABF); F.OAB = (bf16*)(ws + WS_OAB); F.MERGED = (bf16*)(ws + WS_MERGED); F.YS = (bf16*)(ws + WS_YS);
    F.RSTD1 = (float*)(ws + WS_RSTD1); F.RSTD2 = (float*)(ws + WS_RSTD2); F.GATE = (float*)(ws + WS_GATE);
    F.TOKLIST = (int*)(ws + WS_TOKLIST); F.SLOTREF = (int*)(ws + WS_SLOTREF);
    for (int u = F.tid; u < (LDS_BYTES - MISC_OFF) / 4; u += NTHREADS) ((LAS unsigned*)(F.lds + MISC_OFF))[u] = 0u;
    __syncthreads();
    XcdBarrier bar = xcd_barrier_post(F.ctl + CW_BAR, F.MISC + 8);
    const int lo = args.ph_lo, hi = args.ph_hi;
#define IN(k) (lo <= (k) && (k) < hi)
#ifndef REP_PHASE
#define REP_PHASE -1
#endif
#define REPS(k) ((REP_PHASE == (k)) ? 2 : 1)
#define SEAM(k) do { if (IN(k) && IN((k) + 1)) xcd_barrier(bar); } while (0)
    if (IN(0)) { for (int rp = 0; rp < REPS(0); ++rp) p0_prologue(F); } SEAM(0);
    if (IN(1)) { for (int rp = 0; rp < REPS(1); ++rp) { if (OPT_P1) p1_fast(F); else p1_inproj(F); } } SEAM(1);
    if (IN(2)) { for (int rp = 0; rp < REPS(2); ++rp) { if (OPT_SGU) p2_sgu_fast(F); else p2_sgu_simple(F); if (OPT_ATT) p2_attn_fast<ATT_EARLY>(F); else p2_attn_scalar<false>(F); } } SEAM(2);
    if (IN(3)) { for (int rp = 0; rp < REPS(3); ++rp) { if (OPT_P3) p3_fast(F); else p3_merge(F); } } SEAM(3);
    if (IN(4)) { for (int rp = 0; rp < REPS(4); ++rp) { if (OPT_P4) p4_fast(F); else p4_out(F); } } SEAM(4);
    if (IN(5)) { if (OPT_P5) p5_fast(F); else p5_router(F); } SEAM(5);
    if (IN(6)) { for (int rp = 0; rp < REPS(6); ++rp) { if (OPT_P6) p6_fast(F); else p6_moe1(F); } } SEAM(6);
    if (IN(7)) { for (int rp = 0; rp < REPS(7); ++rp) { if (OPT_P7) p7_fast(F); else p7_moe2(F); } } SEAM(7);
    if (IN(8)) { for (int rp = 0; rp < REPS(8); ++rp) p8_combine(F); } SEAM(8);
    if (IN(9)) { for (int rp = 0; rp < REPS(9); ++rp) { if (OPT_P9) p9_fast(F); else p9_ple(F); } } SEAM(9);
    if (IN(10)) { for (int rp = 0; rp < REPS(10); ++rp) p10_final(F); }
#undef IN
#undef SEAM
}

extern "C" void kernel_launch(void* const* d_in, const int* in_sizes, int n_in, void* d_out, int out_size, void* d_ws, size_t ws_size, hipStream_t stream) {
    static int grid = 0;
    if (grid == 0) {
        if (n_in != 21 || out_size != T * D || ws_size < WS_END) { fprintf(stderr, "kernel_launch: unexpected shapes (n_in %d out %d ws %zu)\n", n_in, out_size, ws_size); grid = -1; return; }
        int dev = 0, cus = 0;
        if (hipGetDevice(&dev) != hipSuccess || hipDeviceGetAttribute(&cus, hipDeviceAttributeMultiprocessorCount, dev) != hipSuccess) { grid = -1; return; }
        if (hipFuncSetAttribute((const void*)fwd, hipFuncAttributeMaxDynamicSharedMemorySize, LDS_BYTES) != hipSuccess) { fprintf(stderr, "kernel_launch: hipFuncSetAttribute failed\n"); grid = -1; return; }
        int per_cu = 0;
        if (hipOccupancyMaxActiveBlocksPerMultiprocessor(&per_cu, (const void*)fwd, NTHREADS, LDS_BYTES) != hipSuccess || per_cu < 1) fprintf(stderr, "kernel_launch: occupancy query says %d\n", per_cu);
        (void)hipGetLastError();
        if (cus < 256) { fprintf(stderr, "kernel_launch: needs >= 256 CUs, found %d\n", cus); grid = -1; return; }
        grid = 256;
    }
    if (grid < 0) return;
    (void)hipMemsetAsync((char*)d_ws + WS_CTL, 0, CTL_ZERO_BYTES, stream);
    Args a{};
    for (int i = 0; i < 21; ++i) a.in[i] = (const float*)d_in[i];
    a.out = (float*)d_out; a.ws = (unsigned char*)d_ws; a.ph_lo = 0; a.ph_hi = 11;
    hipLaunchKernelGGL(fwd, dim3(grid), dim3(NTHREADS), LDS_BYTES, stream, a);
}
```

```cpp
#include <hip/hip_runtime.h>
#include <cstdio>
#include <cstdint>

#define GAS __attribute__((address_space(1)))
#define LAS __attribute__((address_space(3)))
typedef unsigned short bf16;
typedef short bf16x8 __attribute__((ext_vector_type(8)));
typedef float f32x4 __attribute__((ext_vector_type(4)));
typedef float f32x16 __attribute__((ext_vector_type(16)));
typedef unsigned u32x4 __attribute__((ext_vector_type(4)));
typedef unsigned u32x2 __attribute__((ext_vector_type(2)));

#ifndef OPT_P1
#define OPT_P1 1
#endif
#ifndef OPT_P3
#define OPT_P3 1
#endif
#ifndef OPT_P4
#define OPT_P4 1
#endif
#ifndef OPT_P6
#define OPT_P6 1
#endif
#ifndef OPT_P7
#define OPT_P7 1
#endif
#ifndef OPT_ATT
#define OPT_ATT 1
#endif
#ifndef OPT_SGU
#define OPT_SGU 1
#endif
#ifndef ATT_EARLY
#define ATT_EARLY true
#endif
#ifndef OPT_P5
#define OPT_P5 1
#endif
#ifndef OPT_P9
#define OPT_P9 1
#endif
constexpr int BATCH = 8, SEQ = 4096, T = BATCH * SEQ, D = 1024, PLE = 256, NH = 8, HD = 64, NE = 32, DE = 1024, INC = 4608;
constexpr int ZQ = 0, ZK = 512, ZV = 1024, ZU = 1536, ZVS = 2048, ZGA = 2560, ZGB = 3584;
constexpr float EPS = 1e-6f;
constexpr float LOG2E = 1.4426950408889634f;
constexpr float QSCALE = 0.125f * LOG2E;
constexpr int LCAP = 32768;
constexpr int HROWS = 139264;

constexpr size_t MiB = 1u << 20;
constexpr size_t WS_CTL = 0, CTL_ZERO_BYTES = 1 * MiB;
constexpr size_t WS_WRHI = 1 * MiB, WS_WRLO = WS_WRHI + 65536, WS_SGUW = WS_WRLO + 65536;
constexpr size_t WS_RSTD1 = WS_SGUW + 262144, WS_RSTD2 = WS_RSTD1 + 131072;
constexpr size_t WS_WIN = 2 * MiB, WS_WAB = 11 * MiB, WS_WOUT = 13 * MiB, WS_WPG = 15 * MiB, WS_WPP = 17 * MiB;
constexpr size_t WS_TOKLIST = 18 * MiB, WS_SLOTREF = 22 * MiB, WS_GATE = WS_SLOTREF + 524288;
constexpr size_t WS_W1 = 28 * MiB, WS_W2 = 156 * MiB, WS_PBF = 220 * MiB, WS_PROJ = 236 * MiB, WS_H1 = 300 * MiB;
constexpr size_t WS_R1 = 364 * MiB;
constexpr size_t WS_ZZ = WS_R1, WS_HID = WS_R1, WS_H2 = WS_R1, WS_H3 = WS_R1 + 64 * MiB;
constexpr size_t WS_R2 = 652 * MiB;
constexpr size_t WS_ABF = WS_R2, WS_OAB = WS_R2 + 64 * MiB, WS_MERGED = WS_R2 + 128 * MiB, WS_YS = WS_R2;
constexpr size_t WS_END = 924 * MiB;
constexpr int CW_BAR = 4096, CW_CNT = 8192;

constexpr int STAGE_OFF = 0, TAB_OFF = 131072, BIAS_OFF = 149504, MISC_OFF = 151552;
constexpr int LDS_BYTES = 152576;
constexpr int NWAVES = 8, NTHREADS = 512;

#define LDS_WAIT() asm volatile("s_waitcnt lgkmcnt(0)" ::: "memory")
__device__ __forceinline__ float bf2f(unsigned v) { return __uint_as_float(v << 16); }
__device__ __forceinline__ unsigned f2bf(float f) { unsigned u = __float_as_uint(f); return (u + 0x7fffu + ((u >> 16) & 1u)) >> 16; }
__device__ __forceinline__ unsigned pk2(float lo, float hi) { return f2bf(lo) | (f2bf(hi) << 16); }
__device__ __forceinline__ float wave_sum(float v) {
#pragma unroll
    for (int o = 1; o < 64; o <<= 1) v += __shfl_xor(v, o);
    return v;
}
__device__ __forceinline__ float wave_max(float v) {
#pragma unroll
    for (int o = 1; o < 64; o <<= 1) v = fmaxf(v, __shfl_xor(v, o));
    return v;
}
__device__ __forceinline__ float sigmoidf_(float x) { return 1.0f / (1.0f + __expf(-x)); }
__device__ __forceinline__ float gelu_tanh(float x) {
    const float u = 1.5957691216057308f * (x + 0.044715f * x * x * x);
    return x * sigmoidf_(u);
}
__device__ __forceinline__ int crow(int r, int hi) { return (r & 3) + 8 * (r >> 2) + 4 * hi; }
__device__ __forceinline__ void unpack8(const u32x4 w, float (&f)[8]) {
    f[0] = bf2f(w.x & 0xffffu); f[1] = bf2f(w.x >> 16); f[2] = bf2f(w.y & 0xffffu); f[3] = bf2f(w.y >> 16);
    f[4] = bf2f(w.z & 0xffffu); f[5] = bf2f(w.z >> 16); f[6] = bf2f(w.w & 0xffffu); f[7] = bf2f(w.w >> 16);
}

#define XB_TMO      128
#define XB_XCNT(j)  (256  + 64 * (j))
#define XB_XSUB(j)  (1280 + 64 * (j))
#define XB_XGEN(j)  (2304 + 64 * (j))
#define XB_TOP      3328
#define XB_TOPGEN   3392
#define XCD_BAR_WORDS 3456
#define XB_SPIN_CAP (1u << 23)
__device__ __forceinline__ unsigned xb_ld(unsigned* p)              { return __hip_atomic_load(p, __ATOMIC_RELAXED, __HIP_MEMORY_SCOPE_AGENT); }
__device__ __forceinline__ unsigned xb_add(unsigned* p, unsigned v) { return __hip_atomic_fetch_add(p, v, __ATOMIC_RELAXED, __HIP_MEMORY_SCOPE_AGENT); }
__device__ __forceinline__ unsigned xb_xcc_id() { return (unsigned)__builtin_amdgcn_s_getreg((3 << 11) | 20) & 0xFu; }
#define XB_SPIN(cond, bar) do { unsigned _sp = 0; while (cond) { __builtin_amdgcn_s_sleep(1); \
    if ((++_sp & 255u) == 0u) { if (xb_ld(&(bar)[XB_TMO])) break; if (_sp > XB_SPIN_CAP) { atomicAdd(&(bar)[XB_TMO], 1u); break; } } } } while (0)
struct XcdBarrier { unsigned* bar; unsigned x; volatile LAS unsigned* st; };
__device__ __forceinline__ XcdBarrier xcd_barrier_post(unsigned* bar, volatile LAS unsigned* st) {
    XcdBarrier b; b.bar = bar; b.x = xb_xcc_id(); b.st = st;
    if (threadIdx.x == 0) (void)xb_add(&bar[XB_XCNT(b.x)], 1u);
    return b;
}
__device__ __forceinline__ void xcd_barrier_complete(unsigned* bar, unsigned x, unsigned& nloc, unsigned& nx) {
    const unsigned G = gridDim.x * gridDim.y * gridDim.z;
    unsigned sum, cnt, mine, sp = 0u;
    for (;;) {
        sum = 0u; cnt = 0u; mine = 0u;
#pragma unroll
        for (unsigned j = 0; j < 16; ++j) { const unsigned c = xb_ld(&bar[XB_XCNT(j)]); sum += c; cnt += (c > 0u) ? 1u : 0u; mine = (j == x) ? c : mine; }
        if (sum == G) break;
        __builtin_amdgcn_s_sleep(1);
        if ((++sp & 255u) == 0u) { if (xb_ld(&bar[XB_TMO])) break; if (sp > XB_SPIN_CAP) { atomicAdd(&bar[XB_TMO], 1u); break; } }
    }
    nloc = mine > 0u ? mine : 1u; nx = cnt > 0u ? cnt : 1u;
}
__device__ __forceinline__ void xcd_barrier(const XcdBarrier& b) {
    asm volatile("s_waitcnt vmcnt(0)" ::: "memory");
    __syncthreads();
    if (threadIdx.x == 0) {
        unsigned* bar = b.bar;
        __builtin_amdgcn_s_waitcnt(0);
        unsigned nloc = b.st[0], nx = b.st[1];
        if (nloc == 0u) { xcd_barrier_complete(bar, b.x, nloc, nx); b.st[0] = nloc; b.st[1] = nx; }
        const unsigned old = xb_add(&bar[XB_XSUB(b.x)], 1u);
        const unsigned gen = old / nloc;
        if (old + 1u == (gen + 1u) * nloc) {
            __builtin_amdgcn_fence(__ATOMIC_RELEASE, "agent");
            asm volatile("s_waitcnt vmcnt(0)" ::: "memory");
            const unsigned og = xb_add(&bar[XB_TOP], 1u);
            const unsigned tg = og / nx;
            if (og + 1u == (tg + 1u) * nx) xb_add(&bar[XB_TOPGEN], 1u);
            else XB_SPIN(xb_ld(&bar[XB_TOPGEN]) == tg, bar);
            __builtin_amdgcn_fence(__ATOMIC_ACQUIRE, "agent");
            xb_add(&bar[XB_XGEN(b.x)], 1u);
            asm volatile("s_waitcnt vmcnt(0)" ::: "memory");
        } else {
            XB_SPIN(xb_ld(&bar[XB_XGEN(b.x)]) == gen, bar);
            __builtin_amdgcn_fence(__ATOMIC_ACQUIRE, "agent");
            asm volatile("s_waitcnt vmcnt(0)" ::: "memory");
        }
    }
    __syncthreads();
}

struct Frame {
    LAS unsigned char* lds;
    volatile LAS unsigned* MISC;
    unsigned* ctl;
    int tid, lane, wave, G;
    const float *x, *p, *g_mix, *w_in, *w_out_a, *w_out_b, *w_out, *sgu_norm, *sgu_w, *sgu_b, *g_moe, *w_router, *b_router, *w1, *b1, *w2, *b2, *g_ple, *w_ple_gate, *w_ple_proj, *g_final;
    float* out;
    bf16 *WRHI, *WRLO, *SGUW, *WIN, *WAB, *WOUT, *WPG, *WPP, *W1T, *W2T, *PBF, *PROJ, *H1, *ZZ, *HID, *H2, *H3, *ABF, *OAB, *MERGED, *YS;
    float *RSTD1, *RSTD2, *GATE;
    int *TOKLIST, *SLOTREF;
};

template <int NB>
__device__ __forceinline__ void smma(const bf16* ap, const bf16* const (&bp)[NB], int K, f32x16 (&acc)[NB]) {
    for (int k0 = 0; k0 < K; k0 += 16) {
        const bf16x8 a = *(const bf16x8*)(ap + k0);
#pragma unroll
        for (int nb = 0; nb < NB; ++nb) { const bf16x8 b = *(const bf16x8*)(bp[nb] + k0); acc[nb] = __builtin_amdgcn_mfma_f32_32x32x16_bf16(a, b, acc[nb], 0, 0, 0); }
    }
}

struct RowId { __device__ __forceinline__ int operator()(int n) const { return n; } };
struct RowW1 { __device__ __forceinline__ int operator()(int n) const { const int hid = n >> 1; return 256 * (hid >> 7) + (hid & 127) + 128 * (n & 1); } };
template <class RM>
__device__ __forceinline__ void tr_item(const float* W, int N, const float* gk, bf16* WT, int ldt, int koff, RM rm, LAS float* scr, int kb, int nb, int lane, float sc = 1.0f) {
    const int k0 = kb * 64, n0 = nb * 64;
    f32x4 v[16];
#pragma unroll
    for (int i = 0; i < 16; ++i) v[i] = __builtin_nontemporal_load((const f32x4*)(W + (size_t)(k0 + 4 * i + (lane >> 4)) * N + n0 + (lane & 15) * 4));
#pragma unroll
    for (int i = 0; i < 16; ++i) {
        const int kk = 4 * i + (lane >> 4), n4 = (lane & 15) * 4;
        f32x4 x = v[i] * sc;
        if (gk) x = x * gk[k0 + kk];
        LAS float* s = scr + kk * 65 + n4;
        s[0] = x.x; s[1] = x.y; s[2] = x.z; s[3] = x.w;
    }
    LDS_WAIT(); asm volatile("" ::: "memory");
    const int c = lane & 7;
#pragma unroll
    for (int j = 0; j < 8; ++j) {
        const int n = (lane >> 3) + 8 * j;
        const LAS float* s = scr + (8 * c) * 65 + n;
        u32x4 o; o.x = pk2(s[0 * 65], s[1 * 65]); o.y = pk2(s[2 * 65], s[3 * 65]); o.z = pk2(s[4 * 65], s[5 * 65]); o.w = pk2(s[6 * 65], s[7 * 65]);
        *(u32x4*)(WT + (size_t)rm(n0 + n) * ldt + koff + k0 + 8 * c) = o;
    }
    LDS_WAIT(); asm volatile("" ::: "memory");
}
__device__ __forceinline__ void p0_prologue(const Frame& F) {
    LAS float* scr = (LAS float*)(F.lds + F.wave * 16640);
    const int gw = blockIdx.x * NWAVES + F.wave, NGW = F.G * NWAVES;
    constexpr int I_IN = 16 * 72, I_A = 8 * 16, I_B = 8 * 16, I_O = 16 * 16, I_PG = 16 * 16, I_PP = 4 * 16, I_W1 = NE * 16 * 32, I_W2 = NE * 16 * 16;
    constexpr int NITEMS = I_IN + I_A + I_B + I_O + I_PG + I_PP;
    for (int it = gw; it < NITEMS; it += NGW) {
        int r = it;
        if (r < I_IN) { tr_item(F.w_in, INC, nullptr, F.WIN, D, 0, RowId(), scr, r / 72, r % 72, F.lane, (r % 72) < 8 ? QSCALE : 1.0f); continue; } r -= I_IN;
        if (r < I_A) { tr_item(F.w_out_a, D, nullptr, F.WAB, D, 0, RowId(), scr, r / 16, r % 16, F.lane); continue; } r -= I_A;
        if (r < I_B) { tr_item(F.w_out_b, D, nullptr, F.WAB, D, 512, RowId(), scr, r / 16, r % 16, F.lane); continue; } r -= I_B;
        if (r < I_O) { tr_item(F.w_out, D, nullptr, F.WOUT, D, 0, RowId(), scr, r / 16, r % 16, F.lane); continue; } r -= I_O;
        if (r < I_PG) { tr_item(F.w_ple_gate, D, F.g_ple, F.WPG, D, 0, RowId(), scr, r / 16, r % 16, F.lane); continue; } r -= I_PG;
        { tr_item(F.w_ple_proj, D, nullptr, F.WPP, PLE, 0, RowId(), scr, r / 16, r % 16, F.lane); }
    }
    (void)I_W1; (void)I_W2;
    for (int m0 = 2 * gw; m0 < T; m0 += 2 * NGW) {
        f32x4 v[2][4];
#pragma unroll
        for (int u = 0; u < 2; ++u) { const f32x4* xr = (const f32x4*)(F.x + (size_t)(m0 + u) * D) + F.lane;
#pragma unroll
            for (int j = 0; j < 4; ++j) v[u][j] = __builtin_nontemporal_load(xr + 64 * j); }
#pragma unroll
        for (int u = 0; u < 2; ++u) { float s = 0.f;
#pragma unroll
            for (int j = 0; j < 4; ++j) s += (v[u][j].x * v[u][j].x + v[u][j].y * v[u][j].y) + (v[u][j].z * v[u][j].z + v[u][j].w * v[u][j].w);
            const float rstd = rsqrtf(wave_sum(s) * (1.f / D) + EPS);
            unsigned long long* o8 = (unsigned long long*)(F.ABF + (size_t)(m0 + u) * D) + F.lane;
#pragma unroll
            for (int j = 0; j < 4; ++j) { const f32x4 g = ((const f32x4*)F.g_mix)[F.lane + 64 * j];
                o8[64 * j] = (unsigned long long)pk2(v[u][j].x * rstd * g.x, v[u][j].y * rstd * g.y) | ((unsigned long long)pk2(v[u][j].z * rstd * g.z, v[u][j].w * rstd * g.w) << 32); } }
    }
    for (int m0 = 4 * gw; m0 < T; m0 += 4 * NGW) {
        f32x4 v[4];
#pragma unroll
        for (int u = 0; u < 4; ++u) v[u] = __builtin_nontemporal_load((const f32x4*)(F.p + (size_t)(m0 + u) * PLE) + F.lane);
#pragma unroll
        for (int u = 0; u < 4; ++u) ((unsigned long long*)(F.PBF + (size_t)(m0 + u) * PLE))[F.lane] = (unsigned long long)pk2(v[u].x, v[u].y) | ((unsigned long long)pk2(v[u].z, v[u].w) << 32);
    }
    const int gt = blockIdx.x * NTHREADS + F.tid, NGT = F.G * NTHREADS;
    for (int i = gt; i < NE * D; i += NGT) { const int e = i / D, k = i % D; const float v = F.w_router[k * NE + e] * F.g_moe[k]; const unsigned h = f2bf(v); F.WRHI[i] = (bf16)h; F.WRLO[i] = (bf16)f2bf(v - bf2f(h)); }
    for (int i = gt; i < 8 * 128 * 128; i += NGT) { const int t = (i >> 7) & 127, s = i & 127; F.SGUW[i] = (bf16)(((s >> 6) <= (t >> 6)) ? f2bf(F.sgu_w[i]) : 0u); }
}

__device__ __forceinline__ void moe_weight_items(const Frame& F) {
    LAS float* scr = (LAS float*)(F.lds + F.wave * 16640);
    const int gw = blockIdx.x * NWAVES + F.wave, NGW = F.G * NWAVES;
    constexpr int I_W1 = NE * 16 * 32, I_W2 = NE * 16 * 16;
    for (int it = gw; it < I_W1 + I_W2; it += NGW) {
        int r = it;
        if (r < I_W1) { const int e = r / 512, q = r % 512; tr_item(F.w1 + (size_t)e * D * 2 * DE, 2 * DE, F.g_moe, F.W1T + (size_t)e * 2 * DE * D, D, 0, RowW1(), scr, q / 32, q % 32, F.lane); continue; } r -= I_W1;
        { const int e = r / 256, q = r % 256; tr_item(F.w2 + (size_t)e * DE * D, D, nullptr, F.W2T + (size_t)e * D * DE, DE, 0, RowId(), scr, q / 16, q % 16, F.lane); }
    }
}
__device__ __forceinline__ void p1_inproj(const Frame& F) {
    const int gw = blockIdx.x * NWAVES + F.wave, NGW = F.G * NWAVES, r32 = F.lane & 31, hi = F.lane >> 5;
    for (int tile = gw; tile < (T / 32) * (INC / 128); tile += NGW) {
        const int mb = tile / (INC / 128), cg = tile % (INC / 128), m0 = mb * 32, n0 = cg * 128;
        const bf16* ap = F.ABF + (size_t)(m0 + r32) * D + 8 * hi;
        const bf16* bp[4];
#pragma unroll
        for (int nb = 0; nb < 4; ++nb) bp[nb] = F.WIN + (size_t)(n0 + 32 * nb + r32) * D + 8 * hi;
        f32x16 acc[4];
#pragma unroll
        for (int nb = 0; nb < 4; ++nb) acc[nb] = f32x16{};
        smma<4>(ap, bp, D, acc);
        const int kind = (n0 < ZK) ? 0 : (n0 < ZU) ? 1 : (n0 < ZGA) ? 2 : 3;
#pragma unroll
        for (int nb = 0; nb < 4; ++nb)
#pragma unroll
            for (int r = 0; r < 16; ++r) {
                float v = acc[nb][r];
                if (kind == 2) v = gelu_tanh(v); else if (kind == 3) v = sigmoidf_(v);
                F.ZZ[(size_t)(m0 + crow(r, hi)) * INC + n0 + 32 * nb + r32] = (bf16)f2bf(v);
            }
    }
    for (int tile = gw; tile < (T / 32) * (D / 128); tile += NGW) {
        const int mb = tile / (D / 128), cg = tile % (D / 128), m0 = mb * 32, n0 = cg * 128;
        const bf16* ap = F.PBF + (size_t)(m0 + r32) * PLE + 8 * hi;
        const bf16* bp[4];
#pragma unroll
        for (int nb = 0; nb < 4; ++nb) bp[nb] = F.WPP + (size_t)(n0 + 32 * nb + r32) * PLE + 8 * hi;
        f32x16 acc[4];
#pragma unroll
        for (int nb = 0; nb < 4; ++nb) acc[nb] = f32x16{};
        smma<4>(ap, bp, PLE, acc);
#pragma unroll
        for (int nb = 0; nb < 4; ++nb)
#pragma unroll
            for (int r = 0; r < 16; ++r) F.PROJ[(size_t)(m0 + crow(r, hi)) * D + n0 + 32 * nb + r32] = (bf16)f2bf(acc[nb][r]);
    }
}

template <bool EARLY>
__device__ __forceinline__ void p2_attn_scalar(const Frame& F) {
    LAS u32x4* Kt = (LAS u32x4*)F.lds;
    LAS u32x4* Vt = Kt + 512;
    for (int pr = blockIdx.x; pr < 256; pr += F.G) {
        for (int half = 0; half < 2; ++half) {
            const int bh = pr >> 2, tb = half == 0 ? (pr & 3) : 7 - (pr & 3), b = bh / NH, h = bh % NH;
            const int t = tb * 512 + F.tid;
            const size_t row = (size_t)b * SEQ + t;
            float q[64], o[64];
            { const u32x4* qp = (const u32x4*)(F.ZZ + row * INC + ZQ + h * HD);
#pragma unroll
              for (int c = 0; c < 8; ++c) { float f[8]; unpack8(qp[c], f);
#pragma unroll
                  for (int j = 0; j < 8; ++j) q[8 * c + j] = f[j]; } }
#pragma unroll
            for (int d = 0; d < 64; ++d) o[d] = 0.f;
            float carry = 1.f;
            for (int kt = tb * 8 + 7; kt >= 0; --kt) {
                __syncthreads();
                { const int kr = F.tid >> 3, c = F.tid & 7; const size_t krow = ((size_t)b * SEQ + kt * 64 + kr) * INC + h * HD + 8 * c;
                  Kt[F.tid] = *(const u32x4*)(F.ZZ + krow + ZK); Vt[F.tid] = *(const u32x4*)(F.ZZ + krow + ZV); }
                __syncthreads();
                for (int sl = 63; sl >= 0; --sl) {
                    const int s = kt * 64 + sl;
                    if (s < t) {
                        float z = 0.f;
#pragma unroll
                        for (int c = 0; c < 8; ++c) { float f[8]; unpack8(Kt[sl * 8 + c], f);
#pragma unroll
                            for (int j = 0; j < 8; ++j) z += q[8 * c + j] * f[j]; }
                        z = fminf(z, 100.f);
                        const float e = exp2f(z), r = 1.0f / (1.0f + e);
                        carry *= r;
                        const float w = e * carry;
#pragma unroll
                        for (int c = 0; c < 8; ++c) { float f[8]; unpack8(Vt[sl * 8 + c], f);
#pragma unroll
                            for (int j = 0; j < 8; ++j) o[8 * c + j] += w * f[j]; }
                    }
                }
            }
            u32x4* op = (u32x4*)(F.OAB + row * D + h * HD);
#pragma unroll
            for (int c = 0; c < 8; ++c) { u32x4 w; w.x = pk2(o[8 * c], o[8 * c + 1]); w.y = pk2(o[8 * c + 2], o[8 * c + 3]); w.z = pk2(o[8 * c + 4], o[8 * c + 5]); w.w = pk2(o[8 * c + 6], o[8 * c + 7]); op[c] = w; }
        }
    }
    __syncthreads();
}
__device__ __forceinline__ void p2_sgu_simple(const Frame& F) {
    LAS bf16* vsn = (LAS bf16*)F.lds;
    for (int unit = blockIdx.x; unit < T / 128; unit += F.G) {
        const int row0 = unit * 128;
        for (int i = 0; i < 16; ++i) {
            const int rl = F.wave * 16 + i;
            const u32x4 w = *(const u32x4*)(F.ZZ + (size_t)(row0 + rl) * INC + ZVS + 8 * F.lane);
            float f[8]; unpack8(w, f);
            float s = 0.f;
#pragma unroll
            for (int j = 0; j < 8; ++j) s += f[j];
            const float mean = wave_sum(s) * (1.f / 512.f);
            float s2 = 0.f;
#pragma unroll
            for (int j = 0; j < 8; ++j) { f[j] -= mean; s2 += f[j] * f[j]; }
            const float rstd = rsqrtf(wave_sum(s2) * (1.f / 512.f) + EPS);
            const f32x4 g0 = *(const f32x4*)(F.sgu_norm + 8 * F.lane), g1 = *(const f32x4*)(F.sgu_norm + 8 * F.lane + 4);
            u32x4 o; o.x = pk2(f[0] * rstd * g0.x, f[1] * rstd * g0.y); o.y = pk2(f[2] * rstd * g0.z, f[3] * rstd * g0.w);
            o.z = pk2(f[4] * rstd * g1.x, f[5] * rstd * g1.y); o.w = pk2(f[6] * rstd * g1.z, f[7] * rstd * g1.w);
            *(LAS u32x4*)(vsn + rl * 512 + 8 * F.lane) = o;
        }
        __syncthreads();
        const int ch = F.tid, g = ch >> 6;
        for (int tl = 0; tl < 128; ++tl) {
            const bf16* wrow = F.SGUW + (g * 128 + tl) * 128;
            float a = 0.f;
            for (int s = 0; s < 128; ++s) a += bf2f(wrow[s]) * bf2f(vsn[s * 512 + ch]);
            const float sv = a + F.sgu_b[g * 128 + tl];
            const float u = bf2f(F.ZZ[(size_t)(row0 + tl) * INC + ZU + ch]);
            F.OAB[(size_t)(row0 + tl) * D + 512 + ch] = (bf16)f2bf(u * sv);
        }
        __syncthreads();
    }
}

__device__ __forceinline__ void p3_merge(const Frame& F) {
    const int gw = blockIdx.x * NWAVES + F.wave, NGW = F.G * NWAVES, r32 = F.lane & 31, hi = F.lane >> 5;
    for (int tile = gw; tile < (T / 32) * (D / 128); tile += NGW) {
        const int mb = tile / (D / 128), cg = tile % (D / 128), m0 = mb * 32, n0 = cg * 128;
        const bf16* ap = F.OAB + (size_t)(m0 + r32) * D + 8 * hi;
        const bf16* bp[4];
#pragma unroll
        for (int nb = 0; nb < 4; ++nb) bp[nb] = F.WAB + (size_t)(n0 + 32 * nb + r32) * D + 8 * hi;
        f32x16 acca[4], accb[4];
#pragma unroll
        for (int nb = 0; nb < 4; ++nb) { acca[nb] = f32x16{}; accb[nb] = f32x16{}; }
        smma<4>(ap, bp, 512, acca);
        const bf16* ap2 = ap + 512; const bf16* bp2[4];
#pragma unroll
        for (int nb = 0; nb < 4; ++nb) bp2[nb] = bp[nb] + 512;
        smma<4>(ap2, bp2, 512, accb);
#pragma unroll
        for (int nb = 0; nb < 4; ++nb)
#pragma unroll
            for (int r = 0; r < 16; ++r) {
                const size_t row = m0 + crow(r, hi); const int col = n0 + 32 * nb + r32;
                const float sga = bf2f(F.ZZ[row * INC + ZGA + col]), sgb = bf2f(F.ZZ[row * INC + ZGB + col]);
                F.MERGED[row * D + col] = (bf16)f2bf(sga * acca[nb][r] + sgb * accb[nb][r]);
            }
    }
}
__device__ __forceinline__ void p4_out(const Frame& F) {
    const int gw = blockIdx.x * NWAVES + F.wave, NGW = F.G * NWAVES, r32 = F.lane & 31, hi = F.lane >> 5;
    for (int tile = gw; tile < (T / 32) * (D / 128); tile += NGW) {
        const int mb = tile / (D / 128), cg = tile % (D / 128), m0 = mb * 32, n0 = cg * 128;
        const bf16* ap = F.MERGED + (size_t)(m0 + r32) * D + 8 * hi;
        const bf16* bp[4];
#pragma unroll
        for (int nb = 0; nb < 4; ++nb) bp[nb] = F.WOUT + (size_t)(n0 + 32 * nb + r32) * D + 8 * hi;
        f32x16 acc[4];
#pragma unroll
        for (int nb = 0; nb < 4; ++nb) acc[nb] = f32x16{};
        smma<4>(ap, bp, D, acc);
#pragma unroll
        for (int nb = 0; nb < 4; ++nb)
#pragma unroll
            for (int r = 0; r < 16; ++r) {
                const size_t row = m0 + crow(r, hi); const int col = n0 + 32 * nb + r32;
                F.H1[row * D + col] = (bf16)f2bf(F.x[row * D + col] + acc[nb][r]);
            }
    }
}
__device__ __forceinline__ void p5_router(const Frame& F) {
    LAS unsigned* hist = (LAS unsigned*)F.lds;
    LAS unsigned* base = hist + 32;
    LAS unsigned* lsel = hist + 64;
    LAS float* lgate = (LAS float*)(hist + 64 + 512);
    const int e = F.lane & 31, half = F.lane >> 5;
    for (int chunk = blockIdx.x; chunk < T / 128; chunk += F.G) {
        if (F.tid < 32) hist[F.tid] = 0u;
        __syncthreads();
        for (int i = 0; i < 16; ++i) {
            const int tl = F.wave * 16 + i, t = chunk * 128 + tl;
            const bf16* hp = F.H1 + (size_t)t * D + half * 512;
            const bf16* whi = F.WRHI + e * D + half * 512;
            const bf16* wlo = F.WRLO + e * D + half * 512;
            float dot = 0.f, ss = 0.f;
            for (int k = 0; k < 512; k += 8) {
                float hf[8], a[8], c[8];
                unpack8(*(const u32x4*)(hp + k), hf); unpack8(*(const u32x4*)(whi + k), a); unpack8(*(const u32x4*)(wlo + k), c);
#pragma unroll
                for (int j = 0; j < 8; ++j) { dot += hf[j] * (a[j] + c[j]); ss += hf[j] * hf[j]; }
            }
            dot += __shfl_xor(dot, 32); ss += __shfl_xor(ss, 32);
            const float rstd = rsqrtf(ss * (1.f / D) + EPS);
            float logit = rstd * dot + F.b_router[e];
            float val[4]; int sel[4];
#pragma unroll
            for (int r = 0; r < 4; ++r) {
                const float m = wave_max(logit);
                const unsigned long long bal = __ballot(logit == m);
                const int le = (int)(__ffsll((long long)bal) - 1) & 31;
                val[r] = m; sel[r] = le;
                if (e == le) logit = -INFINITY;
            }
            float ex[4], sum = 0.f;
#pragma unroll
            for (int r = 0; r < 4; ++r) { ex[r] = __expf(val[r] - val[0]); sum += ex[r]; }
            { const u32x4* hr = (const u32x4*)(F.H1 + (size_t)t * D); u32x4* cr = (u32x4*)(F.ABF + (size_t)t * D);
#pragma unroll
              for (int j = 0; j < 2; ++j) { float f[8]; unpack8(hr[F.lane + 64 * j], f); u32x4 o; o.x = pk2(f[0] * rstd, f[1] * rstd); o.y = pk2(f[2] * rstd, f[3] * rstd); o.z = pk2(f[4] * rstd, f[5] * rstd); o.w = pk2(f[6] * rstd, f[7] * rstd); cr[F.lane + 64 * j] = o; } }
            if (F.lane == 0) {
                F.RSTD1[t] = rstd;
#pragma unroll
                for (int r = 0; r < 4; ++r) { const unsigned loc = atomicAdd((unsigned*)&hist[sel[r]], 1u); lsel[tl * 4 + r] = (unsigned)sel[r] | (loc << 8); lgate[tl * 4 + r] = ex[r] / sum; }
            }
        }
        __syncthreads();
        if (F.tid < 32) { const unsigned n = hist[F.tid]; base[F.tid] = n ? __hip_atomic_fetch_add(F.ctl + CW_CNT + 64 * F.tid, n, __ATOMIC_RELAXED, __HIP_MEMORY_SCOPE_AGENT) : 0u; }
        __syncthreads();
        { const int tl = F.tid >> 2, r = F.tid & 3, t = chunk * 128 + tl; const unsigned s = lsel[tl * 4 + r]; const int ee = s & 255; const unsigned rank = base[ee] + (s >> 8);
          F.TOKLIST[ee * LCAP + rank] = t; F.SLOTREF[t * 4 + r] = (ee << 16) | rank; F.GATE[t * 4 + r] = lgate[tl * 4 + r]; }
        __syncthreads();
    }
}
struct MoeTab { LAS int* cnt; LAS int* toff; LAS int* p32; };
__device__ __forceinline__ MoeTab moe_tables(const Frame& F) {
    MoeTab M; M.cnt = (LAS int*)(F.lds + MISC_OFF + 128); M.toff = M.cnt + 32; M.p32 = M.toff + 33;
    __syncthreads();
    if (F.tid == 0) { int a = 0, c = 0;
        for (int e = 0; e < NE; ++e) { const int n = (int)__hip_atomic_load(F.ctl + CW_CNT + 64 * e, __ATOMIC_RELAXED, __HIP_MEMORY_SCOPE_AGENT); M.cnt[e] = n; M.toff[e] = a; M.p32[e] = c; a += (n + 255) >> 8; c += (n + 31) >> 5; }
        M.toff[NE] = a; M.p32[NE] = c; }
    __syncthreads();
    return M;
}
__device__ __forceinline__ void p6_moe1(const Frame& F) {
    const MoeTab M = moe_tables(F);
    const int gw = blockIdx.x * NWAVES + F.wave, NGW = F.G * NWAVES, r32 = F.lane & 31, hi = F.lane >> 5;
    const int ntiles = M.p32[NE] * 32;
    for (int tile = gw; tile < ntiles; tile += NGW) {
        const int blk = tile >> 5, hb = tile & 31;
        int e = 0; while (M.p32[e + 1] <= blk) ++e;
        const int sb = blk - M.p32[e], cnt = M.cnt[e];
        const int rank = sb * 32 + r32;
        const int tok = F.TOKLIST[e * LCAP + (rank < cnt ? rank : cnt - 1)];
        const bf16* ap = F.ABF + (size_t)tok * D + 8 * hi;
        const int hidb = hb * 32 + r32;
        const bf16* bp[2];
        bp[0] = F.W1T + ((size_t)e * 2048 + 256 * (hidb >> 7) + (hidb & 127)) * D + 8 * hi; bp[1] = bp[0] + 128 * D;
        f32x16 acc[2]; acc[0] = f32x16{}; acc[1] = f32x16{};
        smma<2>(ap, bp, D, acc);
        const float bg = F.b1[e * 2048 + 2 * hidb], bl = F.b1[e * 2048 + 2 * hidb + 1];
#pragma unroll
        for (int r = 0; r < 16; ++r) {
            const int rr = crow(r, hi), rk = sb * 32 + rr;
            float gl = acc[0][r] + bg, li = acc[1][r] + bl;
            gl = fminf(gl, 7.f); li = fminf(fmaxf(li, -7.f), 7.f);
            const float act = gl * sigmoidf_(1.702f * gl) * (li + 1.f);
            if (rk < cnt) F.HID[((size_t)256 * M.toff[e] + rk) * DE + hidb] = (bf16)f2bf(act);
        }
    }
}
__device__ __forceinline__ void p7_moe2(const Frame& F) {
    const MoeTab M = moe_tables(F);
    const int gw = blockIdx.x * NWAVES + F.wave, NGW = F.G * NWAVES, r32 = F.lane & 31, hi = F.lane >> 5;
    const int ntiles = M.p32[NE] * 8;
    for (int tile = gw; tile < ntiles; tile += NGW) {
        const int blk = tile >> 3, cg = tile & 7;
        int e = 0; while (M.p32[e + 1] <= blk) ++e;
        const int sb = blk - M.p32[e], cnt = M.cnt[e];
        const size_t rowb = (size_t)256 * M.toff[e] + sb * 32;
        const bf16* ap = F.HID + (rowb + r32) * DE + 8 * hi;
        const bf16* bp[4];
#pragma unroll
        for (int nb = 0; nb < 4; ++nb) bp[nb] = F.W2T + ((size_t)e * D + cg * 128 + 32 * nb + r32) * DE + 8 * hi;
        f32x16 acc[4];
#pragma unroll
        for (int nb = 0; nb < 4; ++nb) acc[nb] = f32x16{};
        smma<4>(ap, bp, DE, acc);
#pragma unroll
        for (int nb = 0; nb < 4; ++nb) { const int col = cg * 128 + 32 * nb + r32; const float bb = F.b2[e * D + col];
#pragma unroll
            for (int r = 0; r < 16; ++r) { const int rr = crow(r, hi); if (sb * 32 + rr < cnt) F.YS[(rowb + rr) * D + col] = (bf16)f2bf(acc[nb][r] + bb); } }
    }
}
__device__ __forceinline__ void p8_combine(const Frame& F) {
    const MoeTab M = moe_tables(F);
    const int gw = blockIdx.x * NWAVES + F.wave, NGW = F.G * NWAVES;
    for (int t0 = 2 * gw; t0 < T; t0 += 2 * NGW) {
        size_t yrow[2][4]; float gk[2][4];
#pragma unroll
        for (int u = 0; u < 2; ++u)
#pragma unroll
            for (int k = 0; k < 4; ++k) { const int sr = F.SLOTREF[(t0 + u) * 4 + k]; yrow[u][k] = (size_t)256 * M.toff[sr >> 16] + (sr & 0xffff); gk[u][k] = F.GATE[(t0 + u) * 4 + k]; }
        u32x4 hv[2][2], yv[2][2][4];
#pragma unroll
        for (int u = 0; u < 2; ++u)
#pragma unroll
            for (int j = 0; j < 2; ++j) { const int col = 8 * F.lane + 512 * j; hv[u][j] = *(const u32x4*)(F.H1 + (size_t)(t0 + u) * D + col);
#pragma unroll
                for (int k = 0; k < 4; ++k) yv[u][j][k] = *(const u32x4*)(F.YS + yrow[u][k] * D + col); }
#pragma unroll
        for (int u = 0; u < 2; ++u) {
            float ss = 0.f;
#pragma unroll
            for (int j = 0; j < 2; ++j) {
                float a[8]; unpack8(hv[u][j], a);
#pragma unroll
                for (int k = 0; k < 4; ++k) { float y[8]; unpack8(yv[u][j][k], y);
#pragma unroll
                    for (int q = 0; q < 8; ++q) a[q] += gk[u][k] * y[q]; }
                u32x4 o; o.x = pk2(a[0], a[1]); o.y = pk2(a[2], a[3]); o.z = pk2(a[4], a[5]); o.w = pk2(a[6], a[7]);
                *(u32x4*)(F.H2 + (size_t)(t0 + u) * D + 8 * F.lane + 512 * j) = o;
                float b[8]; unpack8(o, b);
#pragma unroll
                for (int q = 0; q < 8; ++q) ss += b[q] * b[q];
            }
            ss = wave_sum(ss);
            if (F.lane == 0) F.RSTD2[t0 + u] = rsqrtf(ss * (1.f / D) + EPS);
        }
    }
}
__device__ __forceinline__ void p9_ple(const Frame& F) {
    const int gw = blockIdx.x * NWAVES + F.wave, NGW = F.G * NWAVES, r32 = F.lane & 31, hi = F.lane >> 5;
    for (int tile = gw; tile < (T / 32) * (D / 128); tile += NGW) {
        const int mb = tile / (D / 128), cg = tile % (D / 128), m0 = mb * 32, n0 = cg * 128;
        const bf16* ap = F.H2 + (size_t)(m0 + r32) * D + 8 * hi;
        const bf16* bp[4];
#pragma unroll
        for (int nb = 0; nb < 4; ++nb) bp[nb] = F.WPG + (size_t)(n0 + 32 * nb + r32) * D + 8 * hi;
        f32x16 acc[4];
#pragma unroll
        for (int nb = 0; nb < 4; ++nb) acc[nb] = f32x16{};
        smma<4>(ap, bp, D, acc);
#pragma unroll
        for (int r = 0; r < 16; ++r) {
            const size_t row = m0 + crow(r, hi); const float rs = F.RSTD2[row];
#pragma unroll
            for (int nb = 0; nb < 4; ++nb) { const int col = n0 + 32 * nb + r32;
                const float pg = sigmoidf_(rs * acc[nb][r]);
                F.H3[row * D + col] = (bf16)f2bf(bf2f(F.H2[row * D + col]) + pg * bf2f(F.PROJ[row * D + col])); }
        }
    }
}
__device__ __forceinline__ void p10_final(const Frame& F) {
    const int gw = blockIdx.x * NWAVES + F.wave, NGW = F.G * NWAVES;
    for (int t = gw; t < T; t += NGW) {
        float a[2][8]; float ss = 0.f;
#pragma unroll
        for (int j = 0; j < 2; ++j) { unpack8(*(const u32x4*)(F.H3 + (size_t)t * D + 8 * F.lane + 512 * j), a[j]);
#pragma unroll
            for (int q = 0; q < 8; ++q) ss += a[j][q] * a[j][q]; }
        const float rstd = rsqrtf(wave_sum(ss) * (1.f / D) + EPS);
#pragma unroll
        for (int j = 0; j < 2; ++j) { const int col = 8 * F.lane + 512 * j;
            const f32x4 g0 = *(const f32x4*)(F.g_final + col), g1 = *(const f32x4*)(F.g_final + col + 4);
            f32x4 o0, o1; o0.x = a[j][0] * rstd * g0.x; o0.y = a[j][1] * rstd * g0.y; o0.z = a[j][2] * rstd * g0.z; o0.w = a[j][3] * rstd * g0.w;
            o1.x = a[j][4] * rstd * g1.x; o1.y = a[j][5] * rstd * g1.y; o1.z = a[j][6] * rstd * g1.z; o1.w = a[j][7] * rstd * g1.w;
            *(f32x4*)(F.out + (size_t)t * D + col) = o0; *(f32x4*)(F.out + (size_t)t * D + col + 4) = o1; }
    }
}


namespace pg {
constexpr int BM = 256, BK = 64, HALF = 128, HTB = HALF * BK * 2, STAGE_BYTES = 8 * HTB, NXCD = 8, WGM = 8;
__device__ __forceinline__ int lds_byte(int r, int c) { const int st = (r >> 4) * 2 + (c >> 5), rr = r & 15, cc = c & 31, ob = rr * 64 + cc * 2; return st * 1024 + (ob ^ (((ob >> 9) & 1) << 5)); }
__device__ __forceinline__ void stage_rc(int b, int& R, int& C) { const int st = b / 1024, sb = b % 1024, swz = sb ^ (((sb >> 9) & 1) << 5); R = (st >> 1) * 16 + swz / 64; C = (st & 1) * 32 + (swz % 64) / 2; }
__device__ __forceinline__ int perm32(int rho) { const int n = rho >> 4, i = rho & 15; return 8 * (i >> 2) + 4 * n + (i & 3); }
struct Unit { int arow, brow, kofs, x0, x1, x2; };
__device__ __forceinline__ unsigned cvt_pk_bf16(float lo, float hi) { unsigned r; asm volatile("v_cvt_pk_bf16_f32 %0, %1, %2" : "=v"(r) : "v"(lo), "v"(hi)); return r; }
typedef f32x4 Acc[2][2][4][2];

struct DenseMap { static constexpr bool GATHER = false; int lda; __device__ __forceinline__ unsigned rowoff(const Unit&, int r) const { return (unsigned)r * (unsigned)lda * 2u; }
    __device__ __forceinline__ size_t base(const Unit& u) const { return (size_t)u.arow * lda * 2; } };
template <int SPLIT>
struct DenseOrder {
    int nM, nN, nwg, G, c, khalf;
    __device__ __forceinline__ void init(int M, int N, int G_, int c_, int khalf_ = 0) { nM = M / BM; nN = N / BM; nwg = nM * nN; G = G_; c = c_; khalf = khalf_; }
    __device__ __forceinline__ bool next(int i, Unit& u) const {
        const int j = SPLIT ? (i >> 1) : i;
        const long L = (long)j * G + c; if (L >= nwg) return false;
        int wgid = (int)L; { const int q = nwg / NXCD, r = nwg % NXCD, xcd = wgid % NXCD, off = wgid / NXCD; wgid = (xcd < r ? xcd * (q + 1) : r * (q + 1) + (xcd - r) * q) + off; }
        const int nig = WGM * nN, gid = wgid / nig, fm = gid * WGM, gsz = (nM - fm) < WGM ? (nM - fm) : WGM;
        const int pm = fm + ((wgid % nig) % gsz), pn = (wgid % nig) / gsz;
        u.arow = pm * BM; u.brow = pn * BM; u.x0 = pm; u.x1 = pn; u.x2 = SPLIT ? (i & 1) : 0; u.kofs = SPLIT ? (i & 1) * khalf : 0; return true;
    }
};

template <class Epi, class Sched, class AMap, bool ALIGN_EPI>
__device__ __forceinline__ void gemm_run(LAS unsigned char* lds, const bf16* A, const bf16* Bt, const int ldb, const int nt, const Sched& S, const Epi& E, const AMap& AM) {
    const int tid = threadIdx.x, wid = __builtin_amdgcn_readfirstlane(tid >> 6), lane = tid & 63, wr = wid >> 2, wc = wid & 3, fr = lane & 15, fq = lane >> 4;
    int RA[2]; unsigned CA2[2], voffB[2];
#pragma unroll
    for (int i = 0; i < 2; ++i) { int R, C; stage_rc(tid * 16 + i * 8192, R, C); RA[i] = R; CA2[i] = (unsigned)C * 2u; const int Rb = (R & ~31) + perm32(R & 31); voffB[i] = (unsigned)(Rb * ldb + C) * 2u; }
    const size_t kstep = (size_t)(BK * 2);
    const size_t hstepB = (size_t)HALF * ldb * 2;
    const unsigned ldsw = (unsigned)wid * 1024u;
    const int aoff = lds_byte(wr * 64 + fr, fq * 8), boff = lds_byte(wc * 32 + fr, fq * 8);
#define PG_SA(b, h) (((b) * 2 + (h)) * HTB)
#define PG_SB(b, h) ((4 + (b) * 2 + (h)) * HTB)
#define PG_STAGE(bufoff, gbase, voff) do { _Pragma("unroll") for (int _i = 0; _i < 2; ++_i) \
        __builtin_amdgcn_global_load_lds((const unsigned*)((const char*)(gbase) + (voff)[_i]), (LAS unsigned*)(lds + (bufoff) + ldsw + _i * 8192), 16, 0, 0); } while (0)
#define PG_LDA(dst, b, h) do { _Pragma("unroll") for (int m = 0; m < 4; ++m) _Pragma("unroll") for (int k = 0; k < 2; ++k) dst[m][k] = *(const LAS bf16x8*)(lds + PG_SA(b, h) + aoff + m * 2048 + k * 1024); } while (0)
#define PG_LDB(dst, b, h) do { _Pragma("unroll") for (int n = 0; n < 2; ++n) _Pragma("unroll") for (int k = 0; k < 2; ++k) dst[n][k] = *(const LAS bf16x8*)(lds + PG_SB(b, h) + boff + n * 2048 + k * 1024); } while (0)
#define PG_MMA(ai, bj, At, Bt_) do { __builtin_amdgcn_s_setprio(1); _Pragma("unroll") for (int m = 0; m < 4; ++m) _Pragma("unroll") for (int n = 0; n < 2; ++n) _Pragma("unroll") for (int k = 0; k < 2; ++k) \
        acc[ai][bj][m][n] = __builtin_amdgcn_mfma_f32_16x16x32_bf16(Bt_[n][k], At[m][k], acc[ai][bj][m][n], 0, 0, 0); __builtin_amdgcn_s_setprio(0); } while (0)
#define PG_WAIT_V(n) asm volatile("s_waitcnt vmcnt(" #n ")" ::: "memory")
#define PG_WAIT_L(n) asm volatile("s_waitcnt lgkmcnt(" #n ")" ::: "memory")
#define PG_BAR __builtin_amdgcn_s_barrier()
#define PG_SCHED __builtin_amdgcn_sched_barrier(0)
#define PG_ZERO() do { _Pragma("unroll") for (int a = 0; a < 2; ++a) _Pragma("unroll") for (int b = 0; b < 2; ++b) _Pragma("unroll") for (int m = 0; m < 4; ++m) _Pragma("unroll") for (int n = 0; n < 2; ++n) acc[a][b][m][n] = (f32x4){0.f, 0.f, 0.f, 0.f}; } while (0)
#define PG_MKVA(u, va) do { _Pragma("unroll") for (int h = 0; h < 2; ++h) _Pragma("unroll") for (int i = 0; i < 2; ++i) va[h][i] = AM.rowoff(u, h * HALF + RA[i]) + CA2[i]; } while (0)
    Unit cur, nxt; int ui = 0;
    if (!S.next(0, cur)) return;
    Acc acc; PG_ZERO();
    bf16x8 At[4][2], B0[2][2], B1[2][2];
    unsigned voffA[2]; unsigned vaC[2][2], vaN[2][2];
    const size_t hstepA = AMap::GATHER ? 0 : (size_t)AM.rowoff(cur, HALF);
    if constexpr (AMap::GATHER) { PG_MKVA(cur, vaC); } else {
#pragma unroll
        for (int i = 0; i < 2; ++i) voffA[i] = AM.rowoff(cur, RA[i]) + CA2[i]; }
#define PG_STAGE_A(bufoff, ptr, h, useNext) do { if constexpr (AMap::GATHER) { unsigned _v[2] = {(useNext) ? vaN[h][0] : vaC[h][0], (useNext) ? vaN[h][1] : vaC[h][1]}; PG_STAGE(bufoff, ptr, _v); } \
        else { PG_STAGE(bufoff, (ptr) + (h) * hstepA, voffA); } } while (0)
    const char* cA = (const char*)A + (size_t)cur.kofs * 2 + AM.base(cur); const char* cB = (const char*)Bt + ((size_t)cur.brow * ldb + cur.kofs) * 2;
    PG_STAGE(PG_SB(0, 0), cB, voffB); PG_STAGE(PG_SB(0, 1), cB + hstepB, voffB); PG_STAGE_A(PG_SA(0, 0), cA, 0, false); PG_STAGE_A(PG_SA(0, 1), cA, 1, false);
    if (wr == 1) PG_BAR;
    PG_WAIT_V(2); PG_BAR;
    PG_STAGE(PG_SB(1, 0), cB + kstep, voffB); PG_STAGE_A(PG_SA(1, 0), cA + kstep, 0, false); PG_STAGE(PG_SB(1, 1), cB + hstepB + kstep, voffB);
    PG_WAIT_V(6); PG_BAR;
    for (;;) {
        const bool has_next = S.next(ui + 1, nxt);
        const char* nA = cA; const char* nB = cB;
        if (has_next) { if constexpr (AMap::GATHER) { PG_MKVA(nxt, vaN); } nA = (const char*)A + (size_t)nxt.kofs * 2 + AM.base(nxt); nB = (const char*)Bt + ((size_t)nxt.brow * ldb + nxt.kofs) * 2; }
        else if constexpr (AMap::GATHER) {
#pragma unroll
            for (int h = 0; h < 2; ++h)
#pragma unroll
                for (int i = 0; i < 2; ++i) vaN[h][i] = vaC[h][i]; }
        E.prefetch(cur, ui, wid, lane);
#pragma unroll 1
        for (int t = 0; t < nt; t += 2) {
            const bool last = (t == nt - 2);
            const char* a1 = cA + (size_t)(t + 1) * kstep;
            const char* a2 = last ? nA : cA + (size_t)(t + 2) * kstep; const char* b2 = last ? nB : cB + (size_t)(t + 2) * kstep;
            const char* a3 = a2 + kstep; const char* b3 = b2 + kstep;
            PG_LDB(B0, 0, 0); PG_LDB(B1, 0, 1); PG_SCHED; PG_LDA(At, 0, 0); PG_STAGE_A(PG_SA(1, 1), a1, 1, false);
            PG_WAIT_V(8); PG_WAIT_L(0); PG_BAR; PG_MMA(0, 0, At, B0); PG_MMA(0, 1, At, B1); PG_BAR; PG_SCHED;
            PG_LDA(At, 0, 1); PG_STAGE(PG_SB(0, 0), b2, voffB); PG_STAGE(PG_SB(0, 1), b2 + hstepB, voffB); PG_STAGE_A(PG_SA(0, 0), a2, 0, last);
            PG_WAIT_V(8); PG_WAIT_L(0); PG_BAR; PG_MMA(1, 0, At, B0); PG_MMA(1, 1, At, B1); PG_BAR; PG_SCHED;
            PG_LDB(B0, 1, 0); PG_LDB(B1, 1, 1); PG_SCHED; PG_LDA(At, 1, 0); PG_STAGE_A(PG_SA(0, 1), a2, 1, last);
            PG_WAIT_V(8); PG_WAIT_L(0); PG_BAR; PG_MMA(0, 0, At, B0); PG_MMA(0, 1, At, B1); PG_BAR; PG_SCHED;
            PG_LDA(At, 1, 1); PG_STAGE(PG_SB(1, 0), b3, voffB); PG_STAGE(PG_SB(1, 1), b3 + hstepB, voffB); PG_STAGE_A(PG_SA(1, 0), a3, 0, last);
            PG_WAIT_V(8); PG_WAIT_L(0); PG_BAR; PG_MMA(1, 0, At, B0); PG_MMA(1, 1, At, B1); PG_BAR; PG_SCHED;
        }
        if constexpr (ALIGN_EPI) { if (wr == 0) PG_BAR; }
        E(acc, cur, ui, wr, wc, fr, fq);
        if (!has_next) break;
        if (!E.keep(cur)) PG_ZERO();
        cur = nxt; cA = nA; cB = nB; ++ui;
        if constexpr (AMap::GATHER) {
#pragma unroll
            for (int h = 0; h < 2; ++h)
#pragma unroll
                for (int i = 0; i < 2; ++i) vaC[h][i] = vaN[h][i]; }
        if constexpr (ALIGN_EPI) { if (wr == 1) PG_BAR; }
    }
    PG_WAIT_V(0);
    if constexpr (!ALIGN_EPI) { if (wr == 0) PG_BAR; }
    PG_BAR;
#undef PG_SA
#undef PG_SB
#undef PG_STAGE
#undef PG_LDA
#undef PG_LDB
#undef PG_MMA
#undef PG_WAIT_V
#undef PG_WAIT_L
#undef PG_BAR
#undef PG_SCHED
#undef PG_ZERO
#undef PG_MKVA
#undef PG_STAGE_A
}

__device__ __forceinline__ float sigm(float x) { return __builtin_amdgcn_rcpf(1.0f + __builtin_amdgcn_exp2f(-LOG2E * x)); }
__device__ __forceinline__ float gelu_t(float x) { const float u = 1.5957691216057308f * (x + 0.044715f * x * x * x); return x * sigm(u); }
__device__ __forceinline__ float act_k(float x, float c1, float c3, bool plain, bool mulx) { const float s = sigm(x * (c1 + c3 * x * x)); const float y = mulx ? x * s : s; return plain ? x : y; }
__device__ __forceinline__ void store_act(const Acc& acc, bf16* base, int ldc, int kind) {
    const bool plain = kind == 1, mulx = kind == 2; const float c1 = kind == 2 ? 1.5957691216057308f : 1.0f, c3 = kind == 2 ? 1.5957691216057308f * 0.044715f : 0.0f;
#pragma unroll
    for (int ai = 0; ai < 2; ++ai)
#pragma unroll
        for (int m = 0; m < 4; ++m) { bf16* rowp = base + (size_t)(ai * HALF + m * 16) * ldc;
#pragma unroll
            for (int bj = 0; bj < 2; ++bj) { const f32x4 v0 = acc[ai][bj][m][0], v1 = acc[ai][bj][m][1];
                u32x4 w; w.x = cvt_pk_bf16(act_k(v0[0], c1, c3, plain, mulx), act_k(v0[1], c1, c3, plain, mulx)); w.y = cvt_pk_bf16(act_k(v0[2], c1, c3, plain, mulx), act_k(v0[3], c1, c3, plain, mulx));
                w.z = cvt_pk_bf16(act_k(v1[0], c1, c3, plain, mulx), act_k(v1[1], c1, c3, plain, mulx)); w.w = cvt_pk_bf16(act_k(v1[2], c1, c3, plain, mulx), act_k(v1[3], c1, c3, plain, mulx));
                __builtin_nontemporal_store(w, (u32x4*)(rowp + bj * HALF)); }
            asm volatile("" ::: "memory"); }
}
__device__ __forceinline__ void store_plain(const Acc& acc, bf16* base, int ldc) {
#pragma unroll
    for (int ai = 0; ai < 2; ++ai)
#pragma unroll
        for (int m = 0; m < 4; ++m) { bf16* rowp = base + (size_t)(ai * HALF + m * 16) * ldc;
#pragma unroll
            for (int bj = 0; bj < 2; ++bj) { const f32x4 v0 = acc[ai][bj][m][0], v1 = acc[ai][bj][m][1];
                u32x4 w; w.x = cvt_pk_bf16(v0[0], v0[1]); w.y = cvt_pk_bf16(v0[2], v0[3]); w.z = cvt_pk_bf16(v1[0], v1[1]); w.w = cvt_pk_bf16(v1[2], v1[3]);
                __builtin_nontemporal_store(w, (u32x4*)(rowp + bj * HALF)); } }
}
struct EpiInproj {
    bf16* ZZ;
    __device__ __forceinline__ bool keep(const Unit&) const { return false; }
    __device__ __forceinline__ void prefetch(const Unit&, int, int, int) const {}
    __device__ __forceinline__ void operator()(const Acc& acc, const Unit& u, int ui, int wr, int wc, int fr, int fq) const {
        bf16* base = ZZ + (size_t)(u.arow + wr * 64 + fr) * INC + u.brow + wc * 32 + 8 * fq;
        const int n0 = u.brow;
        if (n0 < ZU) store_plain(acc, base, INC); else store_act(acc, base, INC, n0 < ZGA ? 2 : 3);
    }
};
struct EpiPlain {
    bf16* O; int ldc;
    __device__ __forceinline__ bool keep(const Unit&) const { return false; }
    __device__ __forceinline__ void prefetch(const Unit&, int, int, int) const {}
    __device__ __forceinline__ void operator()(const Acc& acc, const Unit& u, int ui, int wr, int wc, int fr, int fq) const {
        store_plain(acc, O + (size_t)(u.arow + wr * 64 + fr) * ldc + u.brow + wc * 32 + 8 * fq, ldc);
    }
};
struct EpiMerge {
    const bf16* ZZ; bf16* O;
    __device__ __forceinline__ bool keep(const Unit& u) const { return u.x2 == 0; }
    __device__ __forceinline__ void prefetch(const Unit&, int, int, int) const {}
    __device__ __forceinline__ void operator()(Acc& acc, const Unit& u, int ui, int wr, int wc, int fr, int fq) const {
        const int row0 = u.arow + wr * 64 + fr, col0 = u.brow + wc * 32 + 8 * fq;
#pragma unroll
        for (int ai = 0; ai < 2; ++ai)
#pragma unroll
            for (int m = 0; m < 4; ++m) { const size_t row = row0 + ai * HALF + m * 16;
#pragma unroll
                for (int bj = 0; bj < 2; ++bj) { const int col = col0 + bj * HALF;
                    float gb[8]; unpack8(*(const u32x4*)(ZZ + row * INC + ZGB + col), gb);
#pragma unroll
                    for (int q = 0; q < 8; ++q) gb[q] = fmaxf(gb[q], 1e-30f);
                    if (u.x2 == 0) { float ga[8]; unpack8(*(const u32x4*)(ZZ + row * INC + ZGA + col), ga);
#pragma unroll
                        for (int q = 0; q < 8; ++q) acc[ai][bj][m][q >> 2][q & 3] *= ga[q] * __builtin_amdgcn_rcpf(gb[q]); }
                    else { const f32x4 v0 = acc[ai][bj][m][0], v1 = acc[ai][bj][m][1];
                        u32x4 w; w.x = cvt_pk_bf16(v0[0] * gb[0], v0[1] * gb[1]); w.y = cvt_pk_bf16(v0[2] * gb[2], v0[3] * gb[3]); w.z = cvt_pk_bf16(v1[0] * gb[4], v1[1] * gb[5]); w.w = cvt_pk_bf16(v1[2] * gb[6], v1[3] * gb[7]);
                        *(u32x4*)(O + row * D + col) = w; } }
                asm volatile("" ::: "memory"); }
    }
};
struct EpiOut {
    const float* x; bf16* O;
    __device__ __forceinline__ bool keep(const Unit&) const { return false; }
    __device__ __forceinline__ void prefetch(const Unit&, int, int, int) const {}
    __device__ __forceinline__ void operator()(const Acc& acc, const Unit& u, int ui, int wr, int wc, int fr, int fq) const {
        const int row0 = u.arow + wr * 64 + fr, col0 = u.brow + wc * 32 + 8 * fq;
#pragma unroll
        for (int ai = 0; ai < 2; ++ai)
#pragma unroll
            for (int m = 0; m < 4; ++m) { const size_t row = row0 + ai * HALF + m * 16;
#pragma unroll
                for (int bj = 0; bj < 2; ++bj) { const int col = col0 + bj * HALF;
                    const f32x4 x0 = *(const f32x4*)(x + row * D + col), x1 = *(const f32x4*)(x + row * D + col + 4);
                    const f32x4 v0 = acc[ai][bj][m][0] + x0, v1 = acc[ai][bj][m][1] + x1;
                    u32x4 w; w.x = cvt_pk_bf16(v0[0], v0[1]); w.y = cvt_pk_bf16(v0[2], v0[3]); w.z = cvt_pk_bf16(v1[0], v1[1]); w.w = cvt_pk_bf16(v1[2], v1[3]);
                    *(u32x4*)(O + row * D + col) = w; }
                asm volatile("" ::: "memory"); }
    }
};
struct EpiPle {
    const bf16* H2; const bf16* PROJ; const float* RSTD2; bf16* O;
    __device__ __forceinline__ bool keep(const Unit&) const { return false; }
    __device__ __forceinline__ void prefetch(const Unit&, int, int, int) const {}
    __device__ __forceinline__ void operator()(const Acc& acc, const Unit& u, int ui, int wr, int wc, int fr, int fq) const {
        const int row0 = u.arow + wr * 64 + fr, col0 = u.brow + wc * 32 + 8 * fq;
#pragma unroll
        for (int ai = 0; ai < 2; ++ai)
#pragma unroll
            for (int m = 0; m < 4; ++m) { const size_t row = row0 + ai * HALF + m * 16; const float rs = RSTD2[row];
#pragma unroll
                for (int bj = 0; bj < 2; ++bj) { const int col = col0 + bj * HALF;
                    float h[8], pj[8]; unpack8(*(const u32x4*)(H2 + row * D + col), h); unpack8(*(const u32x4*)(PROJ + row * D + col), pj);
                    float o[8];
#pragma unroll
                    for (int q = 0; q < 8; ++q) o[q] = h[q] + sigm(rs * acc[ai][bj][m][q >> 2][q & 3]) * pj[q];
                    u32x4 w; w.x = cvt_pk_bf16(o[0], o[1]); w.y = cvt_pk_bf16(o[2], o[3]); w.z = cvt_pk_bf16(o[4], o[5]); w.w = cvt_pk_bf16(o[6], o[7]);
                    *(u32x4*)(O + row * D + col) = w; }
                asm volatile("" ::: "memory"); }
    }
};
}

#ifndef STAG_US
#define STAG_US 0
#endif
__device__ __forceinline__ void stagger(int group) {
    if (STAG_US > 0 && group > 0) { const unsigned long long t0 = __builtin_amdgcn_s_memrealtime(), dt = (unsigned long long)(group * STAG_US * 100);
        while (__builtin_amdgcn_s_memrealtime() - t0 < dt) __builtin_amdgcn_s_sleep(8); }
}
__device__ __forceinline__ void p1_fast(const Frame& F) {
    stagger((blockIdx.x >> 3) & 3);
    { pg::DenseOrder<0> S; S.init(T, INC, F.G, (int)blockIdx.x); pg::EpiInproj E{F.ZZ}; pg::DenseMap AM{D};
      pg::gemm_run<pg::EpiInproj, pg::DenseOrder<0>, pg::DenseMap, true>(F.lds + STAGE_OFF, F.ABF, F.WIN, D, D / 64, S, E, AM); }
    { pg::DenseOrder<0> S; S.init(T, D, F.G, (int)blockIdx.x); pg::EpiPlain E{F.PROJ, D}; pg::DenseMap AM{PLE};
      pg::gemm_run<pg::EpiPlain, pg::DenseOrder<0>, pg::DenseMap, true>(F.lds + STAGE_OFF, F.PBF, F.WPP, PLE, PLE / 64, S, E, AM); }
}
__device__ __forceinline__ void p3_fast(const Frame& F) {
    pg::DenseOrder<1> S; S.init(T, D, F.G, (int)blockIdx.x, 512); pg::EpiMerge E{F.ZZ, F.MERGED}; pg::DenseMap AM{D};
    pg::gemm_run<pg::EpiMerge, pg::DenseOrder<1>, pg::DenseMap, true>(F.lds + STAGE_OFF, F.OAB, F.WAB, D, 512 / 64, S, E, AM);
}
__device__ __forceinline__ void p4_fast(const Frame& F) {
    pg::DenseOrder<0> S; S.init(T, D, F.G, (int)blockIdx.x); pg::EpiOut E{F.x, F.H1}; pg::DenseMap AM{D};
    pg::gemm_run<pg::EpiOut, pg::DenseOrder<0>, pg::DenseMap, true>(F.lds + STAGE_OFF, F.MERGED, F.WOUT, D, D / 64, S, E, AM);
}
__device__ __forceinline__ void p9_fast(const Frame& F) {
    pg::DenseOrder<0> S; S.init(T, D, F.G, (int)blockIdx.x); pg::EpiPle E{F.H2, F.PROJ, F.RSTD2, F.H3}; pg::DenseMap AM{D};
    pg::gemm_run<pg::EpiPle, pg::DenseOrder<0>, pg::DenseMap, true>(F.lds + STAGE_OFF, F.H2, F.WPG, D, D / 64, S, E, AM);
}


namespace pg {
template <int MT, int NT, int NROWS_B>
struct MoeOrder {
    LAS const int* cnt; LAS const int* toff; int c;
    __device__ __forceinline__ bool next(int i, Unit& u) const {
        const int x = c & 7, cl = c >> 3, sb = i * 8 + x, mtg = MT * sb + cl / NT, pn = cl % NT;
        if (mtg >= toff[NE]) return false;
        int e = 0; while (toff[e + 1] <= mtg) ++e;
        u.arow = 256 * mtg; u.brow = e * NROWS_B + 256 * pn; u.kofs = 0; u.x0 = e; u.x1 = cnt[e] - 256 * (mtg - toff[e]); u.x2 = i; return true;
    }
};
struct GatherMap { static constexpr bool GATHER = true; LAS const unsigned* tab;
    __device__ __forceinline__ unsigned rowoff(const Unit& u, int r) const { return tab[u.x2 * 256 + r]; }
    __device__ __forceinline__ size_t base(const Unit&) const { return 0; } };
struct EpiSwiglu {
    bf16* HID; const float* b1; LAS unsigned char* lds;
    __device__ __forceinline__ bool keep(const Unit&) const { return false; }
    __device__ __forceinline__ void prefetch(const Unit& u, int ui, int wid, int lane) const {
        if (wid == 0) __builtin_amdgcn_global_load_lds((const unsigned*)(b1 + u.x0 * 2048 + ((u.brow & 2047) >> 8) * 256 + lane * 4), (LAS unsigned*)(lds + BIAS_OFF + (ui & 1) * 1024), 16, 0, 0); }
    __device__ __forceinline__ void operator()(const Acc& acc, const Unit& u, int ui, int wr, int wc, int fr, int fq) const {
        const int e = u.x0, valid = u.x1, pn = (u.brow & 2047) >> 8, hid0 = 128 * pn + 32 * wc + 8 * fq;
        const LAS f32x4* bp = (const LAS f32x4*)(lds + BIAS_OFF + (ui & 1) * 1024 + (32 * wc + 8 * fq) * 8);
        const f32x4 f0 = bp[0], f1 = bp[1], f2 = bp[2], f3 = bp[3];
        const float bg[8] = {f0[0], f0[2], f1[0], f1[2], f2[0], f2[2], f3[0], f3[2]}, bl[8] = {f0[1], f0[3], f1[1], f1[3], f2[1], f2[3], f3[1], f3[3]};
#pragma unroll
        for (int ai = 0; ai < 2; ++ai)
#pragma unroll
            for (int m = 0; m < 4; ++m) { const int rl = ai * HALF + wr * 64 + m * 16 + fr;
                float o[8];
#pragma unroll
                for (int q = 0; q < 8; ++q) { float g = acc[ai][0][m][q >> 2][q & 3] + bg[q], l = acc[ai][1][m][q >> 2][q & 3] + bl[q];
                    g = fminf(g, 7.f); l = fminf(fmaxf(l, -7.f), 7.f); o[q] = g * sigm(1.702f * g) * (l + 1.f); }
                u32x4 w; w.x = cvt_pk_bf16(o[0], o[1]); w.y = cvt_pk_bf16(o[2], o[3]); w.z = cvt_pk_bf16(o[4], o[5]); w.w = cvt_pk_bf16(o[6], o[7]);
                __builtin_nontemporal_store(w, (u32x4*)(HID + (size_t)(u.arow + rl) * DE + hid0)); }
    }
};
struct EpiBias2 {
    bf16* YS; const float* b2; LAS unsigned char* lds;
    __device__ __forceinline__ bool keep(const Unit&) const { return false; }
    __device__ __forceinline__ void prefetch(const Unit& u, int ui, int wid, int lane) const {
        if (wid == 0) __builtin_amdgcn_global_load_lds((const unsigned*)(b2 + u.x0 * D + (u.brow & 1023) + lane * 4), (LAS unsigned*)(lds + BIAS_OFF + (ui & 1) * 1024), 16, 0, 0); }
    __device__ __forceinline__ void operator()(const Acc& acc, const Unit& u, int ui, int wr, int wc, int fr, int fq) const {
        const int valid = u.x1, col0 = (u.brow & 1023) + 32 * wc + 8 * fq;
        f32x4 bb[2][2];
#pragma unroll
        for (int bj = 0; bj < 2; ++bj)
#pragma unroll
            for (int n = 0; n < 2; ++n) bb[bj][n] = *(const LAS f32x4*)(lds + BIAS_OFF + (ui & 1) * 1024 + (32 * wc + 8 * fq + bj * HALF + 4 * n) * 4);
#pragma unroll
        for (int ai = 0; ai < 2; ++ai)
#pragma unroll
            for (int m = 0; m < 4; ++m) { const int rl = ai * HALF + wr * 64 + m * 16 + fr;
#pragma unroll
                for (int bj = 0; bj < 2; ++bj) { const f32x4 v0 = acc[ai][bj][m][0] + bb[bj][0], v1 = acc[ai][bj][m][1] + bb[bj][1];
                    u32x4 w; w.x = cvt_pk_bf16(v0[0], v0[1]); w.y = cvt_pk_bf16(v0[2], v0[3]); w.z = cvt_pk_bf16(v1[0], v1[1]); w.w = cvt_pk_bf16(v1[2], v1[3]);
                    __builtin_nontemporal_store(w, (u32x4*)(YS + (size_t)(u.arow + rl) * D + col0 + bj * HALF)); } }
    }
};
}
__device__ __forceinline__ void p6_fast(const Frame& F) {
    const MoeTab M = moe_tables(F);
    pg::MoeOrder<4, 8, 2048> S{M.cnt, M.toff, (int)blockIdx.x};
    LAS unsigned* tab = (LAS unsigned*)(F.lds + TAB_OFF);
    { pg::Unit u;
      for (int i = 0; i < 18 && S.next(i, u); ++i) { const int e = u.x0, cnt = M.cnt[e], rk0 = cnt - u.x1;
          if (F.tid < 256) { const int rk = rk0 + F.tid; tab[i * 256 + F.tid] = (unsigned)F.TOKLIST[e * LCAP + (rk < cnt ? rk : cnt - 1)] * (unsigned)(D * 2); } } }
    __syncthreads();
    stagger((blockIdx.x >> 3) & 3);
    pg::EpiSwiglu E{F.HID, F.b1, F.lds}; pg::GatherMap AM{tab};
    pg::gemm_run<pg::EpiSwiglu, pg::MoeOrder<4, 8, 2048>, pg::GatherMap, true>(F.lds + STAGE_OFF, F.ABF, F.W1T, D, D / 64, S, E, AM);
}
__device__ __forceinline__ void p7_fast(const Frame& F) {
    const MoeTab M = moe_tables(F);
    pg::MoeOrder<8, 4, 1024> S{M.cnt, M.toff, (int)blockIdx.x};
    stagger((blockIdx.x >> 3) & 3);
    pg::EpiBias2 E{F.YS, F.b2, F.lds}; pg::DenseMap AM{DE};
    pg::gemm_run<pg::EpiBias2, pg::MoeOrder<8, 4, 1024>, pg::DenseMap, true>(F.lds + STAGE_OFF, F.HID, F.W2T, DE, DE / 64, S, E, AM);
}


typedef short s16x4 __attribute__((ext_vector_type(4)));
__device__ __forceinline__ s16x4 vtr(LAS const unsigned char* p) { return __builtin_bit_cast(s16x4, __builtin_amdgcn_ds_read_tr16_b64_v4i16((LAS s16x4*)p)); }
__device__ __forceinline__ bf16x8 cat8(s16x4 a, s16x4 b) { return (bf16x8){a[0], a[1], a[2], a[3], b[0], b[1], b[2], b[3]}; }
template <bool EARLY>
__device__ __forceinline__ void p2_attn_fast(const Frame& F) {
    const int lane = F.lane, r32 = lane & 31, hi = lane >> 5;
    LAS unsigned char* vl = F.lds + F.wave * 16640;
    LAS const unsigned char* vrd = vl + (4 * hi + ((lane & 15) >> 2)) * 64 + ((lane >> 4) & 1) * 32 + (lane & 3) * 8;
    const int gw = blockIdx.x * NWAVES + F.wave, NGW = F.G * NWAVES;
    for (int item = gw; item < BATCH * NH * (SEQ / 32); item += NGW) {
        const int qi = item >> 6, bh = item & 63, b = bh >> 3, h = bh & 7;
        const size_t rowbase = (size_t)b * SEQ;
        bf16x8 qf[4];
        { const bf16* qp = F.ZZ + (rowbase + 32 * qi + r32) * INC + ZQ + h * HD + 8 * hi;
#pragma unroll
          for (int d0 = 0; d0 < 4; ++d0) qf[d0] = *(const bf16x8*)(qp + 16 * d0); }
        f32x16 o[2]; o[0] = f32x16{}; o[1] = f32x16{};
        float carry = 1.0f;
        bf16x8 kn[4]; u32x4 vn[4];
#define ATT_LOAD(j) do { const bf16* kp = F.ZZ + (rowbase + 32 * (j) + r32) * INC + ZK + h * HD + 8 * hi; \
            _Pragma("unroll") for (int d0 = 0; d0 < 4; ++d0) kn[d0] = *(const bf16x8*)(kp + 16 * d0); \
            _Pragma("unroll") for (int i = 0; i < 4; ++i) { const int L = i * 64 + lane; \
                vn[i] = *(const u32x4*)(F.ZZ + (rowbase + 32 * (j) + ((L >> 2) & 31)) * INC + ZV + h * HD + (L >> 7) * 32 + (L & 3) * 8); } } while (0)
        ATT_LOAD(qi);
        for (int j = qi; j >= 0; --j) {
            bf16x8 kf[4];
#pragma unroll
            for (int d0 = 0; d0 < 4; ++d0) kf[d0] = kn[d0];
#pragma unroll
            for (int i = 0; i < 4; ++i) *(LAS u32x4*)(vl + (i * 64 + lane) * 16) = vn[i];
            if (j > 0) ATT_LOAD(j - 1);
            f32x16 p = f32x16{};
#pragma unroll
            for (int d0 = 0; d0 < 4; ++d0) p = __builtin_amdgcn_mfma_f32_32x32x16_bf16(kf[d0], qf[d0], p, 0, 0, 0);
            float e[16], sfx[16];
#pragma unroll
            for (int r = 0; r < 16; ++r) { const float z = fminf(p[r], 100.f); e[r] = __builtin_amdgcn_exp2f(z); sfx[r] = __builtin_amdgcn_rcpf(1.0f + e[r]); }
            if (j == qi) {
#pragma unroll
                for (int r = 0; r < 16; ++r) { const bool ok = crow(r, hi) < r32; e[r] = ok ? e[r] : 0.f; sfx[r] = ok ? sfx[r] : 1.f; }
            }
            float TL[4], TH[4];
#pragma unroll
            for (int g = 0; g < 4; ++g) {
                sfx[4 * g + 2] *= sfx[4 * g + 3]; sfx[4 * g + 1] *= sfx[4 * g + 2]; sfx[4 * g] *= sfx[4 * g + 1];
                const auto rr = __builtin_amdgcn_permlane32_swap(__float_as_uint(sfx[4 * g]), __float_as_uint(sfx[4 * g]), false, false);
                TL[g] = __uint_as_float(rr[0]); TH[g] = __uint_as_float(rr[1]); }
            float R[8];
            R[7] = carry; R[6] = R[7] * TH[3]; R[5] = R[6] * TL[3]; R[4] = R[5] * TH[2]; R[3] = R[4] * TL[2]; R[2] = R[3] * TH[1]; R[1] = R[2] * TL[1]; R[0] = R[1] * TH[0]; carry = R[0] * TL[0];
            unsigned pw[8];
#pragma unroll
            for (int g = 0; g < 4; ++g) { const float off = hi ? R[2 * g + 1] : R[2 * g];
                const float w0 = e[4 * g] * (off * sfx[4 * g]), w1 = e[4 * g + 1] * (off * sfx[4 * g + 1]), w2 = e[4 * g + 2] * (off * sfx[4 * g + 2]), w3 = e[4 * g + 3] * (off * sfx[4 * g + 3]);
                pw[2 * g] = pg::cvt_pk_bf16(w0, w1); pw[2 * g + 1] = pg::cvt_pk_bf16(w2, w3); }
            const bf16x8 pa0 = __builtin_bit_cast(bf16x8, (u32x4){pw[0], pw[1], pw[2], pw[3]}), pa1 = __builtin_bit_cast(bf16x8, (u32x4){pw[4], pw[5], pw[6], pw[7]});
            asm volatile("s_waitcnt lgkmcnt(0)" ::: "memory");
#pragma unroll
            for (int d0 = 0; d0 < 2; ++d0) {
                const s16x4 a0 = vtr(vrd + d0 * 2048), a1 = vtr(vrd + d0 * 2048 + 512), b0 = vtr(vrd + d0 * 2048 + 1024), b1 = vtr(vrd + d0 * 2048 + 1536);
                o[d0] = __builtin_amdgcn_mfma_f32_32x32x16_bf16(pa0, cat8(a0, a1), o[d0], 0, 0, 0);
                o[d0] = __builtin_amdgcn_mfma_f32_32x32x16_bf16(pa1, cat8(b0, b1), o[d0], 0, 0, 0);
            }
            asm volatile("s_waitcnt lgkmcnt(0)" ::: "memory");
            if (EARLY && __all(carry == 0.f)) break;
        }
#undef ATT_LOAD
        bf16* op = F.OAB + (rowbase + 32 * qi) * D + h * HD + r32;
#pragma unroll
        for (int d0 = 0; d0 < 2; ++d0)
#pragma unroll
            for (int r = 0; r < 16; ++r) op[(size_t)crow(r, hi) * D + 32 * d0] = (bf16)f2bf(o[d0][r]);
    }
}
__device__ __forceinline__ void p2_sgu_fast(const Frame& F) {
    const int lane = F.lane, r32 = lane & 31, hi = lane >> 5, g = F.wave;
    for (int unit = blockIdx.x; unit < T / 128; unit += F.G) {
        const int row0 = unit * 128;
        __syncthreads();
        for (int i = 0; i < 16; ++i) {
            const int rl = g * 16 + i;
            const u32x4 w = *(const u32x4*)(F.ZZ + (size_t)(row0 + rl) * INC + ZVS + 8 * lane);
            float f[8]; unpack8(w, f);
            float s = 0.f;
#pragma unroll
            for (int j = 0; j < 8; ++j) s += f[j];
            const float mean = wave_sum(s) * (1.f / 512.f);
            float s2 = 0.f;
#pragma unroll
            for (int j = 0; j < 8; ++j) { f[j] -= mean; s2 += f[j] * f[j]; }
            const float rstd = rsqrtf(wave_sum(s2) * (1.f / 512.f) + EPS);
            const f32x4 g0 = *(const f32x4*)(F.sgu_norm + 8 * lane), g1 = *(const f32x4*)(F.sgu_norm + 8 * lane + 4);
            u32x4 o; o.x = pk2(f[0] * rstd * g0.x, f[1] * rstd * g0.y); o.y = pk2(f[2] * rstd * g0.z, f[3] * rstd * g0.w);
            o.z = pk2(f[4] * rstd * g1.x, f[5] * rstd * g1.y); o.w = pk2(f[6] * rstd * g1.z, f[7] * rstd * g1.w);
            *(LAS u32x4*)(F.lds + (lane >> 2) * 8192 + rl * 64 + (lane & 3) * 16) = o;
        }
        __syncthreads();
        LAS const unsigned char* vrd = F.lds + (2 * g) * 8192 + (8 * hi + ((lane & 15) >> 2)) * 64 + ((lane >> 4) & 1) * 32 + (lane & 3) * 8;
        for (int mt = 0; mt < 4; ++mt) {
            f32x16 acc[2]; acc[0] = f32x16{}; acc[1] = f32x16{};
            const bf16* ap = F.SGUW + ((size_t)g * 128 + 32 * mt + r32) * 128 + 8 * hi;
            const int nks = (mt < 2) ? 4 : 8;
            for (int ks = 0; ks < nks; ++ks) {
                const bf16x8 a = *(const bf16x8*)(ap + 16 * ks);
#pragma unroll
                for (int nt = 0; nt < 2; ++nt) {
                    const s16x4 b0 = vtr(vrd + nt * 8192 + ks * 1024), b1 = vtr(vrd + nt * 8192 + ks * 1024 + 256);
                    acc[nt] = __builtin_amdgcn_mfma_f32_32x32x16_bf16(a, cat8(b0, b1), acc[nt], 0, 0, 0);
                }
            }
#pragma unroll
            for (int r = 0; r < 16; ++r) { const int tl = 32 * mt + crow(r, hi); const float bs = F.sgu_b[g * 128 + tl];
#pragma unroll
                for (int nt = 0; nt < 2; ++nt) { const int ch = 64 * g + 32 * nt + r32;
                    const float u = bf2f(F.ZZ[(size_t)(row0 + tl) * INC + ZU + ch]);
                    F.OAB[(size_t)(row0 + tl) * D + 512 + ch] = (bf16)f2bf(u * (acc[nt][r] + bs)); } }
        }
    }
    __syncthreads();
}


__device__ __forceinline__ void p5_fast(const Frame& F) {
    LAS unsigned* hist = (LAS unsigned*)F.lds;
    LAS unsigned* base = hist + 32;
    LAS unsigned* lsel = hist + 64;
    LAS float* lgate = (LAS float*)(hist + 64 + 512);
    LAS float* rsv = lgate + 512;
    LAS float* part = (LAS float*)(F.lds + 8192);
    const int lane = F.lane, r32 = lane & 31, hi = lane >> 5, wg4 = F.wave & 3, kh = F.wave >> 2;
    for (int chunk = blockIdx.x; chunk < T / 128; chunk += F.G) {
        if (F.tid < 32) hist[F.tid] = 0u;
        const int t0 = chunk * 128 + wg4 * 32;
        const bf16* hp = F.H1 + (size_t)(t0 + r32) * D + kh * 512 + 8 * hi;
        const bf16* whp = F.WRHI + r32 * D + kh * 512 + 8 * hi;
        const bf16* wlp = F.WRLO + r32 * D + kh * 512 + 8 * hi;
        f32x16 acc = f32x16{}; float ss = 0.f;
#pragma unroll 4
        for (int k0 = 0; k0 < 512; k0 += 16) {
            const u32x4 hb = *(const u32x4*)(hp + k0);
            const bf16x8 ah = *(const bf16x8*)(whp + k0), al = *(const bf16x8*)(wlp + k0);
            const bf16x8 bb = __builtin_bit_cast(bf16x8, hb);
            acc = __builtin_amdgcn_mfma_f32_32x32x16_bf16(ah, bb, acc, 0, 0, 0);
            acc = __builtin_amdgcn_mfma_f32_32x32x16_bf16(al, bb, acc, 0, 0, 0);
#pragma unroll
            for (int q = 0; q < 4; ++q) { const float lo = __uint_as_float(hb[q] << 16), hh = __uint_as_float(hb[q] & 0xffff0000u); ss += lo * lo + hh * hh; }
        }
        { const auto rr = __builtin_amdgcn_permlane32_swap(__float_as_uint(ss), __float_as_uint(ss), false, false); ss = __uint_as_float(rr[0]) + __uint_as_float(rr[1]); }
        if (kh == 1) {
#pragma unroll
            for (int r = 0; r < 16; ++r) part[(wg4 * 17 + r) * 64 + lane] = acc[r];
            part[(wg4 * 17 + 16) * 64 + lane] = ss;
        }
        __syncthreads();
        if (kh == 0) {
            ss += part[(wg4 * 17 + 16) * 64 + lane];
            const float rstd = rsqrtf(ss * (1.f / D) + EPS);
            float v[16];
#pragma unroll
            for (int r = 0; r < 16; ++r) v[r] = rstd * (acc[r] + part[(wg4 * 17 + r) * 64 + lane]) + F.b_router[crow(r, hi)];
            float cv[8]; int ce[8];
#pragma unroll
            for (int k = 0; k < 4; ++k) {
                float m = v[0];
#pragma unroll
                for (int r = 1; r < 16; ++r) m = fmaxf(m, v[r]);
                int idx = 15;
#pragma unroll
                for (int r = 14; r >= 0; --r) idx = (v[r] == m) ? r : idx;
                cv[k] = m; ce[k] = (idx & 3) + 8 * (idx >> 2) + 4 * hi;
#pragma unroll
                for (int r = 0; r < 16; ++r) v[r] = (r == idx) ? -INFINITY : v[r];
            }
#pragma unroll
            for (int k = 0; k < 4; ++k) {
                const auto rv = __builtin_amdgcn_permlane32_swap(__float_as_uint(cv[k]), __float_as_uint(cv[k]), false, false);
                const auto re = __builtin_amdgcn_permlane32_swap((unsigned)ce[k], (unsigned)ce[k], false, false);
                cv[4 + k] = __uint_as_float(hi ? rv[0] : rv[1]); ce[4 + k] = (int)(hi ? re[0] : re[1]);
            }
            float tv[4]; int te[4];
#pragma unroll
            for (int k = 0; k < 4; ++k) {
                float bv = cv[0]; int be = ce[0];
#pragma unroll
                for (int c = 1; c < 8; ++c) { const bool better = (cv[c] > bv) || (cv[c] == bv && ce[c] < be); bv = better ? cv[c] : bv; be = better ? ce[c] : be; }
                tv[k] = bv; te[k] = be;
#pragma unroll
                for (int c = 0; c < 8; ++c) cv[c] = (ce[c] == be) ? -INFINITY : cv[c];
            }
            float ex[4], sum = 0.f;
#pragma unroll
            for (int k = 0; k < 4; ++k) { ex[k] = __expf(tv[k] - tv[0]); sum += ex[k]; }
            if (hi == 0) { const int tl = wg4 * 32 + r32; rsv[tl] = rstd;
#pragma unroll
                for (int k = 0; k < 4; ++k) { const unsigned loc = atomicAdd((unsigned*)&hist[te[k]], 1u); lsel[tl * 4 + k] = (unsigned)te[k] | (loc << 8); lgate[tl * 4 + k] = ex[k] / sum; } }
        }
        __syncthreads();
        if (F.tid < 32) { const unsigned n = hist[F.tid]; base[F.tid] = n ? __hip_atomic_fetch_add(F.ctl + CW_CNT + 64 * F.tid, n, __ATOMIC_RELAXED, __HIP_MEMORY_SCOPE_AGENT) : 0u; }
        __syncthreads();
        { const int tl = F.tid >> 2, r = F.tid & 3, t = chunk * 128 + tl; const unsigned sl = lsel[tl * 4 + r]; const int ee = sl & 255; const unsigned rank = base[ee] + (sl >> 8);
          F.TOKLIST[ee * LCAP + rank] = t; F.SLOTREF[t * 4 + r] = (ee << 16) | rank; F.GATE[t * 4 + r] = lgate[tl * 4 + r]; }
        for (int i = 0; i < 16; ++i) {
            const int tl = F.wave * 16 + i, t = chunk * 128 + tl; const float rstd = rsv[tl];
            const u32x4* hr = (const u32x4*)(F.H1 + (size_t)t * D); u32x4* cr = (u32x4*)(F.ABF + (size_t)t * D);
#pragma unroll
            for (int j = 0; j < 2; ++j) { float f[8]; unpack8(hr[lane + 64 * j], f); u32x4 o; o.x = pk2(f[0] * rstd, f[1] * rstd); o.y = pk2(f[2] * rstd, f[3] * rstd); o.z = pk2(f[4] * rstd, f[5] * rstd); o.w = pk2(f[6] * rstd, f[7] * rstd); cr[lane + 64 * j] = o; }
        }
        __syncthreads();
    }
}

struct Args { const float* in[21]; float* out; unsigned char* ws; int ph_lo, ph_hi; };
__global__ void __launch_bounds__(NTHREADS, 2) fwd(Args args) {
    extern __shared__ __attribute__((aligned(16))) unsigned char lds[];
    Frame F;
    F.lds = (LAS unsigned char*)lds; F.MISC = (volatile LAS unsigned*)(F.lds + MISC_OFF);
    F.tid = threadIdx.x; F.lane = F.tid & 63; F.wave = __builtin_amdgcn_readfirstlane(F.tid >> 6); F.G = gridDim.x;
    unsigned char* ws = args.ws;
    F.ctl = (unsigned*)(ws + WS_CTL);
    F.x = args.in[0]; F.p = args.in[1]; F.g_mix = args.in[2]; F.w_in = args.in[3]; F.w_out_a = args.in[4]; F.w_out_b = args.in[5]; F.w_out = args.in[6];
    F.sgu_norm = args.in[7]; F.sgu_w = args.in[8]; F.sgu_b = args.in[9]; F.g_moe = args.in[10]; F.w_router = args.in[11]; F.b_router = args.in[12];
    F.w1 = args.in[13]; F.b1 = args.in[14]; F.w2 = args.in[15]; F.b2 = args.in[16]; F.g_ple = args.in[17]; F.w_ple_gate = args.in[18]; F.w_ple_proj = args.in[19]; F.g_final = args.in[20];
    F.out = args.out;
    F.WRHI = (bf16*)(ws + WS_WRHI); F.WRLO = (bf16*)(ws + WS_WRLO); F.SGUW = (bf16*)(ws + WS_SGUW); F.WIN = (bf16*)(ws + WS_WIN); F.WAB = (bf16*)(ws + WS_WAB);
    F.WOUT = (bf16*)(ws + WS_WOUT); F.WPG = (bf16*)(ws + WS_WPG); F.WPP = (bf16*)(ws + WS_WPP); F.W1T = (bf16*)(ws + WS_W1); F.W2T = (bf16*)(ws + WS_W2);
    F.PBF = (bf16*)(ws + WS_PBF); F.PROJ = (bf16*)(ws + WS_PROJ); F.H1 = (bf16*)(ws + WS_H1); F.ZZ = (bf16*)(ws + WS_ZZ); F.HID = (bf16*)(ws + WS_HID);
    F.H2 = (bf16*)(ws + WS_H2); F.H3 = (bf16*)(ws + WS_H3); F.ABF = (bf16*)(ws + WS_ABF); F.OAB = (bf16*)(ws + WS_OAB); F.MERGED = (bf16*)(ws + WS_MERGED); F.YS = (bf16*)(ws + WS_YS);
    F.RSTD1 = (float*)(ws + WS_RSTD1); F.RSTD2 = (float*)(ws + WS_RSTD2); F.GATE = (float*)(ws + WS_GATE);
    F.TOKLIST = (int*)(ws + WS_TOKLIST); F.SLOTREF = (int*)(ws + WS_SLOTREF);
    for (int u = F.tid; u < (LDS_BYTES - MISC_OFF) / 4; u += NTHREADS) ((LAS unsigned*)(F.lds + MISC_OFF))[u] = 0u;
    __syncthreads();
    XcdBarrier bar = xcd_barrier_post(F.ctl + CW_BAR, F.MISC + 8);
    const int lo = args.ph_lo, hi = args.ph_hi;
#define IN(k) (lo <= (k) && (k) < hi)
#ifndef REP_PHASE
#define REP_PHASE -1
#endif
#define REPS(k) ((REP_PHASE == (k)) ? 2 : 1)
#define SEAM(k) do { if (IN(k) && IN((k) + 1)) xcd_barrier(bar); } while (0)
    if (IN(0)) { for (int rp = 0; rp < REPS(0); ++rp) p0_prologue(F); } SEAM(0);
    if (IN(1)) { for (int rp = 0; rp < REPS(1); ++rp) { if (OPT_P1) p1_fast(F); else p1_inproj(F); } } SEAM(1);
    if (IN(2)) { for (int rp = 0; rp < REPS(2); ++rp) { if (OPT_SGU) p2_sgu_fast(F); else p2_sgu_simple(F); if (OPT_ATT) { if (F.wave & 1) { moe_weight_items(F); p2_attn_fast<ATT_EARLY>(F); } else { p2_attn_fast<ATT_EARLY>(F); moe_weight_items(F); } } else { moe_weight_items(F); __syncthreads(); p2_attn_scalar<false>(F); } } } SEAM(2);
    if (IN(3)) { for (int rp = 0; rp < REPS(3); ++rp) { if (OPT_P3) p3_fast(F); else p3_merge(F); } } SEAM(3);
    if (IN(4)) { for (int rp = 0; rp < REPS(4); ++rp) { if (OPT_P4) p4_fast(F); else p4_out(F); } } SEAM(4);
    if (IN(5)) { if (OPT_P5) p5_fast(F); else p5_router(F); } SEAM(5);
    if (IN(6)) { for (int rp = 0; rp < REPS(6); ++rp) { if (OPT_P6) p6_fast(F); else p6_moe1(F); } } SEAM(6);
    if (IN(7)) { for (int rp = 0; rp < REPS(7); ++rp) { if (OPT_P7) p7_fast(F); else p7_moe2(F); } } SEAM(7);
    if (IN(8)) { for (int rp = 0; rp < REPS(8); ++rp) p8_combine(F); } SEAM(8);
    if (IN(9)) { for (int rp = 0; rp < REPS(9); ++rp) { if (OPT_P9) p9_fast(F); else p9_ple(F); } } SEAM(9);
    if (IN(10)) { for (int rp = 0; rp < REPS(10); ++rp) p10_final(F); }
#undef IN
#undef SEAM
}

extern "C" void kernel_launch(void* const* d_in, const int* in_sizes, int n_in, void* d_out, int out_size, void* d_ws, size_t ws_size, hipStream_t stream) {
    static int grid = 0;
    if (grid == 0) {
        if (n_in != 21 || out_size != T * D || ws_size < WS_END) { fprintf(stderr, "kernel_launch: unexpected shapes (n_in %d out %d ws %zu)\n", n_in, out_size, ws_size); grid = -1; return; }
        int dev = 0, cus = 0;
        if (hipGetDevice(&dev) != hipSuccess || hipDeviceGetAttribute(&cus, hipDeviceAttributeMultiprocessorCount, dev) != hipSuccess) { grid = -1; return; }
        if (hipFuncSetAttribute((const void*)fwd, hipFuncAttributeMaxDynamicSharedMemorySize, LDS_BYTES) != hipSuccess) { fprintf(stderr, "kernel_launch: hipFuncSetAttribute failed\n"); grid = -1; return; }
        int per_cu = 0;
        if (hipOccupancyMaxActiveBlocksPerMultiprocessor(&per_cu, (const void*)fwd, NTHREADS, LDS_BYTES) != hipSuccess || per_cu < 1) fprintf(stderr, "kernel_launch: occupancy query says %d\n", per_cu);
        (void)hipGetLastError();
        if (cus < 256) { fprintf(stderr, "kernel_launch: needs >= 256 CUs, found %d\n", cus); grid = -1; return; }
        grid = 256;
    }
    if (grid < 0) return;
    (void)hipMemsetAsync((char*)d_ws + WS_CTL, 0, CTL_ZERO_BYTES, stream);
    Args a{};
    for (int i = 0; i < 21; ++i) a.in[i] = (const float*)d_in[i];
    a.out = (float*)d_out; a.ws = (unsigned char*)d_ws; a.ph_lo = 0; a.ph_hi = 11;
    hipLaunchKernelGGL(fwd, dim3(grid), dim3(NTHREADS), LDS_BYTES, stream, a);
}
```

```cpp
#include <hip/hip_runtime.h>
#include <cstdio>
#include <cstdint>

#define GAS __attribute__((address_space(1)))
#define LAS __attribute__((address_space(3)))
typedef unsigned short bf16;
typedef short bf16x8 __attribute__((ext_vector_type(8)));
typedef float f32x4 __attribute__((ext_vector_type(4)));
typedef float f32x16 __attribute__((ext_vector_type(16)));
typedef unsigned u32x4 __attribute__((ext_vector_type(4)));
typedef unsigned u32x2 __attribute__((ext_vector_type(2)));

#ifndef OPT_P1
#define OPT_P1 1
#endif
#ifndef OPT_P3
#define OPT_P3 1
#endif
#ifndef OPT_P4
#define OPT_P4 1
#endif
#ifndef OPT_P6
#define OPT_P6 1
#endif
#ifndef OPT_P7
#define OPT_P7 1
#endif
#ifndef OPT_ATT
#define OPT_ATT 1
#endif
#ifndef OPT_SGU
#define OPT_SGU 1
#endif
#ifndef ATT_EARLY
#define ATT_EARLY true
#endif
#ifndef OPT_P5
#define OPT_P5 1
#endif
#ifndef OPT_P9
#define OPT_P9 1
#endif
constexpr int BATCH = 8, SEQ = 4096, T = BATCH * SEQ, D = 1024, PLE = 256, NH = 8, HD = 64, NE = 32, DE = 1024, INC = 4608;
constexpr int ZQ = 0, ZK = 512, ZV = 1024, ZU = 1536, ZVS = 2048, ZGA = 2560, ZGB = 3584;
constexpr float EPS = 1e-6f;
constexpr float LOG2E = 1.4426950408889634f;
constexpr float QSCALE = 0.125f * LOG2E;
constexpr int LCAP = 32768;
constexpr int HROWS = 139264;

constexpr size_t MiB = 1u << 20;
constexpr size_t WS_CTL = 0, CTL_ZERO_BYTES = 1 * MiB;
constexpr size_t WS_WRHI = 1 * MiB, WS_WRLO = WS_WRHI + 65536, WS_SGUW = WS_WRLO + 65536;
constexpr size_t WS_RSTD1 = WS_SGUW + 262144, WS_RSTD2 = WS_RSTD1 + 131072;
constexpr size_t WS_WIN = 2 * MiB, WS_WAB = 11 * MiB, WS_WOUT = 13 * MiB, WS_WPG = 15 * MiB, WS_WPP = 17 * MiB;
constexpr size_t WS_TOKLIST = 18 * MiB, WS_SLOTREF = 22 * MiB, WS_GATE = WS_SLOTREF + 524288;
constexpr size_t WS_W1 = 28 * MiB, WS_W2 = 156 * MiB, WS_PBF = 220 * MiB, WS_PROJ = 236 * MiB, WS_H1 = 300 * MiB;
constexpr size_t WS_R1 = 364 * MiB;
constexpr size_t WS_ZZ = WS_R1, WS_HID = WS_R1, WS_H2 = WS_R1, WS_H3 = WS_R1 + 64 * MiB;
constexpr size_t WS_R2 = 652 * MiB;
constexpr size_t WS_ABF = WS_R2, WS_OAB = WS_R2 + 64 * MiB, WS_MERGED = WS_R2 + 128 * MiB, WS_YS = WS_R2;
constexpr size_t WS_END = 924 * MiB;
constexpr int CW_BAR = 4096, CW_CNT = 8192;

constexpr int STAGE_OFF = 0, TAB_OFF = 131072, BIAS_OFF = 149504, MISC_OFF = 151552;
constexpr int LDS_BYTES = 152576;
constexpr int NWAVES = 8, NTHREADS = 512;

#define LDS_WAIT() asm volatile("s_waitcnt lgkmcnt(0)" ::: "memory")
__device__ __forceinline__ float bf2f(unsigned v) { return __uint_as_float(v << 16); }
__device__ __forceinline__ unsigned f2bf(float f) { unsigned u = __float_as_uint(f); return (u + 0x7fffu + ((u >> 16) & 1u)) >> 16; }
__device__ __forceinline__ unsigned pk2(float lo, float hi) { return f2bf(lo) | (f2bf(hi) << 16); }
__device__ __forceinline__ float wave_sum(float v) {
#pragma unroll
    for (int o = 1; o < 64; o <<= 1) v += __shfl_xor(v, o);
    return v;
}
__device__ __forceinline__ float wave_max(float v) {
#pragma unroll
    for (int o = 1; o < 64; o <<= 1) v = fmaxf(v, __shfl_xor(v, o));
    return v;
}
__device__ __forceinline__ float sigmoidf_(float x) { return 1.0f / (1.0f + __expf(-x)); }
__device__ __forceinline__ float gelu_tanh(float x) {
    const float u = 1.5957691216057308f * (x + 0.044715f * x * x * x);
    return x * sigmoidf_(u);
}
__device__ __forceinline__ int crow(int r, int hi) { return (r & 3) + 8 * (r >> 2) + 4 * hi; }
__device__ __forceinline__ void unpack8(const u32x4 w, float (&f)[8]) {
    f[0] = bf2f(w.x & 0xffffu); f[1] = bf2f(w.x >> 16); f[2] = bf2f(w.y & 0xffffu); f[3] = bf2f(w.y >> 16);
    f[4] = bf2f(w.z & 0xffffu); f[5] = bf2f(w.z >> 16); f[6] = bf2f(w.w & 0xffffu); f[7] = bf2f(w.w >> 16);
}

#define XB_TMO      128
#define XB_XCNT(j)  (256  + 64 * (j))
#define XB_XSUB(j)  (1280 + 64 * (j))
#define XB_XGEN(j)  (2304 + 64 * (j))
#define XB_TOP      3328
#define XB_TOPGEN   3392
#define XCD_BAR_WORDS 3456
#define XB_SPIN_CAP (1u << 23)
__device__ __forceinline__ unsigned xb_ld(unsigned* p)              { return __hip_atomic_load(p, __ATOMIC_RELAXED, __HIP_MEMORY_SCOPE_AGENT); }
__device__ __forceinline__ unsigned xb_add(unsigned* p, unsigned v) { return __hip_atomic_fetch_add(p, v, __ATOMIC_RELAXED, __HIP_MEMORY_SCOPE_AGENT); }
__device__ __forceinline__ unsigned xb_xcc_id() { return (unsigned)__builtin_amdgcn_s_getreg((3 << 11) | 20) & 0xFu; }
#define XB_SPIN(cond, bar) do { unsigned _sp = 0; while (cond) { __builtin_amdgcn_s_sleep(1); \
    if ((++_sp & 255u) == 0u) { if (xb_ld(&(bar)[XB_TMO])) break; if (_sp > XB_SPIN_CAP) { atomicAdd(&(bar)[XB_TMO], 1u); break; } } } } while (0)
struct XcdBarrier { unsigned* bar; unsigned x; volatile LAS unsigned* st; };
__device__ __forceinline__ XcdBarrier xcd_barrier_post(unsigned* bar, volatile LAS unsigned* st) {
    XcdBarrier b; b.bar = bar; b.x = xb_xcc_id(); b.st = st;
    if (threadIdx.x == 0) (void)xb_add(&bar[XB_XCNT(b.x)], 1u);
    return b;
}
__device__ __forceinline__ void xcd_barrier_complete(unsigned* bar, unsigned x, unsigned& nloc, unsigned& nx) {
    const unsigned G = gridDim.x * gridDim.y * gridDim.z;
    unsigned sum, cnt, mine, sp = 0u;
    for (;;) {
        sum = 0u; cnt = 0u; mine = 0u;
#pragma unroll
        for (unsigned j = 0; j < 16; ++j) { const unsigned c = xb_ld(&bar[XB_XCNT(j)]); sum += c; cnt += (c > 0u) ? 1u : 0u; mine = (j == x) ? c : mine; }
        if (sum == G) break;
        __builtin_amdgcn_s_sleep(1);
        if ((++sp & 255u) == 0u) { if (xb_ld(&bar[XB_TMO])) break; if (sp > XB_SPIN_CAP) { atomicAdd(&bar[XB_TMO], 1u); break; } }
    }
    nloc = mine > 0u ? mine : 1u; nx = cnt > 0u ? cnt : 1u;
}
__device__ __forceinline__ void xcd_barrier(const XcdBarrier& b) {
    asm volatile("s_waitcnt vmcnt(0)" ::: "memory");
    __syncthreads();
    if (threadIdx.x == 0) {
        unsigned* bar = b.bar;
        __builtin_amdgcn_s_waitcnt(0);
        unsigned nloc = b.st[0], nx = b.st[1];
        if (nloc == 0u) { xcd_barrier_complete(bar, b.x, nloc, nx); b.st[0] = nloc; b.st[1] = nx; }
        const unsigned old = xb_add(&bar[XB_XSUB(b.x)], 1u);
        const unsigned gen = old / nloc;
        if (old + 1u == (gen + 1u) * nloc) {
            __builtin_amdgcn_fence(__ATOMIC_RELEASE, "agent");
            asm volatile("s_waitcnt vmcnt(0)" ::: "memory");
            const unsigned og = xb_add(&bar[XB_TOP], 1u);
            const unsigned tg = og / nx;
            if (og + 1u == (tg + 1u) * nx) xb_add(&bar[XB_TOPGEN], 1u);
            else XB_SPIN(xb_ld(&bar[XB_TOPGEN]) == tg, bar);
            __builtin_amdgcn_fence(__ATOMIC_ACQUIRE, "agent");
            xb_add(&bar[XB_XGEN(b.x)], 1u);
            asm volatile("s_waitcnt vmcnt(0)" ::: "memory");
        } else {
            XB_SPIN(xb_ld(&bar[XB_XGEN(b.x)]) == gen, bar);
            __builtin_amdgcn_fence(__ATOMIC_ACQUIRE, "agent");
            asm volatile("s_waitcnt vmcnt(0)" ::: "memory");
        }
    }
    __syncthreads();
}

struct Frame {
    LAS unsigned char* lds;
    volatile LAS unsigned* MISC;
    unsigned* ctl;
    int tid, lane, wave, G;
    const float *x, *p, *g_mix, *w_in, *w_out_a, *w_out_b, *w_out, *sgu_norm, *sgu_w, *sgu_b, *g_moe, *w_router, *b_router, *w1, *b1, *w2, *b2, *g_ple, *w_ple_gate, *w_ple_proj, *g_final;
    float* out;
    bf16 *WRHI, *WRLO, *SGUW, *WIN, *WAB, *WOUT, *WPG, *WPP, *W1T, *W2T, *PBF, *PROJ, *H1, *ZZ, *HID, *H2, *H3, *ABF, *OAB, *MERGED, *YS;
    float *RSTD1, *RSTD2, *GATE;
    int *TOKLIST, *SLOTREF;
};

template <int NB>
__device__ __forceinline__ void smma(const bf16* ap, const bf16* const (&bp)[NB], int K, f32x16 (&acc)[NB]) {
    for (int k0 = 0; k0 < K; k0 += 16) {
        const bf16x8 a = *(const bf16x8*)(ap + k0);
#pragma unroll
        for (int nb = 0; nb < NB; ++nb) { const bf16x8 b = *(const bf16x8*)(bp[nb] + k0); acc[nb] = __builtin_amdgcn_mfma_f32_32x32x16_bf16(a, b, acc[nb], 0, 0, 0); }
    }
}

struct RowId { __device__ __forceinline__ int operator()(int n) const { return n; } };
struct RowW1 { __device__ __forceinline__ int operator()(int n) const { const int hid = n >> 1; return 256 * (hid >> 7) + (hid & 127) + 128 * (n & 1); } };
template <class RM>
__device__ __forceinline__ void tr_item(const float* W, int N, const float* gk, bf16* WT, int ldt, int koff, RM rm, LAS float* scr, int kb, int nb, int lane, float sc = 1.0f) {
    const int k0 = kb * 64, n0 = nb * 64;
    f32x4 v[16];
#pragma unroll
    for (int i = 0; i < 16; ++i) v[i] = __builtin_nontemporal_load((const f32x4*)(W + (size_t)(k0 + 4 * i + (lane >> 4)) * N + n0 + (lane & 15) * 4));
#pragma unroll
    for (int i = 0; i < 16; ++i) {
        const int kk = 4 * i + (lane >> 4), n4 = (lane & 15) * 4;
        f32x4 x = v[i] * sc;
        if (gk) x = x * gk[k0 + kk];
        LAS float* s = scr + kk * 65 + n4;
        s[0] = x.x; s[1] = x.y; s[2] = x.z; s[3] = x.w;
    }
    LDS_WAIT(); asm volatile("" ::: "memory");
    const int c = lane & 7;
#pragma unroll
    for (int j = 0; j < 8; ++j) {
        const int n = (lane >> 3) + 8 * j;
        const LAS float* s = scr + (8 * c) * 65 + n;
        u32x4 o; o.x = pk2(s[0 * 65], s[1 * 65]); o.y = pk2(s[2 * 65], s[3 * 65]); o.z = pk2(s[4 * 65], s[5 * 65]); o.w = pk2(s[6 * 65], s[7 * 65]);
        *(u32x4*)(WT + (size_t)rm(n0 + n) * ldt + koff + k0 + 8 * c) = o;
    }
    LDS_WAIT(); asm volatile("" ::: "memory");
}
__device__ __forceinline__ void p0_prologue(const Frame& F) {
    LAS float* scr = (LAS float*)(F.lds + F.wave * 16640);
    const int gw = blockIdx.x * NWAVES + F.wave, NGW = F.G * NWAVES;
    constexpr int I_IN = 16 * 72, I_A = 8 * 16, I_B = 8 * 16, I_O = 16 * 16, I_PG = 16 * 16, I_PP = 4 * 16, I_W1 = NE * 16 * 32, I_W2 = NE * 16 * 16;
    constexpr int NITEMS = I_IN + I_A + I_B + I_O + I_PG + I_PP;
    for (int it = gw; it < NITEMS; it += NGW) {
        int r = it;
        if (r < I_IN) { tr_item(F.w_in, INC, nullptr, F.WIN, D, 0, RowId(), scr, r / 72, r % 72, F.lane, (r % 72) < 8 ? QSCALE : 1.0f); continue; } r -= I_IN;
        if (r < I_A) { tr_item(F.w_out_a, D, nullptr, F.WAB, D, 0, RowId(), scr, r / 16, r % 16, F.lane); continue; } r -= I_A;
        if (r < I_B) { tr_item(F.w_out_b, D, nullptr, F.WAB, D, 512, RowId(), scr, r / 16, r % 16, F.lane); continue; } r -= I_B;
        if (r < I_O) { tr_item(F.w_out, D, nullptr, F.WOUT, D, 0, RowId(), scr, r / 16, r % 16, F.lane); continue; } r -= I_O;
        if (r < I_PG) { tr_item(F.w_ple_gate, D, F.g_ple, F.WPG, D, 0, RowId(), scr, r / 16, r % 16, F.lane); continue; } r -= I_PG;
        { tr_item(F.w_ple_proj, D, nullptr, F.WPP, PLE, 0, RowId(), scr, r / 16, r % 16, F.lane); }
    }
    (void)I_W1; (void)I_W2;
    for (int m0 = 2 * gw; m0 < T; m0 += 2 * NGW) {
        f32x4 v[2][4];
#pragma unroll
        for (int u = 0; u < 2; ++u) { const f32x4* xr = (const f32x4*)(F.x + (size_t)(m0 + u) * D) + F.lane;
#pragma unroll
            for (int j = 0; j < 4; ++j) v[u][j] = __builtin_nontemporal_load(xr + 64 * j); }
#pragma unroll
        for (int u = 0; u < 2; ++u) { float s = 0.f;
#pragma unroll
            for (int j = 0; j < 4; ++j) s += (v[u][j].x * v[u][j].x + v[u][j].y * v[u][j].y) + (v[u][j].z * v[u][j].z + v[u][j].w * v[u][j].w);
            const float rstd = rsqrtf(wave_sum(s) * (1.f / D) + EPS);
            unsigned long long* o8 = (unsigned long long*)(F.ABF + (size_t)(m0 + u) * D) + F.lane;
#pragma unroll
            for (int j = 0; j < 4; ++j) { const f32x4 g = ((const f32x4*)F.g_mix)[F.lane + 64 * j];
                o8[64 * j] = (unsigned long long)pk2(v[u][j].x * rstd * g.x, v[u][j].y * rstd * g.y) | ((unsigned long long)pk2(v[u][j].z * rstd * g.z, v[u][j].w * rstd * g.w) << 32); } }
    }
    for (int m0 = 4 * gw; m0 < T; m0 += 4 * NGW) {
        f32x4 v[4];
#pragma unroll
        for (int u = 0; u < 4; ++u) v[u] = __builtin_nontemporal_load((const f32x4*)(F.p + (size_t)(m0 + u) * PLE) + F.lane);
#pragma unroll
        for (int u = 0; u < 4; ++u) ((unsigned long long*)(F.PBF + (size_t)(m0 + u) * PLE))[F.lane] = (unsigned long long)pk2(v[u].x, v[u].y) | ((unsigned long long)pk2(v[u].z, v[u].w) << 32);
    }
    const int gt = blockIdx.x * NTHREADS + F.tid, NGT = F.G * NTHREADS;
    for (int i = gt; i < NE * D; i += NGT) { const int e = i / D, k = i % D; const float v = F.w_router[k * NE + e] * F.g_moe[k]; const unsigned h = f2bf(v); F.WRHI[i] = (bf16)h; F.WRLO[i] = (bf16)f2bf(v - bf2f(h)); }
    for (int i = gt; i < 8 * 128 * 128; i += NGT) { const int t = (i >> 7) & 127, s = i & 127; F.SGUW[i] = (bf16)(((s >> 6) <= (t >> 6)) ? f2bf(F.sgu_w[i]) : 0u); }
}

__device__ __forceinline__ void moe_weight_items(const Frame& F) {
    LAS float* scr = (LAS float*)(F.lds + F.wave * 16640);
    const int gw = blockIdx.x * NWAVES + F.wave, NGW = F.G * NWAVES;
    constexpr int I_W1 = NE * 16 * 32, I_W2 = NE * 16 * 16;
    for (int it = gw; it < I_W1 + I_W2; it += NGW) {
        int r = it;
        if (r < I_W1) { const int e = r / 512, q = r % 512; tr_item(F.w1 + (size_t)e * D * 2 * DE, 2 * DE, F.g_moe, F.W1T + (size_t)e * 2 * DE * D, D, 0, RowW1(), scr, q / 32, q % 32, F.lane); continue; } r -= I_W1;
        { const int e = r / 256, q = r % 256; tr_item(F.w2 + (size_t)e * DE * D, D, nullptr, F.W2T + (size_t)e * D * DE, DE, 0, RowId(), scr, q / 16, q % 16, F.lane); }
    }
}
__device__ __forceinline__ void p1_inproj(const Frame& F) {
    const int gw = blockIdx.x * NWAVES + F.wave, NGW = F.G * NWAVES, r32 = F.lane & 31, hi = F.lane >> 5;
    for (int tile = gw; tile < (T / 32) * (INC / 128); tile += NGW) {
        const int mb = tile / (INC / 128), cg = tile % (INC / 128), m0 = mb * 32, n0 = cg * 128;
        const bf16* ap = F.ABF + (size_t)(m0 + r32) * D + 8 * hi;
        const bf16* bp[4];
#pragma unroll
        for (int nb = 0; nb < 4; ++nb) bp[nb] = F.WIN + (size_t)(n0 + 32 * nb + r32) * D + 8 * hi;
        f32x16 acc[4];
#pragma unroll
        for (int nb = 0; nb < 4; ++nb) acc[nb] = f32x16{};
        smma<4>(ap, bp, D, acc);
        const int kind = (n0 < ZK) ? 0 : (n0 < ZU) ? 1 : (n0 < ZGA) ? 2 : 3;
#pragma unroll
        for (int nb = 0; nb < 4; ++nb)
#pragma unroll
            for (int r = 0; r < 16; ++r) {
                float v = acc[nb][r];
                if (kind == 2) v = gelu_tanh(v); else if (kind == 3) v = sigmoidf_(v);
                F.ZZ[(size_t)(m0 + crow(r, hi)) * INC + n0 + 32 * nb + r32] = (bf16)f2bf(v);
            }
    }
    for (int tile = gw; tile < (T / 32) * (D / 128); tile += NGW) {
        const int mb = tile / (D / 128), cg = tile % (D / 128), m0 = mb * 32, n0 = cg * 128;
        const bf16* ap = F.PBF + (size_t)(m0 + r32) * PLE + 8 * hi;
        const bf16* bp[4];
#pragma unroll
        for (int nb = 0; nb < 4; ++nb) bp[nb] = F.WPP + (size_t)(n0 + 32 * nb + r32) * PLE + 8 * hi;
        f32x16 acc[4];
#pragma unroll
        for (int nb = 0; nb < 4; ++nb) acc[nb] = f32x16{};
        smma<4>(ap, bp, PLE, acc);
#pragma unroll
        for (int nb = 0; nb < 4; ++nb)
#pragma unroll
            for (int r = 0; r < 16; ++r) F.PROJ[(size_t)(m0 + crow(r, hi)) * D + n0 + 32 * nb + r32] = (bf16)f2bf(acc[nb][r]);
    }
}

template <bool EARLY>
__device__ __forceinline__ void p2_attn_scalar(const Frame& F) {
    LAS u32x4* Kt = (LAS u32x4*)F.lds;
    LAS u32x4* Vt = Kt + 512;
    for (int pr = blockIdx.x; pr < 256; pr += F.G) {
        for (int half = 0; half < 2; ++half) {
            const int bh = pr >> 2, tb = half == 0 ? (pr & 3) : 7 - (pr & 3), b = bh / NH, h = bh % NH;
            const int t = tb * 512 + F.tid;
            const size_t row = (size_t)b * SEQ + t;
            float q[64], o[64];
            { const u32x4* qp = (const u32x4*)(F.ZZ + row * INC + ZQ + h * HD);
#pragma unroll
              for (int c = 0; c < 8; ++c) { float f[8]; unpack8(qp[c], f);
#pragma unroll
                  for (int j = 0; j < 8; ++j) q[8 * c + j] = f[j]; } }
#pragma unroll
            for (int d = 0; d < 64; ++d) o[d] = 0.f;
            float carry = 1.f;
            for (int kt = tb * 8 + 7; kt >= 0; --kt) {
                __syncthreads();
                { const int kr = F.tid >> 3, c = F.tid & 7; const size_t krow = ((size_t)b * SEQ + kt * 64 + kr) * INC + h * HD + 8 * c;
                  Kt[F.tid] = *(const u32x4*)(F.ZZ + krow + ZK); Vt[F.tid] = *(const u32x4*)(F.ZZ + krow + ZV); }
                __syncthreads();
                for (int sl = 63; sl >= 0; --sl) {
                    const int s = kt * 64 + sl;
                    if (s < t) {
                        float z = 0.f;
#pragma unroll
                        for (int c = 0; c < 8; ++c) { float f[8]; unpack8(Kt[sl * 8 + c], f);
#pragma unroll
                            for (int j = 0; j < 8; ++j) z += q[8 * c + j] * f[j]; }
                        z = fminf(z, 100.f);
                        const float e = exp2f(z), r = 1.0f / (1.0f + e);
                        carry *= r;
                        const float w = e * carry;
#pragma unroll
                        for (int c = 0; c < 8; ++c) { float f[8]; unpack8(Vt[sl * 8 + c], f);
#pragma unroll
                            for (int j = 0; j < 8; ++j) o[8 * c + j] += w * f[j]; }
                    }
                }
            }
            u32x4* op = (u32x4*)(F.OAB + row * D + h * HD);
#pragma unroll
            for (int c = 0; c < 8; ++c) { u32x4 w; w.x = pk2(o[8 * c], o[8 * c + 1]); w.y = pk2(o[8 * c + 2], o[8 * c + 3]); w.z = pk2(o[8 * c + 4], o[8 * c + 5]); w.w = pk2(o[8 * c + 6], o[8 * c + 7]); op[c] = w; }
        }
    }
    __syncthreads();
}
__device__ __forceinline__ void p2_sgu_simple(const Frame& F) {
    LAS bf16* vsn = (LAS bf16*)F.lds;
    for (int unit = blockIdx.x; unit < T / 128; unit += F.G) {
        const int row0 = unit * 128;
        for (int i = 0; i < 16; ++i) {
            const int rl = F.wave * 16 + i;
            const u32x4 w = *(const u32x4*)(F.ZZ + (size_t)(row0 + rl) * INC + ZVS + 8 * F.lane);
            float f[8]; unpack8(w, f);
            float s = 0.f;
#pragma unroll
            for (int j = 0; j < 8; ++j) s += f[j];
            const float mean = wave_sum(s) * (1.f / 512.f);
            float s2 = 0.f;
#pragma unroll
            for (int j = 0; j < 8; ++j) { f[j] -= mean; s2 += f[j] * f[j]; }
            const float rstd = rsqrtf(wave_sum(s2) * (1.f / 512.f) + EPS);
            const f32x4 g0 = *(const f32x4*)(F.sgu_norm + 8 * F.lane), g1 = *(const f32x4*)(F.sgu_norm + 8 * F.lane + 4);
            u32x4 o; o.x = pk2(f[0] * rstd * g0.x, f[1] * rstd * g0.y); o.y = pk2(f[2] * rstd * g0.z, f[3] * rstd * g0.w);
            o.z = pk2(f[4] * rstd * g1.x, f[5] * rstd * g1.y); o.w = pk2(f[6] * rstd * g1.z, f[7] * rstd * g1.w);
            *(LAS u32x4*)(vsn + rl * 512 + 8 * F.lane) = o;
        }
        __syncthreads();
        const int ch = F.tid, g = ch >> 6;
        for (int tl = 0; tl < 128; ++tl) {
            const bf16* wrow = F.SGUW + (g * 128 + tl) * 128;
            float a = 0.f;
            for (int s = 0; s < 128; ++s) a += bf2f(wrow[s]) * bf2f(vsn[s * 512 + ch]);
            const float sv = a + F.sgu_b[g * 128 + tl];
            const float u = bf2f(F.ZZ[(size_t)(row0 + tl) * INC + ZU + ch]);
            F.OAB[(size_t)(row0 + tl) * D + 512 + ch] = (bf16)f2bf(u * sv);
        }
        __syncthreads();
    }
}

__device__ __forceinline__ void p3_merge(const Frame& F) {
    const int gw = blockIdx.x * NWAVES + F.wave, NGW = F.G * NWAVES, r32 = F.lane & 31, hi = F.lane >> 5;
    for (int tile = gw; tile < (T / 32) * (D / 128); tile += NGW) {
        const int mb = tile / (D / 128), cg = tile % (D / 128), m0 = mb * 32, n0 = cg * 128;
        const bf16* ap = F.OAB + (size_t)(m0 + r32) * D + 8 * hi;
        const bf16* bp[4];
#pragma unroll
        for (int nb = 0; nb < 4; ++nb) bp[nb] = F.WAB + (size_t)(n0 + 32 * nb + r32) * D + 8 * hi;
        f32x16 acca[4], accb[4];
#pragma unroll
        for (int nb = 0; nb < 4; ++nb) { acca[nb] = f32x16{}; accb[nb] = f32x16{}; }
        smma<4>(ap, bp, 512, acca);
        const bf16* ap2 = ap + 512; const bf16* bp2[4];
#pragma unroll
        for (int nb = 0; nb < 4; ++nb) bp2[nb] = bp[nb] + 512;
        smma<4>(ap2, bp2, 512, accb);
#pragma unroll
        for (int nb = 0; nb < 4; ++nb)
#pragma unroll
            for (int r = 0; r < 16; ++r) {
                const size_t row = m0 + crow(r, hi); const int col = n0 + 32 * nb + r32;
                const float sga = bf2f(F.ZZ[row * INC + ZGA + col]), sgb = bf2f(F.ZZ[row * INC + ZGB + col]);
                F.MERGED[row * D + col] = (bf16)f2bf(sga * acca[nb][r] + sgb * accb[nb][r]);
            }
    }
}
__device__ __forceinline__ void p4_out(const Frame& F) {
    const int gw = blockIdx.x * NWAVES + F.wave, NGW = F.G * NWAVES, r32 = F.lane & 31, hi = F.lane >> 5;
    for (int tile = gw; tile < (T / 32) * (D / 128); tile += NGW) {
        const int mb = tile / (D / 128), cg = tile % (D / 128), m0 = mb * 32, n0 = cg * 128;
        const bf16* ap = F.MERGED + (size_t)(m0 + r32) * D + 8 * hi;
        const bf16* bp[4];
#pragma unroll
        for (int nb = 0; nb < 4; ++nb) bp[nb] = F.WOUT + (size_t)(n0 + 32 * nb + r32) * D + 8 * hi;
        f32x16 acc[4];
#pragma unroll
        for (int nb = 0; nb < 4; ++nb) acc[nb] = f32x16{};
        smma<4>(ap, bp, D, acc);
#pragma unroll
        for (int nb = 0; nb < 4; ++nb)
#pragma unroll
            for (int r = 0; r < 16; ++r) {
                const size_t row = m0 + crow(r, hi); const int col = n0 + 32 * nb + r32;
                F.H1[row * D + col] = (bf16)f2bf(F.x[row * D + col] + acc[nb][r]);
            }
    }
}
__device__ __forceinline__ void p5_router(const Frame& F) {
    LAS unsigned* hist = (LAS unsigned*)F.lds;
    LAS unsigned* base = hist + 32;
    LAS unsigned* lsel = hist + 64;
    LAS float* lgate = (LAS float*)(hist + 64 + 512);
    const int e = F.lane & 31, half = F.lane >> 5;
    for (int chunk = blockIdx.x; chunk < T / 128; chunk += F.G) {
        if (F.tid < 32) hist[F.tid] = 0u;
        __syncthreads();
        for (int i = 0; i < 16; ++i) {
            const int tl = F.wave * 16 + i, t = chunk * 128 + tl;
            const bf16* hp = F.H1 + (size_t)t * D + half * 512;
            const bf16* whi = F.WRHI + e * D + half * 512;
            const bf16* wlo = F.WRLO + e * D + half * 512;
            float dot = 0.f, ss = 0.f;
            for (int k = 0; k < 512; k += 8) {
                float hf[8], a[8], c[8];
                unpack8(*(const u32x4*)(hp + k), hf); unpack8(*(const u32x4*)(whi + k), a); unpack8(*(const u32x4*)(wlo + k), c);
#pragma unroll
                for (int j = 0; j < 8; ++j) { dot += hf[j] * (a[j] + c[j]); ss += hf[j] * hf[j]; }
            }
            dot += __shfl_xor(dot, 32); ss += __shfl_xor(ss, 32);
            const float rstd = rsqrtf(ss * (1.f / D) + EPS);
            float logit = rstd * dot + F.b_router[e];
            float val[4]; int sel[4];
#pragma unroll
            for (int r = 0; r < 4; ++r) {
                const float m = wave_max(logit);
                const unsigned long long bal = __ballot(logit == m);
                const int le = (int)(__ffsll((long long)bal) - 1) & 31;
                val[r] = m; sel[r] = le;
                if (e == le) logit = -INFINITY;
            }
            float ex[4], sum = 0.f;
#pragma unroll
            for (int r = 0; r < 4; ++r) { ex[r] = __expf(val[r] - val[0]); sum += ex[r]; }
            { const u32x4* hr = (const u32x4*)(F.H1 + (size_t)t * D); u32x4* cr = (u32x4*)(F.ABF + (size_t)t * D);
#pragma unroll
              for (int j = 0; j < 2; ++j) { float f[8]; unpack8(hr[F.lane + 64 * j], f); u32x4 o; o.x = pk2(f[0] * rstd, f[1] * rstd); o.y = pk2(f[2] * rstd, f[3] * rstd); o.z = pk2(f[4] * rstd, f[5] * rstd); o.w = pk2(f[6] * rstd, f[7] * rstd); cr[F.lane + 64 * j] = o; } }
            if (F.lane == 0) {
                F.RSTD1[t] = rstd;
#pragma unroll
                for (int r = 0; r < 4; ++r) { const unsigned loc = atomicAdd((unsigned*)&hist[sel[r]], 1u); lsel[tl * 4 + r] = (unsigned)sel[r] | (loc << 8); lgate[tl * 4 + r] = ex[r] / sum; }
            }
        }
        __syncthreads();
        if (F.tid < 32) { const unsigned n = hist[F.tid]; base[F.tid] = n ? __hip_atomic_fetch_add(F.ctl + CW_CNT + 64 * F.tid, n, __ATOMIC_RELAXED, __HIP_MEMORY_SCOPE_AGENT) : 0u; }
        __syncthreads();
        { const int tl = F.tid >> 2, r = F.tid & 3, t = chunk * 128 + tl; const unsigned s = lsel[tl * 4 + r]; const int ee = s & 255; const unsigned rank = base[ee] + (s >> 8);
          F.TOKLIST[ee * LCAP + rank] = t; F.SLOTREF[t * 4 + r] = (ee << 16) | rank; F.GATE[t * 4 + r] = lgate[tl * 4 + r]; }
        __syncthreads();
    }
}
struct MoeTab { LAS int* cnt; LAS int* toff; LAS int* p32; };
__device__ __forceinline__ MoeTab moe_tables(const Frame& F) {
    MoeTab M; M.cnt = (LAS int*)(F.lds + MISC_OFF + 128); M.toff = M.cnt + 32; M.p32 = M.toff + 33;
    __syncthreads();
    if (F.tid == 0) { int a = 0, c = 0;
        for (int e = 0; e < NE; ++e) { const int n = (int)__hip_atomic_load(F.ctl + CW_CNT + 64 * e, __ATOMIC_RELAXED, __HIP_MEMORY_SCOPE_AGENT); M.cnt[e] = n; M.toff[e] = a; M.p32[e] = c; a += (n + 255) >> 8; c += (n + 31) >> 5; }
        M.toff[NE] = a; M.p32[NE] = c; }
    __syncthreads();
    return M;
}
__device__ __forceinline__ void p6_moe1(const Frame& F) {
    const MoeTab M = moe_tables(F);
    const int gw = blockIdx.x * NWAVES + F.wave, NGW = F.G * NWAVES, r32 = F.lane & 31, hi = F.lane >> 5;
    const int ntiles = M.p32[NE] * 32;
    for (int tile = gw; tile < ntiles; tile += NGW) {
        const int blk = tile >> 5, hb = tile & 31;
        int e = 0; while (M.p32[e + 1] <= blk) ++e;
        const int sb = blk - M.p32[e], cnt = M.cnt[e];
        const int rank = sb * 32 + r32;
        const int tok = F.TOKLIST[e * LCAP + (rank < cnt ? rank : cnt - 1)];
        const bf16* ap = F.ABF + (size_t)tok * D + 8 * hi;
        const int hidb = hb * 32 + r32;
        const bf16* bp[2];
        bp[0] = F.W1T + ((size_t)e * 2048 + 256 * (hidb >> 7) + (hidb & 127)) * D + 8 * hi; bp[1] = bp[0] + 128 * D;
        f32x16 acc[2]; acc[0] = f32x16{}; acc[1] = f32x16{};
        smma<2>(ap, bp, D, acc);
        const float bg = F.b1[e * 2048 + 2 * hidb], bl = F.b1[e * 2048 + 2 * hidb + 1];
#pragma unroll
        for (int r = 0; r < 16; ++r) {
            const int rr = crow(r, hi), rk = sb * 32 + rr;
            float gl = acc[0][r] + bg, li = acc[1][r] + bl;
            gl = fminf(gl, 7.f); li = fminf(fmaxf(li, -7.f), 7.f);
            const float act = gl * sigmoidf_(1.702f * gl) * (li + 1.f);
            if (rk < cnt) F.HID[((size_t)256 * M.toff[e] + rk) * DE + hidb] = (bf16)f2bf(act);
        }
    }
}
__device__ __forceinline__ void p7_moe2(const Frame& F) {
    const MoeTab M = moe_tables(F);
    const int gw = blockIdx.x * NWAVES + F.wave, NGW = F.G * NWAVES, r32 = F.lane & 31, hi = F.lane >> 5;
    const int ntiles = M.p32[NE] * 8;
    for (int tile = gw; tile < ntiles; tile += NGW) {
        const int blk = tile >> 3, cg = tile & 7;
        int e = 0; while (M.p32[e + 1] <= blk) ++e;
        const int sb = blk - M.p32[e], cnt = M.cnt[e];
        const size_t rowb = (size_t)256 * M.toff[e] + sb * 32;
        const bf16* ap = F.HID + (rowb + r32) * DE + 8 * hi;
        const bf16* bp[4];
#pragma unroll
        for (int nb = 0; nb < 4; ++nb) bp[nb] = F.W2T + ((size_t)e * D + cg * 128 + 32 * nb + r32) * DE + 8 * hi;
        f32x16 acc[4];
#pragma unroll
        for (int nb = 0; nb < 4; ++nb) acc[nb] = f32x16{};
        smma<4>(ap, bp, DE, acc);
#pragma unroll
        for (int nb = 0; nb < 4; ++nb) { const int col = cg * 128 + 32 * nb + r32; const float bb = F.b2[e * D + col];
#pragma unroll
            for (int r = 0; r < 16; ++r) { const int rr = crow(r, hi); if (sb * 32 + rr < cnt) F.YS[(rowb + rr) * D + col] = (bf16)f2bf(acc[nb][r] + bb); } }
    }
}
__device__ __forceinline__ void p8_combine(const Frame& F) {
    const MoeTab M = moe_tables(F);
    const int gw = blockIdx.x * NWAVES + F.wave, NGW = F.G * NWAVES;
    for (int t0 = 2 * gw; t0 < T; t0 += 2 * NGW) {
        size_t yrow[2][4]; float gk[2][4];
#pragma unroll
        for (int u = 0; u < 2; ++u)
#pragma unroll
            for (int k = 0; k < 4; ++k) { const int sr = F.SLOTREF[(t0 + u) * 4 + k]; yrow[u][k] = (size_t)256 * M.toff[sr >> 16] + (sr & 0xffff); gk[u][k] = F.GATE[(t0 + u) * 4 + k]; }
        u32x4 hv[2][2], yv[2][2][4];
#pragma unroll
        for (int u = 0; u < 2; ++u)
#pragma unroll
            for (int j = 0; j < 2; ++j) { const int col = 8 * F.lane + 512 * j; hv[u][j] = *(const u32x4*)(F.H1 + (size_t)(t0 + u) * D + col);
#pragma unroll
                for (int k = 0; k < 4; ++k) yv[u][j][k] = *(const u32x4*)(F.YS + yrow[u][k] * D + col); }
#pragma unroll
        for (int u = 0; u < 2; ++u) {
            float ss = 0.f;
#pragma unroll
            for (int j = 0; j < 2; ++j) {
                float a[8]; unpack8(hv[u][j], a);
#pragma unroll
                for (int k = 0; k < 4; ++k) { float y[8]; unpack8(yv[u][j][k], y);
#pragma unroll
                    for (int q = 0; q < 8; ++q) a[q] += gk[u][k] * y[q]; }
                u32x4 o; o.x = pk2(a[0], a[1]); o.y = pk2(a[2], a[3]); o.z = pk2(a[4], a[5]); o.w = pk2(a[6], a[7]);
                *(u32x4*)(F.H2 + (size_t)(t0 + u) * D + 8 * F.lane + 512 * j) = o;
                float b[8]; unpack8(o, b);
#pragma unroll
                for (int q = 0; q < 8; ++q) ss += b[q] * b[q];
            }
            ss = wave_sum(ss);
            if (F.lane == 0) F.RSTD2[t0 + u] = rsqrtf(ss * (1.f / D) + EPS);
        }
    }
}
__device__ __forceinline__ void p9_ple(const Frame& F) {
    const int gw = blockIdx.x * NWAVES + F.wave, NGW = F.G * NWAVES, r32 = F.lane & 31, hi = F.lane >> 5;
    for (int tile = gw; tile < (T / 32) * (D / 128); tile += NGW) {
        const int mb = tile / (D / 128), cg = tile % (D / 128), m0 = mb * 32, n0 = cg * 128;
        const bf16* ap = F.H2 + (size_t)(m0 + r32) * D + 8 * hi;
        const bf16* bp[4];
#pragma unroll
        for (int nb = 0; nb < 4; ++nb) bp[nb] = F.WPG + (size_t)(n0 + 32 * nb + r32) * D + 8 * hi;
        f32x16 acc[4];
#pragma unroll
        for (int nb = 0; nb < 4; ++nb) acc[nb] = f32x16{};
        smma<4>(ap, bp, D, acc);
#pragma unroll
        for (int r = 0; r < 16; ++r) {
            const size_t row = m0 + crow(r, hi); const float rs = F.RSTD2[row];
#pragma unroll
            for (int nb = 0; nb < 4; ++nb) { const int col = n0 + 32 * nb + r32;
                const float pg = sigmoidf_(rs * acc[nb][r]);
                F.H3[row * D + col] = (bf16)f2bf(bf2f(F.H2[row * D + col]) + pg * bf2f(F.PROJ[row * D + col])); }
        }
    }
}
__device__ __forceinline__ void p10_final(const Frame& F) {
    const int gw = blockIdx.x * NWAVES + F.wave, NGW = F.G * NWAVES;
    for (int t = gw; t < T; t += NGW) {
        float a[2][8]; float ss = 0.f;
#pragma unroll
        for (int j = 0; j < 2; ++j) { unpack8(*(const u32x4*)(F.H3 + (size_t)t * D + 8 * F.lane + 512 * j), a[j]);
#pragma unroll
            for (int q = 0; q < 8; ++q) ss += a[j][q] * a[j][q]; }
        const float rstd = rsqrtf(wave_sum(ss) * (1.f / D) + EPS);
#pragma unroll
        for (int j = 0; j < 2; ++j) { const int col = 8 * F.lane + 512 * j;
            const f32x4 g0 = *(const f32x4*)(F.g_final + col), g1 = *(const f32x4*)(F.g_final + col + 4);
            f32x4 o0, o1; o0.x = a[j][0] * rstd * g0.x; o0.y = a[j][1] * rstd * g0.y; o0.z = a[j][2] * rstd * g0.z; o0.w = a[j][3] * rstd * g0.w;
            o1.x = a[j][4] * rstd * g1.x; o1.y = a[j][5] * rstd * g1.y; o1.z = a[j][6] * rstd * g1.z; o1.w = a[j][7] * rstd * g1.w;
            *(f32x4*)(F.out + (size_t)t * D + col) = o0; *(f32x4*)(F.out + (size_t)t * D + col + 4) = o1; }
    }
}


namespace pg {
constexpr int BM = 256, BK = 64, HALF = 128, HTB = HALF * BK * 2, STAGE_BYTES = 8 * HTB, NXCD = 8, WGM = 8;
__device__ __forceinline__ int lds_byte(int r, int c) { const int st = (r >> 4) * 2 + (c >> 5), rr = r & 15, cc = c & 31, ob = rr * 64 + cc * 2; return st * 1024 + (ob ^ (((ob >> 9) & 1) << 5)); }
__device__ __forceinline__ void stage_rc(int b, int& R, int& C) { const int st = b / 1024, sb = b % 1024, swz = sb ^ (((sb >> 9) & 1) << 5); R = (st >> 1) * 16 + swz / 64; C = (st & 1) * 32 + (swz % 64) / 2; }
__device__ __forceinline__ int perm32(int rho) { const int n = rho >> 4, i = rho & 15; return 8 * (i >> 2) + 4 * n + (i & 3); }
struct Unit { int arow, brow, kofs, x0, x1, x2; };
typedef float f32x2_t __attribute__((ext_vector_type(2))); typedef __bf16 bf16x2_t __attribute__((ext_vector_type(2)));
__device__ __forceinline__ unsigned cvt_pk_bf16(float lo, float hi) { const f32x2_t v = {lo, hi}; const bf16x2_t b = __builtin_convertvector(v, bf16x2_t); return __builtin_bit_cast(unsigned, b); }
typedef f32x4 Acc[2][2][4][2];

struct DenseMap { static constexpr bool GATHER = false; int lda; __device__ __forceinline__ unsigned rowoff(const Unit&, int r) const { return (unsigned)r * (unsigned)lda * 2u; }
    __device__ __forceinline__ size_t base(const Unit& u) const { return (size_t)u.arow * lda * 2; } };
template <int SPLIT>
struct DenseOrder {
    int nM, nN, nwg, G, c, khalf;
    __device__ __forceinline__ void init(int M, int N, int G_, int c_, int khalf_ = 0) { nM = M / BM; nN = N / BM; nwg = nM * nN; G = G_; c = c_; khalf = khalf_; }
    __device__ __forceinline__ bool next(int i, Unit& u) const {
        const int j = SPLIT ? (i >> 1) : i;
        const long L = (long)j * G + c; if (L >= nwg) return false;
        int wgid = (int)L; { const int q = nwg / NXCD, r = nwg % NXCD, xcd = wgid % NXCD, off = wgid / NXCD; wgid = (xcd < r ? xcd * (q + 1) : r * (q + 1) + (xcd - r) * q) + off; }
        const int nig = WGM * nN, gid = wgid / nig, fm = gid * WGM, gsz = (nM - fm) < WGM ? (nM - fm) : WGM;
        const int pm = fm + ((wgid % nig) % gsz), pn = (wgid % nig) / gsz;
        u.arow = pm * BM; u.brow = pn * BM; u.x0 = pm; u.x1 = pn; u.x2 = SPLIT ? (i & 1) : 0; u.kofs = SPLIT ? (i & 1) * khalf : 0; return true;
    }
};

template <class Epi, class Sched, class AMap, bool ALIGN_EPI>
__device__ __forceinline__ void gemm_run(LAS unsigned char* lds, const bf16* A, const bf16* Bt, const int ldb, const int nt, const Sched& S, const Epi& E, const AMap& AM) {
    const int tid = threadIdx.x, wid = __builtin_amdgcn_readfirstlane(tid >> 6), lane = tid & 63, wr = wid >> 2, wc = wid & 3, fr = lane & 15, fq = lane >> 4;
    int RA[2]; unsigned CA2[2], voffB[2];
#pragma unroll
    for (int i = 0; i < 2; ++i) { int R, C; stage_rc(tid * 16 + i * 8192, R, C); RA[i] = R; CA2[i] = (unsigned)C * 2u; const int Rb = (R & ~31) + perm32(R & 31); voffB[i] = (unsigned)(Rb * ldb + C) * 2u; }
    const size_t kstep = (size_t)(BK * 2);
    const size_t hstepB = (size_t)HALF * ldb * 2;
    const unsigned ldsw = (unsigned)wid * 1024u;
    const int aoff = lds_byte(wr * 64 + fr, fq * 8), boff = lds_byte(wc * 32 + fr, fq * 8);
#define PG_SA(b, h) (((b) * 2 + (h)) * HTB)
#define PG_SB(b, h) ((4 + (b) * 2 + (h)) * HTB)
#define PG_STAGE(bufoff, gbase, voff) do { _Pragma("unroll") for (int _i = 0; _i < 2; ++_i) \
        __builtin_amdgcn_global_load_lds((const unsigned*)((const char*)(gbase) + (voff)[_i]), (LAS unsigned*)(lds + (bufoff) + ldsw + _i * 8192), 16, 0, 0); } while (0)
#define PG_LDA(dst, b, h) do { _Pragma("unroll") for (int m = 0; m < 4; ++m) _Pragma("unroll") for (int k = 0; k < 2; ++k) dst[m][k] = *(const LAS bf16x8*)(lds + PG_SA(b, h) + aoff + m * 2048 + k * 1024); } while (0)
#define PG_LDB(dst, b, h) do { _Pragma("unroll") for (int n = 0; n < 2; ++n) _Pragma("unroll") for (int k = 0; k < 2; ++k) dst[n][k] = *(const LAS bf16x8*)(lds + PG_SB(b, h) + boff + n * 2048 + k * 1024); } while (0)
#define PG_MMA(ai, bj, At, Bt_) do { __builtin_amdgcn_s_setprio(1); _Pragma("unroll") for (int m = 0; m < 4; ++m) _Pragma("unroll") for (int n = 0; n < 2; ++n) _Pragma("unroll") for (int k = 0; k < 2; ++k) \
        acc[ai][bj][m][n] = __builtin_amdgcn_mfma_f32_16x16x32_bf16(Bt_[n][k], At[m][k], acc[ai][bj][m][n], 0, 0, 0); __builtin_amdgcn_s_setprio(0); } while (0)
#define PG_WAIT_V(n) asm volatile("s_waitcnt vmcnt(" #n ")" ::: "memory")
#define PG_WAIT_L(n) asm volatile("s_waitcnt lgkmcnt(" #n ")" ::: "memory")
#define PG_BAR __builtin_amdgcn_s_barrier()
#define PG_SCHED __builtin_amdgcn_sched_barrier(0)
#define PG_ZERO() do { _Pragma("unroll") for (int a = 0; a < 2; ++a) _Pragma("unroll") for (int b = 0; b < 2; ++b) _Pragma("unroll") for (int m = 0; m < 4; ++m) _Pragma("unroll") for (int n = 0; n < 2; ++n) acc[a][b][m][n] = (f32x4){0.f, 0.f, 0.f, 0.f}; } while (0)
#define PG_MKVA(u, va) do { _Pragma("unroll") for (int h = 0; h < 2; ++h) _Pragma("unroll") for (int i = 0; i < 2; ++i) va[h][i] = AM.rowoff(u, h * HALF + RA[i]) + CA2[i]; } while (0)
    Unit cur, nxt; int ui = 0;
    if (!S.next(0, cur)) return;
    Acc acc; PG_ZERO();
    bf16x8 At[4][2], B0[2][2], B1[2][2];
    unsigned voffA[2]; unsigned vaC[2][2], vaN[2][2];
    const size_t hstepA = AMap::GATHER ? 0 : (size_t)AM.rowoff(cur, HALF);
    if constexpr (AMap::GATHER) { PG_MKVA(cur, vaC); } else {
#pragma unroll
        for (int i = 0; i < 2; ++i) voffA[i] = AM.rowoff(cur, RA[i]) + CA2[i]; }
#define PG_STAGE_A(bufoff, ptr, h, useNext) do { if constexpr (AMap::GATHER) { unsigned _v[2] = {(useNext) ? vaN[h][0] : vaC[h][0], (useNext) ? vaN[h][1] : vaC[h][1]}; PG_STAGE(bufoff, ptr, _v); } \
        else { PG_STAGE(bufoff, (ptr) + (h) * hstepA, voffA); } } while (0)
    const char* cA = (const char*)A + (size_t)cur.kofs * 2 + AM.base(cur); const char* cB = (const char*)Bt + ((size_t)cur.brow * ldb + cur.kofs) * 2;
    PG_STAGE(PG_SB(0, 0), cB, voffB); PG_STAGE(PG_SB(0, 1), cB + hstepB, voffB); PG_STAGE_A(PG_SA(0, 0), cA, 0, false); PG_STAGE_A(PG_SA(0, 1), cA, 1, false);
    if (wr == 1) PG_BAR;
    PG_WAIT_V(2); PG_BAR;
    PG_STAGE(PG_SB(1, 0), cB + kstep, voffB); PG_STAGE_A(PG_SA(1, 0), cA + kstep, 0, false); PG_STAGE(PG_SB(1, 1), cB + hstepB + kstep, voffB);
    PG_WAIT_V(6); PG_BAR;
    for (;;) {
        const bool has_next = S.next(ui + 1, nxt);
        const char* nA = cA; const char* nB = cB;
        if (has_next) { if constexpr (AMap::GATHER) { PG_MKVA(nxt, vaN); } nA = (const char*)A + (size_t)nxt.kofs * 2 + AM.base(nxt); nB = (const char*)Bt + ((size_t)nxt.brow * ldb + nxt.kofs) * 2; }
        else if constexpr (AMap::GATHER) {
#pragma unroll
            for (int h = 0; h < 2; ++h)
#pragma unroll
                for (int i = 0; i < 2; ++i) vaN[h][i] = vaC[h][i]; }
        E.prefetch(cur, ui, wid, lane);
#pragma unroll 1
        for (int t = 0; t < nt; t += 2) {
            const bool last = (t == nt - 2);
            const char* a1 = cA + (size_t)(t + 1) * kstep;
            const char* a2 = last ? nA : cA + (size_t)(t + 2) * kstep; const char* b2 = last ? nB : cB + (size_t)(t + 2) * kstep;
            const char* a3 = a2 + kstep; const char* b3 = b2 + kstep;
            PG_LDB(B0, 0, 0); PG_LDB(B1, 0, 1); PG_SCHED; PG_LDA(At, 0, 0); PG_STAGE_A(PG_SA(1, 1), a1, 1, false);
            PG_WAIT_V(8); PG_WAIT_L(0); PG_BAR; PG_MMA(0, 0, At, B0); PG_MMA(0, 1, At, B1); PG_BAR; PG_SCHED;
            PG_LDA(At, 0, 1); PG_STAGE(PG_SB(0, 0), b2, voffB); PG_STAGE(PG_SB(0, 1), b2 + hstepB, voffB); PG_STAGE_A(PG_SA(0, 0), a2, 0, last);
            PG_WAIT_V(8); PG_WAIT_L(0); PG_BAR; PG_MMA(1, 0, At, B0); PG_MMA(1, 1, At, B1); PG_BAR; PG_SCHED;
            PG_LDB(B0, 1, 0); PG_LDB(B1, 1, 1); PG_SCHED; PG_LDA(At, 1, 0); PG_STAGE_A(PG_SA(0, 1), a2, 1, last);
            PG_WAIT_V(8); PG_WAIT_L(0); PG_BAR; PG_MMA(0, 0, At, B0); PG_MMA(0, 1, At, B1); PG_BAR; PG_SCHED;
            PG_LDA(At, 1, 1); PG_STAGE(PG_SB(1, 0), b3, voffB); PG_STAGE(PG_SB(1, 1), b3 + hstepB, voffB); PG_STAGE_A(PG_SA(1, 0), a3, 0, last);
            PG_WAIT_V(8); PG_WAIT_L(0); PG_BAR; PG_MMA(1, 0, At, B0); PG_MMA(1, 1, At, B1); PG_BAR; PG_SCHED;
        }
        if constexpr (ALIGN_EPI) { if (wr == 0) PG_BAR; }
        E(acc, cur, ui, wr, wc, fr, fq);
        if (!has_next) break;
        if (!E.keep(cur)) PG_ZERO();
        cur = nxt; cA = nA; cB = nB; ++ui;
        if constexpr (AMap::GATHER) {
#pragma unroll
            for (int h = 0; h < 2; ++h)
#pragma unroll
                for (int i = 0; i < 2; ++i) vaC[h][i] = vaN[h][i]; }
        if constexpr (ALIGN_EPI) { if (wr == 1) PG_BAR; }
    }
    PG_WAIT_V(0);
    if constexpr (!ALIGN_EPI) { if (wr == 0) PG_BAR; }
    PG_BAR;
#undef PG_SA
#undef PG_SB
#undef PG_STAGE
#undef PG_LDA
#undef PG_LDB
#undef PG_MMA
#undef PG_WAIT_V
#undef PG_WAIT_L
#undef PG_BAR
#undef PG_SCHED
#undef PG_ZERO
#undef PG_MKVA
#undef PG_STAGE_A
}

__device__ __forceinline__ float sigm(float x) { return __builtin_amdgcn_rcpf(1.0f + __builtin_amdgcn_exp2f(-LOG2E * x)); }
__device__ __forceinline__ float gelu_t(float x) { const float u = 1.5957691216057308f * (x + 0.044715f * x * x * x); return x * sigm(u); }
template <int KIND> __device__ __forceinline__ float act_k(float x) {
    if (KIND == 2) { const float t = x * (-2.3022082f + (-0.10294324f) * (x * x)); return x * __builtin_amdgcn_rcpf(1.0f + __builtin_amdgcn_exp2f(t)); }
    return __builtin_amdgcn_rcpf(1.0f + __builtin_amdgcn_exp2f(-LOG2E * x));
}
template <int KIND> __device__ __forceinline__ void store_act(const Acc& acc, bf16* base, int ldc) {
#pragma unroll
    for (int ai = 0; ai < 2; ++ai)
#pragma unroll
        for (int m = 0; m < 4; ++m) { bf16* rowp = base + (size_t)(ai * HALF + m * 16) * ldc;
#pragma unroll
            for (int bj = 0; bj < 2; ++bj) { const f32x4 v0 = acc[ai][bj][m][0], v1 = acc[ai][bj][m][1];
                u32x4 w; w.x = cvt_pk_bf16(act_k<KIND>(v0[0]), act_k<KIND>(v0[1])); w.y = cvt_pk_bf16(act_k<KIND>(v0[2]), act_k<KIND>(v0[3]));
                w.z = cvt_pk_bf16(act_k<KIND>(v1[0]), act_k<KIND>(v1[1])); w.w = cvt_pk_bf16(act_k<KIND>(v1[2]), act_k<KIND>(v1[3]));
                __builtin_nontemporal_store(w, (u32x4*)(rowp + bj * HALF)); }
            asm volatile("" ::: "memory"); }
}
__device__ __forceinline__ void store_plain(const Acc& acc, bf16* base, int ldc) {
#pragma unroll
    for (int ai = 0; ai < 2; ++ai)
#pragma unroll
        for (int m = 0; m < 4; ++m) { bf16* rowp = base + (size_t)(ai * HALF + m * 16) * ldc;
#pragma unroll
            for (int bj = 0; bj < 2; ++bj) { const f32x4 v0 = acc[ai][bj][m][0], v1 = acc[ai][bj][m][1];
                u32x4 w; w.x = cvt_pk_bf16(v0[0], v0[1]); w.y = cvt_pk_bf16(v0[2], v0[3]); w.z = cvt_pk_bf16(v1[0], v1[1]); w.w = cvt_pk_bf16(v1[2], v1[3]);
                __builtin_nontemporal_store(w, (u32x4*)(rowp + bj * HALF)); } }
}
struct EpiInproj {
    bf16* ZZ;
    __device__ __forceinline__ bool keep(const Unit&) const { return false; }
    __device__ __forceinline__ void prefetch(const Unit&, int, int, int) const {}
    __device__ __forceinline__ void operator()(const Acc& acc, const Unit& u, int ui, int wr, int wc, int fr, int fq) const {
        bf16* base = ZZ + (size_t)(u.arow + wr * 64 + fr) * INC + u.brow + wc * 32 + 8 * fq;
        const int n0 = u.brow;
        if (n0 < ZU) store_plain(acc, base, INC); else if (n0 < ZGA) store_act<2>(acc, base, INC); else store_act<3>(acc, base, INC);
    }
};
struct EpiPlain {
    bf16* O; int ldc;
    __device__ __forceinline__ bool keep(const Unit&) const { return false; }
    __device__ __forceinline__ void prefetch(const Unit&, int, int, int) const {}
    __device__ __forceinline__ void operator()(const Acc& acc, const Unit& u, int ui, int wr, int wc, int fr, int fq) const {
        store_plain(acc, O + (size_t)(u.arow + wr * 64 + fr) * ldc + u.brow + wc * 32 + 8 * fq, ldc);
    }
};
struct EpiMerge {
    const bf16* ZZ; bf16* O;
    __device__ __forceinline__ bool keep(const Unit& u) const { return u.x2 == 0; }
    __device__ __forceinline__ void prefetch(const Unit&, int, int, int) const {}
    __device__ __forceinline__ void operator()(Acc& acc, const Unit& u, int ui, int wr, int wc, int fr, int fq) const {
        const int row0 = u.arow + wr * 64 + fr, col0 = u.brow + wc * 32 + 8 * fq;
#pragma unroll
        for (int ai = 0; ai < 2; ++ai)
#pragma unroll
            for (int m = 0; m < 4; ++m) { const size_t row = row0 + ai * HALF + m * 16;
#pragma unroll
                for (int bj = 0; bj < 2; ++bj) { const int col = col0 + bj * HALF;
                    float gb[8]; unpack8(*(const u32x4*)(ZZ + row * INC + ZGB + col), gb);
#pragma unroll
                    for (int q = 0; q < 8; ++q) gb[q] = fmaxf(gb[q], 1e-30f);
                    if (u.x2 == 0) { float ga[8]; unpack8(*(const u32x4*)(ZZ + row * INC + ZGA + col), ga);
#pragma unroll
                        for (int q = 0; q < 8; ++q) acc[ai][bj][m][q >> 2][q & 3] *= ga[q] * __builtin_amdgcn_rcpf(gb[q]); }
                    else { const f32x4 v0 = acc[ai][bj][m][0], v1 = acc[ai][bj][m][1];
                        u32x4 w; w.x = cvt_pk_bf16(v0[0] * gb[0], v0[1] * gb[1]); w.y = cvt_pk_bf16(v0[2] * gb[2], v0[3] * gb[3]); w.z = cvt_pk_bf16(v1[0] * gb[4], v1[1] * gb[5]); w.w = cvt_pk_bf16(v1[2] * gb[6], v1[3] * gb[7]);
                        *(u32x4*)(O + row * D + col) = w; } }
                asm volatile("" ::: "memory"); }
    }
};
struct EpiOut {
    const float* x; bf16* O;
    __device__ __forceinline__ bool keep(const Unit&) const { return false; }
    __device__ __forceinline__ void prefetch(const Unit&, int, int, int) const {}
    __device__ __forceinline__ void operator()(const Acc& acc, const Unit& u, int ui, int wr, int wc, int fr, int fq) const {
        const int row0 = u.arow + wr * 64 + fr, col0 = u.brow + wc * 32 + 8 * fq;
#pragma unroll
        for (int ai = 0; ai < 2; ++ai)
#pragma unroll
            for (int m = 0; m < 4; ++m) { const size_t row = row0 + ai * HALF + m * 16;
#pragma unroll
                for (int bj = 0; bj < 2; ++bj) { const int col = col0 + bj * HALF;
                    const f32x4 x0 = *(const f32x4*)(x + row * D + col), x1 = *(const f32x4*)(x + row * D + col + 4);
                    const f32x4 v0 = acc[ai][bj][m][0] + x0, v1 = acc[ai][bj][m][1] + x1;
                    u32x4 w; w.x = cvt_pk_bf16(v0[0], v0[1]); w.y = cvt_pk_bf16(v0[2], v0[3]); w.z = cvt_pk_bf16(v1[0], v1[1]); w.w = cvt_pk_bf16(v1[2], v1[3]);
                    *(u32x4*)(O + row * D + col) = w; }
                asm volatile("" ::: "memory"); }
    }
};
struct EpiPle {
    const bf16* H2; const bf16* PROJ; const float* RSTD2; bf16* O;
    __device__ __forceinline__ bool keep(const Unit&) const { return false; }
    __device__ __forceinline__ void prefetch(const Unit&, int, int, int) const {}
    __device__ __forceinline__ void operator()(const Acc& acc, const Unit& u, int ui, int wr, int wc, int fr, int fq) const {
        const int row0 = u.arow + wr * 64 + fr, col0 = u.brow + wc * 32 + 8 * fq;
#pragma unroll
        for (int ai = 0; ai < 2; ++ai)
#pragma unroll
            for (int m = 0; m < 4; ++m) { const size_t row = row0 + ai * HALF + m * 16; const float rs = RSTD2[row];
#pragma unroll
                for (int bj = 0; bj < 2; ++bj) { const int col = col0 + bj * HALF;
                    float h[8], pj[8]; unpack8(*(const u32x4*)(H2 + row * D + col), h); unpack8(*(const u32x4*)(PROJ + row * D + col), pj);
                    float o[8];
#pragma unroll
                    for (int q = 0; q < 8; ++q) o[q] = h[q] + sigm(rs * acc[ai][bj][m][q >> 2][q & 3]) * pj[q];
                    u32x4 w; w.x = cvt_pk_bf16(o[0], o[1]); w.y = cvt_pk_bf16(o[2], o[3]); w.z = cvt_pk_bf16(o[4], o[5]); w.w = cvt_pk_bf16(o[6], o[7]);
                    *(u32x4*)(O + row * D + col) = w; }
                asm volatile("" ::: "memory"); }
    }
};
}

#ifndef STAG_US
#define STAG_US 0
#endif
__device__ __forceinline__ void stagger(int group) {
    if (STAG_US > 0 && group > 0) { const unsigned long long t0 = __builtin_amdgcn_s_memrealtime(), dt = (unsigned long long)(group * STAG_US * 100);
        while (__builtin_amdgcn_s_memrealtime() - t0 < dt) __builtin_amdgcn_s_sleep(8); }
}
__device__ __forceinline__ void p1_fast(const Frame& F) {
    stagger((blockIdx.x >> 3) & 3);
    { pg::DenseOrder<0> S; S.init(T, INC, F.G, (int)blockIdx.x); pg::EpiInproj E{F.ZZ}; pg::DenseMap AM{D};
      pg::gemm_run<pg::EpiInproj, pg::DenseOrder<0>, pg::DenseMap, true>(F.lds + STAGE_OFF, F.ABF, F.WIN, D, D / 64, S, E, AM); }
    { pg::DenseOrder<0> S; S.init(T, D, F.G, (int)blockIdx.x); pg::EpiPlain E{F.PROJ, D}; pg::DenseMap AM{PLE};
      pg::gemm_run<pg::EpiPlain, pg::DenseOrder<0>, pg::DenseMap, true>(F.lds + STAGE_OFF, F.PBF, F.WPP, PLE, PLE / 64, S, E, AM); }
}
__device__ __forceinline__ void p3_fast(const Frame& F) {
    pg::DenseOrder<1> S; S.init(T, D, F.G, (int)blockIdx.x, 512); pg::EpiMerge E{F.ZZ, F.MERGED}; pg::DenseMap AM{D};
    pg::gemm_run<pg::EpiMerge, pg::DenseOrder<1>, pg::DenseMap, true>(F.lds + STAGE_OFF, F.OAB, F.WAB, D, 512 / 64, S, E, AM);
}
__device__ __forceinline__ void p4_fast(const Frame& F) {
    pg::DenseOrder<0> S; S.init(T, D, F.G, (int)blockIdx.x); pg::EpiOut E{F.x, F.H1}; pg::DenseMap AM{D};
    pg::gemm_run<pg::EpiOut, pg::DenseOrder<0>, pg::DenseMap, true>(F.lds + STAGE_OFF, F.MERGED, F.WOUT, D, D / 64, S, E, AM);
}
__device__ __forceinline__ void p9_fast(const Frame& F) {
    pg::DenseOrder<0> S; S.init(T, D, F.G, (int)blockIdx.x); pg::EpiPle E{F.H2, F.PROJ, F.RSTD2, F.H3}; pg::DenseMap AM{D};
    pg::gemm_run<pg::EpiPle, pg::DenseOrder<0>, pg::DenseMap, true>(F.lds + STAGE_OFF, F.H2, F.WPG, D, D / 64, S, E, AM);
}


namespace pg {
template <int MT, int NT, int NROWS_B>
struct MoeOrder {
    LAS const int* cnt; LAS const int* toff; int c;
    __device__ __forceinline__ bool next(int i, Unit& u) const {
        const int x = c & 7, cl = c >> 3, sb = i * 8 + x, mtg = MT * sb + cl / NT, pn = cl % NT;
        if (mtg >= toff[NE]) return false;
        int e = 0; while (toff[e + 1] <= mtg) ++e;
        u.arow = 256 * mtg; u.brow = e * NROWS_B + 256 * pn; u.kofs = 0; u.x0 = e; u.x1 = cnt[e] - 256 * (mtg - toff[e]); u.x2 = i; return true;
    }
};
struct GatherMap { static constexpr bool GATHER = true; LAS const unsigned* tab;
    __device__ __forceinline__ unsigned rowoff(const Unit& u, int r) const { return tab[u.x2 * 256 + r]; }
    __device__ __forceinline__ size_t base(const Unit&) const { return 0; } };
struct EpiSwiglu {
    bf16* HID; const float* b1; LAS unsigned char* lds;
    __device__ __forceinline__ bool keep(const Unit&) const { return false; }
    __device__ __forceinline__ void prefetch(const Unit& u, int ui, int wid, int lane) const {
        if (wid == 0) __builtin_amdgcn_global_load_lds((const unsigned*)(b1 + u.x0 * 2048 + ((u.brow & 2047) >> 8) * 256 + lane * 4), (LAS unsigned*)(lds + BIAS_OFF + (ui & 1) * 1024), 16, 0, 0); }
    __device__ __forceinline__ void operator()(const Acc& acc, const Unit& u, int ui, int wr, int wc, int fr, int fq) const {
        const int e = u.x0, valid = u.x1, pn = (u.brow & 2047) >> 8, hid0 = 128 * pn + 32 * wc + 8 * fq;
        const LAS f32x4* bp = (const LAS f32x4*)(lds + BIAS_OFF + (ui & 1) * 1024 + (32 * wc + 8 * fq) * 8);
        const f32x4 f0 = bp[0], f1 = bp[1], f2 = bp[2], f3 = bp[3];
        const float bg[8] = {f0[0], f0[2], f1[0], f1[2], f2[0], f2[2], f3[0], f3[2]}, bl[8] = {f0[1], f0[3], f1[1], f1[3], f2[1], f2[3], f3[1], f3[3]};
#pragma unroll
        for (int ai = 0; ai < 2; ++ai)
#pragma unroll
            for (int m = 0; m < 4; ++m) { const int rl = ai * HALF + wr * 64 + m * 16 + fr;
                float o[8];
#pragma unroll
                for (int q = 0; q < 8; ++q) { float g = acc[ai][0][m][q >> 2][q & 3] + bg[q], l = acc[ai][1][m][q >> 2][q & 3] + bl[q];
                    g = fminf(g, 7.f); l = fminf(fmaxf(l, -7.f), 7.f); o[q] = g * sigm(1.702f * g) * (l + 1.f); }
                u32x4 w; w.x = cvt_pk_bf16(o[0], o[1]); w.y = cvt_pk_bf16(o[2], o[3]); w.z = cvt_pk_bf16(o[4], o[5]); w.w = cvt_pk_bf16(o[6], o[7]);
                __builtin_nontemporal_store(w, (u32x4*)(HID + (size_t)(u.arow + rl) * DE + hid0)); }
    }
};
struct EpiBias2 {
    bf16* YS; const float* b2; LAS unsigned char* lds;
    __device__ __forceinline__ bool keep(const Unit&) const { return false; }
    __device__ __forceinline__ void prefetch(const Unit& u, int ui, int wid, int lane) const {
        if (wid == 0) __builtin_amdgcn_global_load_lds((const unsigned*)(b2 + u.x0 * D + (u.brow & 1023) + lane * 4), (LAS unsigned*)(lds + BIAS_OFF + (ui & 1) * 1024), 16, 0, 0); }
    __device__ __forceinline__ void operator()(const Acc& acc, const Unit& u, int ui, int wr, int wc, int fr, int fq) const {
        const int valid = u.x1, col0 = (u.brow & 1023) + 32 * wc + 8 * fq;
        f32x4 bb[2][2];
#pragma unroll
        for (int bj = 0; bj < 2; ++bj)
#pragma unroll
            for (int n = 0; n < 2; ++n) bb[bj][n] = *(const LAS f32x4*)(lds + BIAS_OFF + (ui & 1) * 1024 + (32 * wc + 8 * fq + bj * HALF + 4 * n) * 4);
#pragma unroll
        for (int ai = 0; ai < 2; ++ai)
#pragma unroll
            for (int m = 0; m < 4; ++m) { const int rl = ai * HALF + wr * 64 + m * 16 + fr;
#pragma unroll
                for (int bj = 0; bj < 2; ++bj) { const f32x4 v0 = acc[ai][bj][m][0] + bb[bj][0], v1 = acc[ai][bj][m][1] + bb[bj][1];
                    u32x4 w; w.x = cvt_pk_bf16(v0[0], v0[1]); w.y = cvt_pk_bf16(v0[2], v0[3]); w.z = cvt_pk_bf16(v1[0], v1[1]); w.w = cvt_pk_bf16(v1[2], v1[3]);
                    __builtin_nontemporal_store(w, (u32x4*)(YS + (size_t)(u.arow + rl) * D + col0 + bj * HALF)); } }
    }
};
}
__device__ __forceinline__ void p6_fast(const Frame& F) {
    const MoeTab M = moe_tables(F);
    pg::MoeOrder<4, 8, 2048> S{M.cnt, M.toff, (int)blockIdx.x};
    LAS unsigned* tab = (LAS unsigned*)(F.lds + TAB_OFF);
    { pg::Unit u;
      for (int i = 0; i < 18 && S.next(i, u); ++i) { const int e = u.x0, cnt = M.cnt[e], rk0 = cnt - u.x1;
          if (F.tid < 256) { const int rk = rk0 + F.tid; tab[i * 256 + F.tid] = (unsigned)F.TOKLIST[e * LCAP + (rk < cnt ? rk : cnt - 1)] * (unsigned)(D * 2); } } }
    __syncthreads();
    stagger((blockIdx.x >> 3) & 3);
    pg::EpiSwiglu E{F.HID, F.b1, F.lds}; pg::GatherMap AM{tab};
    pg::gemm_run<pg::EpiSwiglu, pg::MoeOrder<4, 8, 2048>, pg::GatherMap, true>(F.lds + STAGE_OFF, F.ABF, F.W1T, D, D / 64, S, E, AM);
}
__device__ __forceinline__ void p7_fast(const Frame& F) {
    const MoeTab M = moe_tables(F);
    pg::MoeOrder<8, 4, 1024> S{M.cnt, M.toff, (int)blockIdx.x};
    stagger((blockIdx.x >> 3) & 3);
    pg::EpiBias2 E{F.YS, F.b2, F.lds}; pg::DenseMap AM{DE};
    pg::gemm_run<pg::EpiBias2, pg::MoeOrder<8, 4, 1024>, pg::DenseMap, true>(F.lds + STAGE_OFF, F.HID, F.W2T, DE, DE / 64, S, E, AM);
}


typedef short s16x4 __attribute__((ext_vector_type(4)));
__device__ __forceinline__ s16x4 vtr(LAS const unsigned char* p) { return __builtin_bit_cast(s16x4, __builtin_amdgcn_ds_read_tr16_b64_v4i16((LAS s16x4*)p)); }
__device__ __forceinline__ bf16x8 cat8(s16x4 a, s16x4 b) { return (bf16x8){a[0], a[1], a[2], a[3], b[0], b[1], b[2], b[3]}; }
template <bool EARLY>
__device__ __forceinline__ void p2_attn_fast(const Frame& F) {
    const int lane = F.lane, r32 = lane & 31, hi = lane >> 5;
    LAS unsigned char* vl = F.lds + F.wave * 16640;
    LAS const unsigned char* vrd = vl + (4 * hi + ((lane & 15) >> 2)) * 64 + ((lane >> 4) & 1) * 32 + (lane & 3) * 8;
    const int gw = blockIdx.x * NWAVES + F.wave, NGW = F.G * NWAVES;
    for (int item = gw; item < BATCH * NH * (SEQ / 32); item += NGW) {
        const int qi = item >> 6, bh = item & 63, b = bh >> 3, h = bh & 7;
        const size_t rowbase = (size_t)b * SEQ;
        bf16x8 qf[4];
        { const bf16* qp = F.ZZ + (rowbase + 32 * qi + r32) * INC + ZQ + h * HD + 8 * hi;
#pragma unroll
          for (int d0 = 0; d0 < 4; ++d0) qf[d0] = *(const bf16x8*)(qp + 16 * d0); }
        f32x16 o[2]; o[0] = f32x16{}; o[1] = f32x16{};
        float carry = 1.0f;
        bf16x8 kn[4]; u32x4 vn[4];
#define ATT_LOAD(j) do { const bf16* kp = F.ZZ + (rowbase + 32 * (j) + r32) * INC + ZK + h * HD + 8 * hi; \
            _Pragma("unroll") for (int d0 = 0; d0 < 4; ++d0) kn[d0] = *(const bf16x8*)(kp + 16 * d0); \
            _Pragma("unroll") for (int i = 0; i < 4; ++i) { const int L = i * 64 + lane; \
                vn[i] = *(const u32x4*)(F.ZZ + (rowbase + 32 * (j) + ((L >> 2) & 31)) * INC + ZV + h * HD + (L >> 7) * 32 + (L & 3) * 8); } } while (0)
        ATT_LOAD(qi);
        for (int j = qi; j >= 0; --j) {
            bf16x8 kf[4];
#pragma unroll
            for (int d0 = 0; d0 < 4; ++d0) kf[d0] = kn[d0];
#pragma unroll
            for (int i = 0; i < 4; ++i) *(LAS u32x4*)(vl + (i * 64 + lane) * 16) = vn[i];
            if (j > 0) ATT_LOAD(j - 1);
            f32x16 p = f32x16{};
#pragma unroll
            for (int d0 = 0; d0 < 4; ++d0) p = __builtin_amdgcn_mfma_f32_32x32x16_bf16(kf[d0], qf[d0], p, 0, 0, 0);
            float e[16], sfx[16];
#pragma unroll
            for (int r = 0; r < 16; ++r) { const float z = fminf(p[r], 100.f); e[r] = __builtin_amdgcn_exp2f(z); sfx[r] = __builtin_amdgcn_rcpf(1.0f + e[r]); }
            if (j == qi) {
#pragma unroll
                for (int r = 0; r < 16; ++r) { const bool ok = crow(r, hi) < r32; e[r] = ok ? e[r] : 0.f; sfx[r] = ok ? sfx[r] : 1.f; }
            }
            float TL[4], TH[4];
#pragma unroll
            for (int g = 0; g < 4; ++g) {
                sfx[4 * g + 2] *= sfx[4 * g + 3]; sfx[4 * g + 1] *= sfx[4 * g + 2]; sfx[4 * g] *= sfx[4 * g + 1];
                const auto rr = __builtin_amdgcn_permlane32_swap(__float_as_uint(sfx[4 * g]), __float_as_uint(sfx[4 * g]), false, false);
                TL[g] = __uint_as_float(rr[0]); TH[g] = __uint_as_float(rr[1]); }
            float R[8];
            R[7] = carry; R[6] = R[7] * TH[3]; R[5] = R[6] * TL[3]; R[4] = R[5] * TH[2]; R[3] = R[4] * TL[2]; R[2] = R[3] * TH[1]; R[1] = R[2] * TL[1]; R[0] = R[1] * TH[0]; carry = R[0] * TL[0];
            unsigned pw[8];
#pragma unroll
            for (int g = 0; g < 4; ++g) { const float off = hi ? R[2 * g + 1] : R[2 * g];
                const float w0 = e[4 * g] * (off * sfx[4 * g]), w1 = e[4 * g + 1] * (off * sfx[4 * g + 1]), w2 = e[4 * g + 2] * (off * sfx[4 * g + 2]), w3 = e[4 * g + 3] * (off * sfx[4 * g + 3]);
                pw[2 * g] = pg::cvt_pk_bf16(w0, w1); pw[2 * g + 1] = pg::cvt_pk_bf16(w2, w3); }
            const bf16x8 pa0 = __builtin_bit_cast(bf16x8, (u32x4){pw[0], pw[1], pw[2], pw[3]}), pa1 = __builtin_bit_cast(bf16x8, (u32x4){pw[4], pw[5], pw[6], pw[7]});
            asm volatile("s_waitcnt lgkmcnt(0)" ::: "memory");
#pragma unroll
            for (int d0 = 0; d0 < 2; ++d0) {
                const s16x4 a0 = vtr(vrd + d0 * 2048), a1 = vtr(vrd + d0 * 2048 + 512), b0 = vtr(vrd + d0 * 2048 + 1024), b1 = vtr(vrd + d0 * 2048 + 1536);
                o[d0] = __builtin_amdgcn_mfma_f32_32x32x16_bf16(pa0, cat8(a0, a1), o[d0], 0, 0, 0);
                o[d0] = __builtin_amdgcn_mfma_f32_32x32x16_bf16(pa1, cat8(b0, b1), o[d0], 0, 0, 0);
            }
            asm volatile("s_waitcnt lgkmcnt(0)" ::: "memory");
            if (EARLY && __all(carry == 0.f)) break;
        }
#undef ATT_LOAD
        bf16* op = F.OAB + (rowbase + 32 * qi) * D + h * HD + r32;
#pragma unroll
        for (int d0 = 0; d0 < 2; ++d0)
#pragma unroll
            for (int r = 0; r < 16; ++r) op[(size_t)crow(r, hi) * D + 32 * d0] = (bf16)f2bf(o[d0][r]);
    }
}
__device__ __forceinline__ void p2_sgu_fast(const Frame& F) {
    const int lane = F.lane, r32 = lane & 31, hi = lane >> 5, g = F.wave;
    for (int unit = blockIdx.x; unit < T / 128; unit += F.G) {
        const int row0 = unit * 128;
        __syncthreads();
        for (int i = 0; i < 16; ++i) {
            const int rl = g * 16 + i;
            const u32x4 w = *(const u32x4*)(F.ZZ + (size_t)(row0 + rl) * INC + ZVS + 8 * lane);
            float f[8]; unpack8(w, f);
            float s = 0.f;
#pragma unroll
            for (int j = 0; j < 8; ++j) s += f[j];
            const float mean = wave_sum(s) * (1.f / 512.f);
            float s2 = 0.f;
#pragma unroll
            for (int j = 0; j < 8; ++j) { f[j] -= mean; s2 += f[j] * f[j]; }
            const float rstd = rsqrtf(wave_sum(s2) * (1.f / 512.f) + EPS);
            const f32x4 g0 = *(const f32x4*)(F.sgu_norm + 8 * lane), g1 = *(const f32x4*)(F.sgu_norm + 8 * lane + 4);
            u32x4 o; o.x = pk2(f[0] * rstd * g0.x, f[1] * rstd * g0.y); o.y = pk2(f[2] * rstd * g0.z, f[3] * rstd * g0.w);
            o.z = pk2(f[4] * rstd * g1.x, f[5] * rstd * g1.y); o.w = pk2(f[6] * rstd * g1.z, f[7] * rstd * g1.w);
            *(LAS u32x4*)(F.lds + (lane >> 2) * 8192 + rl * 64 + (lane & 3) * 16) = o;
        }
        __syncthreads();
        LAS const unsigned char* vrd = F.lds + (2 * g) * 8192 + (8 * hi + ((lane & 15) >> 2)) * 64 + ((lane >> 4) & 1) * 32 + (lane & 3) * 8;
        for (int mt = 0; mt < 4; ++mt) {
            f32x16 acc[2]; acc[0] = f32x16{}; acc[1] = f32x16{};
            const bf16* ap = F.SGUW + ((size_t)g * 128 + 32 * mt + r32) * 128 + 8 * hi;
            const int nks = (mt < 2) ? 4 : 8;
            for (int ks = 0; ks < nks; ++ks) {
                const bf16x8 a = *(const bf16x8*)(ap + 16 * ks);
#pragma unroll
                for (int nt = 0; nt < 2; ++nt) {
                    const s16x4 b0 = vtr(vrd + nt * 8192 + ks * 1024), b1 = vtr(vrd + nt * 8192 + ks * 1024 + 256);
                    acc[nt] = __builtin_amdgcn_mfma_f32_32x32x16_bf16(a, cat8(b0, b1), acc[nt], 0, 0, 0);
                }
            }
#pragma unroll
            for (int r = 0; r < 16; ++r) { const int tl = 32 * mt + crow(r, hi); const float bs = F.sgu_b[g * 128 + tl];
#pragma unroll
                for (int nt = 0; nt < 2; ++nt) { const int ch = 64 * g + 32 * nt + r32;
                    const float u = bf2f(F.ZZ[(size_t)(row0 + tl) * INC + ZU + ch]);
                    F.OAB[(size_t)(row0 + tl) * D + 512 + ch] = (bf16)f2bf(u * (acc[nt][r] + bs)); } }
        }
    }
    __syncthreads();
}


__device__ __forceinline__ void p5_fast(const Frame& F) {
    LAS unsigned* hist = (LAS unsigned*)F.lds;
    LAS unsigned* base = hist + 32;
    LAS unsigned* lsel = hist + 64;
    LAS float* lgate = (LAS float*)(hist + 64 + 512);
    LAS float* rsv = lgate + 512;
    LAS float* part = (LAS float*)(F.lds + 8192);
    const int lane = F.lane, r32 = lane & 31, hi = lane >> 5, wg4 = F.wave & 3, kh = F.wave >> 2;
    for (int chunk = blockIdx.x; chunk < T / 128; chunk += F.G) {
        if (F.tid < 32) hist[F.tid] = 0u;
        const int t0 = chunk * 128 + wg4 * 32;
        const bf16* hp = F.H1 + (size_t)(t0 + r32) * D + kh * 512 + 8 * hi;
        const bf16* whp = F.WRHI + r32 * D + kh * 512 + 8 * hi;
        const bf16* wlp = F.WRLO + r32 * D + kh * 512 + 8 * hi;
        f32x16 acc = f32x16{}; float ss = 0.f;
#pragma unroll 4
        for (int k0 = 0; k0 < 512; k0 += 16) {
            const u32x4 hb = *(const u32x4*)(hp + k0);
            const bf16x8 ah = *(const bf16x8*)(whp + k0), al = *(const bf16x8*)(wlp + k0);
            const bf16x8 bb = __builtin_bit_cast(bf16x8, hb);
            acc = __builtin_amdgcn_mfma_f32_32x32x16_bf16(ah, bb, acc, 0, 0, 0);
            acc = __builtin_amdgcn_mfma_f32_32x32x16_bf16(al, bb, acc, 0, 0, 0);
#pragma unroll
            for (int q = 0; q < 4; ++q) { const float lo = __uint_as_float(hb[q] << 16), hh = __uint_as_float(hb[q] & 0xffff0000u); ss += lo * lo + hh * hh; }
        }
        { const auto rr = __builtin_amdgcn_permlane32_swap(__float_as_uint(ss), __float_as_uint(ss), false, false); ss = __uint_as_float(rr[0]) + __uint_as_float(rr[1]); }
        if (kh == 1) {
#pragma unroll
            for (int r = 0; r < 16; ++r) part[(wg4 * 17 + r) * 64 + lane] = acc[r];
            part[(wg4 * 17 + 16) * 64 + lane] = ss;
        }
        __syncthreads();
        if (kh == 0) {
            ss += part[(wg4 * 17 + 16) * 64 + lane];
            const float rstd = rsqrtf(ss * (1.f / D) + EPS);
            float v[16];
#pragma unroll
            for (int r = 0; r < 16; ++r) v[r] = rstd * (acc[r] + part[(wg4 * 17 + r) * 64 + lane]) + F.b_router[crow(r, hi)];
            float cv[8]; int ce[8];
#pragma unroll
            for (int k = 0; k < 4; ++k) {
                float m = v[0];
#pragma unroll
                for (int r = 1; r < 16; ++r) m = fmaxf(m, v[r]);
                int idx = 15;
#pragma unroll
                for (int r = 14; r >= 0; --r) idx = (v[r] == m) ? r : idx;
                cv[k] = m; ce[k] = (idx & 3) + 8 * (idx >> 2) + 4 * hi;
#pragma unroll
                for (int r = 0; r < 16; ++r) v[r] = (r == idx) ? -INFINITY : v[r];
            }
#pragma unroll
            for (int k = 0; k < 4; ++k) {
                const auto rv = __builtin_amdgcn_permlane32_swap(__float_as_uint(cv[k]), __float_as_uint(cv[k]), false, false);
                const auto re = __builtin_amdgcn_permlane32_swap((unsigned)ce[k], (unsigned)ce[k], false, false);
                cv[4 + k] = __uint_as_float(hi ? rv[0] : rv[1]); ce[4 + k] = (int)(hi ? re[0] : re[1]);
            }
            float tv[4]; int te[4];
#pragma unroll
            for (int k = 0; k < 4; ++k) {
                float bv = cv[0]; int be = ce[0];
#pragma unroll
                for (int c = 1; c < 8; ++c) { const bool better = (cv[c] > bv) || (cv[c] == bv && ce[c] < be); bv = better ? cv[c] : bv; be = better ? ce[c] : be; }
                tv[k] = bv; te[k] = be;
#pragma unroll
                for (int c = 0; c < 8; ++c) cv[c] = (ce[c] == be) ? -INFINITY : cv[c];
            }
            float ex[4], sum = 0.f;
#pragma unroll
            for (int k = 0; k < 4; ++k) { ex[k] = __expf(tv[k] - tv[0]); sum += ex[k]; }
            if (hi == 0) { const int tl = wg4 * 32 + r32; rsv[tl] = rstd;
#pragma unroll
                for (int k = 0; k < 4; ++k) { const unsigned loc = atomicAdd((unsigned*)&hist[te[k]], 1u); lsel[tl * 4 + k] = (unsigned)te[k] | (loc << 8); lgate[tl * 4 + k] = ex[k] / sum; } }
        }
        __syncthreads();
        if (F.tid < 32) { const unsigned n = hist[F.tid]; base[F.tid] = n ? __hip_atomic_fetch_add(F.ctl + CW_CNT + 64 * F.tid, n, __ATOMIC_RELAXED, __HIP_MEMORY_SCOPE_AGENT) : 0u; }
        __syncthreads();
        { const int tl = F.tid >> 2, r = F.tid & 3, t = chunk * 128 + tl; const unsigned sl = lsel[tl * 4 + r]; const int ee = sl & 255; const unsigned rank = base[ee] + (sl >> 8);
          F.TOKLIST[ee * LCAP + rank] = t; F.SLOTREF[t * 4 + r] = (ee << 16) | rank; F.GATE[t * 4 + r] = lgate[tl * 4 + r]; }
        for (int i = 0; i < 16; ++i) {
            const int tl = F.wave * 16 + i, t = chunk * 128 + tl; const float rstd = rsv[tl];
            const u32x4* hr = (const u32x4*)(F.H1 + (size_t)t * D); u32x4* cr = (u32x4*)(F.ABF + (size_t)t * D);
#pragma unroll
            for (int j = 0; j < 2; ++j) { float f[8]; unpack8(hr[lane + 64 * j], f); u32x4 o; o.x = pk2(f[0] * rstd, f[1] * rstd); o.y = pk2(f[2] * rstd, f[3] * rstd); o.z = pk2(f[4] * rstd, f[5] * rstd); o.w = pk2(f[6] * rstd, f[7] * rstd); cr[lane + 64 * j] = o; }
        }
        __syncthreads();
    }
}

struct Args { const float* in[21]; float* out; unsigned char* ws; int ph_lo, ph_hi; };
__global__ void __launch_bounds__(NTHREADS, 2) fwd(Args args) {
    extern __shared__ __attribute__((aligned(16))) unsigned char lds[];
    Frame F;
    F.lds = (LAS unsigned char*)lds; F.MISC = (volatile LAS unsigned*)(F.lds + MISC_OFF);
    F.tid = threadIdx.x; F.lane = F.tid & 63; F.wave = __builtin_amdgcn_readfirstlane(F.tid >> 6); F.G = gridDim.x;
    unsigned char* ws = args.ws;
    F.ctl = (unsigned*)(ws + WS_CTL);
    F.x = args.in[0]; F.p = args.in[1]; F.g_mix = args.in[2]; F.w_in = args.in[3]; F.w_out_a = args.in[4]; F.w_out_b = args.in[5]; F.w_out = args.in[6];
    F.sgu_norm = args.in[7]; F.sgu_w = args.in[8]; F.sgu_b = args.in[9]; F.g_moe = args.in[10]; F.w_router = args.in[11]; F.b_router = args.in[12];
    F.w1 = args.in[13]; F.b1 = args.in[14]; F.w2 = args.in[15]; F.b2 = args.in[16]; F.g_ple = args.in[17]; F.w_ple_gate = args.in[18]; F.w_ple_proj = args.in[19]; F.g_final = args.in[20];
    F.out = args.out;
    F.WRHI = (bf16*)(ws + WS_WRHI); F.WRLO = (bf16*)(ws + WS_WRLO); F.SGUW = (bf16*)(ws + WS_SGUW); F.WIN = (bf16*)(ws + WS_WIN); F.WAB = (bf16*)(ws + WS_WAB);
    F.WOUT = (bf16*)(ws + WS_WOUT); F.WPG = (bf16*)(ws + WS_WPG); F.WPP = (bf16*)(ws + WS_WPP); F.W1T = (bf16*)(ws + WS_W1); F.W2T = (bf16*)(ws + WS_W2);
    F.PBF = (bf16*)(ws + WS_PBF); F.PROJ = (bf16*)(ws + WS_PROJ); F.H1 = (bf16*)(ws + WS_H1); F.ZZ = (bf16*)(ws + WS_ZZ); F.HID = (bf16*)(ws + WS_HID);
    F.H2 = (bf16*)(ws + WS_H2); F.H3 = (bf16*)(ws + WS_H3); F.ABF = (bf16*)(ws + WS_ABF); F.OAB = (bf16*)(ws + WS_OAB); F.MERGED = (bf16*)(ws + WS_MERGED); F.YS = (bf16*)(ws + WS_YS);
    F.RSTD1 = (float*)(ws + WS_RSTD1); F.RSTD2 = (float*)(ws + WS_RSTD2); F.GATE = (float*)(ws + WS_GATE);
    F.TOKLIST = (int*)(ws + WS_TOKLIST); F.SLOTREF = (int*)(ws + WS_SLOTREF);
    for (int u = F.tid; u < (LDS_BYTES - MISC_OFF) / 4; u += NTHREADS) ((LAS unsigned*)(F.lds + MISC_OFF))[u] = 0u;
    __syncthreads();
    XcdBarrier bar = xcd_barrier_post(F.ctl + CW_BAR, F.MISC + 8);
    const int lo = args.ph_lo, hi = args.ph_hi;
#define IN(k) (lo <= (k) && (k) < hi)
#ifndef REP_PHASE
#define REP_PHASE -1
#endif
#define REPS(k) ((REP_PHASE == (k)) ? 2 : 1)
#define SEAM(k) do { if (IN(k) && IN((k) + 1)) xcd_barrier(bar); } while (0)
    if (IN(0)) { for (int rp = 0; rp < REPS(0); ++rp) p0_prologue(F); } SEAM(0);
    if (IN(1)) { for (int rp = 0; rp < REPS(1); ++rp) { if (OPT_P1) p1_fast(F); else p1_inproj(F); } } SEAM(1);
    if (IN(2)) {
        const bool sgu_first = (blockIdx.x & 1) != 0;
        if (sgu_first) { if (OPT_SGU) p2_sgu_fast(F); else p2_sgu_simple(F); }
        if (OPT_ATT) { if (F.wave & 1) { moe_weight_items(F); p2_attn_fast<ATT_EARLY>(F); } else { p2_attn_fast<ATT_EARLY>(F); moe_weight_items(F); } } else { moe_weight_items(F); __syncthreads(); p2_attn_scalar<false>(F); }
        if (!sgu_first) { __syncthreads(); if (OPT_SGU) p2_sgu_fast(F); else p2_sgu_simple(F); }
    } SEAM(2);
    if (IN(3)) { for (int rp = 0; rp < REPS(3); ++rp) { if (OPT_P3) p3_fast(F); else p3_merge(F); } } SEAM(3);
    if (IN(4)) { for (int rp = 0; rp < REPS(4); ++rp) { if (OPT_P4) p4_fast(F); else p4_out(F); } } SEAM(4);
    if (IN(5)) { if (OPT_P5) p5_fast(F); else p5_router(F); } SEAM(5);
    if (IN(6)) { for (int rp = 0; rp < REPS(6); ++rp) { if (OPT_P6) p6_fast(F); else p6_moe1(F); } } SEAM(6);
    if (IN(7)) { for (int rp = 0; rp < REPS(7); ++rp) { if (OPT_P7) p7_fast(F); else p7_moe2(F); } } SEAM(7);
    if (IN(8)) { for (int rp = 0; rp < REPS(8); ++rp) p8_combine(F); } SEAM(8);
    if (IN(9)) { for (int rp = 0; rp < REPS(9); ++rp) { if (OPT_P9) p9_fast(F); else p9_ple(F); } } SEAM(9);
    if (IN(10)) { for (int rp = 0; rp < REPS(10); ++rp) p10_final(F); }
#undef IN
#undef SEAM
}

extern "C" void kernel_launch(void* const* d_in, const int* in_sizes, int n_in, void* d_out, int out_size, void* d_ws, size_t ws_size, hipStream_t stream) {
    static int grid = 0;
    if (grid == 0) {
        if (n_in != 21 || out_size != T * D || ws_size < WS_END) { fprintf(stderr, "kernel_launch: unexpected shapes (n_in %d out %d ws %zu)\n", n_in, out_size, ws_size); grid = -1; return; }
        int dev = 0, cus = 0;
        if (hipGetDevice(&dev) != hipSuccess || hipDeviceGetAttribute(&cus, hipDeviceAttributeMultiprocessorCount, dev) != hipSuccess) { grid = -1; return; }
        if (hipFuncSetAttribute((const void*)fwd, hipFuncAttributeMaxDynamicSharedMemorySize, LDS_BYTES) != hipSuccess) { fprintf(stderr, "kernel_launch: hipFuncSetAttribute failed\n"); grid = -1; return; }
        int per_cu = 0;
        if (hipOccupancyMaxActiveBlocksPerMultiprocessor(&per_cu, (const void*)fwd, NTHREADS, LDS_BYTES) != hipSuccess || per_cu < 1) fprintf(stderr, "kernel_launch: occupancy query says %d\n", per_cu);
        (void)hipGetLastError();
        if (cus < 256) { fprintf(stderr, "kernel_launch: needs >= 256 CUs, found %d\n", cus); grid = -1; return; }
        grid = 256;
    }
    if (grid < 0) return;
    (void)hipMemsetAsync((char*)d_ws + WS_CTL, 0, CTL_ZERO_BYTES, stream);
    Args a{};
    for (int i = 0; i < 21; ++i) a.in[i] = (const float*)d_in[i];
    a.out = (float*)d_out; a.ws = (unsigned char*)d_ws; a.ph_lo = 0; a.ph_hi = 11;
    hipLaunchKernelGGL(fwd, dim3(grid), dim3(NTHREADS), LDS_BYTES, stream, a);
}
```

```cpp
#include <hip/hip_runtime.h>
#include <cstdio>
#include <cstdint>

#define GAS __attribute__((address_space(1)))
#define LAS __attribute__((address_space(3)))
typedef unsigned short bf16;
typedef short bf16x8 __attribute__((ext_vector_type(8)));
typedef float f32x4 __attribute__((ext_vector_type(4)));
typedef float f32x16 __attribute__((ext_vector_type(16)));
typedef unsigned u32x4 __attribute__((ext_vector_type(4)));
typedef unsigned u32x2 __attribute__((ext_vector_type(2)));

#ifndef OPT_P1
#define OPT_P1 1
#endif
#ifndef OPT_P3
#define OPT_P3 1
#endif
#ifndef OPT_P4
#define OPT_P4 1
#endif
#ifndef OPT_P6
#define OPT_P6 1
#endif
#ifndef OPT_P7
#define OPT_P7 1
#endif
#ifndef OPT_ATT
#define OPT_ATT 1
#endif
#ifndef OPT_SGU
#define OPT_SGU 1
#endif
#ifndef ATT_EARLY
#define ATT_EARLY true
#endif
#ifndef OPT_P5
#define OPT_P5 1
#endif
#ifndef MOE_FP8_1
#define MOE_FP8_1 1
#endif
#ifndef MOE_FP8_2
#define MOE_FP8_2 1
#endif
#ifndef OPT_P9
#define OPT_P9 1
#endif
constexpr int BATCH = 8, SEQ = 4096, T = BATCH * SEQ, D = 1024, PLE = 256, NH = 8, HD = 64, NE = 32, DE = 1024, INC = 4608;
constexpr int ZQ = 0, ZK = 512, ZV = 1024, ZU = 1536, ZVS = 2048, ZGA = 2560, ZGB = 3584;
constexpr float EPS = 1e-6f;
constexpr float LOG2E = 1.4426950408889634f;
constexpr float QSCALE = 0.125f * LOG2E;
constexpr int LCAP = 32768;
constexpr int HROWS = 139264;

constexpr size_t MiB = 1u << 20;
constexpr size_t WS_CTL = 0, CTL_ZERO_BYTES = 1 * MiB;
constexpr size_t WS_WRHI = 1 * MiB, WS_WRLO = WS_WRHI + 65536, WS_SGUW = WS_WRLO + 65536;
constexpr size_t WS_RSTD1 = WS_SGUW + 262144, WS_RSTD2 = WS_RSTD1 + 131072;
constexpr size_t WS_WIN = 2 * MiB, WS_WAB = 11 * MiB, WS_WOUT = 13 * MiB, WS_WPG = 15 * MiB, WS_WPP = 17 * MiB;
constexpr size_t WS_TOKLIST = 18 * MiB, WS_SLOTREF = 22 * MiB, WS_GATE = WS_SLOTREF + 524288;
constexpr size_t WS_W1 = 28 * MiB, WS_W2 = 156 * MiB, WS_PBF = 220 * MiB, WS_PROJ = 236 * MiB, WS_H1 = 300 * MiB;
constexpr size_t WS_R1 = 364 * MiB;
constexpr size_t WS_ZZ = WS_R1, WS_HID = WS_R1, WS_H2 = WS_R1, WS_H3 = WS_R1 + 64 * MiB;
constexpr size_t WS_R2 = 652 * MiB;
constexpr size_t WS_ABF = WS_R2, WS_OAB = WS_R2 + 64 * MiB, WS_MERGED = WS_R2 + 128 * MiB, WS_YS = WS_R2;
constexpr size_t WS_END = 924 * MiB;
constexpr int CW_BAR = 4096, CW_CNT = 8192;

constexpr int STAGE_OFF = 0, TAB_OFF = 131072, BIAS_OFF = 149504, MISC_OFF = 151552;
constexpr int LDS_BYTES = 152576;
constexpr int NWAVES = 8, NTHREADS = 512;

#define LDS_WAIT() asm volatile("s_waitcnt lgkmcnt(0)" ::: "memory")
__device__ __forceinline__ float bf2f(unsigned v) { return __uint_as_float(v << 16); }
__device__ __forceinline__ unsigned f2bf(float f) { unsigned u = __float_as_uint(f); return (u + 0x7fffu + ((u >> 16) & 1u)) >> 16; }
__device__ __forceinline__ unsigned pk2(float lo, float hi) { return f2bf(lo) | (f2bf(hi) << 16); }
__device__ __forceinline__ float wave_sum(float v) {
#pragma unroll
    for (int o = 1; o < 64; o <<= 1) v += __shfl_xor(v, o);
    return v;
}
__device__ __forceinline__ float wave_max(float v) {
#pragma unroll
    for (int o = 1; o < 64; o <<= 1) v = fmaxf(v, __shfl_xor(v, o));
    return v;
}
__device__ __forceinline__ float sigmoidf_(float x) { return 1.0f / (1.0f + __expf(-x)); }
__device__ __forceinline__ float gelu_tanh(float x) {
    const float u = 1.5957691216057308f * (x + 0.044715f * x * x * x);
    return x * sigmoidf_(u);
}
__device__ __forceinline__ int crow(int r, int hi) { return (r & 3) + 8 * (r >> 2) + 4 * hi; }
__device__ __forceinline__ void unpack8(const u32x4 w, float (&f)[8]) {
    f[0] = bf2f(w.x & 0xffffu); f[1] = bf2f(w.x >> 16); f[2] = bf2f(w.y & 0xffffu); f[3] = bf2f(w.y >> 16);
    f[4] = bf2f(w.z & 0xffffu); f[5] = bf2f(w.z >> 16); f[6] = bf2f(w.w & 0xffffu); f[7] = bf2f(w.w >> 16);
}

constexpr bool FP8_1 = MOE_FP8_1 && OPT_P5 && OPT_P6 && OPT_P7, FP8_2 = MOE_FP8_2 && OPT_P5 && OPT_P6 && OPT_P7;
constexpr float SC_ACT = 4.0f, SC_W = 64.0f, SC_INV = 1.0f / (SC_ACT * SC_W);
__device__ __forceinline__ float clamp448(float v) { return fminf(fmaxf(v, -448.f), 448.f); }
__device__ __forceinline__ unsigned pk4_fp8(float a, float b, float c, float d) {
    unsigned w = __builtin_amdgcn_cvt_pk_fp8_f32(clamp448(a), clamp448(b), 0, false); return __builtin_amdgcn_cvt_pk_fp8_f32(clamp448(c), clamp448(d), w, true); }
#define XB_TMO      128
#define XB_XCNT(j)  (256  + 64 * (j))
#define XB_XSUB(j)  (1280 + 64 * (j))
#define XB_XGEN(j)  (2304 + 64 * (j))
#define XB_TOP      3328
#define XB_TOPGEN   3392
#define XCD_BAR_WORDS 3456
#define XB_SPIN_CAP (1u << 23)
__device__ __forceinline__ unsigned xb_ld(unsigned* p)              { return __hip_atomic_load(p, __ATOMIC_RELAXED, __HIP_MEMORY_SCOPE_AGENT); }
__device__ __forceinline__ unsigned xb_add(unsigned* p, unsigned v) { return __hip_atomic_fetch_add(p, v, __ATOMIC_RELAXED, __HIP_MEMORY_SCOPE_AGENT); }
__device__ __forceinline__ unsigned xb_xcc_id() { return (unsigned)__builtin_amdgcn_s_getreg((3 << 11) | 20) & 0xFu; }
#define XB_SPIN(cond, bar) do { unsigned _sp = 0; while (cond) { __builtin_amdgcn_s_sleep(1); \
    if ((++_sp & 255u) == 0u) { if (xb_ld(&(bar)[XB_TMO])) break; if (_sp > XB_SPIN_CAP) { atomicAdd(&(bar)[XB_TMO], 1u); break; } } } } while (0)
struct XcdBarrier { unsigned* bar; unsigned x; volatile LAS unsigned* st; };
__device__ __forceinline__ XcdBarrier xcd_barrier_post(unsigned* bar, volatile LAS unsigned* st) {
    XcdBarrier b; b.bar = bar; b.x = xb_xcc_id(); b.st = st;
    if (threadIdx.x == 0) (void)xb_add(&bar[XB_XCNT(b.x)], 1u);
    return b;
}
__device__ __forceinline__ void xcd_barrier_complete(unsigned* bar, unsigned x, unsigned& nloc, unsigned& nx) {
    const unsigned G = gridDim.x * gridDim.y * gridDim.z;
    unsigned sum, cnt, mine, sp = 0u;
    for (;;) {
        sum = 0u; cnt = 0u; mine = 0u;
#pragma unroll
        for (unsigned j = 0; j < 16; ++j) { const unsigned c = xb_ld(&bar[XB_XCNT(j)]); sum += c; cnt += (c > 0u) ? 1u : 0u; mine = (j == x) ? c : mine; }
        if (sum == G) break;
        __builtin_amdgcn_s_sleep(1);
        if ((++sp & 255u) == 0u) { if (xb_ld(&bar[XB_TMO])) break; if (sp > XB_SPIN_CAP) { atomicAdd(&bar[XB_TMO], 1u); break; } }
    }
    nloc = mine > 0u ? mine : 1u; nx = cnt > 0u ? cnt : 1u;
}
__device__ __forceinline__ void xcd_barrier(const XcdBarrier& b) {
    asm volatile("s_waitcnt vmcnt(0)" ::: "memory");
    __syncthreads();
    if (threadIdx.x == 0) {
        unsigned* bar = b.bar;
        __builtin_amdgcn_s_waitcnt(0);
        unsigned nloc = b.st[0], nx = b.st[1];
        if (nloc == 0u) { xcd_barrier_complete(bar, b.x, nloc, nx); b.st[0] = nloc; b.st[1] = nx; }
        const unsigned old = xb_add(&bar[XB_XSUB(b.x)], 1u);
        const unsigned gen = old / nloc;
        if (old + 1u == (gen + 1u) * nloc) {
            __builtin_amdgcn_fence(__ATOMIC_RELEASE, "agent");
            asm volatile("s_waitcnt vmcnt(0)" ::: "memory");
            const unsigned og = xb_add(&bar[XB_TOP], 1u);
            const unsigned tg = og / nx;
            if (og + 1u == (tg + 1u) * nx) xb_add(&bar[XB_TOPGEN], 1u);
            else XB_SPIN(xb_ld(&bar[XB_TOPGEN]) == tg, bar);
            __builtin_amdgcn_fence(__ATOMIC_ACQUIRE, "agent");
            xb_add(&bar[XB_XGEN(b.x)], 1u);
            asm volatile("s_waitcnt vmcnt(0)" ::: "memory");
        } else {
            XB_SPIN(xb_ld(&bar[XB_XGEN(b.x)]) == gen, bar);
            __builtin_amdgcn_fence(__ATOMIC_ACQUIRE, "agent");
            asm volatile("s_waitcnt vmcnt(0)" ::: "memory");
        }
    }
    __syncthreads();
}

struct Frame {
    LAS unsigned char* lds;
    volatile LAS unsigned* MISC;
    unsigned* ctl;
    int tid, lane, wave, G;
    const float *x, *p, *g_mix, *w_in, *w_out_a, *w_out_b, *w_out, *sgu_norm, *sgu_w, *sgu_b, *g_moe, *w_router, *b_router, *w1, *b1, *w2, *b2, *g_ple, *w_ple_gate, *w_ple_proj, *g_final;
    float* out;
    bf16 *WRHI, *WRLO, *SGUW, *WIN, *WAB, *WOUT, *WPG, *WPP, *W1T, *W2T, *PBF, *PROJ, *H1, *ZZ, *HID, *H2, *H3, *ABF, *OAB, *MERGED, *YS;
    float *RSTD1, *RSTD2, *GATE;
    int *TOKLIST, *SLOTREF;
};

template <int NB>
__device__ __forceinline__ void smma(const bf16* ap, const bf16* const (&bp)[NB], int K, f32x16 (&acc)[NB]) {
    for (int k0 = 0; k0 < K; k0 += 16) {
        const bf16x8 a = *(const bf16x8*)(ap + k0);
#pragma unroll
        for (int nb = 0; nb < NB; ++nb) { const bf16x8 b = *(const bf16x8*)(bp[nb] + k0); acc[nb] = __builtin_amdgcn_mfma_f32_32x32x16_bf16(a, b, acc[nb], 0, 0, 0); }
    }
}

struct RowId { __device__ __forceinline__ int operator()(int n) const { return n; } };
struct RowW1 { __device__ __forceinline__ int operator()(int n) const { const int hid = n >> 1; return 256 * (hid >> 7) + (hid & 127) + 128 * (n & 1); } };
template <class RM>
__device__ __forceinline__ void tr_item(const float* W, int N, const float* gk, bf16* WT, int ldt, int koff, RM rm, LAS float* scr, int kb, int nb, int lane, float sc = 1.0f) {
    const int k0 = kb * 64, n0 = nb * 64;
    f32x4 v[16];
#pragma unroll
    for (int i = 0; i < 16; ++i) v[i] = __builtin_nontemporal_load((const f32x4*)(W + (size_t)(k0 + 4 * i + (lane >> 4)) * N + n0 + (lane & 15) * 4));
#pragma unroll
    for (int i = 0; i < 16; ++i) {
        const int kk = 4 * i + (lane >> 4), n4 = (lane & 15) * 4;
        f32x4 x = v[i] * sc;
        if (gk) x = x * gk[k0 + kk];
        LAS float* s = scr + kk * 65 + n4;
        s[0] = x.x; s[1] = x.y; s[2] = x.z; s[3] = x.w;
    }
    LDS_WAIT(); asm volatile("" ::: "memory");
    const int c = lane & 7;
#pragma unroll
    for (int j = 0; j < 8; ++j) {
        const int n = (lane >> 3) + 8 * j;
        const LAS float* s = scr + (8 * c) * 65 + n;
        u32x4 o; o.x = pk2(s[0 * 65], s[1 * 65]); o.y = pk2(s[2 * 65], s[3 * 65]); o.z = pk2(s[4 * 65], s[5 * 65]); o.w = pk2(s[6 * 65], s[7 * 65]);
        *(u32x4*)(WT + (size_t)rm(n0 + n) * ldt + koff + k0 + 8 * c) = o;
    }
    LDS_WAIT(); asm volatile("" ::: "memory");
}
template <class RM>
__device__ __forceinline__ void tr_item8(const float* W, int N, const float* gk, unsigned char* WT8, int ldt, RM rm, LAS float* scr, int kb, int nb, int lane, float sc) {
    const int k0 = kb * 64, n0 = nb * 64;
    f32x4 v[16];
#pragma unroll
    for (int i = 0; i < 16; ++i) v[i] = __builtin_nontemporal_load((const f32x4*)(W + (size_t)(k0 + 4 * i + (lane >> 4)) * N + n0 + (lane & 15) * 4));
#pragma unroll
    for (int i = 0; i < 16; ++i) {
        const int kk = 4 * i + (lane >> 4), n4 = (lane & 15) * 4;
        f32x4 x = v[i] * sc;
        if (gk) x = x * gk[k0 + kk];
        LAS float* sp = scr + kk * 65 + n4;
        sp[0] = x.x; sp[1] = x.y; sp[2] = x.z; sp[3] = x.w;
    }
    LDS_WAIT(); asm volatile("" ::: "memory");
    const int c4 = lane & 3;
#pragma unroll
    for (int j = 0; j < 4; ++j) {
        const int n = (lane >> 2) + 16 * j;
        const LAS float* sp = scr + (16 * c4) * 65 + n;
        u32x4 o; o.x = pk4_fp8(sp[0 * 65], sp[1 * 65], sp[2 * 65], sp[3 * 65]); o.y = pk4_fp8(sp[4 * 65], sp[5 * 65], sp[6 * 65], sp[7 * 65]);
        o.z = pk4_fp8(sp[8 * 65], sp[9 * 65], sp[10 * 65], sp[11 * 65]); o.w = pk4_fp8(sp[12 * 65], sp[13 * 65], sp[14 * 65], sp[15 * 65]);
        *(u32x4*)(WT8 + (size_t)rm(n0 + n) * ldt + k0 + 16 * c4) = o;
    }
    LDS_WAIT(); asm volatile("" ::: "memory");
}
__device__ __forceinline__ void p0_prologue(const Frame& F) {
    LAS float* scr = (LAS float*)(F.lds + F.wave * 16640);
    const int gw = blockIdx.x * NWAVES + F.wave, NGW = F.G * NWAVES;
    constexpr int I_IN = 16 * 72, I_A = 8 * 16, I_B = 8 * 16, I_O = 16 * 16, I_PG = 16 * 16, I_PP = 4 * 16, I_W1 = NE * 16 * 32, I_W2 = NE * 16 * 16;
    constexpr int NITEMS = I_IN + I_A + I_B + I_O + I_PG + I_PP;
    for (int it = gw; it < NITEMS; it += NGW) {
        int r = it;
        if (r < I_IN) { tr_item(F.w_in, INC, nullptr, F.WIN, D, 0, RowId(), scr, r / 72, r % 72, F.lane, (r % 72) < 8 ? QSCALE : 1.0f); continue; } r -= I_IN;
        if (r < I_A) { tr_item(F.w_out_a, D, nullptr, F.WAB, D, 0, RowId(), scr, r / 16, r % 16, F.lane); continue; } r -= I_A;
        if (r < I_B) { tr_item(F.w_out_b, D, nullptr, F.WAB, D, 512, RowId(), scr, r / 16, r % 16, F.lane); continue; } r -= I_B;
        if (r < I_O) { tr_item(F.w_out, D, nullptr, F.WOUT, D, 0, RowId(), scr, r / 16, r % 16, F.lane); continue; } r -= I_O;
        if (r < I_PG) { tr_item(F.w_ple_gate, D, F.g_ple, F.WPG, D, 0, RowId(), scr, r / 16, r % 16, F.lane); continue; } r -= I_PG;
        { tr_item(F.w_ple_proj, D, nullptr, F.WPP, PLE, 0, RowId(), scr, r / 16, r % 16, F.lane); }
    }
    (void)I_W1; (void)I_W2;
    for (int m0 = 2 * gw; m0 < T; m0 += 2 * NGW) {
        f32x4 v[2][4];
#pragma unroll
        for (int u = 0; u < 2; ++u) { const f32x4* xr = (const f32x4*)(F.x + (size_t)(m0 + u) * D) + F.lane;
#pragma unroll
            for (int j = 0; j < 4; ++j) v[u][j] = __builtin_nontemporal_load(xr + 64 * j); }
#pragma unroll
        for (int u = 0; u < 2; ++u) { float s = 0.f;
#pragma unroll
            for (int j = 0; j < 4; ++j) s += (v[u][j].x * v[u][j].x + v[u][j].y * v[u][j].y) + (v[u][j].z * v[u][j].z + v[u][j].w * v[u][j].w);
            const float rstd = rsqrtf(wave_sum(s) * (1.f / D) + EPS);
            unsigned long long* o8 = (unsigned long long*)(F.ABF + (size_t)(m0 + u) * D) + F.lane;
#pragma unroll
            for (int j = 0; j < 4; ++j) { const f32x4 g = ((const f32x4*)F.g_mix)[F.lane + 64 * j];
                o8[64 * j] = (unsigned long long)pk2(v[u][j].x * rstd * g.x, v[u][j].y * rstd * g.y) | ((unsigned long long)pk2(v[u][j].z * rstd * g.z, v[u][j].w * rstd * g.w) << 32); } }
    }
    for (int m0 = 4 * gw; m0 < T; m0 += 4 * NGW) {
        f32x4 v[4];
#pragma unroll
        for (int u = 0; u < 4; ++u) v[u] = __builtin_nontemporal_load((const f32x4*)(F.p + (size_t)(m0 + u) * PLE) + F.lane);
#pragma unroll
        for (int u = 0; u < 4; ++u) ((unsigned long long*)(F.PBF + (size_t)(m0 + u) * PLE))[F.lane] = (unsigned long long)pk2(v[u].x, v[u].y) | ((unsigned long long)pk2(v[u].z, v[u].w) << 32);
    }
    const int gt = blockIdx.x * NTHREADS + F.tid, NGT = F.G * NTHREADS;
    for (int i = gt; i < NE * D; i += NGT) { const int e = i / D, k = i % D; const float v = F.w_router[k * NE + e] * F.g_moe[k]; const unsigned h = f2bf(v); F.WRHI[i] = (bf16)h; F.WRLO[i] = (bf16)f2bf(v - bf2f(h)); }
    for (int i = gt; i < 8 * 128 * 128; i += NGT) { const int t = (i >> 7) & 127, s = i & 127; F.SGUW[i] = (bf16)(((s >> 6) <= (t >> 6)) ? f2bf(F.sgu_w[i]) : 0u); }
}

__device__ __forceinline__ void moe_weight_items(const Frame& F) {
    LAS float* scr = (LAS float*)(F.lds + F.wave * 16640);
    const int gw = blockIdx.x * NWAVES + F.wave, NGW = F.G * NWAVES;
    constexpr int I_W1 = NE * 16 * 32, I_W2 = NE * 16 * 16;
    for (int it = gw; it < I_W1 + I_W2; it += NGW) {
        int r = it;
        if (r < I_W1) { const int e = r / 512, q = r % 512; const float* W = F.w1 + (size_t)e * D * 2 * DE;
            if (FP8_1) tr_item8(W, 2 * DE, F.g_moe, (unsigned char*)F.W1T + (size_t)e * 2 * DE * D, D, RowW1(), scr, q / 32, q % 32, F.lane, SC_W);
            else tr_item(W, 2 * DE, F.g_moe, F.W1T + (size_t)e * 2 * DE * D, D, 0, RowW1(), scr, q / 32, q % 32, F.lane);
            continue; } r -= I_W1;
        { const int e = r / 256, q = r % 256; const float* W = F.w2 + (size_t)e * DE * D;
            if (FP8_2) tr_item8(W, D, nullptr, (unsigned char*)F.W2T + (size_t)e * D * DE, DE, RowId(), scr, q / 16, q % 16, F.lane, SC_W);
            else tr_item(W, D, nullptr, F.W2T + (size_t)e * D * DE, DE, 0, RowId(), scr, q / 16, q % 16, F.lane); }
    }
}
__device__ __forceinline__ void p1_inproj(const Frame& F) {
    const int gw = blockIdx.x * NWAVES + F.wave, NGW = F.G * NWAVES, r32 = F.lane & 31, hi = F.lane >> 5;
    for (int tile = gw; tile < (T / 32) * (INC / 128); tile += NGW) {
        const int mb = tile / (INC / 128), cg = tile % (INC / 128), m0 = mb * 32, n0 = cg * 128;
        const bf16* ap = F.ABF + (size_t)(m0 + r32) * D + 8 * hi;
        const bf16* bp[4];
#pragma unroll
        for (int nb = 0; nb < 4; ++nb) bp[nb] = F.WIN + (size_t)(n0 + 32 * nb + r32) * D + 8 * hi;
        f32x16 acc[4];
#pragma unroll
        for (int nb = 0; nb < 4; ++nb) acc[nb] = f32x16{};
        smma<4>(ap, bp, D, acc);
        const int kind = (n0 < ZK) ? 0 : (n0 < ZU) ? 1 : (n0 < ZGA) ? 2 : 3;
#pragma unroll
        for (int nb = 0; nb < 4; ++nb)
#pragma unroll
            for (int r = 0; r < 16; ++r) {
                float v = acc[nb][r];
                if (kind == 2) v = gelu_tanh(v); else if (kind == 3) v = sigmoidf_(v);
                F.ZZ[(size_t)(m0 + crow(r, hi)) * INC + n0 + 32 * nb + r32] = (bf16)f2bf(v);
            }
    }
    for (int tile = gw; tile < (T / 32) * (D / 128); tile += NGW) {
        const int mb = tile / (D / 128), cg = tile % (D / 128), m0 = mb * 32, n0 = cg * 128;
        const bf16* ap = F.PBF + (size_t)(m0 + r32) * PLE + 8 * hi;
        const bf16* bp[4];
#pragma unroll
        for (int nb = 0; nb < 4; ++nb) bp[nb] = F.WPP + (size_t)(n0 + 32 * nb + r32) * PLE + 8 * hi;
        f32x16 acc[4];
#pragma unroll
        for (int nb = 0; nb < 4; ++nb) acc[nb] = f32x16{};
        smma<4>(ap, bp, PLE, acc);
#pragma unroll
        for (int nb = 0; nb < 4; ++nb)
#pragma unroll
            for (int r = 0; r < 16; ++r) F.PROJ[(size_t)(m0 + crow(r, hi)) * D + n0 + 32 * nb + r32] = (bf16)f2bf(acc[nb][r]);
    }
}

template <bool EARLY>
__device__ __forceinline__ void p2_attn_scalar(const Frame& F) {
    LAS u32x4* Kt = (LAS u32x4*)F.lds;
    LAS u32x4* Vt = Kt + 512;
    for (int pr = blockIdx.x; pr < 256; pr += F.G) {
        for (int half = 0; half < 2; ++half) {
            const int bh = pr >> 2, tb = half == 0 ? (pr & 3) : 7 - (pr & 3), b = bh / NH, h = bh % NH;
            const int t = tb * 512 + F.tid;
            const size_t row = (size_t)b * SEQ + t;
            float q[64], o[64];
            { const u32x4* qp = (const u32x4*)(F.ZZ + row * INC + ZQ + h * HD);
#pragma unroll
              for (int c = 0; c < 8; ++c) { float f[8]; unpack8(qp[c], f);
#pragma unroll
                  for (int j = 0; j < 8; ++j) q[8 * c + j] = f[j]; } }
#pragma unroll
            for (int d = 0; d < 64; ++d) o[d] = 0.f;
            float carry = 1.f;
            for (int kt = tb * 8 + 7; kt >= 0; --kt) {
                __syncthreads();
                { const int kr = F.tid >> 3, c = F.tid & 7; const size_t krow = ((size_t)b * SEQ + kt * 64 + kr) * INC + h * HD + 8 * c;
                  Kt[F.tid] = *(const u32x4*)(F.ZZ + krow + ZK); Vt[F.tid] = *(const u32x4*)(F.ZZ + krow + ZV); }
                __syncthreads();
                for (int sl = 63; sl >= 0; --sl) {
                    const int s = kt * 64 + sl;
                    if (s < t) {
                        float z = 0.f;
#pragma unroll
                        for (int c = 0; c < 8; ++c) { float f[8]; unpack8(Kt[sl * 8 + c], f);
#pragma unroll
                            for (int j = 0; j < 8; ++j) z += q[8 * c + j] * f[j]; }
                        z = fminf(z, 100.f);
                        const float e = exp2f(z), r = 1.0f / (1.0f + e);
                        carry *= r;
                        const float w = e * carry;
#pragma unroll
                        for (int c = 0; c < 8; ++c) { float f[8]; unpack8(Vt[sl * 8 + c], f);
#pragma unroll
                            for (int j = 0; j < 8; ++j) o[8 * c + j] += w * f[j]; }
                    }
                }
            }
            u32x4* op = (u32x4*)(F.OAB + row * D + h * HD);
#pragma unroll
            for (int c = 0; c < 8; ++c) { u32x4 w; w.x = pk2(o[8 * c], o[8 * c + 1]); w.y = pk2(o[8 * c + 2], o[8 * c + 3]); w.z = pk2(o[8 * c + 4], o[8 * c + 5]); w.w = pk2(o[8 * c + 6], o[8 * c + 7]); op[c] = w; }
        }
    }
    __syncthreads();
}
__device__ __forceinline__ void p2_sgu_simple(const Frame& F) {
    LAS bf16* vsn = (LAS bf16*)F.lds;
    for (int unit = blockIdx.x; unit < T / 128; unit += F.G) {
        const int row0 = unit * 128;
        for (int i = 0; i < 16; ++i) {
            const int rl = F.wave * 16 + i;
            const u32x4 w = *(const u32x4*)(F.ZZ + (size_t)(row0 + rl) * INC + ZVS + 8 * F.lane);
            float f[8]; unpack8(w, f);
            float s = 0.f;
#pragma unroll
            for (int j = 0; j < 8; ++j) s += f[j];
            const float mean = wave_sum(s) * (1.f / 512.f);
            float s2 = 0.f;
#pragma unroll
            for (int j = 0; j < 8; ++j) { f[j] -= mean; s2 += f[j] * f[j]; }
            const float rstd = rsqrtf(wave_sum(s2) * (1.f / 512.f) + EPS);
            const f32x4 g0 = *(const f32x4*)(F.sgu_norm + 8 * F.lane), g1 = *(const f32x4*)(F.sgu_norm + 8 * F.lane + 4);
            u32x4 o; o.x = pk2(f[0] * rstd * g0.x, f[1] * rstd * g0.y); o.y = pk2(f[2] * rstd * g0.z, f[3] * rstd * g0.w);
            o.z = pk2(f[4] * rstd * g1.x, f[5] * rstd * g1.y); o.w = pk2(f[6] * rstd * g1.z, f[7] * rstd * g1.w);
            *(LAS u32x4*)(vsn + rl * 512 + 8 * F.lane) = o;
        }
        __syncthreads();
        const int ch = F.tid, g = ch >> 6;
        for (int tl = 0; tl < 128; ++tl) {
            const bf16* wrow = F.SGUW + (g * 128 + tl) * 128;
            float a = 0.f;
            for (int s = 0; s < 128; ++s) a += bf2f(wrow[s]) * bf2f(vsn[s * 512 + ch]);
            const float sv = a + F.sgu_b[g * 128 + tl];
            const float u = bf2f(F.ZZ[(size_t)(row0 + tl) * INC + ZU + ch]);
            F.OAB[(size_t)(row0 + tl) * D + 512 + ch] = (bf16)f2bf(u * sv);
        }
        __syncthreads();
    }
}

__device__ __forceinline__ void p3_merge(const Frame& F) {
    const int gw = blockIdx.x * NWAVES + F.wave, NGW = F.G * NWAVES, r32 = F.lane & 31, hi = F.lane >> 5;
    for (int tile = gw; tile < (T / 32) * (D / 128); tile += NGW) {
        const int mb = tile / (D / 128), cg = tile % (D / 128), m0 = mb * 32, n0 = cg * 128;
        const bf16* ap = F.OAB + (size_t)(m0 + r32) * D + 8 * hi;
        const bf16* bp[4];
#pragma unroll
        for (int nb = 0; nb < 4; ++nb) bp[nb] = F.WAB + (size_t)(n0 + 32 * nb + r32) * D + 8 * hi;
        f32x16 acca[4], accb[4];
#pragma unroll
        for (int nb = 0; nb < 4; ++nb) { acca[nb] = f32x16{}; accb[nb] = f32x16{}; }
        smma<4>(ap, bp, 512, acca);
        const bf16* ap2 = ap + 512; const bf16* bp2[4];
#pragma unroll
        for (int nb = 0; nb < 4; ++nb) bp2[nb] = bp[nb] + 512;
        smma<4>(ap2, bp2, 512, accb);
#pragma unroll
        for (int nb = 0; nb < 4; ++nb)
#pragma unroll
            for (int r = 0; r < 16; ++r) {
                const size_t row = m0 + crow(r, hi); const int col = n0 + 32 * nb + r32;
                const float sga = bf2f(F.ZZ[row * INC + ZGA + col]), sgb = bf2f(F.ZZ[row * INC + ZGB + col]);
                F.MERGED[row * D + col] = (bf16)f2bf(sga * acca[nb][r] + sgb * accb[nb][r]);
            }
    }
}
__device__ __forceinline__ void p4_out(const Frame& F) {
    const int gw = blockIdx.x * NWAVES + F.wave, NGW = F.G * NWAVES, r32 = F.lane & 31, hi = F.lane >> 5;
    for (int tile = gw; tile < (T / 32) * (D / 128); tile += NGW) {
        const int mb = tile / (D / 128), cg = tile % (D / 128), m0 = mb * 32, n0 = cg * 128;
        const bf16* ap = F.MERGED + (size_t)(m0 + r32) * D + 8 * hi;
        const bf16* bp[4];
#pragma unroll
        for (int nb = 0; nb < 4; ++nb) bp[nb] = F.WOUT + (size_t)(n0 + 32 * nb + r32) * D + 8 * hi;
        f32x16 acc[4];
#pragma unroll
        for (int nb = 0; nb < 4; ++nb) acc[nb] = f32x16{};
        smma<4>(ap, bp, D, acc);
#pragma unroll
        for (int nb = 0; nb < 4; ++nb)
#pragma unroll
            for (int r = 0; r < 16; ++r) {
                const size_t row = m0 + crow(r, hi); const int col = n0 + 32 * nb + r32;
                F.H1[row * D + col] = (bf16)f2bf(F.x[row * D + col] + acc[nb][r]);
            }
    }
}
__device__ __forceinline__ void p5_router(const Frame& F) {
    LAS unsigned* hist = (LAS unsigned*)F.lds;
    LAS unsigned* base = hist + 32;
    LAS unsigned* lsel = hist + 64;
    LAS float* lgate = (LAS float*)(hist + 64 + 512);
    const int e = F.lane & 31, half = F.lane >> 5;
    for (int chunk = blockIdx.x; chunk < T / 128; chunk += F.G) {
        if (F.tid < 32) hist[F.tid] = 0u;
        __syncthreads();
        for (int i = 0; i < 16; ++i) {
            const int tl = F.wave * 16 + i, t = chunk * 128 + tl;
            const bf16* hp = F.H1 + (size_t)t * D + half * 512;
            const bf16* whi = F.WRHI + e * D + half * 512;
            const bf16* wlo = F.WRLO + e * D + half * 512;
            float dot = 0.f, ss = 0.f;
            for (int k = 0; k < 512; k += 8) {
                float hf[8], a[8], c[8];
                unpack8(*(const u32x4*)(hp + k), hf); unpack8(*(const u32x4*)(whi + k), a); unpack8(*(const u32x4*)(wlo + k), c);
#pragma unroll
                for (int j = 0; j < 8; ++j) { dot += hf[j] * (a[j] + c[j]); ss += hf[j] * hf[j]; }
            }
            dot += __shfl_xor(dot, 32); ss += __shfl_xor(ss, 32);
            const float rstd = rsqrtf(ss * (1.f / D) + EPS);
            float logit = rstd * dot + F.b_router[e];
            float val[4]; int sel[4];
#pragma unroll
            for (int r = 0; r < 4; ++r) {
                const float m = wave_max(logit);
                const unsigned long long bal = __ballot(logit == m);
                const int le = (int)(__ffsll((long long)bal) - 1) & 31;
                val[r] = m; sel[r] = le;
                if (e == le) logit = -INFINITY;
            }
            float ex[4], sum = 0.f;
#pragma unroll
            for (int r = 0; r < 4; ++r) { ex[r] = __expf(val[r] - val[0]); sum += ex[r]; }
            { const u32x4* hr = (const u32x4*)(F.H1 + (size_t)t * D); u32x4* cr = (u32x4*)(F.ABF + (size_t)t * D);
#pragma unroll
              for (int j = 0; j < 2; ++j) { float f[8]; unpack8(hr[F.lane + 64 * j], f); u32x4 o; o.x = pk2(f[0] * rstd, f[1] * rstd); o.y = pk2(f[2] * rstd, f[3] * rstd); o.z = pk2(f[4] * rstd, f[5] * rstd); o.w = pk2(f[6] * rstd, f[7] * rstd); cr[F.lane + 64 * j] = o; } }
            if (F.lane == 0) {
                F.RSTD1[t] = rstd;
#pragma unroll
                for (int r = 0; r < 4; ++r) { const unsigned loc = atomicAdd((unsigned*)&hist[sel[r]], 1u); lsel[tl * 4 + r] = (unsigned)sel[r] | (loc << 8); lgate[tl * 4 + r] = ex[r] / sum; }
            }
        }
        __syncthreads();
        if (F.tid < 32) { const unsigned n = hist[F.tid]; base[F.tid] = n ? __hip_atomic_fetch_add(F.ctl + CW_CNT + 64 * F.tid, n, __ATOMIC_RELAXED, __HIP_MEMORY_SCOPE_AGENT) : 0u; }
        __syncthreads();
        { const int tl = F.tid >> 2, r = F.tid & 3, t = chunk * 128 + tl; const unsigned s = lsel[tl * 4 + r]; const int ee = s & 255; const unsigned rank = base[ee] + (s >> 8);
          F.TOKLIST[ee * LCAP + rank] = t; F.SLOTREF[t * 4 + r] = (ee << 16) | rank; F.GATE[t * 4 + r] = lgate[tl * 4 + r]; }
        __syncthreads();
    }
}
struct MoeTab { LAS int* cnt; LAS int* toff; LAS int* p32; };
__device__ __forceinline__ MoeTab moe_tables(const Frame& F) {
    MoeTab M; M.cnt = (LAS int*)(F.lds + MISC_OFF + 128); M.toff = M.cnt + 32; M.p32 = M.toff + 33;
    __syncthreads();
    if (F.tid == 0) { int a = 0, c = 0;
        for (int e = 0; e < NE; ++e) { const int n = (int)__hip_atomic_load(F.ctl + CW_CNT + 64 * e, __ATOMIC_RELAXED, __HIP_MEMORY_SCOPE_AGENT); M.cnt[e] = n; M.toff[e] = a; M.p32[e] = c; a += (n + 255) >> 8; c += (n + 31) >> 5; }
        M.toff[NE] = a; M.p32[NE] = c; }
    __syncthreads();
    return M;
}
__device__ __forceinline__ void p6_moe1(const Frame& F) {
    const MoeTab M = moe_tables(F);
    const int gw = blockIdx.x * NWAVES + F.wave, NGW = F.G * NWAVES, r32 = F.lane & 31, hi = F.lane >> 5;
    const int ntiles = M.p32[NE] * 32;
    for (int tile = gw; tile < ntiles; tile += NGW) {
        const int blk = tile >> 5, hb = tile & 31;
        int e = 0; while (M.p32[e + 1] <= blk) ++e;
        const int sb = blk - M.p32[e], cnt = M.cnt[e];
        const int rank = sb * 32 + r32;
        const int tok = F.TOKLIST[e * LCAP + (rank < cnt ? rank : cnt - 1)];
        const bf16* ap = F.ABF + (size_t)tok * D + 8 * hi;
        const int hidb = hb * 32 + r32;
        const bf16* bp[2];
        bp[0] = F.W1T + ((size_t)e * 2048 + 256 * (hidb >> 7) + (hidb & 127)) * D + 8 * hi; bp[1] = bp[0] + 128 * D;
        f32x16 acc[2]; acc[0] = f32x16{}; acc[1] = f32x16{};
        smma<2>(ap, bp, D, acc);
        const float bg = F.b1[e * 2048 + 2 * hidb], bl = F.b1[e * 2048 + 2 * hidb + 1];
#pragma unroll
        for (int r = 0; r < 16; ++r) {
            const int rr = crow(r, hi), rk = sb * 32 + rr;
            float gl = acc[0][r] + bg, li = acc[1][r] + bl;
            gl = fminf(gl, 7.f); li = fminf(fmaxf(li, -7.f), 7.f);
            const float act = gl * sigmoidf_(1.702f * gl) * (li + 1.f);
            if (rk < cnt) F.HID[((size_t)256 * M.toff[e] + rk) * DE + hidb] = (bf16)f2bf(act);
        }
    }
}
__device__ __forceinline__ void p7_moe2(const Frame& F) {
    const MoeTab M = moe_tables(F);
    const int gw = blockIdx.x * NWAVES + F.wave, NGW = F.G * NWAVES, r32 = F.lane & 31, hi = F.lane >> 5;
    const int ntiles = M.p32[NE] * 8;
    for (int tile = gw; tile < ntiles; tile += NGW) {
        const int blk = tile >> 3, cg = tile & 7;
        int e = 0; while (M.p32[e + 1] <= blk) ++e;
        const int sb = blk - M.p32[e], cnt = M.cnt[e];
        const size_t rowb = (size_t)256 * M.toff[e] + sb * 32;
        const bf16* ap = F.HID + (rowb + r32) * DE + 8 * hi;
        const bf16* bp[4];
#pragma unroll
        for (int nb = 0; nb < 4; ++nb) bp[nb] = F.W2T + ((size_t)e * D + cg * 128 + 32 * nb + r32) * DE + 8 * hi;
        f32x16 acc[4];
#pragma unroll
        for (int nb = 0; nb < 4; ++nb) acc[nb] = f32x16{};
        smma<4>(ap, bp, DE, acc);
#pragma unroll
        for (int nb = 0; nb < 4; ++nb) { const int col = cg * 128 + 32 * nb + r32; const float bb = F.b2[e * D + col];
#pragma unroll
            for (int r = 0; r < 16; ++r) { const int rr = crow(r, hi); if (sb * 32 + rr < cnt) F.YS[(rowb + rr) * D + col] = (bf16)f2bf(acc[nb][r] + bb); } }
    }
}
__device__ __forceinline__ void p8_combine(const Frame& F) {
    const MoeTab M = moe_tables(F);
    const int gw = blockIdx.x * NWAVES + F.wave, NGW = F.G * NWAVES;
    for (int t0 = 2 * gw; t0 < T; t0 += 2 * NGW) {
        size_t yrow[2][4]; float gk[2][4];
#pragma unroll
        for (int u = 0; u < 2; ++u)
#pragma unroll
            for (int k = 0; k < 4; ++k) { const int sr = F.SLOTREF[(t0 + u) * 4 + k]; yrow[u][k] = (size_t)256 * M.toff[sr >> 16] + (sr & 0xffff); gk[u][k] = F.GATE[(t0 + u) * 4 + k]; }
        u32x4 hv[2][2], yv[2][2][4];
#pragma unroll
        for (int u = 0; u < 2; ++u)
#pragma unroll
            for (int j = 0; j < 2; ++j) { const int col = 8 * F.lane + 512 * j; hv[u][j] = *(const u32x4*)(F.H1 + (size_t)(t0 + u) * D + col);
#pragma unroll
                for (int k = 0; k < 4; ++k) yv[u][j][k] = *(const u32x4*)(F.YS + yrow[u][k] * D + col); }
#pragma unroll
        for (int u = 0; u < 2; ++u) {
            float ss = 0.f;
#pragma unroll
            for (int j = 0; j < 2; ++j) {
                float a[8]; unpack8(hv[u][j], a);
#pragma unroll
                for (int k = 0; k < 4; ++k) { float y[8]; unpack8(yv[u][j][k], y);
#pragma unroll
                    for (int q = 0; q < 8; ++q) a[q] += gk[u][k] * y[q]; }
                u32x4 o; o.x = pk2(a[0], a[1]); o.y = pk2(a[2], a[3]); o.z = pk2(a[4], a[5]); o.w = pk2(a[6], a[7]);
                *(u32x4*)(F.H2 + (size_t)(t0 + u) * D + 8 * F.lane + 512 * j) = o;
                float b[8]; unpack8(o, b);
#pragma unroll
                for (int q = 0; q < 8; ++q) ss += b[q] * b[q];
            }
            ss = wave_sum(ss);
            if (F.lane == 0) F.RSTD2[t0 + u] = rsqrtf(ss * (1.f / D) + EPS);
        }
    }
}
__device__ __forceinline__ void p9_ple(const Frame& F) {
    const int gw = blockIdx.x * NWAVES + F.wave, NGW = F.G * NWAVES, r32 = F.lane & 31, hi = F.lane >> 5;
    for (int tile = gw; tile < (T / 32) * (D / 128); tile += NGW) {
        const int mb = tile / (D / 128), cg = tile % (D / 128), m0 = mb * 32, n0 = cg * 128;
        const bf16* ap = F.H2 + (size_t)(m0 + r32) * D + 8 * hi;
        const bf16* bp[4];
#pragma unroll
        for (int nb = 0; nb < 4; ++nb) bp[nb] = F.WPG + (size_t)(n0 + 32 * nb + r32) * D + 8 * hi;
        f32x16 acc[4];
#pragma unroll
        for (int nb = 0; nb < 4; ++nb) acc[nb] = f32x16{};
        smma<4>(ap, bp, D, acc);
#pragma unroll
        for (int r = 0; r < 16; ++r) {
            const size_t row = m0 + crow(r, hi); const float rs = F.RSTD2[row];
#pragma unroll
            for (int nb = 0; nb < 4; ++nb) { const int col = n0 + 32 * nb + r32;
                const float pg = sigmoidf_(rs * acc[nb][r]);
                F.H3[row * D + col] = (bf16)f2bf(bf2f(F.H2[row * D + col]) + pg * bf2f(F.PROJ[row * D + col])); }
        }
    }
}
__device__ __forceinline__ void p10_final(const Frame& F) {
    const int gw = blockIdx.x * NWAVES + F.wave, NGW = F.G * NWAVES;
    for (int t = gw; t < T; t += NGW) {
        float a[2][8]; float ss = 0.f;
#pragma unroll
        for (int j = 0; j < 2; ++j) { unpack8(*(const u32x4*)(F.H3 + (size_t)t * D + 8 * F.lane + 512 * j), a[j]);
#pragma unroll
            for (int q = 0; q < 8; ++q) ss += a[j][q] * a[j][q]; }
        const float rstd = rsqrtf(wave_sum(ss) * (1.f / D) + EPS);
#pragma unroll
        for (int j = 0; j < 2; ++j) { const int col = 8 * F.lane + 512 * j;
            const f32x4 g0 = *(const f32x4*)(F.g_final + col), g1 = *(const f32x4*)(F.g_final + col + 4);
            f32x4 o0, o1; o0.x = a[j][0] * rstd * g0.x; o0.y = a[j][1] * rstd * g0.y; o0.z = a[j][2] * rstd * g0.z; o0.w = a[j][3] * rstd * g0.w;
            o1.x = a[j][4] * rstd * g1.x; o1.y = a[j][5] * rstd * g1.y; o1.z = a[j][6] * rstd * g1.z; o1.w = a[j][7] * rstd * g1.w;
            *(f32x4*)(F.out + (size_t)t * D + col) = o0; *(f32x4*)(F.out + (size_t)t * D + col + 4) = o1; }
    }
}


namespace pg {
constexpr int BM = 256, BK = 64, HALF = 128, HTB = HALF * BK * 2, STAGE_BYTES = 8 * HTB, NXCD = 8, WGM = 8;
__device__ __forceinline__ int lds_byte(int r, int c) { const int st = (r >> 4) * 2 + (c >> 5), rr = r & 15, cc = c & 31, ob = rr * 64 + cc * 2; return st * 1024 + (ob ^ (((ob >> 9) & 1) << 5)); }
__device__ __forceinline__ void stage_rc(int b, int& R, int& C) { const int st = b / 1024, sb = b % 1024, swz = sb ^ (((sb >> 9) & 1) << 5); R = (st >> 1) * 16 + swz / 64; C = (st & 1) * 32 + (swz % 64) / 2; }
__device__ __forceinline__ int perm32(int rho) { const int n = rho >> 4, i = rho & 15; return 8 * (i >> 2) + 4 * n + (i & 3); }
struct Unit { int arow, brow, kofs, x0, x1, x2; };
typedef float f32x2_t __attribute__((ext_vector_type(2))); typedef __bf16 bf16x2_t __attribute__((ext_vector_type(2)));
__device__ __forceinline__ unsigned cvt_pk_bf16(float lo, float hi) { const f32x2_t v = {lo, hi}; const bf16x2_t b = __builtin_convertvector(v, bf16x2_t); return __builtin_bit_cast(unsigned, b); }
typedef f32x4 Acc[2][2][4][2];
typedef int i32x8 __attribute__((ext_vector_type(8)));
typedef i32x8 i32x8_a16 __attribute__((aligned(16)));

__device__ __forceinline__ void dma16(const void* sbase, unsigned voff, unsigned ldsdst) { unsigned keep;
    asm volatile("s_mov_b32 %0, m0\n\ts_mov_b32 m0, %3\n\ts_nop 0\n\tglobal_load_lds_dwordx4 %1, %2\n\ts_mov_b32 m0, %0" : "=&s"(keep) : "v"(voff), "s"(sbase), "s"(ldsdst) : "memory"); }
struct DenseMap { static constexpr bool GATHER = false; int lda; __device__ __forceinline__ unsigned rowoff(const Unit&, int r) const { return (unsigned)r * (unsigned)lda * 2u; }
    __device__ __forceinline__ size_t base(const Unit& u) const { return (size_t)u.arow * lda * 2; } };
template <int SPLIT>
struct DenseOrder {
    int nM, nN, nwg, G, c, khalf;
    __device__ __forceinline__ void init(int M, int N, int G_, int c_, int khalf_ = 0) { nM = M / BM; nN = N / BM; nwg = nM * nN; G = G_; c = c_; khalf = khalf_; }
    __device__ __forceinline__ bool next(int i, Unit& u) const {
        const int j = SPLIT ? (i >> 1) : i;
        const long L = (long)j * G + c; if (L >= nwg) return false;
        int wgid = (int)L; { const int q = nwg / NXCD, r = nwg % NXCD, xcd = wgid % NXCD, off = wgid / NXCD; wgid = (xcd < r ? xcd * (q + 1) : r * (q + 1) + (xcd - r) * q) + off; }
        const int nig = WGM * nN, gid = wgid / nig, fm = gid * WGM, gsz = (nM - fm) < WGM ? (nM - fm) : WGM;
        const int pm = fm + ((wgid % nig) % gsz), pn = (wgid % nig) / gsz;
        u.arow = pm * BM; u.brow = pn * BM; u.x0 = pm; u.x1 = pn; u.x2 = SPLIT ? (i & 1) : 0; u.kofs = SPLIT ? (i & 1) * khalf : 0; return true;
    }
};

template <class Epi, class Sched, class AMap, bool ALIGN_EPI, int PREC = 0>
__device__ __forceinline__ void gemm_run(LAS unsigned char* lds, const bf16* A, const bf16* Bt, const int ldb, const int nt, const Sched& S, const Epi& E, const AMap& AM) {
    const int tid = threadIdx.x, wid = __builtin_amdgcn_readfirstlane(tid >> 6), lane = tid & 63, wr = wid >> 2, wc = wid & 3, fr = lane & 15, fq = lane >> 4;
    int RA[2]; unsigned CA2[2], voffB[2];
#pragma unroll
    for (int i = 0; i < 2; ++i) { int R, C; stage_rc(tid * 16 + i * 8192, R, C); RA[i] = R; CA2[i] = (unsigned)C * 2u; const int Rb = (R & ~31) + perm32(R & 31); voffB[i] = (unsigned)(Rb * ldb + C) * 2u; }
    const size_t kstep = (size_t)(BK * 2);
    const size_t hstepB = (size_t)HALF * ldb * 2;
    const unsigned ldsw = (unsigned)wid * 1024u;
    const unsigned lds32 = (unsigned)(uintptr_t)lds;
    const int aoff = lds_byte(wr * 64 + fr, fq * (PREC ? 16 : 8)), boff = lds_byte(wc * 32 + fr, fq * (PREC ? 16 : 8));
#define PG_SA(b, h) (((b) * 2 + (h)) * HTB)
#define PG_SB(b, h) ((4 + (b) * 2 + (h)) * HTB)
#define PG_DMA(gbase, voff32, ldsdst) do { unsigned _keep; asm volatile("s_mov_b32 %0, m0\n\ts_mov_b32 m0, %3\n\ts_nop 0\n\tglobal_load_lds_dwordx4 %1, %2\n\ts_mov_b32 m0, %0" \
        : "=&s"(_keep) : "v"(voff32), "s"(gbase), "s"(ldsdst) : "memory"); } while (0)
#define PG_STAGE(bufoff, gbase, voff) do { _Pragma("unroll") for (int _i = 0; _i < 2; ++_i) PG_DMA((const char*)(gbase), (voff)[_i], lds32 + (unsigned)((bufoff) + _i * 8192) + ldsw); } while (0)
#define PG_LD8(addr) (*(const LAS i32x8_a16*)(addr))
#define PG_LDA(dst, b, h) do { if constexpr (PREC == 0) { _Pragma("unroll") for (int m = 0; m < 4; ++m) _Pragma("unroll") for (int k = 0; k < 2; ++k) dst[m][k] = *(const LAS bf16x8*)(lds + PG_SA(b, h) + aoff + m * 2048 + k * 1024); } \
        else { _Pragma("unroll") for (int m = 0; m < 4; ++m) dst##8[m] = PG_LD8(lds + PG_SA(b, h) + aoff + m * 2048); } } while (0)
#define PG_LDB(dst, b, h) do { if constexpr (PREC == 0) { _Pragma("unroll") for (int n = 0; n < 2; ++n) _Pragma("unroll") for (int k = 0; k < 2; ++k) dst[n][k] = *(const LAS bf16x8*)(lds + PG_SB(b, h) + boff + n * 2048 + k * 1024); } \
        else { _Pragma("unroll") for (int n = 0; n < 2; ++n) dst##8[n] = PG_LD8(lds + PG_SB(b, h) + boff + n * 2048); } } while (0)
#define PG_MMA(ai, bj, At, Bt_) do { __builtin_amdgcn_s_setprio(1); _Pragma("unroll") for (int m = 0; m < 4; ++m) _Pragma("unroll") for (int n = 0; n < 2; ++n) { \
        if constexpr (PREC == 0) { _Pragma("unroll") for (int k = 0; k < 2; ++k) acc[ai][bj][m][n] = __builtin_amdgcn_mfma_f32_16x16x32_bf16(Bt_[n][k], At[m][k], acc[ai][bj][m][n], 0, 0, 0); } \
        else { asm volatile("v_mfma_scale_f32_16x16x128_f8f6f4 %0, %1, %2, %0, %3, %3 op_sel_hi:[0,0,0]" : "+v"(acc[ai][bj][m][n]) : "v"(Bt_##8[n]), "v"(At##8[m]), "v"(one_scale)); } } \
        __builtin_amdgcn_s_setprio(0); } while (0)
#define PG_WAIT_V(n) asm volatile("s_waitcnt vmcnt(" #n ")" ::: "memory")
#define PG_WAIT_L(n) asm volatile("s_waitcnt lgkmcnt(" #n ")" ::: "memory")
#define PG_BAR __builtin_amdgcn_s_barrier()
#define PG_SCHED __builtin_amdgcn_sched_barrier(0)
#define PG_ZERO() do { _Pragma("unroll") for (int a = 0; a < 2; ++a) _Pragma("unroll") for (int b = 0; b < 2; ++b) _Pragma("unroll") for (int m = 0; m < 4; ++m) _Pragma("unroll") for (int n = 0; n < 2; ++n) acc[a][b][m][n] = (f32x4){0.f, 0.f, 0.f, 0.f}; } while (0)
#define PG_MKVA(u, va) do { _Pragma("unroll") for (int h = 0; h < 2; ++h) _Pragma("unroll") for (int i = 0; i < 2; ++i) va[h][i] = AM.rowoff(u, h * HALF + RA[i]) + CA2[i]; } while (0)
    Unit cur, nxt; int ui = 0;
    if (!S.next(0, cur)) return;
    Acc acc; PG_ZERO();
    bf16x8 At[4][2], B0[2][2], B1[2][2];
    i32x8 At8[4], B08[2], B18[2];
    const unsigned one_scale = 0x7f7f7f7fu;
    unsigned voffA[2]; unsigned vaC[2][2], vaN[2][2];
    const size_t hstepA = AMap::GATHER ? 0 : (size_t)AM.rowoff(cur, HALF);
    if constexpr (AMap::GATHER) { PG_MKVA(cur, vaC); } else {
#pragma unroll
        for (int i = 0; i < 2; ++i) voffA[i] = AM.rowoff(cur, RA[i]) + CA2[i]; }
#define PG_STAGE_A(bufoff, ptr, h, useNext) do { if constexpr (AMap::GATHER) { unsigned _v[2] = {(useNext) ? vaN[h][0] : vaC[h][0], (useNext) ? vaN[h][1] : vaC[h][1]}; PG_STAGE(bufoff, ptr, _v); } \
        else { PG_STAGE(bufoff, (ptr) + (h) * hstepA, voffA); } } while (0)
    const char* cA = (const char*)A + (size_t)cur.kofs * 2 + AM.base(cur); const char* cB = (const char*)Bt + ((size_t)cur.brow * ldb + cur.kofs) * 2;
    PG_STAGE(PG_SB(0, 0), cB, voffB); PG_STAGE(PG_SB(0, 1), cB + hstepB, voffB); PG_STAGE_A(PG_SA(0, 0), cA, 0, false); PG_STAGE_A(PG_SA(0, 1), cA, 1, false);
    if (wr == 1) PG_BAR;
    PG_WAIT_V(2); PG_BAR;
    PG_STAGE(PG_SB(1, 0), cB + kstep, voffB); PG_STAGE_A(PG_SA(1, 0), cA + kstep, 0, false); PG_STAGE(PG_SB(1, 1), cB + hstepB + kstep, voffB);
    PG_WAIT_V(6); PG_BAR;
    for (;;) {
        const bool has_next = S.next(ui + 1, nxt);
        const char* nA = cA; const char* nB = cB;
        if (has_next) { if constexpr (AMap::GATHER) { PG_MKVA(nxt, vaN); } nA = (const char*)A + (size_t)nxt.kofs * 2 + AM.base(nxt); nB = (const char*)Bt + ((size_t)nxt.brow * ldb + nxt.kofs) * 2; }
        else if constexpr (AMap::GATHER) {
#pragma unroll
            for (int h = 0; h < 2; ++h)
#pragma unroll
                for (int i = 0; i < 2; ++i) vaN[h][i] = vaC[h][i]; }
        E.prefetch(cur, ui, wid, lane);
#pragma unroll 1
        for (int t = 0; t < nt; t += 2) {
            const bool last = (t == nt - 2);
            const char* a1 = cA + (size_t)(t + 1) * kstep;
            const char* a2 = last ? nA : cA + (size_t)(t + 2) * kstep; const char* b2 = last ? nB : cB + (size_t)(t + 2) * kstep;
            const char* a3 = a2 + kstep; const char* b3 = b2 + kstep;
            PG_LDB(B0, 0, 0); PG_LDB(B1, 0, 1); PG_SCHED; PG_LDA(At, 0, 0); PG_STAGE_A(PG_SA(1, 1), a1, 1, false);
            PG_WAIT_V(8); PG_WAIT_L(0); PG_BAR; PG_MMA(0, 0, At, B0); PG_MMA(0, 1, At, B1); PG_BAR; PG_SCHED;
            PG_LDA(At, 0, 1); PG_STAGE(PG_SB(0, 0), b2, voffB); PG_STAGE(PG_SB(0, 1), b2 + hstepB, voffB); PG_STAGE_A(PG_SA(0, 0), a2, 0, last);
            PG_WAIT_V(8); PG_WAIT_L(0); PG_BAR; PG_MMA(1, 0, At, B0); PG_MMA(1, 1, At, B1); PG_BAR; PG_SCHED;
            PG_LDB(B0, 1, 0); PG_LDB(B1, 1, 1); PG_SCHED; PG_LDA(At, 1, 0); PG_STAGE_A(PG_SA(0, 1), a2, 1, last);
            PG_WAIT_V(8); PG_WAIT_L(0); PG_BAR; PG_MMA(0, 0, At, B0); PG_MMA(0, 1, At, B1); PG_BAR; PG_SCHED;
            PG_LDA(At, 1, 1); PG_STAGE(PG_SB(1, 0), b3, voffB); PG_STAGE(PG_SB(1, 1), b3 + hstepB, voffB); PG_STAGE_A(PG_SA(1, 0), a3, 0, last);
            PG_WAIT_V(8); PG_WAIT_L(0); PG_BAR; PG_MMA(1, 0, At, B0); PG_MMA(1, 1, At, B1); PG_BAR; PG_SCHED;
        }
        if constexpr (ALIGN_EPI) { if (wr == 0) PG_BAR; }
        if constexpr (PREC == 1) asm volatile("s_nop 15\n\ts_nop 15\n\ts_nop 15\n\ts_nop 15" ::: "memory");
        E(acc, cur, ui, wr, wc, fr, fq);
        if (!has_next) break;
        if (!E.keep(cur)) PG_ZERO();
        cur = nxt; cA = nA; cB = nB; ++ui;
        if constexpr (AMap::GATHER) {
#pragma unroll
            for (int h = 0; h < 2; ++h)
#pragma unroll
                for (int i = 0; i < 2; ++i) vaC[h][i] = vaN[h][i]; }
        if constexpr (ALIGN_EPI) { if (wr == 1) PG_BAR; }
    }
    PG_WAIT_V(0);
    if constexpr (!ALIGN_EPI) { if (wr == 0) PG_BAR; }
    PG_BAR;
#undef PG_SA
#undef PG_SB
#undef PG_STAGE
#undef PG_DMA
#undef PG_LDA
#undef PG_LDB
#undef PG_LD8
#undef PG_MMA
#undef PG_WAIT_V
#undef PG_WAIT_L
#undef PG_BAR
#undef PG_SCHED
#undef PG_ZERO
#undef PG_MKVA
#undef PG_STAGE_A
}

__device__ __forceinline__ float sigm(float x) { return __builtin_amdgcn_rcpf(1.0f + __builtin_amdgcn_exp2f(-LOG2E * x)); }
__device__ __forceinline__ float gelu_t(float x) { const float u = 1.5957691216057308f * (x + 0.044715f * x * x * x); return x * sigm(u); }
template <int KIND> __device__ __forceinline__ float act_k(float x) {
    if (KIND == 2) { const float t = x * (-2.3022082f + (-0.10294324f) * (x * x)); return x * __builtin_amdgcn_rcpf(1.0f + __builtin_amdgcn_exp2f(t)); }
    return __builtin_amdgcn_rcpf(1.0f + __builtin_amdgcn_exp2f(-LOG2E * x));
}
template <int KIND> __device__ __forceinline__ void store_act(const Acc& acc, bf16* base, int ldc) {
#pragma unroll
    for (int ai = 0; ai < 2; ++ai)
#pragma unroll
        for (int m = 0; m < 4; ++m) { bf16* rowp = base + (size_t)(ai * HALF + m * 16) * ldc;
#pragma unroll
            for (int bj = 0; bj < 2; ++bj) { const f32x4 v0 = acc[ai][bj][m][0], v1 = acc[ai][bj][m][1];
                u32x4 w; w.x = cvt_pk_bf16(act_k<KIND>(v0[0]), act_k<KIND>(v0[1])); w.y = cvt_pk_bf16(act_k<KIND>(v0[2]), act_k<KIND>(v0[3]));
                w.z = cvt_pk_bf16(act_k<KIND>(v1[0]), act_k<KIND>(v1[1])); w.w = cvt_pk_bf16(act_k<KIND>(v1[2]), act_k<KIND>(v1[3]));
                *(u32x4*)(rowp + bj * HALF) = w; }
            asm volatile("" ::: "memory"); }
}
__device__ __forceinline__ void store_plain(const Acc& acc, bf16* base, int ldc) {
#pragma unroll
    for (int ai = 0; ai < 2; ++ai)
#pragma unroll
        for (int m = 0; m < 4; ++m) { bf16* rowp = base + (size_t)(ai * HALF + m * 16) * ldc;
#pragma unroll
            for (int bj = 0; bj < 2; ++bj) { const f32x4 v0 = acc[ai][bj][m][0], v1 = acc[ai][bj][m][1];
                u32x4 w; w.x = cvt_pk_bf16(v0[0], v0[1]); w.y = cvt_pk_bf16(v0[2], v0[3]); w.z = cvt_pk_bf16(v1[0], v1[1]); w.w = cvt_pk_bf16(v1[2], v1[3]);
                *(u32x4*)(rowp + bj * HALF) = w; } }
}
struct EpiInproj {
    bf16* ZZ;
    __device__ __forceinline__ bool keep(const Unit&) const { return false; }
    __device__ __forceinline__ void prefetch(const Unit&, int, int, int) const {}
    __device__ __forceinline__ void operator()(const Acc& acc, const Unit& u, int ui, int wr, int wc, int fr, int fq) const {
        bf16* base = ZZ + (size_t)(u.arow + wr * 64 + fr) * INC + u.brow + wc * 32 + 8 * fq;
        const int n0 = u.brow;
        if (n0 < ZU) store_plain(acc, base, INC); else if (n0 < ZGA) store_act<2>(acc, base, INC); else store_act<3>(acc, base, INC);
    }
};
struct EpiPlain {
    bf16* O; int ldc;
    __device__ __forceinline__ bool keep(const Unit&) const { return false; }
    __device__ __forceinline__ void prefetch(const Unit&, int, int, int) const {}
    __device__ __forceinline__ void operator()(const Acc& acc, const Unit& u, int ui, int wr, int wc, int fr, int fq) const {
        store_plain(acc, O + (size_t)(u.arow + wr * 64 + fr) * ldc + u.brow + wc * 32 + 8 * fq, ldc);
    }
};
struct EpiMerge {
    const bf16* ZZ; bf16* O;
    __device__ __forceinline__ bool keep(const Unit& u) const { return u.x2 == 0; }
    __device__ __forceinline__ void prefetch(const Unit&, int, int, int) const {}
    __device__ __forceinline__ void operator()(Acc& acc, const Unit& u, int ui, int wr, int wc, int fr, int fq) const {
        const int row0 = u.arow + wr * 64 + fr, col0 = u.brow + wc * 32 + 8 * fq;
#pragma unroll
        for (int ai = 0; ai < 2; ++ai)
#pragma unroll
            for (int m = 0; m < 4; ++m) { const size_t row = row0 + ai * HALF + m * 16;
#pragma unroll
                for (int bj = 0; bj < 2; ++bj) { const int col = col0 + bj * HALF;
                    float gb[8]; unpack8(*(const u32x4*)(ZZ + row * INC + ZGB + col), gb);
#pragma unroll
                    for (int q = 0; q < 8; ++q) gb[q] = fmaxf(gb[q], 1e-30f);
                    if (u.x2 == 0) { float ga[8]; unpack8(*(const u32x4*)(ZZ + row * INC + ZGA + col), ga);
#pragma unroll
                        for (int q = 0; q < 8; ++q) acc[ai][bj][m][q >> 2][q & 3] *= ga[q] * __builtin_amdgcn_rcpf(gb[q]); }
                    else { const f32x4 v0 = acc[ai][bj][m][0], v1 = acc[ai][bj][m][1];
                        u32x4 w; w.x = cvt_pk_bf16(v0[0] * gb[0], v0[1] * gb[1]); w.y = cvt_pk_bf16(v0[2] * gb[2], v0[3] * gb[3]); w.z = cvt_pk_bf16(v1[0] * gb[4], v1[1] * gb[5]); w.w = cvt_pk_bf16(v1[2] * gb[6], v1[3] * gb[7]);
                        *(u32x4*)(O + row * D + col) = w; } }
                asm volatile("" ::: "memory"); }
    }
};
struct EpiOut {
    const float* x; bf16* O;
    __device__ __forceinline__ bool keep(const Unit&) const { return false; }
    __device__ __forceinline__ void prefetch(const Unit&, int, int, int) const {}
    __device__ __forceinline__ void operator()(const Acc& acc, const Unit& u, int ui, int wr, int wc, int fr, int fq) const {
        const int row0 = u.arow + wr * 64 + fr, col0 = u.brow + wc * 32 + 8 * fq;
#pragma unroll
        for (int ai = 0; ai < 2; ++ai)
#pragma unroll
            for (int m = 0; m < 4; ++m) { const size_t row = row0 + ai * HALF + m * 16;
#pragma unroll
                for (int bj = 0; bj < 2; ++bj) { const int col = col0 + bj * HALF;
                    const f32x4 x0 = *(const f32x4*)(x + row * D + col), x1 = *(const f32x4*)(x + row * D + col + 4);
                    const f32x4 v0 = acc[ai][bj][m][0] + x0, v1 = acc[ai][bj][m][1] + x1;
                    u32x4 w; w.x = cvt_pk_bf16(v0[0], v0[1]); w.y = cvt_pk_bf16(v0[2], v0[3]); w.z = cvt_pk_bf16(v1[0], v1[1]); w.w = cvt_pk_bf16(v1[2], v1[3]);
                    *(u32x4*)(O + row * D + col) = w; }
                asm volatile("" ::: "memory"); }
    }
};
struct EpiPle {
    const bf16* H2; const bf16* PROJ; const float* RSTD2; bf16* O;
    __device__ __forceinline__ bool keep(const Unit&) const { return false; }
    __device__ __forceinline__ void prefetch(const Unit&, int, int, int) const {}
    __device__ __forceinline__ void operator()(const Acc& acc, const Unit& u, int ui, int wr, int wc, int fr, int fq) const {
        const int row0 = u.arow + wr * 64 + fr, col0 = u.brow + wc * 32 + 8 * fq;
#pragma unroll
        for (int ai = 0; ai < 2; ++ai)
#pragma unroll
            for (int m = 0; m < 4; ++m) { const size_t row = row0 + ai * HALF + m * 16; const float rs = RSTD2[row];
#pragma unroll
                for (int bj = 0; bj < 2; ++bj) { const int col = col0 + bj * HALF;
                    float h[8], pj[8]; unpack8(*(const u32x4*)(H2 + row * D + col), h); unpack8(*(const u32x4*)(PROJ + row * D + col), pj);
                    float o[8];
#pragma unroll
                    for (int q = 0; q < 8; ++q) o[q] = h[q] + sigm(rs * acc[ai][bj][m][q >> 2][q & 3]) * pj[q];
                    u32x4 w; w.x = cvt_pk_bf16(o[0], o[1]); w.y = cvt_pk_bf16(o[2], o[3]); w.z = cvt_pk_bf16(o[4], o[5]); w.w = cvt_pk_bf16(o[6], o[7]);
                    *(u32x4*)(O + row * D + col) = w; }
                asm volatile("" ::: "memory"); }
    }
};
}

__device__ __forceinline__ void p1_fast(const Frame& F) {
    { pg::DenseOrder<0> S; S.init(T, INC, F.G, (int)blockIdx.x); pg::EpiInproj E{F.ZZ}; pg::DenseMap AM{D};
      pg::gemm_run<pg::EpiInproj, pg::DenseOrder<0>, pg::DenseMap, true>(F.lds + STAGE_OFF, F.ABF, F.WIN, D, D / 64, S, E, AM); }
    { pg::DenseOrder<0> S; S.init(T, D, F.G, (int)blockIdx.x); pg::EpiPlain E{F.PROJ, D}; pg::DenseMap AM{PLE};
      pg::gemm_run<pg::EpiPlain, pg::DenseOrder<0>, pg::DenseMap, true>(F.lds + STAGE_OFF, F.PBF, F.WPP, PLE, PLE / 64, S, E, AM); }
}
__device__ __forceinline__ void p3_fast(const Frame& F) {
    pg::DenseOrder<1> S; S.init(T, D, F.G, (int)blockIdx.x, 512); pg::EpiMerge E{F.ZZ, F.MERGED}; pg::DenseMap AM{D};
    pg::gemm_run<pg::EpiMerge, pg::DenseOrder<1>, pg::DenseMap, true>(F.lds + STAGE_OFF, F.OAB, F.WAB, D, 512 / 64, S, E, AM);
}
__device__ __forceinline__ void p4_fast(const Frame& F) {
    pg::DenseOrder<0> S; S.init(T, D, F.G, (int)blockIdx.x); pg::EpiOut E{F.x, F.H1}; pg::DenseMap AM{D};
    pg::gemm_run<pg::EpiOut, pg::DenseOrder<0>, pg::DenseMap, true>(F.lds + STAGE_OFF, F.MERGED, F.WOUT, D, D / 64, S, E, AM);
}
__device__ __forceinline__ void p9_fast(const Frame& F) {
    pg::DenseOrder<0> S; S.init(T, D, F.G, (int)blockIdx.x); pg::EpiPle E{F.H2, F.PROJ, F.RSTD2, F.H3}; pg::DenseMap AM{D};
    pg::gemm_run<pg::EpiPle, pg::DenseOrder<0>, pg::DenseMap, true>(F.lds + STAGE_OFF, F.H2, F.WPG, D, D / 64, S, E, AM);
}


namespace pg {
template <int MT, int NT, int NROWS_B>
struct MoeOrder {
    LAS const int* cnt; LAS const int* toff; int c;
    __device__ __forceinline__ bool next(int i, Unit& u) const {
        const int x = c & 7, cl = c >> 3, sb = i * 8 + x, mtg = MT * sb + cl / NT, pn = cl % NT;
        if (mtg >= __builtin_amdgcn_readfirstlane(toff[NE])) return false;
        int e = 0; while (toff[e + 1] <= mtg) ++e;
        e = __builtin_amdgcn_readfirstlane(e);
        const int valid = __builtin_amdgcn_readfirstlane(cnt[e] - 256 * (mtg - toff[e]));
        u.arow = 256 * mtg; u.brow = e * NROWS_B + 256 * pn; u.kofs = 0; u.x0 = e; u.x1 = valid; u.x2 = i; return true;
    }
};
struct GatherMap { static constexpr bool GATHER = true; LAS const unsigned* tab;
    __device__ __forceinline__ unsigned rowoff(const Unit& u, int r) const { return tab[u.x2 * 256 + r]; }
    __device__ __forceinline__ size_t base(const Unit&) const { return 0; } };
struct EpiSwiglu {
    bf16* HID; const float* b1; LAS unsigned char* lds;
    __device__ __forceinline__ bool keep(const Unit&) const { return false; }
    __device__ __forceinline__ void prefetch(const Unit& u, int ui, int wid, int lane) const {
        if (wid == 0) dma16(b1 + u.x0 * 2048 + ((u.brow & 2047) >> 8) * 256, (unsigned)lane * 16u, (unsigned)(uintptr_t)lds + BIAS_OFF + (ui & 1) * 1024); }
    __device__ __forceinline__ void operator()(const Acc& acc, const Unit& u, int ui, int wr, int wc, int fr, int fq) const {
        const int e = u.x0, valid = u.x1, pn = (u.brow & 2047) >> 8, hid0 = 128 * pn + 32 * wc + 8 * fq;
        const LAS f32x4* bp = (const LAS f32x4*)(lds + BIAS_OFF + (ui & 1) * 1024 + (32 * wc + 8 * fq) * 8);
        const f32x4 f0 = bp[0], f1 = bp[1], f2 = bp[2], f3 = bp[3];
        const float bg[8] = {f0[0], f0[2], f1[0], f1[2], f2[0], f2[2], f3[0], f3[2]}, bl[8] = {f0[1], f0[3], f1[1], f1[3], f2[1], f2[3], f3[1], f3[3]};
#pragma unroll
        for (int ai = 0; ai < 2; ++ai)
#pragma unroll
            for (int m = 0; m < 4; ++m) { const int rl = ai * HALF + wr * 64 + m * 16 + fr;
                float o[8];
#pragma unroll
                for (int q = 0; q < 8; ++q) { float g = acc[ai][0][m][q >> 2][q & 3] * (FP8_1 ? SC_INV : 1.0f) + bg[q], l = acc[ai][1][m][q >> 2][q & 3] * (FP8_1 ? SC_INV : 1.0f) + bl[q];
                    g = fminf(g, 7.f); l = fminf(fmaxf(l, -7.f), 7.f); o[q] = g * sigm(1.702f * g) * (l + 1.f); }
                if (FP8_2) { u32x2 w; w.x = pk4_fp8(o[0] * SC_ACT, o[1] * SC_ACT, o[2] * SC_ACT, o[3] * SC_ACT); w.y = pk4_fp8(o[4] * SC_ACT, o[5] * SC_ACT, o[6] * SC_ACT, o[7] * SC_ACT);
                    *(u32x2*)((unsigned char*)HID + (size_t)(u.arow + rl) * DE + hid0) = w; }
                else { u32x4 w; w.x = cvt_pk_bf16(o[0], o[1]); w.y = cvt_pk_bf16(o[2], o[3]); w.z = cvt_pk_bf16(o[4], o[5]); w.w = cvt_pk_bf16(o[6], o[7]);
                    *(u32x4*)(HID + (size_t)(u.arow + rl) * DE + hid0) = w; } }
    }
};
struct EpiBias2 {
    bf16* YS; const float* b2; LAS unsigned char* lds;
    __device__ __forceinline__ bool keep(const Unit&) const { return false; }
    __device__ __forceinline__ void prefetch(const Unit& u, int ui, int wid, int lane) const {
        if (wid == 0) dma16(b2 + u.x0 * D + (u.brow & 1023), (unsigned)lane * 16u, (unsigned)(uintptr_t)lds + BIAS_OFF + (ui & 1) * 1024); }
    __device__ __forceinline__ void operator()(const Acc& acc, const Unit& u, int ui, int wr, int wc, int fr, int fq) const {
        const int valid = u.x1, col0 = (u.brow & 1023) + 32 * wc + 8 * fq;
        f32x4 bb[2][2];
#pragma unroll
        for (int bj = 0; bj < 2; ++bj)
#pragma unroll
            for (int n = 0; n < 2; ++n) bb[bj][n] = *(const LAS f32x4*)(lds + BIAS_OFF + (ui & 1) * 1024 + (32 * wc + 8 * fq + bj * HALF + 4 * n) * 4);
#pragma unroll
        for (int ai = 0; ai < 2; ++ai)
#pragma unroll
            for (int m = 0; m < 4; ++m) { const int rl = ai * HALF + wr * 64 + m * 16 + fr;
#pragma unroll
                for (int bj = 0; bj < 2; ++bj) { const f32x4 v0 = acc[ai][bj][m][0] * (FP8_2 ? SC_INV : 1.0f) + bb[bj][0], v1 = acc[ai][bj][m][1] * (FP8_2 ? SC_INV : 1.0f) + bb[bj][1];
                    u32x4 w; w.x = cvt_pk_bf16(v0[0], v0[1]); w.y = cvt_pk_bf16(v0[2], v0[3]); w.z = cvt_pk_bf16(v1[0], v1[1]); w.w = cvt_pk_bf16(v1[2], v1[3]);
                    *(u32x4*)(YS + (size_t)(u.arow + rl) * D + col0 + bj * HALF) = w; } }
    }
};
}
__device__ __forceinline__ void p6_fast(const Frame& F) {
    const MoeTab M = moe_tables(F);
    pg::MoeOrder<4, 8, 2048> S{M.cnt, M.toff, (int)blockIdx.x};
    LAS unsigned* tab = (LAS unsigned*)(F.lds + TAB_OFF);
    { pg::Unit u;
      for (int i = 0; i < 18 && S.next(i, u); ++i) { const int e = u.x0, cnt = M.cnt[e], rk0 = cnt - u.x1;
          if (F.tid < 256) { const int rk = rk0 + F.tid; tab[i * 256 + F.tid] = (unsigned)F.TOKLIST[e * LCAP + (rk < cnt ? rk : cnt - 1)] * (unsigned)(FP8_1 ? D : D * 2); } } }
    __syncthreads();
    pg::EpiSwiglu E{F.HID, F.b1, F.lds}; pg::GatherMap AM{tab};
    if (FP8_1) pg::gemm_run<pg::EpiSwiglu, pg::MoeOrder<4, 8, 2048>, pg::GatherMap, true, 1>(F.lds + STAGE_OFF, F.ABF, F.W1T, D / 2, D / 128, S, E, AM);
    else pg::gemm_run<pg::EpiSwiglu, pg::MoeOrder<4, 8, 2048>, pg::GatherMap, true, 0>(F.lds + STAGE_OFF, F.ABF, F.W1T, D, D / 64, S, E, AM);
}
__device__ __forceinline__ void p7_fast(const Frame& F) {
    const MoeTab M = moe_tables(F);
    pg::MoeOrder<8, 4, 1024> S{M.cnt, M.toff, (int)blockIdx.x};
    pg::EpiBias2 E{F.YS, F.b2, F.lds}; pg::DenseMap AM{FP8_2 ? DE / 2 : DE};
    if (FP8_2) pg::gemm_run<pg::EpiBias2, pg::MoeOrder<8, 4, 1024>, pg::DenseMap, true, 1>(F.lds + STAGE_OFF, F.HID, F.W2T, DE / 2, DE / 128, S, E, AM);
    else pg::gemm_run<pg::EpiBias2, pg::MoeOrder<8, 4, 1024>, pg::DenseMap, true, 0>(F.lds + STAGE_OFF, F.HID, F.W2T, DE, DE / 64, S, E, AM);
}


typedef short s16x4 __attribute__((ext_vector_type(4)));
__device__ __forceinline__ s16x4 vtr(LAS const unsigned char* p) { return __builtin_bit_cast(s16x4, __builtin_amdgcn_ds_read_tr16_b64_v4i16((LAS s16x4*)p)); }
__device__ __forceinline__ bf16x8 cat8(s16x4 a, s16x4 b) { return (bf16x8){a[0], a[1], a[2], a[3], b[0], b[1], b[2], b[3]}; }
template <bool EARLY>
__device__ __forceinline__ void p2_attn_fast(const Frame& F) {
    const int lane = F.lane, r32 = lane & 31, hi = lane >> 5;
    LAS unsigned char* vl = F.lds + F.wave * 16640;
    LAS const unsigned char* vrd = vl + (4 * hi + ((lane & 15) >> 2)) * 64 + ((lane >> 4) & 1) * 32 + (lane & 3) * 8;
    const int gw = blockIdx.x * NWAVES + F.wave, NGW = F.G * NWAVES;
    for (int item = gw; item < BATCH * NH * (SEQ / 32); item += NGW) {
        const int qi = item >> 6, bh = item & 63, b = bh >> 3, h = bh & 7;
        const size_t rowbase = (size_t)b * SEQ;
        bf16x8 qf[4];
        { const bf16* qp = F.ZZ + (rowbase + 32 * qi + r32) * INC + ZQ + h * HD + 8 * hi;
#pragma unroll
          for (int d0 = 0; d0 < 4; ++d0) qf[d0] = *(const bf16x8*)(qp + 16 * d0); }
        f32x16 o[2]; o[0] = f32x16{}; o[1] = f32x16{};
        float carry = 1.0f;
        bf16x8 kn[4]; u32x4 vn[4];
#define ATT_LOAD(j) do { const bf16* kp = F.ZZ + (rowbase + 32 * (j) + r32) * INC + ZK + h * HD + 8 * hi; \
            _Pragma("unroll") for (int d0 = 0; d0 < 4; ++d0) kn[d0] = *(const bf16x8*)(kp + 16 * d0); \
            _Pragma("unroll") for (int i = 0; i < 4; ++i) { const int L = i * 64 + lane; \
                vn[i] = *(const u32x4*)(F.ZZ + (rowbase + 32 * (j) + ((L >> 2) & 31)) * INC + ZV + h * HD + (L >> 7) * 32 + (L & 3) * 8); } } while (0)
        ATT_LOAD(qi);
        for (int j = qi; j >= 0; --j) {
            bf16x8 kf[4];
#pragma unroll
            for (int d0 = 0; d0 < 4; ++d0) kf[d0] = kn[d0];
#pragma unroll
            for (int i = 0; i < 4; ++i) *(LAS u32x4*)(vl + (i * 64 + lane) * 16) = vn[i];
            if (j > 0) ATT_LOAD(j - 1);
            f32x16 p = f32x16{};
#pragma unroll
            for (int d0 = 0; d0 < 4; ++d0) p = __builtin_amdgcn_mfma_f32_32x32x16_bf16(kf[d0], qf[d0], p, 0, 0, 0);
            float e[16], sfx[16];
#pragma unroll
            for (int r = 0; r < 16; ++r) { const float z = fminf(p[r], 100.f); e[r] = __builtin_amdgcn_exp2f(z); sfx[r] = __builtin_amdgcn_rcpf(1.0f + e[r]); }
            if (j == qi) {
#pragma unroll
                for (int r = 0; r < 16; ++r) { const bool ok = crow(r, hi) < r32; e[r] = ok ? e[r] : 0.f; sfx[r] = ok ? sfx[r] : 1.f; }
            }
            float TL[4], TH[4];
#pragma unroll
            for (int g = 0; g < 4; ++g) {
                sfx[4 * g + 2] *= sfx[4 * g + 3]; sfx[4 * g + 1] *= sfx[4 * g + 2]; sfx[4 * g] *= sfx[4 * g + 1];
                const auto rr = __builtin_amdgcn_permlane32_swap(__float_as_uint(sfx[4 * g]), __float_as_uint(sfx[4 * g]), false, false);
                TL[g] = __uint_as_float(rr[0]); TH[g] = __uint_as_float(rr[1]); }
            float R[8];
            R[7] = carry; R[6] = R[7] * TH[3]; R[5] = R[6] * TL[3]; R[4] = R[5] * TH[2]; R[3] = R[4] * TL[2]; R[2] = R[3] * TH[1]; R[1] = R[2] * TL[1]; R[0] = R[1] * TH[0]; carry = R[0] * TL[0];
            unsigned pw[8];
#pragma unroll
            for (int g = 0; g < 4; ++g) { const float off = hi ? R[2 * g + 1] : R[2 * g];
                const float w0 = e[4 * g] * (off * sfx[4 * g]), w1 = e[4 * g + 1] * (off * sfx[4 * g + 1]), w2 = e[4 * g + 2] * (off * sfx[4 * g + 2]), w3 = e[4 * g + 3] * (off * sfx[4 * g + 3]);
                pw[2 * g] = pg::cvt_pk_bf16(w0, w1); pw[2 * g + 1] = pg::cvt_pk_bf16(w2, w3); }
            const bf16x8 pa0 = __builtin_bit_cast(bf16x8, (u32x4){pw[0], pw[1], pw[2], pw[3]}), pa1 = __builtin_bit_cast(bf16x8, (u32x4){pw[4], pw[5], pw[6], pw[7]});
            asm volatile("s_waitcnt lgkmcnt(0)" ::: "memory");
#pragma unroll
            for (int d0 = 0; d0 < 2; ++d0) {
                const s16x4 a0 = vtr(vrd + d0 * 2048), a1 = vtr(vrd + d0 * 2048 + 512), b0 = vtr(vrd + d0 * 2048 + 1024), b1 = vtr(vrd + d0 * 2048 + 1536);
                o[d0] = __builtin_amdgcn_mfma_f32_32x32x16_bf16(pa0, cat8(a0, a1), o[d0], 0, 0, 0);
                o[d0] = __builtin_amdgcn_mfma_f32_32x32x16_bf16(pa1, cat8(b0, b1), o[d0], 0, 0, 0);
            }
            asm volatile("s_waitcnt lgkmcnt(0)" ::: "memory");
            if (EARLY && __all(carry == 0.f)) break;
        }
#undef ATT_LOAD
        bf16* op = F.OAB + (rowbase + 32 * qi) * D + h * HD + r32;
#pragma unroll
        for (int d0 = 0; d0 < 2; ++d0)
#pragma unroll
            for (int r = 0; r < 16; ++r) op[(size_t)crow(r, hi) * D + 32 * d0] = (bf16)f2bf(o[d0][r]);
    }
}
__device__ __forceinline__ void p2_sgu_fast(const Frame& F) {
    const int lane = F.lane, r32 = lane & 31, hi = lane >> 5, g = F.wave;
    for (int unit = blockIdx.x; unit < T / 128; unit += F.G) {
        const int row0 = unit * 128;
        __syncthreads();
        for (int i = 0; i < 16; ++i) {
            const int rl = g * 16 + i;
            const u32x4 w = *(const u32x4*)(F.ZZ + (size_t)(row0 + rl) * INC + ZVS + 8 * lane);
            float f[8]; unpack8(w, f);
            float s = 0.f;
#pragma unroll
            for (int j = 0; j < 8; ++j) s += f[j];
            const float mean = wave_sum(s) * (1.f / 512.f);
            float s2 = 0.f;
#pragma unroll
            for (int j = 0; j < 8; ++j) { f[j] -= mean; s2 += f[j] * f[j]; }
            const float rstd = rsqrtf(wave_sum(s2) * (1.f / 512.f) + EPS);
            const f32x4 g0 = *(const f32x4*)(F.sgu_norm + 8 * lane), g1 = *(const f32x4*)(F.sgu_norm + 8 * lane + 4);
            u32x4 o; o.x = pk2(f[0] * rstd * g0.x, f[1] * rstd * g0.y); o.y = pk2(f[2] * rstd * g0.z, f[3] * rstd * g0.w);
            o.z = pk2(f[4] * rstd * g1.x, f[5] * rstd * g1.y); o.w = pk2(f[6] * rstd * g1.z, f[7] * rstd * g1.w);
            *(LAS u32x4*)(F.lds + (lane >> 2) * 8192 + rl * 64 + (lane & 3) * 16) = o;
        }
        __syncthreads();
        LAS const unsigned char* vrd = F.lds + (2 * g) * 8192 + (8 * hi + ((lane & 15) >> 2)) * 64 + ((lane >> 4) & 1) * 32 + (lane & 3) * 8;
        for (int mt = 0; mt < 4; ++mt) {
            f32x16 acc[2]; acc[0] = f32x16{}; acc[1] = f32x16{};
            const bf16* ap = F.SGUW + ((size_t)g * 128 + 32 * mt + r32) * 128 + 8 * hi;
            const int nks = (mt < 2) ? 4 : 8;
            for (int ks = 0; ks < nks; ++ks) {
                const bf16x8 a = *(const bf16x8*)(ap + 16 * ks);
#pragma unroll
                for (int nt = 0; nt < 2; ++nt) {
                    const s16x4 b0 = vtr(vrd + nt * 8192 + ks * 1024), b1 = vtr(vrd + nt * 8192 + ks * 1024 + 256);
                    acc[nt] = __builtin_amdgcn_mfma_f32_32x32x16_bf16(a, cat8(b0, b1), acc[nt], 0, 0, 0);
                }
            }
#pragma unroll
            for (int r = 0; r < 16; ++r) { const int tl = 32 * mt + crow(r, hi); const float bs = F.sgu_b[g * 128 + tl];
#pragma unroll
                for (int nt = 0; nt < 2; ++nt) { const int ch = 64 * g + 32 * nt + r32;
                    const float u = bf2f(F.ZZ[(size_t)(row0 + tl) * INC + ZU + ch]);
                    F.OAB[(size_t)(row0 + tl) * D + 512 + ch] = (bf16)f2bf(u * (acc[nt][r] + bs)); } }
        }
    }
    __syncthreads();
}


__device__ __forceinline__ void p5_fast(const Frame& F) {
    LAS unsigned* hist = (LAS unsigned*)F.lds;
    LAS unsigned* base = hist + 32;
    LAS unsigned* lsel = hist + 64;
    LAS float* lgate = (LAS float*)(hist + 64 + 512);
    LAS float* rsv = lgate + 512;
    LAS float* part = (LAS float*)(F.lds + 8192);
    const int lane = F.lane, r32 = lane & 31, hi = lane >> 5, wg4 = F.wave & 3, kh = F.wave >> 2;
    for (int chunk = blockIdx.x; chunk < T / 128; chunk += F.G) {
        if (F.tid < 32) hist[F.tid] = 0u;
        const int t0 = chunk * 128 + wg4 * 32;
        const bf16* hp = F.H1 + (size_t)(t0 + r32) * D + kh * 512 + 8 * hi;
        const bf16* whp = F.WRHI + r32 * D + kh * 512 + 8 * hi;
        const bf16* wlp = F.WRLO + r32 * D + kh * 512 + 8 * hi;
        f32x16 acc = f32x16{}; float ss = 0.f;
#pragma unroll 4
        for (int k0 = 0; k0 < 512; k0 += 16) {
            const u32x4 hb = *(const u32x4*)(hp + k0);
            const bf16x8 ah = *(const bf16x8*)(whp + k0), al = *(const bf16x8*)(wlp + k0);
            const bf16x8 bb = __builtin_bit_cast(bf16x8, hb);
            acc = __builtin_amdgcn_mfma_f32_32x32x16_bf16(ah, bb, acc, 0, 0, 0);
            acc = __builtin_amdgcn_mfma_f32_32x32x16_bf16(al, bb, acc, 0, 0, 0);
#pragma unroll
            for (int q = 0; q < 4; ++q) { const float lo = __uint_as_float(hb[q] << 16), hh = __uint_as_float(hb[q] & 0xffff0000u); ss += lo * lo + hh * hh; }
        }
        { const auto rr = __builtin_amdgcn_permlane32_swap(__float_as_uint(ss), __float_as_uint(ss), false, false); ss = __uint_as_float(rr[0]) + __uint_as_float(rr[1]); }
        if (kh == 1) {
#pragma unroll
            for (int r = 0; r < 16; ++r) part[(wg4 * 17 + r) * 64 + lane] = acc[r];
            part[(wg4 * 17 + 16) * 64 + lane] = ss;
        }
        __syncthreads();
        if (kh == 0) {
            ss += part[(wg4 * 17 + 16) * 64 + lane];
            const float rstd = rsqrtf(ss * (1.f / D) + EPS);
            float v[16];
#pragma unroll
            for (int r = 0; r < 16; ++r) v[r] = rstd * (acc[r] + part[(wg4 * 17 + r) * 64 + lane]) + F.b_router[crow(r, hi)];
            float cv[8]; int ce[8];
#pragma unroll
            for (int k = 0; k < 4; ++k) {
                float m = v[0];
#pragma unroll
                for (int r = 1; r < 16; ++r) m = fmaxf(m, v[r]);
                int idx = 15;
#pragma unroll
                for (int r = 14; r >= 0; --r) idx = (v[r] == m) ? r : idx;
                cv[k] = m; ce[k] = (idx & 3) + 8 * (idx >> 2) + 4 * hi;
#pragma unroll
                for (int r = 0; r < 16; ++r) v[r] = (r == idx) ? -INFINITY : v[r];
            }
#pragma unroll
            for (int k = 0; k < 4; ++k) {
                const auto rv = __builtin_amdgcn_permlane32_swap(__float_as_uint(cv[k]), __float_as_uint(cv[k]), false, false);
                const auto re = __builtin_amdgcn_permlane32_swap((unsigned)ce[k], (unsigned)ce[k], false, false);
                cv[4 + k] = __uint_as_float(hi ? rv[0] : rv[1]); ce[4 + k] = (int)(hi ? re[0] : re[1]);
            }
            float tv[4]; int te[4];
#pragma unroll
            for (int k = 0; k < 4; ++k) {
                float bv = cv[0]; int be = ce[0];
#pragma unroll
                for (int c = 1; c < 8; ++c) { const bool better = (cv[c] > bv) || (cv[c] == bv && ce[c] < be); bv = better ? cv[c] : bv; be = better ? ce[c] : be; }
                tv[k] = bv; te[k] = be;
#pragma unroll
                for (int c = 0; c < 8; ++c) cv[c] = (ce[c] == be) ? -INFINITY : cv[c];
            }
            float ex[4], sum = 0.f;
#pragma unroll
            for (int k = 0; k < 4; ++k) { ex[k] = __expf(tv[k] - tv[0]); sum += ex[k]; }
            if (hi == 0) { const int tl = wg4 * 32 + r32; rsv[tl] = rstd;
#pragma unroll
                for (int k = 0; k < 4; ++k) { const unsigned loc = atomicAdd((unsigned*)&hist[te[k]], 1u); lsel[tl * 4 + k] = (unsigned)te[k] | (loc << 8); lgate[tl * 4 + k] = ex[k] / sum; } }
        }
        __syncthreads();
        if (F.tid < 32) { const unsigned n = hist[F.tid]; base[F.tid] = n ? __hip_atomic_fetch_add(F.ctl + CW_CNT + 64 * F.tid, n, __ATOMIC_RELAXED, __HIP_MEMORY_SCOPE_AGENT) : 0u; }
        __syncthreads();
        { const int tl = F.tid >> 2, r = F.tid & 3, t = chunk * 128 + tl; const unsigned sl = lsel[tl * 4 + r]; const int ee = sl & 255; const unsigned rank = base[ee] + (sl >> 8);
          F.TOKLIST[ee * LCAP + rank] = t; F.SLOTREF[t * 4 + r] = (ee << 16) | rank; F.GATE[t * 4 + r] = lgate[tl * 4 + r]; }
        for (int i = 0; i < 16; ++i) {
            const int tl = F.wave * 16 + i, t = chunk * 128 + tl; const float rstd = rsv[tl];
            const u32x4* hr = (const u32x4*)(F.H1 + (size_t)t * D);
            if (FP8_1) {
                float f[8], g[8]; unpack8(hr[2 * lane], f); unpack8(hr[2 * lane + 1], g); const float sc = rstd * SC_ACT;
                u32x4 o; o.x = pk4_fp8(f[0] * sc, f[1] * sc, f[2] * sc, f[3] * sc); o.y = pk4_fp8(f[4] * sc, f[5] * sc, f[6] * sc, f[7] * sc);
                o.z = pk4_fp8(g[0] * sc, g[1] * sc, g[2] * sc, g[3] * sc); o.w = pk4_fp8(g[4] * sc, g[5] * sc, g[6] * sc, g[7] * sc);
                *(u32x4*)((unsigned char*)F.ABF + (size_t)t * D + 16 * lane) = o;
            } else { u32x4* cr = (u32x4*)(F.ABF + (size_t)t * D);
#pragma unroll
            for (int j = 0; j < 2; ++j) { float f[8]; unpack8(hr[lane + 64 * j], f); u32x4 o; o.x = pk2(f[0] * rstd, f[1] * rstd); o.y = pk2(f[2] * rstd, f[3] * rstd); o.z = pk2(f[4] * rstd, f[5] * rstd); o.w = pk2(f[6] * rstd, f[7] * rstd); cr[lane + 64 * j] = o; } }
        }
        __syncthreads();
    }
}

struct Args { const float* in[21]; float* out; unsigned char* ws; int ph_lo, ph_hi; };
__global__ void __launch_bounds__(NTHREADS, 2) fwd(Args args) {
    extern __shared__ __attribute__((aligned(16))) unsigned char lds[];
    Frame F;
    F.lds = (LAS unsigned char*)lds; F.MISC = (volatile LAS unsigned*)(F.lds + MISC_OFF);
    F.tid = threadIdx.x; F.lane = F.tid & 63; F.wave = __builtin_amdgcn_readfirstlane(F.tid >> 6); F.G = gridDim.x;
    unsigned char* ws = args.ws;
    F.ctl = (unsigned*)(ws + WS_CTL);
    F.x = args.in[0]; F.p = args.in[1]; F.g_mix = args.in[2]; F.w_in = args.in[3]; F.w_out_a = args.in[4]; F.w_out_b = args.in[5]; F.w_out = args.in[6];
    F.sgu_norm = args.in[7]; F.sgu_w = args.in[8]; F.sgu_b = args.in[9]; F.g_moe = args.in[10]; F.w_router = args.in[11]; F.b_router = args.in[12];
    F.w1 = args.in[13]; F.b1 = args.in[14]; F.w2 = args.in[15]; F.b2 = args.in[16]; F.g_ple = args.in[17]; F.w_ple_gate = args.in[18]; F.w_ple_proj = args.in[19]; F.g_final = args.in[20];
    F.out = args.out;
    F.WRHI = (bf16*)(ws + WS_WRHI); F.WRLO = (bf16*)(ws + WS_WRLO); F.SGUW = (bf16*)(ws + WS_SGUW); F.WIN = (bf16*)(ws + WS_WIN); F.WAB = (bf16*)(ws + WS_WAB);
    F.WOUT = (bf16*)(ws + WS_WOUT); F.WPG = (bf16*)(ws + WS_WPG); F.WPP = (bf16*)(ws + WS_WPP); F.W1T = (bf16*)(ws + WS_W1); F.W2T = (bf16*)(ws + WS_W2);
    F.PBF = (bf16*)(ws + WS_PBF); F.PROJ = (bf16*)(ws + WS_PROJ); F.H1 = (bf16*)(ws + WS_H1); F.ZZ = (bf16*)(ws + WS_ZZ); F.HID = (bf16*)(ws + WS_HID);
    F.H2 = (bf16*)(ws + WS_H2); F.H3 = (bf16*)(ws + WS_H3); F.ABF = (bf16*)(ws + WS_ABF); F.OAB = (bf16*)(ws + WS_OAB); F.MERGED = (bf16*)(ws + WS_MERGED); F.YS = (bf16*)(ws + WS_YS);
    F.RSTD1 = (float*)(ws + WS_RSTD1); F.RSTD2 = (float*)(ws + WS_RSTD2); F.GATE = (float*)(ws + WS_GATE);
    F.TOKLIST = (int*)(ws + WS_TOKLIST); F.SLOTREF = (int*)(ws + WS_SLOTREF);
    for (int u = F.tid; u < (LDS_BYTES - MISC_OFF) / 4; u += NTHREADS) ((LAS unsigned*)(F.lds + MISC_OFF))[u] = 0u;
    __syncthreads();
    XcdBarrier bar = xcd_barrier_post(F.ctl + CW_BAR, F.MISC + 8);
    const int lo = args.ph_lo, hi = args.ph_hi;
#define IN(k) (lo <= (k) && (k) < hi)
#define SEAM(k) do { if (IN(k) && IN((k) + 1)) xcd_barrier(bar); } while (0)
    if (IN(0)) { p0_prologue(F); } SEAM(0);
    if (IN(1)) { { if (OPT_P1) p1_fast(F); else p1_inproj(F); } } SEAM(1);
    if (IN(2)) {
        const bool sgu_first = (blockIdx.x & 1) != 0;
        if (sgu_first) { if (OPT_SGU) p2_sgu_fast(F); else p2_sgu_simple(F); }
        if (OPT_ATT) { if (F.wave & 1) { moe_weight_items(F); p2_attn_fast<ATT_EARLY>(F); } else { p2_attn_fast<ATT_EARLY>(F); moe_weight_items(F); } } else { moe_weight_items(F); __syncthreads(); p2_attn_scalar<false>(F); }
        if (!sgu_first) { __syncthreads(); if (OPT_SGU) p2_sgu_fast(F); else p2_sgu_simple(F); }
    } SEAM(2);
    if (IN(3)) { { if (OPT_P3) p3_fast(F); else p3_merge(F); } } SEAM(3);
    if (IN(4)) { { if (OPT_P4) p4_fast(F); else p4_out(F); } } SEAM(4);
    if (IN(5)) { if (OPT_P5) p5_fast(F); else p5_router(F); } SEAM(5);
    if (IN(6)) { { if (OPT_P6) p6_fast(F); else p6_moe1(F); } } SEAM(6);
    if (IN(7)) { { if (OPT_P7) p7_fast(F); else p7_moe2(F); } } SEAM(7);
    if (IN(8)) { p8_combine(F); } SEAM(8);
    if (IN(9)) { { if (OPT_P9) p9_fast(F); else p9_ple(F); } } SEAM(9);
    if (IN(10)) { p10_final(F); }
#undef IN
#undef SEAM
}

extern "C" void kernel_launch(void* const* d_in, const int* in_sizes, int n_in, void* d_out, int out_size, void* d_ws, size_t ws_size, hipStream_t stream) {
    static int grid = 0;
    if (grid == 0) {
        if (n_in != 21 || out_size != T * D || ws_size < WS_END) { fprintf(stderr, "kernel_launch: unexpected shapes (n_in %d out %d ws %zu)\n", n_in, out_size, ws_size); grid = -1; return; }
        int dev = 0, cus = 0;
        if (hipGetDevice(&dev) != hipSuccess || hipDeviceGetAttribute(&cus, hipDeviceAttributeMultiprocessorCount, dev) != hipSuccess) { grid = -1; return; }
        if (hipFuncSetAttribute((const void*)fwd, hipFuncAttributeMaxDynamicSharedMemorySize, LDS_BYTES) != hipSuccess) { fprintf(stderr, "kernel_launch: hipFuncSetAttribute failed\n"); grid = -1; return; }
        int per_cu = 0;
        if (hipOccupancyMaxActiveBlocksPerMultiprocessor(&per_cu, (const void*)fwd, NTHREADS, LDS_BYTES) != hipSuccess || per_cu < 1) fprintf(stderr, "kernel_launch: occupancy query says %d\n", per_cu);
        (void)hipGetLastError();
        if (cus < 256) { fprintf(stderr, "kernel_launch: needs >= 256 CUs, found %d\n", cus); grid = -1; return; }
        grid = 256;
    }
    if (grid < 0) return;
    (void)hipMemsetAsync((char*)d_ws + WS_CTL, 0, CTL_ZERO_BYTES, stream);
    Args a{};
    for (int i = 0; i < 21; ++i) a.in[i] = (const float*)d_in[i];
    a.out = (float*)d_out; a.ws = (unsigned char*)d_ws; a.ph_lo = 0; a.ph_hi = 11;
    hipLaunchKernelGGL(fwd, dim3(grid), dim3(NTHREADS), LDS_BYTES, stream, a);
}
```

```cpp
#include <hip/hip_runtime.h>
#include <cstdio>
#include <cstdint>

#define GAS __attribute__((address_space(1)))
#define LAS __attribute__((address_space(3)))
typedef unsigned short bf16;
typedef short bf16x8 __attribute__((ext_vector_type(8)));
typedef float f32x4 __attribute__((ext_vector_type(4)));
typedef float f32x16 __attribute__((ext_vector_type(16)));
typedef unsigned u32x4 __attribute__((ext_vector_type(4)));
typedef unsigned u32x2 __attribute__((ext_vector_type(2)));

#ifndef OPT_P1
#define OPT_P1 1
#endif
#ifndef OPT_P3
#define OPT_P3 1
#endif
#ifndef OPT_P4
#define OPT_P4 1
#endif
#ifndef OPT_P6
#define OPT_P6 1
#endif
#ifndef OPT_P7
#define OPT_P7 1
#endif
#ifndef OPT_ATT
#define OPT_ATT 1
#endif
#ifndef OPT_SGU
#define OPT_SGU 1
#endif
#ifndef ATT_EARLY
#define ATT_EARLY true
#endif
#ifndef OPT_P5
#define OPT_P5 1
#endif
#ifndef MOE_FP8_1
#define MOE_FP8_1 1
#endif
#ifndef MOE_FP8_2
#define MOE_FP8_2 1
#endif
#ifndef OPT_P9
#define OPT_P9 1
#endif
constexpr int BATCH = 8, SEQ = 4096, T = BATCH * SEQ, D = 1024, PLE = 256, NH = 8, HD = 64, NE = 32, DE = 1024, INC = 4608;
constexpr int ZQ = 0, ZK = 512, ZV = 1024, ZU = 1536, ZVS = 2048, ZGA = 2560, ZGB = 3584;
constexpr float EPS = 1e-6f;
constexpr float LOG2E = 1.4426950408889634f;
constexpr float QSCALE = 0.125f * LOG2E;
constexpr int LCAP = 32768;
constexpr int HROWS = 139264;

constexpr size_t MiB = 1u << 20;
constexpr size_t WS_CTL = 0, CTL_ZERO_BYTES = 1 * MiB;
constexpr size_t WS_WRHI = 1 * MiB, WS_WRLO = WS_WRHI + 65536, WS_SGUW = WS_WRLO + 65536;
constexpr size_t WS_RSTD1 = WS_SGUW + 262144, WS_RSTD2 = WS_RSTD1 + 131072;
constexpr size_t WS_WIN = 2 * MiB, WS_WAB = 11 * MiB, WS_WOUT = 13 * MiB, WS_WPG = 15 * MiB, WS_WPP = 17 * MiB;
constexpr size_t WS_TOKLIST = 18 * MiB, WS_SLOTREF = 22 * MiB, WS_GATE = WS_SLOTREF + 524288;
constexpr size_t WS_W1 = 28 * MiB, WS_W2 = 156 * MiB, WS_PBF = 220 * MiB, WS_PROJ = 236 * MiB, WS_H1 = 300 * MiB;
constexpr size_t WS_R1 = 364 * MiB;
constexpr size_t WS_ZZ = WS_R1, WS_HID = WS_R1, WS_H2 = WS_R1, WS_H3 = WS_R1 + 64 * MiB;
constexpr size_t WS_R2 = 652 * MiB;
constexpr size_t WS_ABF = WS_R2, WS_OAB = WS_R2 + 64 * MiB, WS_MERGED = WS_R2 + 128 * MiB, WS_YS = WS_R2;
constexpr size_t WS_END = 924 * MiB;
constexpr int CW_BAR = 4096, CW_CNT = 8192;

constexpr int STAGE_OFF = 0, TAB_OFF = 131072, BIAS_OFF = 149504, MISC_OFF = 151552;
constexpr int LDS_BYTES = 152576;
constexpr int NWAVES = 8, NTHREADS = 512;

#define LDS_WAIT() asm volatile("s_waitcnt lgkmcnt(0)" ::: "memory")
__device__ __forceinline__ float bf2f(unsigned v) { return __uint_as_float(v << 16); }
__device__ __forceinline__ unsigned f2bf(float f) { unsigned u = __float_as_uint(f); return (u + 0x7fffu + ((u >> 16) & 1u)) >> 16; }
__device__ __forceinline__ unsigned pk2(float lo, float hi) { return f2bf(lo) | (f2bf(hi) << 16); }
__device__ __forceinline__ float wave_sum(float v) {
#pragma unroll
    for (int o = 1; o < 64; o <<= 1) v += __shfl_xor(v, o);
    return v;
}
__device__ __forceinline__ float wave_max(float v) {
#pragma unroll
    for (int o = 1; o < 64; o <<= 1) v = fmaxf(v, __shfl_xor(v, o));
    return v;
}
__device__ __forceinline__ float sigmoidf_(float x) { return 1.0f / (1.0f + __expf(-x)); }
__device__ __forceinline__ float gelu_tanh(float x) {
    const float u = 1.5957691216057308f * (x + 0.044715f * x * x * x);
    return x * sigmoidf_(u);
}
__device__ __forceinline__ int crow(int r, int hi) { return (r & 3) + 8 * (r >> 2) + 4 * hi; }
__device__ __forceinline__ void unpack8(const u32x4 w, float (&f)[8]) {
    f[0] = bf2f(w.x & 0xffffu); f[1] = bf2f(w.x >> 16); f[2] = bf2f(w.y & 0xffffu); f[3] = bf2f(w.y >> 16);
    f[4] = bf2f(w.z & 0xffffu); f[5] = bf2f(w.z >> 16); f[6] = bf2f(w.w & 0xffffu); f[7] = bf2f(w.w >> 16);
}

constexpr bool FP8_1 = MOE_FP8_1 && OPT_P5 && OPT_P6 && OPT_P7, FP8_2 = MOE_FP8_2 && OPT_P5 && OPT_P6 && OPT_P7;
constexpr float SC_ACT = 4.0f, SC_W = 64.0f, SC_INV = 1.0f / (SC_ACT * SC_W);
#ifndef YS_FP8
#define YS_FP8 1
#endif
constexpr bool YS8 = YS_FP8 && OPT_P7; constexpr float SC_Y = 16.0f;
typedef float f32x2v __attribute__((ext_vector_type(2)));
__device__ __forceinline__ void unpack4_fp8(unsigned w, float (&f)[4]) { const f32x2v lo = __builtin_amdgcn_cvt_pk_f32_fp8(w, false), hi = __builtin_amdgcn_cvt_pk_f32_fp8(w, true); f[0] = lo[0]; f[1] = lo[1]; f[2] = hi[0]; f[3] = hi[1]; }
__device__ __forceinline__ float clamp448(float v) { return fminf(fmaxf(v, -448.f), 448.f); }
__device__ __forceinline__ unsigned pk4_fp8(float a, float b, float c, float d) {
    unsigned w = __builtin_amdgcn_cvt_pk_fp8_f32(clamp448(a), clamp448(b), 0, false); return __builtin_amdgcn_cvt_pk_fp8_f32(clamp448(c), clamp448(d), w, true); }
#define XB_TMO      128
#define XB_XCNT(j)  (256  + 64 * (j))
#define XB_XSUB(j)  (1280 + 64 * (j))
#define XB_XGEN(j)  (2304 + 64 * (j))
#define XB_TOP      3328
#define XB_TOPGEN   3392
#define XCD_BAR_WORDS 3456
#define XB_SPIN_CAP (1u << 23)
__device__ __forceinline__ unsigned xb_ld(unsigned* p)              { return __hip_atomic_load(p, __ATOMIC_RELAXED, __HIP_MEMORY_SCOPE_AGENT); }
__device__ __forceinline__ unsigned xb_add(unsigned* p, unsigned v) { return __hip_atomic_fetch_add(p, v, __ATOMIC_RELAXED, __HIP_MEMORY_SCOPE_AGENT); }
__device__ __forceinline__ unsigned xb_xcc_id() { return (unsigned)__builtin_amdgcn_s_getreg((3 << 11) | 20) & 0xFu; }
#define XB_SPIN(cond, bar) do { unsigned _sp = 0; while (cond) { __builtin_amdgcn_s_sleep(1); \
    if ((++_sp & 255u) == 0u) { if (xb_ld(&(bar)[XB_TMO])) break; if (_sp > XB_SPIN_CAP) { atomicAdd(&(bar)[XB_TMO], 1u); break; } } } } while (0)
struct XcdBarrier { unsigned* bar; unsigned x; volatile LAS unsigned* st; };
__device__ __forceinline__ XcdBarrier xcd_barrier_post(unsigned* bar, volatile LAS unsigned* st) {
    XcdBarrier b; b.bar = bar; b.x = xb_xcc_id(); b.st = st;
    if (threadIdx.x == 0) (void)xb_add(&bar[XB_XCNT(b.x)], 1u);
    return b;
}
__device__ __forceinline__ void xcd_barrier_complete(unsigned* bar, unsigned x, unsigned& nloc, unsigned& nx) {
    const unsigned G = gridDim.x * gridDim.y * gridDim.z;
    unsigned sum, cnt, mine, sp = 0u;
    for (;;) {
        sum = 0u; cnt = 0u; mine = 0u;
#pragma unroll
        for (unsigned j = 0; j < 16; ++j) { const unsigned c = xb_ld(&bar[XB_XCNT(j)]); sum += c; cnt += (c > 0u) ? 1u : 0u; mine = (j == x) ? c : mine; }
        if (sum == G) break;
        __builtin_amdgcn_s_sleep(1);
        if ((++sp & 255u) == 0u) { if (xb_ld(&bar[XB_TMO])) break; if (sp > XB_SPIN_CAP) { atomicAdd(&bar[XB_TMO], 1u); break; } }
    }
    nloc = mine > 0u ? mine : 1u; nx = cnt > 0u ? cnt : 1u;
}
__device__ __forceinline__ void xcd_barrier(const XcdBarrier& b) {
    asm volatile("s_waitcnt vmcnt(0)" ::: "memory");
    __syncthreads();
    if (threadIdx.x == 0) {
        unsigned* bar = b.bar;
        __builtin_amdgcn_s_waitcnt(0);
        unsigned nloc = b.st[0], nx = b.st[1];
        if (nloc == 0u) { xcd_barrier_complete(bar, b.x, nloc, nx); b.st[0] = nloc; b.st[1] = nx; }
        const unsigned old = xb_add(&bar[XB_XSUB(b.x)], 1u);
        const unsigned gen = old / nloc;
        if (old + 1u == (gen + 1u) * nloc) {
            __builtin_amdgcn_fence(__ATOMIC_RELEASE, "agent");
            asm volatile("s_waitcnt vmcnt(0)" ::: "memory");
            const unsigned og = xb_add(&bar[XB_TOP], 1u);
            const unsigned tg = og / nx;
            if (og + 1u == (tg + 1u) * nx) xb_add(&bar[XB_TOPGEN], 1u);
            else XB_SPIN(xb_ld(&bar[XB_TOPGEN]) == tg, bar);
            __builtin_amdgcn_fence(__ATOMIC_ACQUIRE, "agent");
            xb_add(&bar[XB_XGEN(b.x)], 1u);
            asm volatile("s_waitcnt vmcnt(0)" ::: "memory");
        } else {
            XB_SPIN(xb_ld(&bar[XB_XGEN(b.x)]) == gen, bar);
            __builtin_amdgcn_fence(__ATOMIC_ACQUIRE, "agent");
            asm volatile("s_waitcnt vmcnt(0)" ::: "memory");
        }
    }
    __syncthreads();
}

struct Frame {
    LAS unsigned char* lds;
    volatile LAS unsigned* MISC;
    unsigned* ctl;
    int tid, lane, wave, G;
    const float *x, *p, *g_mix, *w_in, *w_out_a, *w_out_b, *w_out, *sgu_norm, *sgu_w, *sgu_b, *g_moe, *w_router, *b_router, *w1, *b1, *w2, *b2, *g_ple, *w_ple_gate, *w_ple_proj, *g_final;
    float* out;
    bf16 *WRHI, *WRLO, *SGUW, *WIN, *WAB, *WOUT, *WPG, *WPP, *W1T, *W2T, *PBF, *PROJ, *H1, *ZZ, *HID, *H2, *H3, *ABF, *OAB, *MERGED, *YS;
    float *RSTD1, *RSTD2, *GATE;
    int *TOKLIST, *SLOTREF;
};

template <int NB>
__device__ __forceinline__ void smma(const bf16* ap, const bf16* const (&bp)[NB], int K, f32x16 (&acc)[NB]) {
    for (int k0 = 0; k0 < K; k0 += 16) {
        const bf16x8 a = *(const bf16x8*)(ap + k0);
#pragma unroll
        for (int nb = 0; nb < NB; ++nb) { const bf16x8 b = *(const bf16x8*)(bp[nb] + k0); acc[nb] = __builtin_amdgcn_mfma_f32_32x32x16_bf16(a, b, acc[nb], 0, 0, 0); }
    }
}

struct RowId { __device__ __forceinline__ int operator()(int n) const { return n; } };
struct RowW1 { __device__ __forceinline__ int operator()(int n) const { const int hid = n >> 1; return 256 * (hid >> 7) + (hid & 127) + 128 * (n & 1); } };
template <class RM>
__device__ __forceinline__ void tr_item(const float* W, int N, const float* gk, bf16* WT, int ldt, int koff, RM rm, LAS float* scr, int kb, int nb, int lane, float sc = 1.0f) {
    const int k0 = kb * 64, n0 = nb * 64;
    f32x4 v[16];
#pragma unroll
    for (int i = 0; i < 16; ++i) v[i] = __builtin_nontemporal_load((const f32x4*)(W + (size_t)(k0 + 4 * i + (lane >> 4)) * N + n0 + (lane & 15) * 4));
#pragma unroll
    for (int i = 0; i < 16; ++i) {
        const int kk = 4 * i + (lane >> 4), n4 = (lane & 15) * 4;
        f32x4 x = v[i] * sc;
        if (gk) x = x * gk[k0 + kk];
        LAS float* s = scr + kk * 65 + n4;
        s[0] = x.x; s[1] = x.y; s[2] = x.z; s[3] = x.w;
    }
    LDS_WAIT(); asm volatile("" ::: "memory");
    const int c = lane & 7;
#pragma unroll
    for (int j = 0; j < 8; ++j) {
        const int n = (lane >> 3) + 8 * j;
        const LAS float* s = scr + (8 * c) * 65 + n;
        u32x4 o; o.x = pk2(s[0 * 65], s[1 * 65]); o.y = pk2(s[2 * 65], s[3 * 65]); o.z = pk2(s[4 * 65], s[5 * 65]); o.w = pk2(s[6 * 65], s[7 * 65]);
        *(u32x4*)(WT + (size_t)rm(n0 + n) * ldt + koff + k0 + 8 * c) = o;
    }
    LDS_WAIT(); asm volatile("" ::: "memory");
}
template <class RM>
__device__ __forceinline__ void tr_item8(const float* W, int N, const float* gk, unsigned char* WT8, int ldt, RM rm, LAS float* scr, int kb, int nb, int lane, float sc) {
    const int k0 = kb * 64, n0 = nb * 64;
    f32x4 v[16];
#pragma unroll
    for (int i = 0; i < 16; ++i) v[i] = __builtin_nontemporal_load((const f32x4*)(W + (size_t)(k0 + 4 * i + (lane >> 4)) * N + n0 + (lane & 15) * 4));
#pragma unroll
    for (int i = 0; i < 16; ++i) {
        const int kk = 4 * i + (lane >> 4), n4 = (lane & 15) * 4;
        f32x4 x = v[i] * sc;
        if (gk) x = x * gk[k0 + kk];
        LAS float* sp = scr + kk * 65 + n4;
        sp[0] = x.x; sp[1] = x.y; sp[2] = x.z; sp[3] = x.w;
    }
    LDS_WAIT(); asm volatile("" ::: "memory");
    const int c4 = lane & 3;
#pragma unroll
    for (int j = 0; j < 4; ++j) {
        const int n = (lane >> 2) + 16 * j;
        const LAS float* sp = scr + (16 * c4) * 65 + n;
        u32x4 o; o.x = pk4_fp8(sp[0 * 65], sp[1 * 65], sp[2 * 65], sp[3 * 65]); o.y = pk4_fp8(sp[4 * 65], sp[5 * 65], sp[6 * 65], sp[7 * 65]);
        o.z = pk4_fp8(sp[8 * 65], sp[9 * 65], sp[10 * 65], sp[11 * 65]); o.w = pk4_fp8(sp[12 * 65], sp[13 * 65], sp[14 * 65], sp[15 * 65]);
        *(u32x4*)(WT8 + (size_t)rm(n0 + n) * ldt + k0 + 16 * c4) = o;
    }
    LDS_WAIT(); asm volatile("" ::: "memory");
}
__device__ __forceinline__ void p0_prologue(const Frame& F) {
    LAS float* scr = (LAS float*)(F.lds + F.wave * 16640);
    const int gw = blockIdx.x * NWAVES + F.wave, NGW = F.G * NWAVES;
    constexpr int I_IN = 16 * 72, I_A = 8 * 16, I_B = 8 * 16, I_O = 16 * 16, I_PG = 16 * 16, I_PP = 4 * 16, I_W1 = NE * 16 * 32, I_W2 = NE * 16 * 16;
    constexpr int NITEMS = I_IN + I_A + I_B + I_O + I_PG + I_PP;
    for (int it = gw; it < NITEMS; it += NGW) {
        int r = it;
        if (r < I_IN) { tr_item(F.w_in, INC, nullptr, F.WIN, D, 0, RowId(), scr, r / 72, r % 72, F.lane, (r % 72) < 8 ? QSCALE : 1.0f); continue; } r -= I_IN;
        if (r < I_A) { tr_item(F.w_out_a, D, nullptr, F.WAB, D, 0, RowId(), scr, r / 16, r % 16, F.lane); continue; } r -= I_A;
        if (r < I_B) { tr_item(F.w_out_b, D, nullptr, F.WAB, D, 512, RowId(), scr, r / 16, r % 16, F.lane); continue; } r -= I_B;
        if (r < I_O) { tr_item(F.w_out, D, nullptr, F.WOUT, D, 0, RowId(), scr, r / 16, r % 16, F.lane); continue; } r -= I_O;
        if (r < I_PG) { tr_item(F.w_ple_gate, D, F.g_ple, F.WPG, D, 0, RowId(), scr, r / 16, r % 16, F.lane); continue; } r -= I_PG;
        { tr_item(F.w_ple_proj, D, nullptr, F.WPP, PLE, 0, RowId(), scr, r / 16, r % 16, F.lane); }
    }
    (void)I_W1; (void)I_W2;
    for (int m0 = 2 * gw; m0 < T; m0 += 2 * NGW) {
        f32x4 v[2][4];
#pragma unroll
        for (int u = 0; u < 2; ++u) { const f32x4* xr = (const f32x4*)(F.x + (size_t)(m0 + u) * D) + F.lane;
#pragma unroll
            for (int j = 0; j < 4; ++j) v[u][j] = __builtin_nontemporal_load(xr + 64 * j); }
#pragma unroll
        for (int u = 0; u < 2; ++u) { float s = 0.f;
#pragma unroll
            for (int j = 0; j < 4; ++j) s += (v[u][j].x * v[u][j].x + v[u][j].y * v[u][j].y) + (v[u][j].z * v[u][j].z + v[u][j].w * v[u][j].w);
            const float rstd = rsqrtf(wave_sum(s) * (1.f / D) + EPS);
            unsigned long long* o8 = (unsigned long long*)(F.ABF + (size_t)(m0 + u) * D) + F.lane;
#pragma unroll
            for (int j = 0; j < 4; ++j) { const f32x4 g = ((const f32x4*)F.g_mix)[F.lane + 64 * j];
                o8[64 * j] = (unsigned long long)pk2(v[u][j].x * rstd * g.x, v[u][j].y * rstd * g.y) | ((unsigned long long)pk2(v[u][j].z * rstd * g.z, v[u][j].w * rstd * g.w) << 32); } }
    }
    for (int m0 = 4 * gw; m0 < T; m0 += 4 * NGW) {
        f32x4 v[4];
#pragma unroll
        for (int u = 0; u < 4; ++u) v[u] = __builtin_nontemporal_load((const f32x4*)(F.p + (size_t)(m0 + u) * PLE) + F.lane);
#pragma unroll
        for (int u = 0; u < 4; ++u) ((unsigned long long*)(F.PBF + (size_t)(m0 + u) * PLE))[F.lane] = (unsigned long long)pk2(v[u].x, v[u].y) | ((unsigned long long)pk2(v[u].z, v[u].w) << 32);
    }
    const int gt = blockIdx.x * NTHREADS + F.tid, NGT = F.G * NTHREADS;
    for (int i = gt; i < NE * D; i += NGT) { const int e = i / D, k = i % D; const float v = F.w_router[k * NE + e] * F.g_moe[k]; const unsigned h = f2bf(v); F.WRHI[i] = (bf16)h; F.WRLO[i] = (bf16)f2bf(v - bf2f(h)); }
    for (int i = gt; i < 8 * 128 * 128; i += NGT) { const int t = (i >> 7) & 127, s = i & 127; F.SGUW[i] = (bf16)(((s >> 6) <= (t >> 6)) ? f2bf(F.sgu_w[i]) : 0u); }
}

struct TrItem { const float* W; const float* gk; unsigned char* out; int N, ldt, kb, nb, w1; };
__device__ __forceinline__ TrItem moe_item(const Frame& F, int r) {
    constexpr int I_W1 = NE * 16 * 32;
    TrItem t;
    if (r < I_W1) { const int e = r / 512, q = r % 512; t.W = F.w1 + (size_t)e * D * 2 * DE; t.gk = F.g_moe; t.N = 2 * DE; t.kb = q / 32; t.nb = q % 32; t.w1 = 1;
        t.out = (unsigned char*)F.W1T + (size_t)e * 2 * DE * D * (FP8_1 ? 1 : 2); t.ldt = D * (FP8_1 ? 1 : 2); }
    else { r -= I_W1; const int e = r / 256, q = r % 256; t.W = F.w2 + (size_t)e * DE * D; t.gk = nullptr; t.N = D; t.kb = q / 16; t.nb = q % 16; t.w1 = 0;
        t.out = (unsigned char*)F.W2T + (size_t)e * D * DE * (FP8_2 ? 1 : 2); t.ldt = DE * (FP8_2 ? 1 : 2); }
    return t;
}
__device__ __forceinline__ void tr_load(f32x4 (&v)[16], const TrItem& t, int lane) {
#pragma unroll
    for (int i = 0; i < 16; ++i) v[i] = __builtin_nontemporal_load((const f32x4*)(t.W + (size_t)(t.kb * 64 + 4 * i + (lane >> 4)) * t.N + t.nb * 64 + (lane & 15) * 4));
}
__device__ __forceinline__ void tr_finish(const f32x4 (&v)[16], const TrItem& t, LAS float* scr, int lane) {
    const int k0 = t.kb * 64, n0 = t.nb * 64; const bool f8 = t.w1 ? FP8_1 : FP8_2; const float sc = f8 ? SC_W : 1.0f;
#pragma unroll
    for (int i = 0; i < 16; ++i) {
        const int kk = 4 * i + (lane >> 4), n4 = (lane & 15) * 4;
        f32x4 x = v[i] * sc;
        if (t.gk) x = x * t.gk[k0 + kk];
        LAS float* sp = scr + kk * 65 + n4;
        sp[0] = x.x; sp[1] = x.y; sp[2] = x.z; sp[3] = x.w;
    }
    LDS_WAIT(); asm volatile("" ::: "memory");
    if (f8) { const int c4 = lane & 3;
#pragma unroll
        for (int j = 0; j < 4; ++j) { const int n = (lane >> 2) + 16 * j, nn = n0 + n, row = t.w1 ? RowW1()(nn) : nn;
            const LAS float* sp = scr + (16 * c4) * 65 + n;
            u32x4 o; o.x = pk4_fp8(sp[0 * 65], sp[1 * 65], sp[2 * 65], sp[3 * 65]); o.y = pk4_fp8(sp[4 * 65], sp[5 * 65], sp[6 * 65], sp[7 * 65]);
            o.z = pk4_fp8(sp[8 * 65], sp[9 * 65], sp[10 * 65], sp[11 * 65]); o.w = pk4_fp8(sp[12 * 65], sp[13 * 65], sp[14 * 65], sp[15 * 65]);
            *(u32x4*)(t.out + (size_t)row * t.ldt + k0 + 16 * c4) = o; } }
    else { const int c = lane & 7;
#pragma unroll
        for (int j = 0; j < 8; ++j) { const int n = (lane >> 3) + 8 * j, nn = n0 + n, row = t.w1 ? RowW1()(nn) : nn;
            const LAS float* sp = scr + (8 * c) * 65 + n;
            u32x4 o; o.x = pk2(sp[0 * 65], sp[1 * 65]); o.y = pk2(sp[2 * 65], sp[3 * 65]); o.z = pk2(sp[4 * 65], sp[5 * 65]); o.w = pk2(sp[6 * 65], sp[7 * 65]);
            *(u32x4*)(t.out + (size_t)row * t.ldt + (k0 + 8 * c) * 2) = o; } }
    LDS_WAIT(); asm volatile("" ::: "memory");
}
__device__ __forceinline__ void moe_weight_items(const Frame& F) {
    LAS float* scr = (LAS float*)(F.lds + F.wave * 16640);
    const int gw = blockIdx.x * NWAVES + F.wave, NGW = F.G * NWAVES;
    constexpr int NIT = NE * 16 * 32 + NE * 16 * 16;
    f32x4 va[16], vb[16];
    int it = gw;
    if (it >= NIT) return;
    TrItem ta = moe_item(F, it), tb = ta;
    tr_load(va, ta, F.lane);
    for (;;) {
        const bool hb = it + NGW < NIT;
        if (hb) { tb = moe_item(F, it + NGW); tr_load(vb, tb, F.lane); }
        tr_finish(va, ta, scr, F.lane);
        if (!hb) break;
        const bool ha = it + 2 * NGW < NIT;
        if (ha) { ta = moe_item(F, it + 2 * NGW); tr_load(va, ta, F.lane); }
        tr_finish(vb, tb, scr, F.lane);
        if (!ha) break;
        it += 2 * NGW;
    }
}
__device__ __forceinline__ void p1_inproj(const Frame& F) {
    const int gw = blockIdx.x * NWAVES + F.wave, NGW = F.G * NWAVES, r32 = F.lane & 31, hi = F.lane >> 5;
    for (int tile = gw; tile < (T / 32) * (INC / 128); tile += NGW) {
        const int mb = tile / (INC / 128), cg = tile % (INC / 128), m0 = mb * 32, n0 = cg * 128;
        const bf16* ap = F.ABF + (size_t)(m0 + r32) * D + 8 * hi;
        const bf16* bp[4];
#pragma unroll
        for (int nb = 0; nb < 4; ++nb) bp[nb] = F.WIN + (size_t)(n0 + 32 * nb + r32) * D + 8 * hi;
        f32x16 acc[4];
#pragma unroll
        for (int nb = 0; nb < 4; ++nb) acc[nb] = f32x16{};
        smma<4>(ap, bp, D, acc);
        const int kind = (n0 < ZK) ? 0 : (n0 < ZU) ? 1 : (n0 < ZGA) ? 2 : 3;
#pragma unroll
        for (int nb = 0; nb < 4; ++nb)
#pragma unroll
            for (int r = 0; r < 16; ++r) {
                float v = acc[nb][r];
                if (kind == 2) v = gelu_tanh(v); else if (kind == 3) v = sigmoidf_(v);
                F.ZZ[(size_t)(m0 + crow(r, hi)) * INC + n0 + 32 * nb + r32] = (bf16)f2bf(v);
            }
    }
    for (int tile = gw; tile < (T / 32) * (D / 128); tile += NGW) {
        const int mb = tile / (D / 128), cg = tile % (D / 128), m0 = mb * 32, n0 = cg * 128;
        const bf16* ap = F.PBF + (size_t)(m0 + r32) * PLE + 8 * hi;
        const bf16* bp[4];
#pragma unroll
        for (int nb = 0; nb < 4; ++nb) bp[nb] = F.WPP + (size_t)(n0 + 32 * nb + r32) * PLE + 8 * hi;
        f32x16 acc[4];
#pragma unroll
        for (int nb = 0; nb < 4; ++nb) acc[nb] = f32x16{};
        smma<4>(ap, bp, PLE, acc);
#pragma unroll
        for (int nb = 0; nb < 4; ++nb)
#pragma unroll
            for (int r = 0; r < 16; ++r) F.PROJ[(size_t)(m0 + crow(r, hi)) * D + n0 + 32 * nb + r32] = (bf16)f2bf(acc[nb][r]);
    }
}

template <bool EARLY>
__device__ __forceinline__ void p2_attn_scalar(const Frame& F) {
    LAS u32x4* Kt = (LAS u32x4*)F.lds;
    LAS u32x4* Vt = Kt + 512;
    for (int pr = blockIdx.x; pr < 256; pr += F.G) {
        for (int half = 0; half < 2; ++half) {
            const int bh = pr >> 2, tb = half == 0 ? (pr & 3) : 7 - (pr & 3), b = bh / NH, h = bh % NH;
            const int t = tb * 512 + F.tid;
            const size_t row = (size_t)b * SEQ + t;
            float q[64], o[64];
            { const u32x4* qp = (const u32x4*)(F.ZZ + row * INC + ZQ + h * HD);
#pragma unroll
              for (int c = 0; c < 8; ++c) { float f[8]; unpack8(qp[c], f);
#pragma unroll
                  for (int j = 0; j < 8; ++j) q[8 * c + j] = f[j]; } }
#pragma unroll
            for (int d = 0; d < 64; ++d) o[d] = 0.f;
            float carry = 1.f;
            for (int kt = tb * 8 + 7; kt >= 0; --kt) {
                __syncthreads();
                { const int kr = F.tid >> 3, c = F.tid & 7; const size_t krow = ((size_t)b * SEQ + kt * 64 + kr) * INC + h * HD + 8 * c;
                  Kt[F.tid] = *(const u32x4*)(F.ZZ + krow + ZK); Vt[F.tid] = *(const u32x4*)(F.ZZ + krow + ZV); }
                __syncthreads();
                for (int sl = 63; sl >= 0; --sl) {
                    const int s = kt * 64 + sl;
                    if (s < t) {
                        float z = 0.f;
#pragma unroll
                        for (int c = 0; c < 8; ++c) { float f[8]; unpack8(Kt[sl * 8 + c], f);
#pragma unroll
                            for (int j = 0; j < 8; ++j) z += q[8 * c + j] * f[j]; }
                        z = fminf(z, 100.f);
                        const float e = exp2f(z), r = 1.0f / (1.0f + e);
                        carry *= r;
                        const float w = e * carry;
#pragma unroll
                        for (int c = 0; c < 8; ++c) { float f[8]; unpack8(Vt[sl * 8 + c], f);
#pragma unroll
                            for (int j = 0; j < 8; ++j) o[8 * c + j] += w * f[j]; }
                    }
                }
            }
            u32x4* op = (u32x4*)(F.OAB + row * D + h * HD);
#pragma unroll
            for (int c = 0; c < 8; ++c) { u32x4 w; w.x = pk2(o[8 * c], o[8 * c + 1]); w.y = pk2(o[8 * c + 2], o[8 * c + 3]); w.z = pk2(o[8 * c + 4], o[8 * c + 5]); w.w = pk2(o[8 * c + 6], o[8 * c + 7]); op[c] = w; }
        }
    }
    __syncthreads();
}
__device__ __forceinline__ void p2_sgu_simple(const Frame& F) {
    LAS bf16* vsn = (LAS bf16*)F.lds;
    for (int unit = blockIdx.x; unit < T / 128; unit += F.G) {
        const int row0 = unit * 128;
        for (int i = 0; i < 16; ++i) {
            const int rl = F.wave * 16 + i;
            const u32x4 w = *(const u32x4*)(F.ZZ + (size_t)(row0 + rl) * INC + ZVS + 8 * F.lane);
            float f[8]; unpack8(w, f);
            float s = 0.f;
#pragma unroll
            for (int j = 0; j < 8; ++j) s += f[j];
            const float mean = wave_sum(s) * (1.f / 512.f);
            float s2 = 0.f;
#pragma unroll
            for (int j = 0; j < 8; ++j) { f[j] -= mean; s2 += f[j] * f[j]; }
            const float rstd = rsqrtf(wave_sum(s2) * (1.f / 512.f) + EPS);
            const f32x4 g0 = *(const f32x4*)(F.sgu_norm + 8 * F.lane), g1 = *(const f32x4*)(F.sgu_norm + 8 * F.lane + 4);
            u32x4 o; o.x = pk2(f[0] * rstd * g0.x, f[1] * rstd * g0.y); o.y = pk2(f[2] * rstd * g0.z, f[3] * rstd * g0.w);
            o.z = pk2(f[4] * rstd * g1.x, f[5] * rstd * g1.y); o.w = pk2(f[6] * rstd * g1.z, f[7] * rstd * g1.w);
            *(LAS u32x4*)(vsn + rl * 512 + 8 * F.lane) = o;
        }
        __syncthreads();
        const int ch = F.tid, g = ch >> 6;
        for (int tl = 0; tl < 128; ++tl) {
            const bf16* wrow = F.SGUW + (g * 128 + tl) * 128;
            float a = 0.f;
            for (int s = 0; s < 128; ++s) a += bf2f(wrow[s]) * bf2f(vsn[s * 512 + ch]);
            const float sv = a + F.sgu_b[g * 128 + tl];
            const float u = bf2f(F.ZZ[(size_t)(row0 + tl) * INC + ZU + ch]);
            F.OAB[(size_t)(row0 + tl) * D + 512 + ch] = (bf16)f2bf(u * sv);
        }
        __syncthreads();
    }
}

__device__ __forceinline__ void p3_merge(const Frame& F) {
    const int gw = blockIdx.x * NWAVES + F.wave, NGW = F.G * NWAVES, r32 = F.lane & 31, hi = F.lane >> 5;
    for (int tile = gw; tile < (T / 32) * (D / 128); tile += NGW) {
        const int mb = tile / (D / 128), cg = tile % (D / 128), m0 = mb * 32, n0 = cg * 128;
        const bf16* ap = F.OAB + (size_t)(m0 + r32) * D + 8 * hi;
        const bf16* bp[4];
#pragma unroll
        for (int nb = 0; nb < 4; ++nb) bp[nb] = F.WAB + (size_t)(n0 + 32 * nb + r32) * D + 8 * hi;
        f32x16 acca[4], accb[4];
#pragma unroll
        for (int nb = 0; nb < 4; ++nb) { acca[nb] = f32x16{}; accb[nb] = f32x16{}; }
        smma<4>(ap, bp, 512, acca);
        const bf16* ap2 = ap + 512; const bf16* bp2[4];
#pragma unroll
        for (int nb = 0; nb < 4; ++nb) bp2[nb] = bp[nb] + 512;
        smma<4>(ap2, bp2, 512, accb);
#pragma unroll
        for (int nb = 0; nb < 4; ++nb)
#pragma unroll
            for (int r = 0; r < 16; ++r) {
                const size_t row = m0 + crow(r, hi); const int col = n0 + 32 * nb + r32;
                const float sga = bf2f(F.ZZ[row * INC + ZGA + col]), sgb = bf2f(F.ZZ[row * INC + ZGB + col]);
                F.MERGED[row * D + col] = (bf16)f2bf(sga * acca[nb][r] + sgb * accb[nb][r]);
            }
    }
}
__device__ __forceinline__ void p4_out(const Frame& F) {
    const int gw = blockIdx.x * NWAVES + F.wave, NGW = F.G * NWAVES, r32 = F.lane & 31, hi = F.lane >> 5;
    for (int tile = gw; tile < (T / 32) * (D / 128); tile += NGW) {
        const int mb = tile / (D / 128), cg = tile % (D / 128), m0 = mb * 32, n0 = cg * 128;
        const bf16* ap = F.MERGED + (size_t)(m0 + r32) * D + 8 * hi;
        const bf16* bp[4];
#pragma unroll
        for (int nb = 0; nb < 4; ++nb) bp[nb] = F.WOUT + (size_t)(n0 + 32 * nb + r32) * D + 8 * hi;
        f32x16 acc[4];
#pragma unroll
        for (int nb = 0; nb < 4; ++nb) acc[nb] = f32x16{};
        smma<4>(ap, bp, D, acc);
#pragma unroll
        for (int nb = 0; nb < 4; ++nb)
#pragma unroll
            for (int r = 0; r < 16; ++r) {
                const size_t row = m0 + crow(r, hi); const int col = n0 + 32 * nb + r32;
                F.H1[row * D + col] = (bf16)f2bf(F.x[row * D + col] + acc[nb][r]);
            }
    }
}
__device__ __forceinline__ void p5_router(const Frame& F) {
    LAS unsigned* hist = (LAS unsigned*)F.lds;
    LAS unsigned* base = hist + 32;
    LAS unsigned* lsel = hist + 64;
    LAS float* lgate = (LAS float*)(hist + 64 + 512);
    const int e = F.lane & 31, half = F.lane >> 5;
    for (int chunk = blockIdx.x; chunk < T / 128; chunk += F.G) {
        if (F.tid < 32) hist[F.tid] = 0u;
        __syncthreads();
        for (int i = 0; i < 16; ++i) {
            const int tl = F.wave * 16 + i, t = chunk * 128 + tl;
            const bf16* hp = F.H1 + (size_t)t * D + half * 512;
            const bf16* whi = F.WRHI + e * D + half * 512;
            const bf16* wlo = F.WRLO + e * D + half * 512;
            float dot = 0.f, ss = 0.f;
            for (int k = 0; k < 512; k += 8) {
                float hf[8], a[8], c[8];
                unpack8(*(const u32x4*)(hp + k), hf); unpack8(*(const u32x4*)(whi + k), a); unpack8(*(const u32x4*)(wlo + k), c);
#pragma unroll
                for (int j = 0; j < 8; ++j) { dot += hf[j] * (a[j] + c[j]); ss += hf[j] * hf[j]; }
            }
            dot += __shfl_xor(dot, 32); ss += __shfl_xor(ss, 32);
            const float rstd = rsqrtf(ss * (1.f / D) + EPS);
            float logit = rstd * dot + F.b_router[e];
            float val[4]; int sel[4];
#pragma unroll
            for (int r = 0; r < 4; ++r) {
                const float m = wave_max(logit);
                const unsigned long long bal = __ballot(logit == m);
                const int le = (int)(__ffsll((long long)bal) - 1) & 31;
                val[r] = m; sel[r] = le;
                if (e == le) logit = -INFINITY;
            }
            float ex[4], sum = 0.f;
#pragma unroll
            for (int r = 0; r < 4; ++r) { ex[r] = __expf(val[r] - val[0]); sum += ex[r]; }
            { const u32x4* hr = (const u32x4*)(F.H1 + (size_t)t * D); u32x4* cr = (u32x4*)(F.ABF + (size_t)t * D);
#pragma unroll
              for (int j = 0; j < 2; ++j) { float f[8]; unpack8(hr[F.lane + 64 * j], f); u32x4 o; o.x = pk2(f[0] * rstd, f[1] * rstd); o.y = pk2(f[2] * rstd, f[3] * rstd); o.z = pk2(f[4] * rstd, f[5] * rstd); o.w = pk2(f[6] * rstd, f[7] * rstd); cr[F.lane + 64 * j] = o; } }
            if (F.lane == 0) {
                F.RSTD1[t] = rstd;
#pragma unroll
                for (int r = 0; r < 4; ++r) { const unsigned loc = atomicAdd((unsigned*)&hist[sel[r]], 1u); lsel[tl * 4 + r] = (unsigned)sel[r] | (loc << 8); lgate[tl * 4 + r] = ex[r] / sum; }
            }
        }
        __syncthreads();
        if (F.tid < 32) { const unsigned n = hist[F.tid]; base[F.tid] = n ? __hip_atomic_fetch_add(F.ctl + CW_CNT + 64 * F.tid, n, __ATOMIC_RELAXED, __HIP_MEMORY_SCOPE_AGENT) : 0u; }
        __syncthreads();
        { const int tl = F.tid >> 2, r = F.tid & 3, t = chunk * 128 + tl; const unsigned s = lsel[tl * 4 + r]; const int ee = s & 255; const unsigned rank = base[ee] + (s >> 8);
          F.TOKLIST[ee * LCAP + rank] = t; F.SLOTREF[t * 4 + r] = (ee << 16) | rank; F.GATE[t * 4 + r] = lgate[tl * 4 + r]; }
        __syncthreads();
    }
}
struct MoeTab { LAS int* cnt; LAS int* toff; LAS int* p32; };
__device__ __forceinline__ MoeTab moe_tables(const Frame& F) {
    MoeTab M; M.cnt = (LAS int*)(F.lds + MISC_OFF + 128); M.toff = M.cnt + 32; M.p32 = M.toff + 33;
    __syncthreads();
    if (F.tid == 0) { int a = 0, c = 0;
        for (int e = 0; e < NE; ++e) { const int n = (int)__hip_atomic_load(F.ctl + CW_CNT + 64 * e, __ATOMIC_RELAXED, __HIP_MEMORY_SCOPE_AGENT); M.cnt[e] = n; M.toff[e] = a; M.p32[e] = c; a += (n + 255) >> 8; c += (n + 31) >> 5; }
        M.toff[NE] = a; M.p32[NE] = c; }
    __syncthreads();
    return M;
}
__device__ __forceinline__ void p6_moe1(const Frame& F) {
    const MoeTab M = moe_tables(F);
    const int gw = blockIdx.x * NWAVES + F.wave, NGW = F.G * NWAVES, r32 = F.lane & 31, hi = F.lane >> 5;
    const int ntiles = M.p32[NE] * 32;
    for (int tile = gw; tile < ntiles; tile += NGW) {
        const int blk = tile >> 5, hb = tile & 31;
        int e = 0; while (M.p32[e + 1] <= blk) ++e;
        const int sb = blk - M.p32[e], cnt = M.cnt[e];
        const int rank = sb * 32 + r32;
        const int tok = F.TOKLIST[e * LCAP + (rank < cnt ? rank : cnt - 1)];
        const bf16* ap = F.ABF + (size_t)tok * D + 8 * hi;
        const int hidb = hb * 32 + r32;
        const bf16* bp[2];
        bp[0] = F.W1T + ((size_t)e * 2048 + 256 * (hidb >> 7) + (hidb & 127)) * D + 8 * hi; bp[1] = bp[0] + 128 * D;
        f32x16 acc[2]; acc[0] = f32x16{}; acc[1] = f32x16{};
        smma<2>(ap, bp, D, acc);
        const float bg = F.b1[e * 2048 + 2 * hidb], bl = F.b1[e * 2048 + 2 * hidb + 1];
#pragma unroll
        for (int r = 0; r < 16; ++r) {
            const int rr = crow(r, hi), rk = sb * 32 + rr;
            float gl = acc[0][r] + bg, li = acc[1][r] + bl;
            gl = fminf(gl, 7.f); li = fminf(fmaxf(li, -7.f), 7.f);
            const float act = gl * sigmoidf_(1.702f * gl) * (li + 1.f);
            if (rk < cnt) F.HID[((size_t)256 * M.toff[e] + rk) * DE + hidb] = (bf16)f2bf(act);
        }
    }
}
__device__ __forceinline__ void p7_moe2(const Frame& F) {
    const MoeTab M = moe_tables(F);
    const int gw = blockIdx.x * NWAVES + F.wave, NGW = F.G * NWAVES, r32 = F.lane & 31, hi = F.lane >> 5;
    const int ntiles = M.p32[NE] * 8;
    for (int tile = gw; tile < ntiles; tile += NGW) {
        const int blk = tile >> 3, cg = tile & 7;
        int e = 0; while (M.p32[e + 1] <= blk) ++e;
        const int sb = blk - M.p32[e], cnt = M.cnt[e];
        const size_t rowb = (size_t)256 * M.toff[e] + sb * 32;
        const bf16* ap = F.HID + (rowb + r32) * DE + 8 * hi;
        const bf16* bp[4];
#pragma unroll
        for (int nb = 0; nb < 4; ++nb) bp[nb] = F.W2T + ((size_t)e * D + cg * 128 + 32 * nb + r32) * DE + 8 * hi;
        f32x16 acc[4];
#pragma unroll
        for (int nb = 0; nb < 4; ++nb) acc[nb] = f32x16{};
        smma<4>(ap, bp, DE, acc);
#pragma unroll
        for (int nb = 0; nb < 4; ++nb) { const int col = cg * 128 + 32 * nb + r32; const float bb = F.b2[e * D + col];
#pragma unroll
            for (int r = 0; r < 16; ++r) { const int rr = crow(r, hi); if (sb * 32 + rr < cnt) F.YS[(rowb + rr) * D + col] = (bf16)f2bf(acc[nb][r] + bb); } }
    }
}
__device__ __forceinline__ void p8_combine(const Frame& F) {
    const MoeTab M = moe_tables(F);
    const int gw = blockIdx.x * NWAVES + F.wave, NGW = F.G * NWAVES;
    if (YS8) {
        for (int t0 = 2 * gw; t0 < T; t0 += 2 * NGW) {
            size_t yrow[2][4]; float gk[2][4];
#pragma unroll
            for (int u = 0; u < 2; ++u)
#pragma unroll
                for (int k = 0; k < 4; ++k) { const int sr = F.SLOTREF[(t0 + u) * 4 + k]; yrow[u][k] = (size_t)256 * M.toff[sr >> 16] + (sr & 0xffff); gk[u][k] = F.GATE[(t0 + u) * 4 + k] * (1.0f / SC_Y); }
            u32x4 hv[2][2], yv[2][4];
#pragma unroll
            for (int u = 0; u < 2; ++u) { hv[u][0] = *(const u32x4*)(F.H1 + (size_t)(t0 + u) * D + 16 * F.lane); hv[u][1] = *(const u32x4*)(F.H1 + (size_t)(t0 + u) * D + 16 * F.lane + 8);
#pragma unroll
                for (int k = 0; k < 4; ++k) yv[u][k] = *(const u32x4*)((const unsigned char*)F.YS + yrow[u][k] * D + 16 * F.lane); }
#pragma unroll
            for (int u = 0; u < 2; ++u) {
                float a[16]; { float lo[8], hi8[8]; unpack8(hv[u][0], lo); unpack8(hv[u][1], hi8);
#pragma unroll
                    for (int q = 0; q < 8; ++q) { a[q] = lo[q]; a[8 + q] = hi8[q]; } }
#pragma unroll
                for (int k = 0; k < 4; ++k)
#pragma unroll
                    for (int d = 0; d < 4; ++d) { float y[4]; unpack4_fp8(yv[u][k][d], y);
#pragma unroll
                        for (int q = 0; q < 4; ++q) a[4 * d + q] += gk[u][k] * y[q]; }
                u32x4 o0, o1; o0.x = pk2(a[0], a[1]); o0.y = pk2(a[2], a[3]); o0.z = pk2(a[4], a[5]); o0.w = pk2(a[6], a[7]); o1.x = pk2(a[8], a[9]); o1.y = pk2(a[10], a[11]); o1.z = pk2(a[12], a[13]); o1.w = pk2(a[14], a[15]);
                *(u32x4*)(F.H2 + (size_t)(t0 + u) * D + 16 * F.lane) = o0; *(u32x4*)(F.H2 + (size_t)(t0 + u) * D + 16 * F.lane + 8) = o1;
                float b[8], c[8]; unpack8(o0, b); unpack8(o1, c); float ss = 0.f;
#pragma unroll
                for (int q = 0; q < 8; ++q) ss += b[q] * b[q] + c[q] * c[q];
                ss = wave_sum(ss);
                if (F.lane == 0) F.RSTD2[t0 + u] = rsqrtf(ss * (1.f / D) + EPS);
            }
        }
        return;
    }
    for (int t0 = 2 * gw; t0 < T; t0 += 2 * NGW) {
        size_t yrow[2][4]; float gk[2][4];
#pragma unroll
        for (int u = 0; u < 2; ++u)
#pragma unroll
            for (int k = 0; k < 4; ++k) { const int sr = F.SLOTREF[(t0 + u) * 4 + k]; yrow[u][k] = (size_t)256 * M.toff[sr >> 16] + (sr & 0xffff); gk[u][k] = F.GATE[(t0 + u) * 4 + k]; }
        u32x4 hv[2][2], yv[2][2][4];
#pragma unroll
        for (int u = 0; u < 2; ++u)
#pragma unroll
            for (int j = 0; j < 2; ++j) { const int col = 8 * F.lane + 512 * j; hv[u][j] = *(const u32x4*)(F.H1 + (size_t)(t0 + u) * D + col);
#pragma unroll
                for (int k = 0; k < 4; ++k) yv[u][j][k] = *(const u32x4*)(F.YS + yrow[u][k] * D + col); }
#pragma unroll
        for (int u = 0; u < 2; ++u) {
            float ss = 0.f;
#pragma unroll
            for (int j = 0; j < 2; ++j) {
                float a[8]; unpack8(hv[u][j], a);
#pragma unroll
                for (int k = 0; k < 4; ++k) { float y[8]; unpack8(yv[u][j][k], y);
#pragma unroll
                    for (int q = 0; q < 8; ++q) a[q] += gk[u][k] * y[q]; }
                u32x4 o; o.x = pk2(a[0], a[1]); o.y = pk2(a[2], a[3]); o.z = pk2(a[4], a[5]); o.w = pk2(a[6], a[7]);
                *(u32x4*)(F.H2 + (size_t)(t0 + u) * D + 8 * F.lane + 512 * j) = o;
                float b[8]; unpack8(o, b);
#pragma unroll
                for (int q = 0; q < 8; ++q) ss += b[q] * b[q];
            }
            ss = wave_sum(ss);
            if (F.lane == 0) F.RSTD2[t0 + u] = rsqrtf(ss * (1.f / D) + EPS);
        }
    }
}
__device__ __forceinline__ void p9_ple(const Frame& F) {
    const int gw = blockIdx.x * NWAVES + F.wave, NGW = F.G * NWAVES, r32 = F.lane & 31, hi = F.lane >> 5;
    for (int tile = gw; tile < (T / 32) * (D / 128); tile += NGW) {
        const int mb = tile / (D / 128), cg = tile % (D / 128), m0 = mb * 32, n0 = cg * 128;
        const bf16* ap = F.H2 + (size_t)(m0 + r32) * D + 8 * hi;
        const bf16* bp[4];
#pragma unroll
        for (int nb = 0; nb < 4; ++nb) bp[nb] = F.WPG + (size_t)(n0 + 32 * nb + r32) * D + 8 * hi;
        f32x16 acc[4];
#pragma unroll
        for (int nb = 0; nb < 4; ++nb) acc[nb] = f32x16{};
        smma<4>(ap, bp, D, acc);
#pragma unroll
        for (int r = 0; r < 16; ++r) {
            const size_t row = m0 + crow(r, hi); const float rs = F.RSTD2[row];
#pragma unroll
            for (int nb = 0; nb < 4; ++nb) { const int col = n0 + 32 * nb + r32;
                const float pg = sigmoidf_(rs * acc[nb][r]);
                F.H3[row * D + col] = (bf16)f2bf(bf2f(F.H2[row * D + col]) + pg * bf2f(F.PROJ[row * D + col])); }
        }
    }
}
__device__ __forceinline__ void p10_final(const Frame& F) {
    const int gw = blockIdx.x * NWAVES + F.wave, NGW = F.G * NWAVES;
    for (int t = gw; t < T; t += NGW) {
        float a[2][8]; float ss = 0.f;
#pragma unroll
        for (int j = 0; j < 2; ++j) { unpack8(*(const u32x4*)(F.H3 + (size_t)t * D + 8 * F.lane + 512 * j), a[j]);
#pragma unroll
            for (int q = 0; q < 8; ++q) ss += a[j][q] * a[j][q]; }
        const float rstd = rsqrtf(wave_sum(ss) * (1.f / D) + EPS);
#pragma unroll
        for (int j = 0; j < 2; ++j) { const int col = 8 * F.lane + 512 * j;
            const f32x4 g0 = *(const f32x4*)(F.g_final + col), g1 = *(const f32x4*)(F.g_final + col + 4);
            f32x4 o0, o1; o0.x = a[j][0] * rstd * g0.x; o0.y = a[j][1] * rstd * g0.y; o0.z = a[j][2] * rstd * g0.z; o0.w = a[j][3] * rstd * g0.w;
            o1.x = a[j][4] * rstd * g1.x; o1.y = a[j][5] * rstd * g1.y; o1.z = a[j][6] * rstd * g1.z; o1.w = a[j][7] * rstd * g1.w;
            *(f32x4*)(F.out + (size_t)t * D + col) = o0; *(f32x4*)(F.out + (size_t)t * D + col + 4) = o1; }
    }
}


namespace pg {
constexpr int BM = 256, BK = 64, HALF = 128, HTB = HALF * BK * 2, STAGE_BYTES = 8 * HTB, NXCD = 8, WGM = 8;
__device__ __forceinline__ int lds_byte(int r, int c) { const int st = (r >> 4) * 2 + (c >> 5), rr = r & 15, cc = c & 31, ob = rr * 64 + cc * 2; return st * 1024 + (ob ^ (((ob >> 9) & 1) << 5)); }
__device__ __forceinline__ void stage_rc(int b, int& R, int& C) { const int st = b / 1024, sb = b % 1024, swz = sb ^ (((sb >> 9) & 1) << 5); R = (st >> 1) * 16 + swz / 64; C = (st & 1) * 32 + (swz % 64) / 2; }
__device__ __forceinline__ int perm32(int rho) { const int n = rho >> 4, i = rho & 15; return 8 * (i >> 2) + 4 * n + (i & 3); }
struct Unit { int arow, brow, kofs, x0, x1, x2; };
typedef float f32x2_t __attribute__((ext_vector_type(2))); typedef __bf16 bf16x2_t __attribute__((ext_vector_type(2)));
__device__ __forceinline__ unsigned cvt_pk_bf16(float lo, float hi) { const f32x2_t v = {lo, hi}; const bf16x2_t b = __builtin_convertvector(v, bf16x2_t); return __builtin_bit_cast(unsigned, b); }
typedef f32x4 Acc[2][2][4][2];
typedef int i32x8 __attribute__((ext_vector_type(8)));
typedef int i32x4 __attribute__((ext_vector_type(4)));

__device__ __forceinline__ void dma16(const void* sbase, unsigned voff, unsigned ldsdst) { unsigned keep;
    asm volatile("s_mov_b32 %0, m0\n\ts_mov_b32 m0, %3\n\ts_nop 0\n\tglobal_load_lds_dwordx4 %1, %2\n\ts_mov_b32 m0, %0" : "=&s"(keep) : "v"(voff), "s"(sbase), "s"(ldsdst) : "memory"); }
struct DenseMap { static constexpr bool GATHER = false; int lda; __device__ __forceinline__ unsigned rowoff(const Unit&, int r) const { return (unsigned)r * (unsigned)lda * 2u; }
    __device__ __forceinline__ size_t base(const Unit& u) const { return (size_t)u.arow * lda * 2; } };
template <int SPLIT>
struct DenseOrder {
    int nM, nN, nwg, G, c, khalf;
    __device__ __forceinline__ void init(int M, int N, int G_, int c_, int khalf_ = 0) { nM = M / BM; nN = N / BM; nwg = nM * nN; G = G_; c = c_; khalf = khalf_; }
    __device__ __forceinline__ bool next(int i, Unit& u) const {
        const int j = SPLIT ? (i >> 1) : i;
        const long L = (long)j * G + c; if (L >= nwg) return false;
        int wgid = (int)L; { const int q = nwg / NXCD, r = nwg % NXCD, xcd = wgid % NXCD, off = wgid / NXCD; wgid = (xcd < r ? xcd * (q + 1) : r * (q + 1) + (xcd - r) * q) + off; }
        const int nig = WGM * nN, gid = wgid / nig, fm = gid * WGM, gsz = (nM - fm) < WGM ? (nM - fm) : WGM;
        const int pm = fm + ((wgid % nig) % gsz), pn = (wgid % nig) / gsz;
        u.arow = pm * BM; u.brow = pn * BM; u.x0 = pm; u.x1 = pn; u.x2 = SPLIT ? (i & 1) : 0; u.kofs = SPLIT ? (i & 1) * khalf : 0; return true;
    }
};

template <class Epi, class Sched, class AMap, bool ALIGN_EPI, int PREC = 0>
__device__ __forceinline__ void gemm_run(LAS unsigned char* lds, const bf16* A, const bf16* Bt, const int ldb, const int nt, const Sched& S, const Epi& E, const AMap& AM) {
    const int tid = threadIdx.x, wid = __builtin_amdgcn_readfirstlane(tid >> 6), lane = tid & 63, wr = wid >> 2, wc = wid & 3, fr = lane & 15, fq = lane >> 4;
    int RA[2]; unsigned CA2[2], voffB[2];
#pragma unroll
    for (int i = 0; i < 2; ++i) { int R, C; stage_rc(tid * 16 + i * 8192, R, C); RA[i] = R; CA2[i] = (unsigned)C * 2u; const int Rb = (R & ~31) + perm32(R & 31); voffB[i] = (unsigned)(Rb * ldb + C) * 2u; }
    const size_t kstep = (size_t)(BK * 2);
    const size_t hstepB = (size_t)HALF * ldb * 2;
    const unsigned ldsw = (unsigned)wid * 1024u;
    const unsigned lds32 = (unsigned)(uintptr_t)lds;
    const int aoff = lds_byte(wr * 64 + fr, fq * 8), boff = lds_byte(wc * 32 + fr, fq * 8);
#define PG_SA(b, h) (((b) * 2 + (h)) * HTB)
#define PG_SB(b, h) ((4 + (b) * 2 + (h)) * HTB)
#define PG_DMA(gbase, voff32, ldsdst) do { unsigned _keep; asm volatile("s_mov_b32 %0, m0\n\ts_mov_b32 m0, %3\n\ts_nop 0\n\tglobal_load_lds_dwordx4 %1, %2\n\ts_mov_b32 m0, %0" \
        : "=&s"(_keep) : "v"(voff32), "s"(gbase), "s"(ldsdst) : "memory"); } while (0)
#define PG_STAGE(bufoff, gbase, voff) do { _Pragma("unroll") for (int _i = 0; _i < 2; ++_i) PG_DMA((const char*)(gbase), (voff)[_i], lds32 + (unsigned)((bufoff) + _i * 8192) + ldsw); } while (0)
#define PG_LD8(addr) __builtin_shufflevector(*(const LAS i32x4*)(addr), *(const LAS i32x4*)((addr) + 1024), 0, 1, 2, 3, 4, 5, 6, 7)
#define PG_LDA(dst, b, h) do { if constexpr (PREC == 0) { _Pragma("unroll") for (int m = 0; m < 4; ++m) _Pragma("unroll") for (int k = 0; k < 2; ++k) dst[m][k] = *(const LAS bf16x8*)(lds + PG_SA(b, h) + aoff + m * 2048 + k * 1024); } \
        else { _Pragma("unroll") for (int m = 0; m < 4; ++m) dst##8[m] = PG_LD8(lds + PG_SA(b, h) + aoff + m * 2048); } } while (0)
#define PG_LDB(dst, b, h) do { if constexpr (PREC == 0) { _Pragma("unroll") for (int n = 0; n < 2; ++n) _Pragma("unroll") for (int k = 0; k < 2; ++k) dst[n][k] = *(const LAS bf16x8*)(lds + PG_SB(b, h) + boff + n * 2048 + k * 1024); } \
        else { _Pragma("unroll") for (int n = 0; n < 2; ++n) dst##8[n] = PG_LD8(lds + PG_SB(b, h) + boff + n * 2048); } } while (0)
#define PG_MMA(ai, bj, At, Bt_) do { __builtin_amdgcn_s_setprio(1); _Pragma("unroll") for (int m = 0; m < 4; ++m) _Pragma("unroll") for (int n = 0; n < 2; ++n) { \
        if constexpr (PREC == 0) { _Pragma("unroll") for (int k = 0; k < 2; ++k) acc[ai][bj][m][n] = __builtin_amdgcn_mfma_f32_16x16x32_bf16(Bt_[n][k], At[m][k], acc[ai][bj][m][n], 0, 0, 0); } \
        else { asm volatile("v_mfma_scale_f32_16x16x128_f8f6f4 %0, %1, %2, %0, %3, %3 op_sel_hi:[0,0,0]" : "+v"(acc[ai][bj][m][n]) : "v"(Bt_##8[n]), "v"(At##8[m]), "v"(one_scale)); } } \
        __builtin_amdgcn_s_setprio(0); } while (0)
#define PG_WAIT_V(n) asm volatile("s_waitcnt vmcnt(" #n ")" ::: "memory")
#define PG_WAIT_L(n) asm volatile("s_waitcnt lgkmcnt(" #n ")" ::: "memory")
#define PG_BAR __builtin_amdgcn_s_barrier()
#define PG_SCHED __builtin_amdgcn_sched_barrier(0)
#define PG_ZERO() do { _Pragma("unroll") for (int a = 0; a < 2; ++a) _Pragma("unroll") for (int b = 0; b < 2; ++b) _Pragma("unroll") for (int m = 0; m < 4; ++m) _Pragma("unroll") for (int n = 0; n < 2; ++n) acc[a][b][m][n] = (f32x4){0.f, 0.f, 0.f, 0.f}; } while (0)
#define PG_MKVA(u, va) do { _Pragma("unroll") for (int h = 0; h < 2; ++h) _Pragma("unroll") for (int i = 0; i < 2; ++i) va[h][i] = AM.rowoff(u, h * HALF + RA[i]) + CA2[i]; } while (0)
    Unit cur, nxt; int ui = 0;
    if (!S.next(0, cur)) return;
    Acc acc; PG_ZERO();
    bf16x8 At[4][2], B0[2][2], B1[2][2];
    i32x8 At8[4], B08[2], B18[2];
    unsigned one_scale; asm volatile("v_mov_b32 %0, 0x7f7f7f7f" : "=v"(one_scale));
    unsigned voffA[2]; unsigned vaC[2][2], vaN[2][2];
    const size_t hstepA = AMap::GATHER ? 0 : (size_t)AM.rowoff(cur, HALF);
    if constexpr (AMap::GATHER) { PG_MKVA(cur, vaC); } else {
#pragma unroll
        for (int i = 0; i < 2; ++i) voffA[i] = AM.rowoff(cur, RA[i]) + CA2[i]; }
#define PG_STAGE_A(bufoff, ptr, h, useNext) do { if constexpr (AMap::GATHER) { unsigned _v[2] = {(useNext) ? vaN[h][0] : vaC[h][0], (useNext) ? vaN[h][1] : vaC[h][1]}; PG_STAGE(bufoff, ptr, _v); } \
        else { PG_STAGE(bufoff, (ptr) + (h) * hstepA, voffA); } } while (0)
    const char* cA = (const char*)A + (size_t)cur.kofs * 2 + AM.base(cur); const char* cB = (const char*)Bt + ((size_t)cur.brow * ldb + cur.kofs) * 2;
    PG_STAGE(PG_SB(0, 0), cB, voffB); PG_STAGE(PG_SB(0, 1), cB + hstepB, voffB); PG_STAGE_A(PG_SA(0, 0), cA, 0, false); PG_STAGE_A(PG_SA(0, 1), cA, 1, false);
    if (wr == 1) PG_BAR;
    PG_WAIT_V(2); PG_BAR;
    PG_STAGE(PG_SB(1, 0), cB + kstep, voffB); PG_STAGE_A(PG_SA(1, 0), cA + kstep, 0, false); PG_STAGE(PG_SB(1, 1), cB + hstepB + kstep, voffB);
    PG_WAIT_V(6); PG_BAR;
    for (;;) {
        const bool has_next = S.next(ui + 1, nxt);
        const char* nA = cA; const char* nB = cB;
        if (has_next) { if constexpr (AMap::GATHER) { PG_MKVA(nxt, vaN); } nA = (const char*)A + (size_t)nxt.kofs * 2 + AM.base(nxt); nB = (const char*)Bt + ((size_t)nxt.brow * ldb + nxt.kofs) * 2; }
        else if constexpr (AMap::GATHER) {
#pragma unroll
            for (int h = 0; h < 2; ++h)
#pragma unroll
                for (int i = 0; i < 2; ++i) vaN[h][i] = vaC[h][i]; }
        E.prefetch(cur, ui, wid, lane);
#pragma unroll 1
        for (int t = 0; t < nt; t += 2) {
            const bool last = (t == nt - 2);
            const char* a1 = cA + (size_t)(t + 1) * kstep;
            const char* a2 = last ? nA : cA + (size_t)(t + 2) * kstep; const char* b2 = last ? nB : cB + (size_t)(t + 2) * kstep;
            const char* a3 = a2 + kstep; const char* b3 = b2 + kstep;
            PG_LDB(B0, 0, 0); PG_LDB(B1, 0, 1); PG_SCHED; PG_LDA(At, 0, 0); PG_STAGE_A(PG_SA(1, 1), a1, 1, false);
            PG_WAIT_V(8); PG_WAIT_L(0); PG_BAR; PG_MMA(0, 0, At, B0); PG_MMA(0, 1, At, B1); PG_BAR; PG_SCHED;
            PG_LDA(At, 0, 1); PG_STAGE(PG_SB(0, 0), b2, voffB); PG_STAGE(PG_SB(0, 1), b2 + hstepB, voffB); PG_STAGE_A(PG_SA(0, 0), a2, 0, last);
            PG_WAIT_V(8); PG_WAIT_L(0); PG_BAR; PG_MMA(1, 0, At, B0); PG_MMA(1, 1, At, B1); PG_BAR; PG_SCHED;
            PG_LDB(B0, 1, 0); PG_LDB(B1, 1, 1); PG_SCHED; PG_LDA(At, 1, 0); PG_STAGE_A(PG_SA(0, 1), a2, 1, last);
            PG_WAIT_V(8); PG_WAIT_L(0); PG_BAR; PG_MMA(0, 0, At, B0); PG_MMA(0, 1, At, B1); PG_BAR; PG_SCHED;
            PG_LDA(At, 1, 1); PG_STAGE(PG_SB(1, 0), b3, voffB); PG_STAGE(PG_SB(1, 1), b3 + hstepB, voffB); PG_STAGE_A(PG_SA(1, 0), a3, 0, last);
            PG_WAIT_V(8); PG_WAIT_L(0); PG_BAR; PG_MMA(1, 0, At, B0); PG_MMA(1, 1, At, B1); PG_BAR; PG_SCHED;
        }
        if constexpr (ALIGN_EPI) { if (wr == 0) PG_BAR; }
        if constexpr (PREC == 1) asm volatile("s_nop 15\n\ts_nop 15\n\ts_nop 15\n\ts_nop 15" ::: "memory");
        E(acc, cur, ui, wr, wc, fr, fq);
        if (!has_next) break;
        if (!E.keep(cur)) PG_ZERO();
        cur = nxt; cA = nA; cB = nB; ++ui;
        if constexpr (AMap::GATHER) {
#pragma unroll
            for (int h = 0; h < 2; ++h)
#pragma unroll
                for (int i = 0; i < 2; ++i) vaC[h][i] = vaN[h][i]; }
        if constexpr (ALIGN_EPI) { if (wr == 1) PG_BAR; }
    }
    PG_WAIT_V(0);
    if constexpr (!ALIGN_EPI) { if (wr == 0) PG_BAR; }
    PG_BAR;
#undef PG_SA
#undef PG_SB
#undef PG_STAGE
#undef PG_DMA
#undef PG_LDA
#undef PG_LDB
#undef PG_LD8
#undef PG_MMA
#undef PG_WAIT_V
#undef PG_WAIT_L
#undef PG_BAR
#undef PG_SCHED
#undef PG_ZERO
#undef PG_MKVA
#undef PG_STAGE_A
}

__device__ __forceinline__ float sigm(float x) { return __builtin_amdgcn_rcpf(1.0f + __builtin_amdgcn_exp2f(-LOG2E * x)); }
__device__ __forceinline__ float gelu_t(float x) { const float u = 1.5957691216057308f * (x + 0.044715f * x * x * x); return x * sigm(u); }
template <int KIND> __device__ __forceinline__ float act_k(float x) {
    if (KIND == 2) { const float t = x * (-2.3022082f + (-0.10294324f) * (x * x)); return x * __builtin_amdgcn_rcpf(1.0f + __builtin_amdgcn_exp2f(t)); }
    return __builtin_amdgcn_rcpf(1.0f + __builtin_amdgcn_exp2f(-LOG2E * x));
}
template <int KIND> __device__ __forceinline__ void store_act(const Acc& acc, bf16* base, int ldc) {
#pragma unroll
    for (int ai = 0; ai < 2; ++ai)
#pragma unroll
        for (int m = 0; m < 4; ++m) { bf16* rowp = base + (size_t)(ai * HALF + m * 16) * ldc;
#pragma unroll
            for (int bj = 0; bj < 2; ++bj) { const f32x4 v0 = acc[ai][bj][m][0], v1 = acc[ai][bj][m][1];
                u32x4 w; w.x = cvt_pk_bf16(act_k<KIND>(v0[0]), act_k<KIND>(v0[1])); w.y = cvt_pk_bf16(act_k<KIND>(v0[2]), act_k<KIND>(v0[3]));
                w.z = cvt_pk_bf16(act_k<KIND>(v1[0]), act_k<KIND>(v1[1])); w.w = cvt_pk_bf16(act_k<KIND>(v1[2]), act_k<KIND>(v1[3]));
                *(u32x4*)(rowp + bj * HALF) = w; }
            asm volatile("" ::: "memory"); }
}
__device__ __forceinline__ void store_plain(const Acc& acc, bf16* base, int ldc) {
#pragma unroll
    for (int ai = 0; ai < 2; ++ai)
#pragma unroll
        for (int m = 0; m < 4; ++m) { bf16* rowp = base + (size_t)(ai * HALF + m * 16) * ldc;
#pragma unroll
            for (int bj = 0; bj < 2; ++bj) { const f32x4 v0 = acc[ai][bj][m][0], v1 = acc[ai][bj][m][1];
                u32x4 w; w.x = cvt_pk_bf16(v0[0], v0[1]); w.y = cvt_pk_bf16(v0[2], v0[3]); w.z = cvt_pk_bf16(v1[0], v1[1]); w.w = cvt_pk_bf16(v1[2], v1[3]);
                *(u32x4*)(rowp + bj * HALF) = w; } }
}
struct EpiInproj {
    bf16* ZZ;
    __device__ __forceinline__ bool keep(const Unit&) const { return false; }
    __device__ __forceinline__ void prefetch(const Unit&, int, int, int) const {}
    __device__ __forceinline__ void operator()(const Acc& acc, const Unit& u, int ui, int wr, int wc, int fr, int fq) const {
        bf16* base = ZZ + (size_t)(u.arow + wr * 64 + fr) * INC + u.brow + wc * 32 + 8 * fq;
        const int n0 = u.brow;
        if (n0 < ZU) store_plain(acc, base, INC); else if (n0 < ZGA) store_act<2>(acc, base, INC); else store_act<3>(acc, base, INC);
    }
};
struct EpiPlain {
    bf16* O; int ldc;
    __device__ __forceinline__ bool keep(const Unit&) const { return false; }
    __device__ __forceinline__ void prefetch(const Unit&, int, int, int) const {}
    __device__ __forceinline__ void operator()(const Acc& acc, const Unit& u, int ui, int wr, int wc, int fr, int fq) const {
        store_plain(acc, O + (size_t)(u.arow + wr * 64 + fr) * ldc + u.brow + wc * 32 + 8 * fq, ldc);
    }
};
struct EpiMerge {
    const bf16* ZZ; bf16* O;
    __device__ __forceinline__ bool keep(const Unit& u) const { return u.x2 == 0; }
    __device__ __forceinline__ void prefetch(const Unit&, int, int, int) const {}
    __device__ __forceinline__ void operator()(Acc& acc, const Unit& u, int ui, int wr, int wc, int fr, int fq) const {
        const int row0 = u.arow + wr * 64 + fr, col0 = u.brow + wc * 32 + 8 * fq;
#pragma unroll
        for (int ai = 0; ai < 2; ++ai)
#pragma unroll
            for (int m = 0; m < 4; ++m) { const size_t row = row0 + ai * HALF + m * 16;
#pragma unroll
                for (int bj = 0; bj < 2; ++bj) { const int col = col0 + bj * HALF;
                    float gb[8]; unpack8(*(const u32x4*)(ZZ + row * INC + ZGB + col), gb);
#pragma unroll
                    for (int q = 0; q < 8; ++q) gb[q] = fmaxf(gb[q], 1e-30f);
                    if (u.x2 == 0) { float ga[8]; unpack8(*(const u32x4*)(ZZ + row * INC + ZGA + col), ga);
#pragma unroll
                        for (int q = 0; q < 8; ++q) acc[ai][bj][m][q >> 2][q & 3] *= ga[q] * __builtin_amdgcn_rcpf(gb[q]); }
                    else { const f32x4 v0 = acc[ai][bj][m][0], v1 = acc[ai][bj][m][1];
                        u32x4 w; w.x = cvt_pk_bf16(v0[0] * gb[0], v0[1] * gb[1]); w.y = cvt_pk_bf16(v0[2] * gb[2], v0[3] * gb[3]); w.z = cvt_pk_bf16(v1[0] * gb[4], v1[1] * gb[5]); w.w = cvt_pk_bf16(v1[2] * gb[6], v1[3] * gb[7]);
                        *(u32x4*)(O + row * D + col) = w; } }
                asm volatile("" ::: "memory"); }
    }
};
struct EpiOut {
    const float* x; bf16* O;
    __device__ __forceinline__ bool keep(const Unit&) const { return false; }
    __device__ __forceinline__ void prefetch(const Unit&, int, int, int) const {}
    __device__ __forceinline__ void operator()(const Acc& acc, const Unit& u, int ui, int wr, int wc, int fr, int fq) const {
        const int row0 = u.arow + wr * 64 + fr, col0 = u.brow + wc * 32 + 8 * fq;
#pragma unroll
        for (int ai = 0; ai < 2; ++ai)
#pragma unroll
            for (int m = 0; m < 4; ++m) { const size_t row = row0 + ai * HALF + m * 16;
#pragma unroll
                for (int bj = 0; bj < 2; ++bj) { const int col = col0 + bj * HALF;
                    const f32x4 x0 = *(const f32x4*)(x + row * D + col), x1 = *(const f32x4*)(x + row * D + col + 4);
                    const f32x4 v0 = acc[ai][bj][m][0] + x0, v1 = acc[ai][bj][m][1] + x1;
                    u32x4 w; w.x = cvt_pk_bf16(v0[0], v0[1]); w.y = cvt_pk_bf16(v0[2], v0[3]); w.z = cvt_pk_bf16(v1[0], v1[1]); w.w = cvt_pk_bf16(v1[2], v1[3]);
                    *(u32x4*)(O + row * D + col) = w; }
                asm volatile("" ::: "memory"); }
    }
};
struct EpiPle {
    const bf16* H2; const bf16* PROJ; const float* RSTD2; bf16* O;
    __device__ __forceinline__ bool keep(const Unit&) const { return false; }
    __device__ __forceinline__ void prefetch(const Unit&, int, int, int) const {}
    __device__ __forceinline__ void operator()(const Acc& acc, const Unit& u, int ui, int wr, int wc, int fr, int fq) const {
        const int row0 = u.arow + wr * 64 + fr, col0 = u.brow + wc * 32 + 8 * fq;
#pragma unroll
        for (int ai = 0; ai < 2; ++ai)
#pragma unroll
            for (int m = 0; m < 4; ++m) { const size_t row = row0 + ai * HALF + m * 16; const float rs = RSTD2[row];
#pragma unroll
                for (int bj = 0; bj < 2; ++bj) { const int col = col0 + bj * HALF;
                    float h[8], pj[8]; unpack8(*(const u32x4*)(H2 + row * D + col), h); unpack8(*(const u32x4*)(PROJ + row * D + col), pj);
                    float o[8];
#pragma unroll
                    for (int q = 0; q < 8; ++q) o[q] = h[q] + sigm(rs * acc[ai][bj][m][q >> 2][q & 3]) * pj[q];
                    u32x4 w; w.x = cvt_pk_bf16(o[0], o[1]); w.y = cvt_pk_bf16(o[2], o[3]); w.z = cvt_pk_bf16(o[4], o[5]); w.w = cvt_pk_bf16(o[6], o[7]);
                    *(u32x4*)(O + row * D + col) = w; }
                asm volatile("" ::: "memory"); }
    }
};
}

__device__ __forceinline__ void p1_fast(const Frame& F) {
    { pg::DenseOrder<0> S; S.init(T, INC, F.G, (int)blockIdx.x); pg::EpiInproj E{F.ZZ}; pg::DenseMap AM{D};
      pg::gemm_run<pg::EpiInproj, pg::DenseOrder<0>, pg::DenseMap, true>(F.lds + STAGE_OFF, F.ABF, F.WIN, D, D / 64, S, E, AM); }
    { pg::DenseOrder<0> S; S.init(T, D, F.G, (int)blockIdx.x); pg::EpiPlain E{F.PROJ, D}; pg::DenseMap AM{PLE};
      pg::gemm_run<pg::EpiPlain, pg::DenseOrder<0>, pg::DenseMap, true>(F.lds + STAGE_OFF, F.PBF, F.WPP, PLE, PLE / 64, S, E, AM); }
}
__device__ __forceinline__ void p3_fast(const Frame& F) {
    pg::DenseOrder<1> S; S.init(T, D, F.G, (int)blockIdx.x, 512); pg::EpiMerge E{F.ZZ, F.MERGED}; pg::DenseMap AM{D};
    pg::gemm_run<pg::EpiMerge, pg::DenseOrder<1>, pg::DenseMap, true>(F.lds + STAGE_OFF, F.OAB, F.WAB, D, 512 / 64, S, E, AM);
}
__device__ __forceinline__ void p4_fast(const Frame& F) {
    pg::DenseOrder<0> S; S.init(T, D, F.G, (int)blockIdx.x); pg::EpiOut E{F.x, F.H1}; pg::DenseMap AM{D};
    pg::gemm_run<pg::EpiOut, pg::DenseOrder<0>, pg::DenseMap, true>(F.lds + STAGE_OFF, F.MERGED, F.WOUT, D, D / 64, S, E, AM);
}
__device__ __forceinline__ void p9_fast(const Frame& F) {
    pg::DenseOrder<0> S; S.init(T, D, F.G, (int)blockIdx.x); pg::EpiPle E{F.H2, F.PROJ, F.RSTD2, F.H3}; pg::DenseMap AM{D};
    pg::gemm_run<pg::EpiPle, pg::DenseOrder<0>, pg::DenseMap, true>(F.lds + STAGE_OFF, F.H2, F.WPG, D, D / 64, S, E, AM);
}


namespace pg {
template <int MT, int NT, int NROWS_B>
struct MoeOrder {
    LAS const int* cnt; LAS const int* toff; int c;
    __device__ __forceinline__ bool next(int i, Unit& u) const {
        const int x = c & 7, cl = c >> 3, sb = i * 8 + x, mtg = MT * sb + cl / NT, pn = cl % NT;
        if (mtg >= __builtin_amdgcn_readfirstlane(toff[NE])) return false;
        int e = 0; while (toff[e + 1] <= mtg) ++e;
        e = __builtin_amdgcn_readfirstlane(e);
        const int valid = __builtin_amdgcn_readfirstlane(cnt[e] - 256 * (mtg - toff[e]));
        u.arow = 256 * mtg; u.brow = e * NROWS_B + 256 * pn; u.kofs = 0; u.x0 = e; u.x1 = valid; u.x2 = i; return true;
    }
};
struct GatherMap { static constexpr bool GATHER = true; LAS const unsigned* tab;
    __device__ __forceinline__ unsigned rowoff(const Unit& u, int r) const { return tab[u.x2 * 256 + r]; }
    __device__ __forceinline__ size_t base(const Unit&) const { return 0; } };
struct EpiSwiglu {
    bf16* HID; const float* b1; LAS unsigned char* lds;
    __device__ __forceinline__ bool keep(const Unit&) const { return false; }
    __device__ __forceinline__ void prefetch(const Unit& u, int ui, int wid, int lane) const {
        if (wid == 0) dma16(b1 + u.x0 * 2048 + ((u.brow & 2047) >> 8) * 256, (unsigned)lane * 16u, (unsigned)(uintptr_t)lds + BIAS_OFF + (ui & 1) * 1024); }
    __device__ __forceinline__ void operator()(const Acc& acc, const Unit& u, int ui, int wr, int wc, int fr, int fq) const {
        const int e = u.x0, valid = u.x1, pn = (u.brow & 2047) >> 8, hid0 = 128 * pn + 32 * wc + 8 * fq;
        const LAS f32x4* bp = (const LAS f32x4*)(lds + BIAS_OFF + (ui & 1) * 1024 + (32 * wc + 8 * fq) * 8);
        const f32x4 f0 = bp[0], f1 = bp[1], f2 = bp[2], f3 = bp[3];
        const float bg[8] = {f0[0], f0[2], f1[0], f1[2], f2[0], f2[2], f3[0], f3[2]}, bl[8] = {f0[1], f0[3], f1[1], f1[3], f2[1], f2[3], f3[1], f3[3]};
#pragma unroll
        for (int ai = 0; ai < 2; ++ai)
#pragma unroll
            for (int m = 0; m < 4; ++m) { const int rl = ai * HALF + wr * 64 + m * 16 + fr;
                float o[8];
#pragma unroll
                for (int q = 0; q < 8; ++q) { float g = acc[ai][0][m][q >> 2][q & 3] * (FP8_1 ? SC_INV : 1.0f) + bg[q], l = acc[ai][1][m][q >> 2][q & 3] * (FP8_1 ? SC_INV : 1.0f) + bl[q];
                    g = fminf(g, 7.f); l = fminf(fmaxf(l, -7.f), 7.f); o[q] = g * sigm(1.702f * g) * (l + 1.f); }
                if (FP8_2) { u32x2 w; w.x = pk4_fp8(o[0] * SC_ACT, o[1] * SC_ACT, o[2] * SC_ACT, o[3] * SC_ACT); w.y = pk4_fp8(o[4] * SC_ACT, o[5] * SC_ACT, o[6] * SC_ACT, o[7] * SC_ACT);
                    *(u32x2*)((unsigned char*)HID + (size_t)(u.arow + rl) * DE + hid0) = w; }
                else { u32x4 w; w.x = cvt_pk_bf16(o[0], o[1]); w.y = cvt_pk_bf16(o[2], o[3]); w.z = cvt_pk_bf16(o[4], o[5]); w.w = cvt_pk_bf16(o[6], o[7]);
                    *(u32x4*)(HID + (size_t)(u.arow + rl) * DE + hid0) = w; } }
    }
};
struct EpiBias2 {
    bf16* YS; const float* b2; LAS unsigned char* lds;
    __device__ __forceinline__ bool keep(const Unit&) const { return false; }
    __device__ __forceinline__ void prefetch(const Unit& u, int ui, int wid, int lane) const {
        if (wid == 0) dma16(b2 + u.x0 * D + (u.brow & 1023), (unsigned)lane * 16u, (unsigned)(uintptr_t)lds + BIAS_OFF + (ui & 1) * 1024); }
    __device__ __forceinline__ void operator()(const Acc& acc, const Unit& u, int ui, int wr, int wc, int fr, int fq) const {
        const int valid = u.x1, col0 = (u.brow & 1023) + 32 * wc + 8 * fq;
        f32x4 bb[2][2];
#pragma unroll
        for (int bj = 0; bj < 2; ++bj)
#pragma unroll
            for (int n = 0; n < 2; ++n) bb[bj][n] = *(const LAS f32x4*)(lds + BIAS_OFF + (ui & 1) * 1024 + (32 * wc + 8 * fq + bj * HALF + 4 * n) * 4);
#pragma unroll
        for (int ai = 0; ai < 2; ++ai)
#pragma unroll
            for (int m = 0; m < 4; ++m) { const int rl = ai * HALF + wr * 64 + m * 16 + fr;
#pragma unroll
                for (int bj = 0; bj < 2; ++bj) { const f32x4 v0 = acc[ai][bj][m][0] * (FP8_2 ? SC_INV : 1.0f) + bb[bj][0], v1 = acc[ai][bj][m][1] * (FP8_2 ? SC_INV : 1.0f) + bb[bj][1];
                    if (YS8) { u32x2 w; w.x = pk4_fp8(v0[0] * SC_Y, v0[1] * SC_Y, v0[2] * SC_Y, v0[3] * SC_Y); w.y = pk4_fp8(v1[0] * SC_Y, v1[1] * SC_Y, v1[2] * SC_Y, v1[3] * SC_Y);
                        *(u32x2*)((unsigned char*)YS + (size_t)(u.arow + rl) * D + col0 + bj * HALF) = w; }
                    else { u32x4 w; w.x = cvt_pk_bf16(v0[0], v0[1]); w.y = cvt_pk_bf16(v0[2], v0[3]); w.z = cvt_pk_bf16(v1[0], v1[1]); w.w = cvt_pk_bf16(v1[2], v1[3]);
                        *(u32x4*)(YS + (size_t)(u.arow + rl) * D + col0 + bj * HALF) = w; } } }
    }
};
}
__device__ __forceinline__ void p6_fast(const Frame& F) {
    const MoeTab M = moe_tables(F);
    pg::MoeOrder<4, 8, 2048> S{M.cnt, M.toff, (int)blockIdx.x};
    LAS unsigned* tab = (LAS unsigned*)(F.lds + TAB_OFF);
    { pg::Unit u;
      for (int i = 0; i < 18 && S.next(i, u); ++i) { const int e = u.x0, cnt = M.cnt[e], rk0 = cnt - u.x1;
          if (F.tid < 256) { const int rk = rk0 + F.tid; tab[i * 256 + F.tid] = (unsigned)F.TOKLIST[e * LCAP + (rk < cnt ? rk : cnt - 1)] * (unsigned)(FP8_1 ? D : D * 2); } } }
    __syncthreads();
    pg::EpiSwiglu E{F.HID, F.b1, F.lds}; pg::GatherMap AM{tab};
    if (FP8_1) pg::gemm_run<pg::EpiSwiglu, pg::MoeOrder<4, 8, 2048>, pg::GatherMap, true, 1>(F.lds + STAGE_OFF, F.ABF, F.W1T, D / 2, D / 128, S, E, AM);
    else pg::gemm_run<pg::EpiSwiglu, pg::MoeOrder<4, 8, 2048>, pg::GatherMap, true, 0>(F.lds + STAGE_OFF, F.ABF, F.W1T, D, D / 64, S, E, AM);
}
__device__ __forceinline__ void p7_fast(const Frame& F) {
    const MoeTab M = moe_tables(F);
    pg::MoeOrder<8, 4, 1024> S{M.cnt, M.toff, (int)blockIdx.x};
    pg::EpiBias2 E{F.YS, F.b2, F.lds}; pg::DenseMap AM{FP8_2 ? DE / 2 : DE};
    if (FP8_2) pg::gemm_run<pg::EpiBias2, pg::MoeOrder<8, 4, 1024>, pg::DenseMap, true, 1>(F.lds + STAGE_OFF, F.HID, F.W2T, DE / 2, DE / 128, S, E, AM);
    else pg::gemm_run<pg::EpiBias2, pg::MoeOrder<8, 4, 1024>, pg::DenseMap, true, 0>(F.lds + STAGE_OFF, F.HID, F.W2T, DE, DE / 64, S, E, AM);
}


typedef short s16x4 __attribute__((ext_vector_type(4)));
__device__ __forceinline__ s16x4 vtr(LAS const unsigned char* p) { return __builtin_bit_cast(s16x4, __builtin_amdgcn_ds_read_tr16_b64_v4i16((LAS s16x4*)p)); }
__device__ __forceinline__ bf16x8 cat8(s16x4 a, s16x4 b) { return (bf16x8){a[0], a[1], a[2], a[3], b[0], b[1], b[2], b[3]}; }
template <bool EARLY>
__device__ __forceinline__ void p2_attn_fast(const Frame& F) {
    const int lane = F.lane, r32 = lane & 31, hi = lane >> 5;
    LAS unsigned char* vl = F.lds + F.wave * 16640;
    LAS const unsigned char* vrd = vl + (4 * hi + ((lane & 15) >> 2)) * 64 + ((lane >> 4) & 1) * 32 + (lane & 3) * 8;
    const int gw = blockIdx.x * NWAVES + F.wave, NGW = F.G * NWAVES;
    for (int item = gw; item < BATCH * NH * (SEQ / 32); item += NGW) {
        const int qi = item >> 6, bh = item & 63, b = bh >> 3, h = bh & 7;
        const size_t rowbase = (size_t)b * SEQ;
        bf16x8 qf[4];
        { const bf16* qp = F.ZZ + (rowbase + 32 * qi + r32) * INC + ZQ + h * HD + 8 * hi;
#pragma unroll
          for (int d0 = 0; d0 < 4; ++d0) qf[d0] = *(const bf16x8*)(qp + 16 * d0); }
        f32x16 o[2]; o[0] = f32x16{}; o[1] = f32x16{};
        float carry = 1.0f;
        bf16x8 kn[4]; u32x4 vn[4];
#define ATT_LOAD(j) do { const bf16* kp = F.ZZ + (rowbase + 32 * (j) + r32) * INC + ZK + h * HD + 8 * hi; \
            _Pragma("unroll") for (int d0 = 0; d0 < 4; ++d0) kn[d0] = *(const bf16x8*)(kp + 16 * d0); \
            _Pragma("unroll") for (int i = 0; i < 4; ++i) { const int L = i * 64 + lane; \
                vn[i] = *(const u32x4*)(F.ZZ + (rowbase + 32 * (j) + ((L >> 2) & 31)) * INC + ZV + h * HD + (L >> 7) * 32 + (L & 3) * 8); } } while (0)
        ATT_LOAD(qi);
        for (int j = qi; j >= 0; --j) {
            bf16x8 kf[4];
#pragma unroll
            for (int d0 = 0; d0 < 4; ++d0) kf[d0] = kn[d0];
#pragma unroll
            for (int i = 0; i < 4; ++i) *(LAS u32x4*)(vl + (i * 64 + lane) * 16) = vn[i];
            if (j > 0) ATT_LOAD(j - 1);
            f32x16 p = f32x16{};
#pragma unroll
            for (int d0 = 0; d0 < 4; ++d0) p = __builtin_amdgcn_mfma_f32_32x32x16_bf16(kf[d0], qf[d0], p, 0, 0, 0);
            float e[16], sfx[16];
#pragma unroll
            for (int r = 0; r < 16; ++r) { const float z = fminf(p[r], 100.f); e[r] = __builtin_amdgcn_exp2f(z); sfx[r] = __builtin_amdgcn_rcpf(1.0f + e[r]); }
            if (j == qi) {
#pragma unroll
                for (int r = 0; r < 16; ++r) { const bool ok = crow(r, hi) < r32; e[r] = ok ? e[r] : 0.f; sfx[r] = ok ? sfx[r] : 1.f; }
            }
            float TL[4], TH[4];
#pragma unroll
            for (int g = 0; g < 4; ++g) {
                sfx[4 * g + 2] *= sfx[4 * g + 3]; sfx[4 * g + 1] *= sfx[4 * g + 2]; sfx[4 * g] *= sfx[4 * g + 1];
                const auto rr = __builtin_amdgcn_permlane32_swap(__float_as_uint(sfx[4 * g]), __float_as_uint(sfx[4 * g]), false, false);
                TL[g] = __uint_as_float(rr[0]); TH[g] = __uint_as_float(rr[1]); }
            float R[8];
            R[7] = carry; R[6] = R[7] * TH[3]; R[5] = R[6] * TL[3]; R[4] = R[5] * TH[2]; R[3] = R[4] * TL[2]; R[2] = R[3] * TH[1]; R[1] = R[2] * TL[1]; R[0] = R[1] * TH[0]; carry = R[0] * TL[0];
            unsigned pw[8];
#pragma unroll
            for (int g = 0; g < 4; ++g) { const float off = hi ? R[2 * g + 1] : R[2 * g];
                const float w0 = e[4 * g] * (off * sfx[4 * g]), w1 = e[4 * g + 1] * (off * sfx[4 * g + 1]), w2 = e[4 * g + 2] * (off * sfx[4 * g + 2]), w3 = e[4 * g + 3] * (off * sfx[4 * g + 3]);
                pw[2 * g] = pg::cvt_pk_bf16(w0, w1); pw[2 * g + 1] = pg::cvt_pk_bf16(w2, w3); }
            const bf16x8 pa0 = __builtin_bit_cast(bf16x8, (u32x4){pw[0], pw[1], pw[2], pw[3]}), pa1 = __builtin_bit_cast(bf16x8, (u32x4){pw[4], pw[5], pw[6], pw[7]});
            asm volatile("s_waitcnt lgkmcnt(0)" ::: "memory");
#pragma unroll
            for (int d0 = 0; d0 < 2; ++d0) {
                const s16x4 a0 = vtr(vrd + d0 * 2048), a1 = vtr(vrd + d0 * 2048 + 512), b0 = vtr(vrd + d0 * 2048 + 1024), b1 = vtr(vrd + d0 * 2048 + 1536);
                o[d0] = __builtin_amdgcn_mfma_f32_32x32x16_bf16(pa0, cat8(a0, a1), o[d0], 0, 0, 0);
                o[d0] = __builtin_amdgcn_mfma_f32_32x32x16_bf16(pa1, cat8(b0, b1), o[d0], 0, 0, 0);
            }
            asm volatile("s_waitcnt lgkmcnt(0)" ::: "memory");
            if (EARLY && __all(carry == 0.f)) break;
        }
#undef ATT_LOAD
        bf16* op = F.OAB + (rowbase + 32 * qi) * D + h * HD + r32;
#pragma unroll
        for (int d0 = 0; d0 < 2; ++d0)
#pragma unroll
            for (int r = 0; r < 16; ++r) op[(size_t)crow(r, hi) * D + 32 * d0] = (bf16)f2bf(o[d0][r]);
    }
}
__device__ __forceinline__ void p2_sgu_fast(const Frame& F) {
    const int lane = F.lane, r32 = lane & 31, hi = lane >> 5, g = F.wave;
    for (int unit = blockIdx.x; unit < T / 128; unit += F.G) {
        const int row0 = unit * 128;
        __syncthreads();
        {
            u32x4 w[16]; float sm[16], rs[16];
#pragma unroll
            for (int i = 0; i < 16; ++i) w[i] = *(const u32x4*)(F.ZZ + (size_t)(row0 + g * 16 + i) * INC + ZVS + 8 * lane);
#pragma unroll
            for (int i = 0; i < 16; ++i) { float f[8]; unpack8(w[i], f); sm[i] = ((f[0] + f[1]) + (f[2] + f[3])) + ((f[4] + f[5]) + (f[6] + f[7])); }
#pragma unroll
            for (int o = 1; o < 64; o <<= 1)
#pragma unroll
                for (int i = 0; i < 16; ++i) sm[i] += __shfl_xor(sm[i], o);
#pragma unroll
            for (int i = 0; i < 16; ++i) { sm[i] *= (1.f / 512.f); float f[8]; unpack8(w[i], f); float q = 0.f;
#pragma unroll
                for (int j = 0; j < 8; ++j) { const float d = f[j] - sm[i]; q += d * d; }
                rs[i] = q; }
#pragma unroll
            for (int o = 1; o < 64; o <<= 1)
#pragma unroll
                for (int i = 0; i < 16; ++i) rs[i] += __shfl_xor(rs[i], o);
            const f32x4 g0 = *(const f32x4*)(F.sgu_norm + 8 * lane), g1 = *(const f32x4*)(F.sgu_norm + 8 * lane + 4);
#pragma unroll
            for (int i = 0; i < 16; ++i) { const float rstd = rsqrtf(rs[i] * (1.f / 512.f) + EPS), mean = sm[i]; float f[8]; unpack8(w[i], f);
                u32x4 o; o.x = pk2((f[0] - mean) * rstd * g0.x, (f[1] - mean) * rstd * g0.y); o.y = pk2((f[2] - mean) * rstd * g0.z, (f[3] - mean) * rstd * g0.w);
                o.z = pk2((f[4] - mean) * rstd * g1.x, (f[5] - mean) * rstd * g1.y); o.w = pk2((f[6] - mean) * rstd * g1.z, (f[7] - mean) * rstd * g1.w);
                *(LAS u32x4*)(F.lds + (lane >> 2) * 8192 + (g * 16 + i) * 64 + (lane & 3) * 16) = o; }
        }
        __syncthreads();
        LAS const unsigned char* vrd = F.lds + (2 * g) * 8192 + (8 * hi + ((lane & 15) >> 2)) * 64 + ((lane >> 4) & 1) * 32 + (lane & 3) * 8;
        f32x16 acc[4][2];
#pragma unroll
        for (int mt = 0; mt < 4; ++mt) {
            acc[mt][0] = f32x16{}; acc[mt][1] = f32x16{};
            const bf16* ap = F.SGUW + ((size_t)g * 128 + 32 * mt + r32) * 128 + 8 * hi;
            const int nks = (mt < 2) ? 4 : 8;
#pragma unroll 1
            for (int ks = 0; ks < nks; ++ks) {
                const bf16x8 a = *(const bf16x8*)(ap + 16 * ks);
#pragma unroll
                for (int nt = 0; nt < 2; ++nt) {
                    const s16x4 b0 = vtr(vrd + nt * 8192 + ks * 1024), b1 = vtr(vrd + nt * 8192 + ks * 1024 + 256);
                    acc[mt][nt] = __builtin_amdgcn_mfma_f32_32x32x16_bf16(a, cat8(b0, b1), acc[mt][nt], 0, 0, 0);
                }
            }
        }
        asm volatile("s_waitcnt lgkmcnt(0)" ::: "memory");
        LAS bf16* stg = (LAS bf16*)(F.lds + (2 * g) * 8192);
#pragma unroll
        for (int mt = 0; mt < 4; ++mt)
#pragma unroll
            for (int r = 0; r < 16; ++r) { const int tl = 32 * mt + crow(r, hi); const float bs = F.sgu_b[g * 128 + tl];
#pragma unroll
                for (int nt = 0; nt < 2; ++nt) stg[tl * 64 + 32 * nt + r32] = (bf16)f2bf(acc[mt][nt][r] + bs); }
        asm volatile("s_waitcnt lgkmcnt(0)" ::: "memory");
#pragma unroll 4
        for (int i = 0; i < 16; ++i) { const int tl = 8 * i + (lane >> 3), ch8 = (lane & 7) * 8;
            float sv[8], uu[8]; unpack8(*(const LAS u32x4*)(stg + tl * 64 + ch8), sv); unpack8(*(const u32x4*)(F.ZZ + (size_t)(row0 + tl) * INC + ZU + 64 * g + ch8), uu);
            u32x4 o; o.x = pk2(uu[0] * sv[0], uu[1] * sv[1]); o.y = pk2(uu[2] * sv[2], uu[3] * sv[3]); o.z = pk2(uu[4] * sv[4], uu[5] * sv[5]); o.w = pk2(uu[6] * sv[6], uu[7] * sv[7]);
            *(u32x4*)(F.OAB + (size_t)(row0 + tl) * D + 512 + 64 * g + ch8) = o; }
    }
    __syncthreads();
}


__device__ __forceinline__ void p5_fast(const Frame& F) {
    LAS unsigned* hist = (LAS unsigned*)F.lds;
    LAS unsigned* base = hist + 32;
    LAS unsigned* lsel = hist + 64;
    LAS float* lgate = (LAS float*)(hist + 64 + 512);
    LAS float* rsv = lgate + 512;
    LAS float* part = (LAS float*)(F.lds + 8192);
    const int lane = F.lane, r32 = lane & 31, hi = lane >> 5, wg4 = F.wave & 3, kh = F.wave >> 2;
    for (int chunk = blockIdx.x; chunk < T / 128; chunk += F.G) {
        if (F.tid < 32) hist[F.tid] = 0u;
        const int t0 = chunk * 128 + wg4 * 32;
        const bf16* hp = F.H1 + (size_t)(t0 + r32) * D + kh * 512 + 8 * hi;
        const bf16* whp = F.WRHI + r32 * D + kh * 512 + 8 * hi;
        const bf16* wlp = F.WRLO + r32 * D + kh * 512 + 8 * hi;
        f32x16 acc = f32x16{}; float ss = 0.f;
#pragma unroll 8
        for (int k0 = 0; k0 < 512; k0 += 16) {
            const u32x4 hb = *(const u32x4*)(hp + k0);
            const bf16x8 ah = *(const bf16x8*)(whp + k0), al = *(const bf16x8*)(wlp + k0);
            const bf16x8 bb = __builtin_bit_cast(bf16x8, hb);
            acc = __builtin_amdgcn_mfma_f32_32x32x16_bf16(ah, bb, acc, 0, 0, 0);
            acc = __builtin_amdgcn_mfma_f32_32x32x16_bf16(al, bb, acc, 0, 0, 0);
#pragma unroll
            for (int q = 0; q < 4; ++q) { const float lo = __uint_as_float(hb[q] << 16), hh = __uint_as_float(hb[q] & 0xffff0000u); ss += lo * lo + hh * hh; }
        }
        { const auto rr = __builtin_amdgcn_permlane32_swap(__float_as_uint(ss), __float_as_uint(ss), false, false); ss = __uint_as_float(rr[0]) + __uint_as_float(rr[1]); }
        if (kh == 1) {
#pragma unroll
            for (int r = 0; r < 16; ++r) part[(wg4 * 17 + r) * 64 + lane] = acc[r];
            part[(wg4 * 17 + 16) * 64 + lane] = ss;
        }
        __syncthreads();
        if (kh == 0) {
            ss += part[(wg4 * 17 + 16) * 64 + lane];
            const float rstd = rsqrtf(ss * (1.f / D) + EPS);
            float v[16];
#pragma unroll
            for (int r = 0; r < 16; ++r) v[r] = rstd * (acc[r] + part[(wg4 * 17 + r) * 64 + lane]) + F.b_router[crow(r, hi)];
            float cv[8]; int ce[8];
#pragma unroll
            for (int k = 0; k < 4; ++k) {
                float m = v[0];
#pragma unroll
                for (int r = 1; r < 16; ++r) m = fmaxf(m, v[r]);
                int idx = 15;
#pragma unroll
                for (int r = 14; r >= 0; --r) idx = (v[r] == m) ? r : idx;
                cv[k] = m; ce[k] = (idx & 3) + 8 * (idx >> 2) + 4 * hi;
#pragma unroll
                for (int r = 0; r < 16; ++r) v[r] = (r == idx) ? -INFINITY : v[r];
            }
#pragma unroll
            for (int k = 0; k < 4; ++k) {
                const auto rv = __builtin_amdgcn_permlane32_swap(__float_as_uint(cv[k]), __float_as_uint(cv[k]), false, false);
                const auto re = __builtin_amdgcn_permlane32_swap((unsigned)ce[k], (unsigned)ce[k], false, false);
                cv[4 + k] = __uint_as_float(hi ? rv[0] : rv[1]); ce[4 + k] = (int)(hi ? re[0] : re[1]);
            }
            float tv[4]; int te[4];
#pragma unroll
            for (int k = 0; k < 4; ++k) {
                float bv = cv[0]; int be = ce[0];
#pragma unroll
                for (int c = 1; c < 8; ++c) { const bool better = (cv[c] > bv) || (cv[c] == bv && ce[c] < be); bv = better ? cv[c] : bv; be = better ? ce[c] : be; }
                tv[k] = bv; te[k] = be;
#pragma unroll
                for (int c = 0; c < 8; ++c) cv[c] = (ce[c] == be) ? -INFINITY : cv[c];
            }
            float ex[4], sum = 0.f;
#pragma unroll
            for (int k = 0; k < 4; ++k) { ex[k] = __expf(tv[k] - tv[0]); sum += ex[k]; }
            if (hi == 0) { const int tl = wg4 * 32 + r32; rsv[tl] = rstd;
#pragma unroll
                for (int k = 0; k < 4; ++k) { const unsigned loc = atomicAdd((unsigned*)&hist[te[k]], 1u); lsel[tl * 4 + k] = (unsigned)te[k] | (loc << 8); lgate[tl * 4 + k] = ex[k] / sum; } }
        }
        __syncthreads();
        if (F.tid < 32) { const unsigned n = hist[F.tid]; base[F.tid] = n ? __hip_atomic_fetch_add(F.ctl + CW_CNT + 64 * F.tid, n, __ATOMIC_RELAXED, __HIP_MEMORY_SCOPE_AGENT) : 0u; }
        __syncthreads();
        { const int tl = F.tid >> 2, r = F.tid & 3, t = chunk * 128 + tl; const unsigned sl = lsel[tl * 4 + r]; const int ee = sl & 255; const unsigned rank = base[ee] + (sl >> 8);
          F.TOKLIST[ee * LCAP + rank] = t; F.SLOTREF[t * 4 + r] = (ee << 16) | rank; F.GATE[t * 4 + r] = lgate[tl * 4 + r]; }
#pragma unroll 8
        for (int i = 0; i < 16; ++i) {
            const int tl = F.wave * 16 + i, t = chunk * 128 + tl; const float rstd = rsv[tl];
            const u32x4* hr = (const u32x4*)(F.H1 + (size_t)t * D);
            if (FP8_1) {
                float f[8], g[8]; unpack8(hr[2 * lane], f); unpack8(hr[2 * lane + 1], g); const float sc = rstd * SC_ACT;
                u32x4 o; o.x = pk4_fp8(f[0] * sc, f[1] * sc, f[2] * sc, f[3] * sc); o.y = pk4_fp8(f[4] * sc, f[5] * sc, f[6] * sc, f[7] * sc);
                o.z = pk4_fp8(g[0] * sc, g[1] * sc, g[2] * sc, g[3] * sc); o.w = pk4_fp8(g[4] * sc, g[5] * sc, g[6] * sc, g[7] * sc);
                *(u32x4*)((unsigned char*)F.ABF + (size_t)t * D + 16 * lane) = o;
            } else { u32x4* cr = (u32x4*)(F.ABF + (size_t)t * D);
#pragma unroll
            for (int j = 0; j < 2; ++j) { float f[8]; unpack8(hr[lane + 64 * j], f); u32x4 o; o.x = pk2(f[0] * rstd, f[1] * rstd); o.y = pk2(f[2] * rstd, f[3] * rstd); o.z = pk2(f[4] * rstd, f[5] * rstd); o.w = pk2(f[6] * rstd, f[7] * rstd); cr[lane + 64 * j] = o; } }
        }
        __syncthreads();
    }
}

struct Args { const float* in[21]; float* out; unsigned char* ws; int ph_lo, ph_hi; };
__global__ void __launch_bounds__(NTHREADS, 2) fwd(Args args) {
    extern __shared__ __attribute__((aligned(16))) unsigned char lds[];
    Frame F;
    F.lds = (LAS unsigned char*)lds; F.MISC = (volatile LAS unsigned*)(F.lds + MISC_OFF);
    F.tid = threadIdx.x; F.lane = F.tid & 63; F.wave = __builtin_amdgcn_readfirstlane(F.tid >> 6); F.G = gridDim.x;
    unsigned char* ws = args.ws;
    F.ctl = (unsigned*)(ws + WS_CTL);
    F.x = args.in[0]; F.p = args.in[1]; F.g_mix = args.in[2]; F.w_in = args.in[3]; F.w_out_a = args.in[4]; F.w_out_b = args.in[5]; F.w_out = args.in[6];
    F.sgu_norm = args.in[7]; F.sgu_w = args.in[8]; F.sgu_b = args.in[9]; F.g_moe = args.in[10]; F.w_router = args.in[11]; F.b_router = args.in[12];
    F.w1 = args.in[13]; F.b1 = args.in[14]; F.w2 = args.in[15]; F.b2 = args.in[16]; F.g_ple = args.in[17]; F.w_ple_gate = args.in[18]; F.w_ple_proj = args.in[19]; F.g_final = args.in[20];
    F.out = args.out;
    F.WRHI = (bf16*)(ws + WS_WRHI); F.WRLO = (bf16*)(ws + WS_WRLO); F.SGUW = (bf16*)(ws + WS_SGUW); F.WIN = (bf16*)(ws + WS_WIN); F.WAB = (bf16*)(ws + WS_WAB);
    F.WOUT = (bf16*)(ws + WS_WOUT); F.WPG = (bf16*)(ws + WS_WPG); F.WPP = (bf16*)(ws + WS_WPP); F.W1T = (bf16*)(ws + WS_W1); F.W2T = (bf16*)(ws + WS_W2);
    F.PBF = (bf16*)(ws + WS_PBF); F.PROJ = (bf16*)(ws + WS_PROJ); F.H1 = (bf16*)(ws + WS_H1); F.ZZ = (bf16*)(ws + WS_ZZ); F.HID = (bf16*)(ws + WS_HID);
    F.H2 = (bf16*)(ws + WS_H2); F.H3 = (bf16*)(ws + WS_H3); F.ABF = (bf16*)(ws + WS_ABF); F.OAB = (bf16*)(ws + WS_OAB); F.MERGED = (bf16*)(ws + WS_MERGED); F.YS = (bf16*)(ws + WS_YS);
    F.RSTD1 = (float*)(ws + WS_RSTD1); F.RSTD2 = (float*)(ws + WS_RSTD2); F.GATE = (float*)(ws + WS_GATE);
    F.TOKLIST = (int*)(ws + WS_TOKLIST); F.SLOTREF = (int*)(ws + WS_SLOTREF);
    for (int u = F.tid; u < (LDS_BYTES - MISC_OFF) / 4; u += NTHREADS) ((LAS unsigned*)(F.lds + MISC_OFF))[u] = 0u;
    __syncthreads();
    XcdBarrier bar = xcd_barrier_post(F.ctl + CW_BAR, F.MISC + 8);
    const int lo = args.ph_lo, hi = args.ph_hi;
#define IN(k) (lo <= (k) && (k) < hi)
#define SEAM(k) do { if (IN(k) && IN((k) + 1)) xcd_barrier(bar); } while (0)
    if (IN(0)) { p0_prologue(F); } SEAM(0);
    if (IN(1)) { { if (OPT_P1) p1_fast(F); else p1_inproj(F); } } SEAM(1);
    if (IN(2)) {
        const bool sgu_first = (blockIdx.x & 1) != 0;
        if (sgu_first) { if (OPT_SGU) p2_sgu_fast(F); else p2_sgu_simple(F); }
        if (OPT_ATT) { if (F.wave & 1) { moe_weight_items(F); p2_attn_fast<ATT_EARLY>(F); } else { p2_attn_fast<ATT_EARLY>(F); moe_weight_items(F); } } else { moe_weight_items(F); __syncthreads(); p2_attn_scalar<false>(F); }
        if (!sgu_first) { __syncthreads(); if (OPT_SGU) p2_sgu_fast(F); else p2_sgu_simple(F); }
    } SEAM(2);
    if (IN(3)) { { if (OPT_P3) p3_fast(F); else p3_merge(F); } } SEAM(3);
    if (IN(4)) { { if (OPT_P4) p4_fast(F); else p4_out(F); } } SEAM(4);
    if (IN(5)) { if (OPT_P5) p5_fast(F); else p5_router(F); } SEAM(5);
    if (IN(6)) { { if (OPT_P6) p6_fast(F); else p6_moe1(F); } } SEAM(6);
    if (IN(7)) { { if (OPT_P7) p7_fast(F); else p7_moe2(F); } } SEAM(7);
    if (IN(8)) { p8_combine(F); } SEAM(8);
    if (IN(9)) { { if (OPT_P9) p9_fast(F); else p9_ple(F); } } SEAM(9);
    if (IN(10)) { p10_final(F); }
#undef IN
#undef SEAM
}

extern "C" void kernel_launch(void* const* d_in, const int* in_sizes, int n_in, void* d_out, int out_size, void* d_ws, size_t ws_size, hipStream_t stream) {
    static int grid = 0;
    if (grid == 0) {
        if (n_in != 21 || out_size != T * D || ws_size < WS_END) { fprintf(stderr, "kernel_launch: unexpected shapes (n_in %d out %d ws %zu)\n", n_in, out_size, ws_size); grid = -1; return; }
        int dev = 0, cus = 0;
        if (hipGetDevice(&dev) != hipSuccess || hipDeviceGetAttribute(&cus, hipDeviceAttributeMultiprocessorCount, dev) != hipSuccess) { grid = -1; return; }
        if (hipFuncSetAttribute((const void*)fwd, hipFuncAttributeMaxDynamicSharedMemorySize, LDS_BYTES) != hipSuccess) { fprintf(stderr, "kernel_launch: hipFuncSetAttribute failed\n"); grid = -1; return; }
        int per_cu = 0;
        if (hipOccupancyMaxActiveBlocksPerMultiprocessor(&per_cu, (const void*)fwd, NTHREADS, LDS_BYTES) != hipSuccess || per_cu < 1) fprintf(stderr, "kernel_launch: occupancy query says %d\n", per_cu);
        (void)hipGetLastError();
        if (cus < 256) { fprintf(stderr, "kernel_launch: needs >= 256 CUs, found %d\n", cus); grid = -1; return; }
        grid = 256;
    }
    if (grid < 0) return;
    (void)hipMemsetAsync((char*)d_ws + WS_CTL, 0, CTL_ZERO_BYTES, stream);
    Args a{};
    for (int i = 0; i < 21; ++i) a.in[i] = (const float*)d_in[i];
    a.out = (float*)d_out; a.ws = (unsigned char*)d_ws; a.ph_lo = 0; a.ph_hi = 11;
    hipLaunchKernelGGL(fwd, dim3(grid), dim3(NTHREADS), LDS_BYTES, stream, a);
}
```

```cpp
#include <hip/hip_runtime.h>
#include <cstdio>
#include <cstdint>

#define GAS __attribute__((address_space(1)))
#define LAS __attribute__((address_space(3)))
typedef unsigned short bf16;
typedef short bf16x8 __attribute__((ext_vector_type(8)));
typedef float f32x4 __attribute__((ext_vector_type(4)));
typedef float f32x16 __attribute__((ext_vector_type(16)));
typedef unsigned u32x4 __attribute__((ext_vector_type(4)));
typedef unsigned u32x2 __attribute__((ext_vector_type(2)));

#ifndef OPT_P1
#define OPT_P1 1
#endif
#ifndef OPT_P3
#define OPT_P3 1
#endif
#ifndef OPT_P4
#define OPT_P4 1
#endif
#ifndef OPT_P6
#define OPT_P6 1
#endif
#ifndef OPT_P7
#define OPT_P7 1
#endif
#ifndef OPT_ATT
#define OPT_ATT 1
#endif
#ifndef OPT_SGU
#define OPT_SGU 1
#endif
#ifndef ATT_EARLY
#define ATT_EARLY true
#endif
#ifndef OPT_P5
#define OPT_P5 1
#endif
#ifndef MOE_FP8_1
#define MOE_FP8_1 1
#endif
#ifndef MOE_FP8_2
#define MOE_FP8_2 1
#endif
#ifndef OPT_P9
#define OPT_P9 1
#endif
constexpr int BATCH = 8, SEQ = 4096, T = BATCH * SEQ, D = 1024, PLE = 256, NH = 8, HD = 64, NE = 32, DE = 1024, INC = 4608;
constexpr int ZQ = 0, ZK = 512, ZV = 1024, ZU = 1536, ZVS = 2048, ZGA = 2560, ZGB = 3584;
constexpr float EPS = 1e-6f;
constexpr float LOG2E = 1.4426950408889634f;
constexpr float QSCALE = 0.125f * LOG2E;
constexpr int LCAP = 32768;
constexpr int HROWS = 139264;

constexpr size_t MiB = 1u << 20;
constexpr size_t WS_CTL = 0, CTL_ZERO_BYTES = 1 * MiB;
constexpr size_t WS_WRHI = 1 * MiB, WS_WRLO = WS_WRHI + 65536, WS_SGUW = WS_WRLO + 65536;
constexpr size_t WS_RSTD1 = WS_SGUW + 262144, WS_RSTD2 = WS_RSTD1 + 131072;
constexpr size_t WS_WIN = 2 * MiB, WS_WAB = 11 * MiB, WS_WOUT = 13 * MiB, WS_WPG = 15 * MiB, WS_WPP = 17 * MiB;
constexpr size_t WS_TOKLIST = 18 * MiB, WS_SLOTREF = 22 * MiB, WS_GATE = WS_SLOTREF + 524288;
constexpr size_t WS_W1 = 28 * MiB, WS_W2 = 156 * MiB, WS_PBF = 220 * MiB, WS_PROJ = 236 * MiB, WS_H1 = 300 * MiB;
constexpr size_t WS_R1 = 364 * MiB;
constexpr size_t WS_ZZ = WS_R1, WS_HID = WS_R1, WS_H2 = WS_R1, WS_H3 = WS_R1 + 64 * MiB;
constexpr size_t WS_R2 = 652 * MiB;
constexpr size_t WS_ABF = WS_R2, WS_OAB = WS_R2 + 64 * MiB, WS_MERGED = WS_R2 + 128 * MiB, WS_YS = WS_R2;
constexpr size_t WS_END = 924 * MiB;
constexpr int CW_BAR = 4096, CW_CNT = 8192;

constexpr int STAGE_OFF = 0, TAB_OFF = 131072, BIAS_OFF = 149504, MISC_OFF = 151552;
constexpr int LDS_BYTES = 152576;
constexpr int NWAVES = 8, NTHREADS = 512;

#define LDS_WAIT() asm volatile("s_waitcnt lgkmcnt(0)" ::: "memory")
__device__ __forceinline__ float bf2f(unsigned v) { return __uint_as_float(v << 16); }
__device__ __forceinline__ unsigned f2bf(float f) { unsigned u = __float_as_uint(f); return (u + 0x7fffu + ((u >> 16) & 1u)) >> 16; }
__device__ __forceinline__ unsigned pk2(float lo, float hi) { return f2bf(lo) | (f2bf(hi) << 16); }
__device__ __forceinline__ float wave_sum(float v) {
#pragma unroll
    for (int o = 1; o < 64; o <<= 1) v += __shfl_xor(v, o);
    return v;
}
__device__ __forceinline__ float wave_max(float v) {
#pragma unroll
    for (int o = 1; o < 64; o <<= 1) v = fmaxf(v, __shfl_xor(v, o));
    return v;
}
__device__ __forceinline__ float sigmoidf_(float x) { return 1.0f / (1.0f + __expf(-x)); }
__device__ __forceinline__ float gelu_tanh(float x) {
    const float u = 1.5957691216057308f * (x + 0.044715f * x * x * x);
    return x * sigmoidf_(u);
}
__device__ __forceinline__ int crow(int r, int hi) { return (r & 3) + 8 * (r >> 2) + 4 * hi; }
__device__ __forceinline__ void unpack8(const u32x4 w, float (&f)[8]) {
    f[0] = bf2f(w.x & 0xffffu); f[1] = bf2f(w.x >> 16); f[2] = bf2f(w.y & 0xffffu); f[3] = bf2f(w.y >> 16);
    f[4] = bf2f(w.z & 0xffffu); f[5] = bf2f(w.z >> 16); f[6] = bf2f(w.w & 0xffffu); f[7] = bf2f(w.w >> 16);
}

constexpr bool FP8_1 = MOE_FP8_1 && OPT_P5 && OPT_P6 && OPT_P7, FP8_2 = MOE_FP8_2 && OPT_P5 && OPT_P6 && OPT_P7;
constexpr float SC_ACT = 4.0f, SC_W = 64.0f, SC_INV = 1.0f / (SC_ACT * SC_W);
#ifndef YS_FP8
#define YS_FP8 1
#endif
constexpr bool YS8 = YS_FP8 && OPT_P7; constexpr float SC_Y = 16.0f;
typedef float f32x2v __attribute__((ext_vector_type(2)));
__device__ __forceinline__ void unpack4_fp8(unsigned w, float (&f)[4]) { const f32x2v lo = __builtin_amdgcn_cvt_pk_f32_fp8(w, false), hi = __builtin_amdgcn_cvt_pk_f32_fp8(w, true); f[0] = lo[0]; f[1] = lo[1]; f[2] = hi[0]; f[3] = hi[1]; }
__device__ __forceinline__ float clamp448(float v) { return fminf(fmaxf(v, -448.f), 448.f); }
__device__ __forceinline__ unsigned pk4_fp8(float a, float b, float c, float d) {
    unsigned w = __builtin_amdgcn_cvt_pk_fp8_f32(clamp448(a), clamp448(b), 0, false); return __builtin_amdgcn_cvt_pk_fp8_f32(clamp448(c), clamp448(d), w, true); }
#define XB_TMO      128
#define XB_XCNT(j)  (256  + 64 * (j))
#define XB_XSUB(j)  (1280 + 64 * (j))
#define XB_XGEN(j)  (2304 + 64 * (j))
#define XB_TOP      3328
#define XB_TOPGEN   3392
#define XCD_BAR_WORDS 3456
#define XB_SPIN_CAP (1u << 23)
__device__ __forceinline__ unsigned xb_ld(unsigned* p)              { return __hip_atomic_load(p, __ATOMIC_RELAXED, __HIP_MEMORY_SCOPE_AGENT); }
__device__ __forceinline__ unsigned xb_add(unsigned* p, unsigned v) { return __hip_atomic_fetch_add(p, v, __ATOMIC_RELAXED, __HIP_MEMORY_SCOPE_AGENT); }
__device__ __forceinline__ unsigned xb_xcc_id() { return (unsigned)__builtin_amdgcn_s_getreg((3 << 11) | 20) & 0xFu; }
#define XB_SPIN(cond, bar) do { unsigned _sp = 0; while (cond) { __builtin_amdgcn_s_sleep(1); \
    if ((++_sp & 255u) == 0u) { if (xb_ld(&(bar)[XB_TMO])) break; if (_sp > XB_SPIN_CAP) { atomicAdd(&(bar)[XB_TMO], 1u); break; } } } } while (0)
struct XcdBarrier { unsigned* bar; unsigned x; volatile LAS unsigned* st; };
__device__ __forceinline__ XcdBarrier xcd_barrier_post(unsigned* bar, volatile LAS unsigned* st) {
    XcdBarrier b; b.bar = bar; b.x = xb_xcc_id(); b.st = st;
    if (threadIdx.x == 0) (void)xb_add(&bar[XB_XCNT(b.x)], 1u);
    return b;
}
__device__ __forceinline__ void xcd_barrier_complete(unsigned* bar, unsigned x, unsigned& nloc, unsigned& nx) {
    const unsigned G = gridDim.x * gridDim.y * gridDim.z;
    unsigned sum, cnt, mine, sp = 0u;
    for (;;) {
        sum = 0u; cnt = 0u; mine = 0u;
#pragma unroll
        for (unsigned j = 0; j < 16; ++j) { const unsigned c = xb_ld(&bar[XB_XCNT(j)]); sum += c; cnt += (c > 0u) ? 1u : 0u; mine = (j == x) ? c : mine; }
        if (sum == G) break;
        __builtin_amdgcn_s_sleep(1);
        if ((++sp & 255u) == 0u) { if (xb_ld(&bar[XB_TMO])) break; if (sp > XB_SPIN_CAP) { atomicAdd(&bar[XB_TMO], 1u); break; } }
    }
    nloc = mine > 0u ? mine : 1u; nx = cnt > 0u ? cnt : 1u;
}
__device__ __forceinline__ void xcd_barrier(const XcdBarrier& b) {
    asm volatile("s_waitcnt vmcnt(0)" ::: "memory");
    __syncthreads();
    if (threadIdx.x == 0) {
        unsigned* bar = b.bar;
        __builtin_amdgcn_s_waitcnt(0);
        unsigned nloc = b.st[0], nx = b.st[1];
        if (nloc == 0u) { xcd_barrier_complete(bar, b.x, nloc, nx); b.st[0] = nloc; b.st[1] = nx; }
        const unsigned old = xb_add(&bar[XB_XSUB(b.x)], 1u);
        const unsigned gen = old / nloc;
        if (old + 1u == (gen + 1u) * nloc) {
            __builtin_amdgcn_fence(__ATOMIC_RELEASE, "agent");
            asm volatile("s_waitcnt vmcnt(0)" ::: "memory");
            const unsigned og = xb_add(&bar[XB_TOP], 1u);
            const unsigned tg = og / nx;
            if (og + 1u == (tg + 1u) * nx) xb_add(&bar[XB_TOPGEN], 1u);
            else XB_SPIN(xb_ld(&bar[XB_TOPGEN]) == tg, bar);
            __builtin_amdgcn_fence(__ATOMIC_ACQUIRE, "agent");
            xb_add(&bar[XB_XGEN(b.x)], 1u);
            asm volatile("s_waitcnt vmcnt(0)" ::: "memory");
        } else {
            XB_SPIN(xb_ld(&bar[XB_XGEN(b.x)]) == gen, bar);
            __builtin_amdgcn_fence(__ATOMIC_ACQUIRE, "agent");
            asm volatile("s_waitcnt vmcnt(0)" ::: "memory");
        }
    }
    __syncthreads();
}

struct Frame {
    LAS unsigned char* lds;
    volatile LAS unsigned* MISC;
    unsigned* ctl;
    int tid, lane, wave, G;
    const float *x, *p, *g_mix, *w_in, *w_out_a, *w_out_b, *w_out, *sgu_norm, *sgu_w, *sgu_b, *g_moe, *w_router, *b_router, *w1, *b1, *w2, *b2, *g_ple, *w_ple_gate, *w_ple_proj, *g_final;
    float* out;
    bf16 *WRHI, *WRLO, *SGUW, *WIN, *WAB, *WOUT, *WPG, *WPP, *W1T, *W2T, *PBF, *PROJ, *H1, *ZZ, *HID, *H2, *H3, *ABF, *OAB, *MERGED, *YS;
    float *RSTD1, *RSTD2, *GATE;
    int *TOKLIST, *SLOTREF;
};

template <int NB>
__device__ __forceinline__ void smma(const bf16* ap, const bf16* const (&bp)[NB], int K, f32x16 (&acc)[NB]) {
    for (int k0 = 0; k0 < K; k0 += 16) {
        const bf16x8 a = *(const bf16x8*)(ap + k0);
#pragma unroll
        for (int nb = 0; nb < NB; ++nb) { const bf16x8 b = *(const bf16x8*)(bp[nb] + k0); acc[nb] = __builtin_amdgcn_mfma_f32_32x32x16_bf16(a, b, acc[nb], 0, 0, 0); }
    }
}

struct RowId { __device__ __forceinline__ int operator()(int n) const { return n; } };
struct RowW1 { __device__ __forceinline__ int operator()(int n) const { const int hid = n >> 1; return 256 * (hid >> 7) + (hid & 127) + 128 * (n & 1); } };
template <class RM>
__device__ __forceinline__ void tr_item(const float* W, int N, const float* gk, bf16* WT, int ldt, int koff, RM rm, LAS float* scr, int kb, int nb, int lane, float sc = 1.0f) {
    const int k0 = kb * 64, n0 = nb * 64;
    f32x4 v[16];
#pragma unroll
    for (int i = 0; i < 16; ++i) v[i] = __builtin_nontemporal_load((const f32x4*)(W + (size_t)(k0 + 4 * i + (lane >> 4)) * N + n0 + (lane & 15) * 4));
#pragma unroll
    for (int i = 0; i < 16; ++i) {
        const int kk = 4 * i + (lane >> 4), n4 = (lane & 15) * 4;
        f32x4 x = v[i] * sc;
        if (gk) x = x * gk[k0 + kk];
        LAS float* s = scr + kk * 65 + n4;
        s[0] = x.x; s[1] = x.y; s[2] = x.z; s[3] = x.w;
    }
    LDS_WAIT(); asm volatile("" ::: "memory");
    const int c = lane & 7;
#pragma unroll
    for (int j = 0; j < 8; ++j) {
        const int n = (lane >> 3) + 8 * j;
        const LAS float* s = scr + (8 * c) * 65 + n;
        u32x4 o; o.x = pk2(s[0 * 65], s[1 * 65]); o.y = pk2(s[2 * 65], s[3 * 65]); o.z = pk2(s[4 * 65], s[5 * 65]); o.w = pk2(s[6 * 65], s[7 * 65]);
        *(u32x4*)(WT + (size_t)rm(n0 + n) * ldt + koff + k0 + 8 * c) = o;
    }
    LDS_WAIT(); asm volatile("" ::: "memory");
}
template <class RM>
__device__ __forceinline__ void tr_item8(const float* W, int N, const float* gk, unsigned char* WT8, int ldt, RM rm, LAS float* scr, int kb, int nb, int lane, float sc) {
    const int k0 = kb * 64, n0 = nb * 64;
    f32x4 v[16];
#pragma unroll
    for (int i = 0; i < 16; ++i) v[i] = __builtin_nontemporal_load((const f32x4*)(W + (size_t)(k0 + 4 * i + (lane >> 4)) * N + n0 + (lane & 15) * 4));
#pragma unroll
    for (int i = 0; i < 16; ++i) {
        const int kk = 4 * i + (lane >> 4), n4 = (lane & 15) * 4;
        f32x4 x = v[i] * sc;
        if (gk) x = x * gk[k0 + kk];
        LAS float* sp = scr + kk * 65 + n4;
        sp[0] = x.x; sp[1] = x.y; sp[2] = x.z; sp[3] = x.w;
    }
    LDS_WAIT(); asm volatile("" ::: "memory");
    const int c4 = lane & 3;
#pragma unroll
    for (int j = 0; j < 4; ++j) {
        const int n = (lane >> 2) + 16 * j;
        const LAS float* sp = scr + (16 * c4) * 65 + n;
        u32x4 o; o.x = pk4_fp8(sp[0 * 65], sp[1 * 65], sp[2 * 65], sp[3 * 65]); o.y = pk4_fp8(sp[4 * 65], sp[5 * 65], sp[6 * 65], sp[7 * 65]);
        o.z = pk4_fp8(sp[8 * 65], sp[9 * 65], sp[10 * 65], sp[11 * 65]); o.w = pk4_fp8(sp[12 * 65], sp[13 * 65], sp[14 * 65], sp[15 * 65]);
        *(u32x4*)(WT8 + (size_t)rm(n0 + n) * ldt + k0 + 16 * c4) = o;
    }
    LDS_WAIT(); asm volatile("" ::: "memory");
}
__device__ __forceinline__ void p0_prologue(const Frame& F) {
    LAS float* scr = (LAS float*)(F.lds + F.wave * 16640);
    const int gw = blockIdx.x * NWAVES + F.wave, NGW = F.G * NWAVES;
    constexpr int I_IN = 16 * 72, I_A = 8 * 16, I_B = 8 * 16, I_O = 16 * 16, I_PG = 16 * 16, I_PP = 4 * 16, I_W1 = NE * 16 * 32, I_W2 = NE * 16 * 16;
    constexpr int NITEMS = I_IN + I_A + I_B + I_O + I_PG + I_PP;
    for (int it = gw; it < NITEMS; it += NGW) {
        int r = it;
        if (r < I_IN) { tr_item(F.w_in, INC, nullptr, F.WIN, D, 0, RowId(), scr, r / 72, r % 72, F.lane, (r % 72) < 8 ? QSCALE : 1.0f); continue; } r -= I_IN;
        if (r < I_A) { tr_item(F.w_out_a, D, nullptr, F.WAB, D, 0, RowId(), scr, r / 16, r % 16, F.lane); continue; } r -= I_A;
        if (r < I_B) { tr_item(F.w_out_b, D, nullptr, F.WAB, D, 512, RowId(), scr, r / 16, r % 16, F.lane); continue; } r -= I_B;
        if (r < I_O) { tr_item(F.w_out, D, nullptr, F.WOUT, D, 0, RowId(), scr, r / 16, r % 16, F.lane); continue; } r -= I_O;
        if (r < I_PG) { tr_item(F.w_ple_gate, D, F.g_ple, F.WPG, D, 0, RowId(), scr, r / 16, r % 16, F.lane); continue; } r -= I_PG;
        { tr_item(F.w_ple_proj, D, nullptr, F.WPP, PLE, 0, RowId(), scr, r / 16, r % 16, F.lane); }
    }
    (void)I_W1; (void)I_W2;
    for (int m0 = 2 * gw; m0 < T; m0 += 2 * NGW) {
        f32x4 v[2][4];
#pragma unroll
        for (int u = 0; u < 2; ++u) { const f32x4* xr = (const f32x4*)(F.x + (size_t)(m0 + u) * D) + F.lane;
#pragma unroll
            for (int j = 0; j < 4; ++j) v[u][j] = __builtin_nontemporal_load(xr + 64 * j); }
#pragma unroll
        for (int u = 0; u < 2; ++u) { float s = 0.f;
#pragma unroll
            for (int j = 0; j < 4; ++j) s += (v[u][j].x * v[u][j].x + v[u][j].y * v[u][j].y) + (v[u][j].z * v[u][j].z + v[u][j].w * v[u][j].w);
            const float rstd = rsqrtf(wave_sum(s) * (1.f / D) + EPS);
            unsigned long long* o8 = (unsigned long long*)(F.ABF + (size_t)(m0 + u) * D) + F.lane;
#pragma unroll
            for (int j = 0; j < 4; ++j) { const f32x4 g = ((const f32x4*)F.g_mix)[F.lane + 64 * j];
                o8[64 * j] = (unsigned long long)pk2(v[u][j].x * rstd * g.x, v[u][j].y * rstd * g.y) | ((unsigned long long)pk2(v[u][j].z * rstd * g.z, v[u][j].w * rstd * g.w) << 32); } }
    }
    for (int m0 = 4 * gw; m0 < T; m0 += 4 * NGW) {
        f32x4 v[4];
#pragma unroll
        for (int u = 0; u < 4; ++u) v[u] = __builtin_nontemporal_load((const f32x4*)(F.p + (size_t)(m0 + u) * PLE) + F.lane);
#pragma unroll
        for (int u = 0; u < 4; ++u) ((unsigned long long*)(F.PBF + (size_t)(m0 + u) * PLE))[F.lane] = (unsigned long long)pk2(v[u].x, v[u].y) | ((unsigned long long)pk2(v[u].z, v[u].w) << 32);
    }
    const int gt = blockIdx.x * NTHREADS + F.tid, NGT = F.G * NTHREADS;
    for (int i = gt; i < NE * D; i += NGT) { const int e = i / D, k = i % D; const float v = F.w_router[k * NE + e] * F.g_moe[k]; const unsigned h = f2bf(v); F.WRHI[i] = (bf16)h; F.WRLO[i] = (bf16)f2bf(v - bf2f(h)); }
    for (int i = gt; i < 8 * 128 * 128; i += NGT) { const int t = (i >> 7) & 127, s = i & 127; F.SGUW[i] = (bf16)(((s >> 6) <= (t >> 6)) ? f2bf(F.sgu_w[i]) : 0u); }
}

struct TrItem { const float* W; const float* gk; unsigned char* out; int N, ldt, kb, nb, w1; };
__device__ __forceinline__ TrItem moe_item(const Frame& F, int r) {
    constexpr int I_W1 = NE * 16 * 32;
    TrItem t;
    if (r < I_W1) { const int e = r / 512, q = r % 512; t.W = F.w1 + (size_t)e * D * 2 * DE; t.gk = F.g_moe; t.N = 2 * DE; t.kb = q / 32; t.nb = q % 32; t.w1 = 1;
        t.out = (unsigned char*)F.W1T + (size_t)e * 2 * DE * D * (FP8_1 ? 1 : 2); t.ldt = D * (FP8_1 ? 1 : 2); }
    else { r -= I_W1; const int e = r / 256, q = r % 256; t.W = F.w2 + (size_t)e * DE * D; t.gk = nullptr; t.N = D; t.kb = q / 16; t.nb = q % 16; t.w1 = 0;
        t.out = (unsigned char*)F.W2T + (size_t)e * D * DE * (FP8_2 ? 1 : 2); t.ldt = DE * (FP8_2 ? 1 : 2); }
    return t;
}
__device__ __forceinline__ void tr_load(f32x4 (&v)[16], const TrItem& t, int lane) {
#pragma unroll
    for (int i = 0; i < 16; ++i) v[i] = __builtin_nontemporal_load((const f32x4*)(t.W + (size_t)(t.kb * 64 + 4 * i + (lane >> 4)) * t.N + t.nb * 64 + (lane & 15) * 4));
}
__device__ __forceinline__ void tr_finish(const f32x4 (&v)[16], const TrItem& t, LAS float* scr, int lane) {
    const int k0 = t.kb * 64, n0 = t.nb * 64; const bool f8 = t.w1 ? FP8_1 : FP8_2; const float sc = f8 ? SC_W : 1.0f;
#pragma unroll
    for (int i = 0; i < 16; ++i) {
        const int kk = 4 * i + (lane >> 4), n4 = (lane & 15) * 4;
        f32x4 x = v[i] * sc;
        if (t.gk) x = x * t.gk[k0 + kk];
        LAS float* sp = scr + kk * 65 + n4;
        sp[0] = x.x; sp[1] = x.y; sp[2] = x.z; sp[3] = x.w;
    }
    LDS_WAIT(); asm volatile("" ::: "memory");
    if (f8) { const int c4 = lane & 3;
#pragma unroll
        for (int j = 0; j < 4; ++j) { const int n = (lane >> 2) + 16 * j, nn = n0 + n, row = t.w1 ? RowW1()(nn) : nn;
            const LAS float* sp = scr + (16 * c4) * 65 + n;
            u32x4 o; o.x = pk4_fp8(sp[0 * 65], sp[1 * 65], sp[2 * 65], sp[3 * 65]); o.y = pk4_fp8(sp[4 * 65], sp[5 * 65], sp[6 * 65], sp[7 * 65]);
            o.z = pk4_fp8(sp[8 * 65], sp[9 * 65], sp[10 * 65], sp[11 * 65]); o.w = pk4_fp8(sp[12 * 65], sp[13 * 65], sp[14 * 65], sp[15 * 65]);
            *(u32x4*)(t.out + (size_t)row * t.ldt + k0 + 16 * c4) = o; } }
    else { const int c = lane & 7;
#pragma unroll
        for (int j = 0; j < 8; ++j) { const int n = (lane >> 3) + 8 * j, nn = n0 + n, row = t.w1 ? RowW1()(nn) : nn;
            const LAS float* sp = scr + (8 * c) * 65 + n;
            u32x4 o; o.x = pk2(sp[0 * 65], sp[1 * 65]); o.y = pk2(sp[2 * 65], sp[3 * 65]); o.z = pk2(sp[4 * 65], sp[5 * 65]); o.w = pk2(sp[6 * 65], sp[7 * 65]);
            *(u32x4*)(t.out + (size_t)row * t.ldt + (k0 + 8 * c) * 2) = o; } }
    LDS_WAIT(); asm volatile("" ::: "memory");
}
__device__ __forceinline__ void moe_weight_items(const Frame& F, LAS unsigned* cnt_cv) {
    LAS float* scr = (LAS float*)(F.lds + F.wave * 16640);
    const int NGW = F.G * NWAVES;
    constexpr int NIT = NE * 16 * 32 + NE * 16 * 16, PER_WG = 96;
    f32x4 va[16], vb[16];
#define CV_GRAB(jv) do { int _j = 0; if (F.lane == 0) _j = (int)atomicAdd((unsigned*)cnt_cv, 1u); jv = __builtin_amdgcn_readfirstlane(_j); } while (0)
#define CV_ITEM(jv) ((int)blockIdx.x * NWAVES + ((jv) & 7) + ((jv) >> 3) * NGW)
    int ja; CV_GRAB(ja);
    if (ja >= PER_WG || CV_ITEM(ja) >= NIT) return;
    TrItem ta = moe_item(F, CV_ITEM(ja)), tb = ta;
    tr_load(va, ta, F.lane);
    for (;;) {
        int jb; CV_GRAB(jb); const bool hb = jb < PER_WG && CV_ITEM(jb) < NIT;
        if (hb) { tb = moe_item(F, CV_ITEM(jb)); tr_load(vb, tb, F.lane); }
        tr_finish(va, ta, scr, F.lane);
        if (!hb) break;
        CV_GRAB(ja); const bool ha = ja < PER_WG && CV_ITEM(ja) < NIT;
        if (ha) { ta = moe_item(F, CV_ITEM(ja)); tr_load(va, ta, F.lane); }
        tr_finish(vb, tb, scr, F.lane);
        if (!ha) break;
    }
#undef CV_GRAB
#undef CV_ITEM
}
__device__ __forceinline__ void p1_inproj(const Frame& F) {
    const int gw = blockIdx.x * NWAVES + F.wave, NGW = F.G * NWAVES, r32 = F.lane & 31, hi = F.lane >> 5;
    for (int tile = gw; tile < (T / 32) * (INC / 128); tile += NGW) {
        const int mb = tile / (INC / 128), cg = tile % (INC / 128), m0 = mb * 32, n0 = cg * 128;
        const bf16* ap = F.ABF + (size_t)(m0 + r32) * D + 8 * hi;
        const bf16* bp[4];
#pragma unroll
        for (int nb = 0; nb < 4; ++nb) bp[nb] = F.WIN + (size_t)(n0 + 32 * nb + r32) * D + 8 * hi;
        f32x16 acc[4];
#pragma unroll
        for (int nb = 0; nb < 4; ++nb) acc[nb] = f32x16{};
        smma<4>(ap, bp, D, acc);
        const int kind = (n0 < ZK) ? 0 : (n0 < ZU) ? 1 : (n0 < ZGA) ? 2 : 3;
#pragma unroll
        for (int nb = 0; nb < 4; ++nb)
#pragma unroll
            for (int r = 0; r < 16; ++r) {
                float v = acc[nb][r];
                if (kind == 2) v = gelu_tanh(v); else if (kind == 3) v = sigmoidf_(v);
                F.ZZ[(size_t)(m0 + crow(r, hi)) * INC + n0 + 32 * nb + r32] = (bf16)f2bf(v);
            }
    }
    for (int tile = gw; tile < (T / 32) * (D / 128); tile += NGW) {
        const int mb = tile / (D / 128), cg = tile % (D / 128), m0 = mb * 32, n0 = cg * 128;
        const bf16* ap = F.PBF + (size_t)(m0 + r32) * PLE + 8 * hi;
        const bf16* bp[4];
#pragma unroll
        for (int nb = 0; nb < 4; ++nb) bp[nb] = F.WPP + (size_t)(n0 + 32 * nb + r32) * PLE + 8 * hi;
        f32x16 acc[4];
#pragma unroll
        for (int nb = 0; nb < 4; ++nb) acc[nb] = f32x16{};
        smma<4>(ap, bp, PLE, acc);
#pragma unroll
        for (int nb = 0; nb < 4; ++nb)
#pragma unroll
            for (int r = 0; r < 16; ++r) F.PROJ[(size_t)(m0 + crow(r, hi)) * D + n0 + 32 * nb + r32] = (bf16)f2bf(acc[nb][r]);
    }
}

template <bool EARLY>
__device__ __forceinline__ void p2_attn_scalar(const Frame& F) {
    LAS u32x4* Kt = (LAS u32x4*)F.lds;
    LAS u32x4* Vt = Kt + 512;
    for (int pr = blockIdx.x; pr < 256; pr += F.G) {
        for (int half = 0; half < 2; ++half) {
            const int bh = pr >> 2, tb = half == 0 ? (pr & 3) : 7 - (pr & 3), b = bh / NH, h = bh % NH;
            const int t = tb * 512 + F.tid;
            const size_t row = (size_t)b * SEQ + t;
            float q[64], o[64];
            { const u32x4* qp = (const u32x4*)(F.ZZ + row * INC + ZQ + h * HD);
#pragma unroll
              for (int c = 0; c < 8; ++c) { float f[8]; unpack8(qp[c], f);
#pragma unroll
                  for (int j = 0; j < 8; ++j) q[8 * c + j] = f[j]; } }
#pragma unroll
            for (int d = 0; d < 64; ++d) o[d] = 0.f;
            float carry = 1.f;
            for (int kt = tb * 8 + 7; kt >= 0; --kt) {
                __syncthreads();
                { const int kr = F.tid >> 3, c = F.tid & 7; const size_t krow = ((size_t)b * SEQ + kt * 64 + kr) * INC + h * HD + 8 * c;
                  Kt[F.tid] = *(const u32x4*)(F.ZZ + krow + ZK); Vt[F.tid] = *(const u32x4*)(F.ZZ + krow + ZV); }
                __syncthreads();
                for (int sl = 63; sl >= 0; --sl) {
                    const int s = kt * 64 + sl;
                    if (s < t) {
                        float z = 0.f;
#pragma unroll
                        for (int c = 0; c < 8; ++c) { float f[8]; unpack8(Kt[sl * 8 + c], f);
#pragma unroll
                            for (int j = 0; j < 8; ++j) z += q[8 * c + j] * f[j]; }
                        z = fminf(z, 100.f);
                        const float e = exp2f(z), r = 1.0f / (1.0f + e);
                        carry *= r;
                        const float w = e * carry;
#pragma unroll
                        for (int c = 0; c < 8; ++c) { float f[8]; unpack8(Vt[sl * 8 + c], f);
#pragma unroll
                            for (int j = 0; j < 8; ++j) o[8 * c + j] += w * f[j]; }
                    }
                }
            }
            u32x4* op = (u32x4*)(F.OAB + row * D + h * HD);
#pragma unroll
            for (int c = 0; c < 8; ++c) { u32x4 w; w.x = pk2(o[8 * c], o[8 * c + 1]); w.y = pk2(o[8 * c + 2], o[8 * c + 3]); w.z = pk2(o[8 * c + 4], o[8 * c + 5]); w.w = pk2(o[8 * c + 6], o[8 * c + 7]); op[c] = w; }
        }
    }
    __syncthreads();
}
__device__ __forceinline__ void p2_sgu_simple(const Frame& F) {
    LAS bf16* vsn = (LAS bf16*)F.lds;
    for (int unit = blockIdx.x; unit < T / 128; unit += F.G) {
        const int row0 = unit * 128;
        for (int i = 0; i < 16; ++i) {
            const int rl = F.wave * 16 + i;
            const u32x4 w = *(const u32x4*)(F.ZZ + (size_t)(row0 + rl) * INC + ZVS + 8 * F.lane);
            float f[8]; unpack8(w, f);
            float s = 0.f;
#pragma unroll
            for (int j = 0; j < 8; ++j) s += f[j];
            const float mean = wave_sum(s) * (1.f / 512.f);
            float s2 = 0.f;
#pragma unroll
            for (int j = 0; j < 8; ++j) { f[j] -= mean; s2 += f[j] * f[j]; }
            const float rstd = rsqrtf(wave_sum(s2) * (1.f / 512.f) + EPS);
            const f32x4 g0 = *(const f32x4*)(F.sgu_norm + 8 * F.lane), g1 = *(const f32x4*)(F.sgu_norm + 8 * F.lane + 4);
            u32x4 o; o.x = pk2(f[0] * rstd * g0.x, f[1] * rstd * g0.y); o.y = pk2(f[2] * rstd * g0.z, f[3] * rstd * g0.w);
            o.z = pk2(f[4] * rstd * g1.x, f[5] * rstd * g1.y); o.w = pk2(f[6] * rstd * g1.z, f[7] * rstd * g1.w);
            *(LAS u32x4*)(vsn + rl * 512 + 8 * F.lane) = o;
        }
        __syncthreads();
        const int ch = F.tid, g = ch >> 6;
        for (int tl = 0; tl < 128; ++tl) {
            const bf16* wrow = F.SGUW + (g * 128 + tl) * 128;
            float a = 0.f;
            for (int s = 0; s < 128; ++s) a += bf2f(wrow[s]) * bf2f(vsn[s * 512 + ch]);
            const float sv = a + F.sgu_b[g * 128 + tl];
            const float u = bf2f(F.ZZ[(size_t)(row0 + tl) * INC + ZU + ch]);
            F.OAB[(size_t)(row0 + tl) * D + 512 + ch] = (bf16)f2bf(u * sv);
        }
        __syncthreads();
    }
}

__device__ __forceinline__ void p3_merge(const Frame& F) {
    const int gw = blockIdx.x * NWAVES + F.wave, NGW = F.G * NWAVES, r32 = F.lane & 31, hi = F.lane >> 5;
    for (int tile = gw; tile < (T / 32) * (D / 128); tile += NGW) {
        const int mb = tile / (D / 128), cg = tile % (D / 128), m0 = mb * 32, n0 = cg * 128;
        const bf16* ap = F.OAB + (size_t)(m0 + r32) * D + 8 * hi;
        const bf16* bp[4];
#pragma unroll
        for (int nb = 0; nb < 4; ++nb) bp[nb] = F.WAB + (size_t)(n0 + 32 * nb + r32) * D + 8 * hi;
        f32x16 acca[4], accb[4];
#pragma unroll
        for (int nb = 0; nb < 4; ++nb) { acca[nb] = f32x16{}; accb[nb] = f32x16{}; }
        smma<4>(ap, bp, 512, acca);
        const bf16* ap2 = ap + 512; const bf16* bp2[4];
#pragma unroll
        for (int nb = 0; nb < 4; ++nb) bp2[nb] = bp[nb] + 512;
        smma<4>(ap2, bp2, 512, accb);
#pragma unroll
        for (int nb = 0; nb < 4; ++nb)
#pragma unroll
            for (int r = 0; r < 16; ++r) {
                const size_t row = m0 + crow(r, hi); const int col = n0 + 32 * nb + r32;
                const float sga = bf2f(F.ZZ[row * INC + ZGA + col]), sgb = bf2f(F.ZZ[row * INC + ZGB + col]);
                F.MERGED[row * D + col] = (bf16)f2bf(sga * acca[nb][r] + sgb * accb[nb][r]);
            }
    }
}
__device__ __forceinline__ void p4_out(const Frame& F) {
    const int gw = blockIdx.x * NWAVES + F.wave, NGW = F.G * NWAVES, r32 = F.lane & 31, hi = F.lane >> 5;
    for (int tile = gw; tile < (T / 32) * (D / 128); tile += NGW) {
        const int mb = tile / (D / 128), cg = tile % (D / 128), m0 = mb * 32, n0 = cg * 128;
        const bf16* ap = F.MERGED + (size_t)(m0 + r32) * D + 8 * hi;
        const bf16* bp[4];
#pragma unroll
        for (int nb = 0; nb < 4; ++nb) bp[nb] = F.WOUT + (size_t)(n0 + 32 * nb + r32) * D + 8 * hi;
        f32x16 acc[4];
#pragma unroll
        for (int nb = 0; nb < 4; ++nb) acc[nb] = f32x16{};
        smma<4>(ap, bp, D, acc);
#pragma unroll
        for (int nb = 0; nb < 4; ++nb)
#pragma unroll
            for (int r = 0; r < 16; ++r) {
                const size_t row = m0 + crow(r, hi); const int col = n0 + 32 * nb + r32;
                F.H1[row * D + col] = (bf16)f2bf(F.x[row * D + col] + acc[nb][r]);
            }
    }
}
__device__ __forceinline__ void p5_router(const Frame& F) {
    LAS unsigned* hist = (LAS unsigned*)F.lds;
    LAS unsigned* base = hist + 32;
    LAS unsigned* lsel = hist + 64;
    LAS float* lgate = (LAS float*)(hist + 64 + 512);
    const int e = F.lane & 31, half = F.lane >> 5;
    for (int chunk = blockIdx.x; chunk < T / 128; chunk += F.G) {
        if (F.tid < 32) hist[F.tid] = 0u;
        __syncthreads();
        for (int i = 0; i < 16; ++i) {
            const int tl = F.wave * 16 + i, t = chunk * 128 + tl;
            const bf16* hp = F.H1 + (size_t)t * D + half * 512;
            const bf16* whi = F.WRHI + e * D + half * 512;
            const bf16* wlo = F.WRLO + e * D + half * 512;
            float dot = 0.f, ss = 0.f;
            for (int k = 0; k < 512; k += 8) {
                float hf[8], a[8], c[8];
                unpack8(*(const u32x4*)(hp + k), hf); unpack8(*(const u32x4*)(whi + k), a); unpack8(*(const u32x4*)(wlo + k), c);
#pragma unroll
                for (int j = 0; j < 8; ++j) { dot += hf[j] * (a[j] + c[j]); ss += hf[j] * hf[j]; }
            }
            dot += __shfl_xor(dot, 32); ss += __shfl_xor(ss, 32);
            const float rstd = rsqrtf(ss * (1.f / D) + EPS);
            float logit = rstd * dot + F.b_router[e];
            float val[4]; int sel[4];
#pragma unroll
            for (int r = 0; r < 4; ++r) {
                const float m = wave_max(logit);
                const unsigned long long bal = __ballot(logit == m);
                const int le = (int)(__ffsll((long long)bal) - 1) & 31;
                val[r] = m; sel[r] = le;
                if (e == le) logit = -INFINITY;
            }
            float ex[4], sum = 0.f;
#pragma unroll
            for (int r = 0; r < 4; ++r) { ex[r] = __expf(val[r] - val[0]); sum += ex[r]; }
            { const u32x4* hr = (const u32x4*)(F.H1 + (size_t)t * D); u32x4* cr = (u32x4*)(F.ABF + (size_t)t * D);
#pragma unroll
              for (int j = 0; j < 2; ++j) { float f[8]; unpack8(hr[F.lane + 64 * j], f); u32x4 o; o.x = pk2(f[0] * rstd, f[1] * rstd); o.y = pk2(f[2] * rstd, f[3] * rstd); o.z = pk2(f[4] * rstd, f[5] * rstd); o.w = pk2(f[6] * rstd, f[7] * rstd); cr[F.lane + 64 * j] = o; } }
            if (F.lane == 0) {
                F.RSTD1[t] = rstd;
#pragma unroll
                for (int r = 0; r < 4; ++r) { const unsigned loc = atomicAdd((unsigned*)&hist[sel[r]], 1u); lsel[tl * 4 + r] = (unsigned)sel[r] | (loc << 8); lgate[tl * 4 + r] = ex[r] / sum; }
            }
        }
        __syncthreads();
        if (F.tid < 32) { const unsigned n = hist[F.tid]; base[F.tid] = n ? __hip_atomic_fetch_add(F.ctl + CW_CNT + 64 * F.tid, n, __ATOMIC_RELAXED, __HIP_MEMORY_SCOPE_AGENT) : 0u; }
        __syncthreads();
        { const int tl = F.tid >> 2, r = F.tid & 3, t = chunk * 128 + tl; const unsigned s = lsel[tl * 4 + r]; const int ee = s & 255; const unsigned rank = base[ee] + (s >> 8);
          F.TOKLIST[ee * LCAP + rank] = t; F.SLOTREF[t * 4 + r] = (ee << 16) | rank; F.GATE[t * 4 + r] = lgate[tl * 4 + r]; }
        __syncthreads();
    }
}
struct MoeTab { LAS int* cnt; LAS int* toff; LAS int* p32; };
__device__ __forceinline__ MoeTab moe_tables(const Frame& F) {
    MoeTab M; M.cnt = (LAS int*)(F.lds + MISC_OFF + 128); M.toff = M.cnt + 32; M.p32 = M.toff + 33;
    __syncthreads();
    if (F.tid == 0) { int a = 0, c = 0;
        for (int e = 0; e < NE; ++e) { const int n = (int)__hip_atomic_load(F.ctl + CW_CNT + 64 * e, __ATOMIC_RELAXED, __HIP_MEMORY_SCOPE_AGENT); M.cnt[e] = n; M.toff[e] = a; M.p32[e] = c; a += (n + 255) >> 8; c += (n + 31) >> 5; }
        M.toff[NE] = a; M.p32[NE] = c; }
    __syncthreads();
    return M;
}
__device__ __forceinline__ void p6_moe1(const Frame& F) {
    const MoeTab M = moe_tables(F);
    const int gw = blockIdx.x * NWAVES + F.wave, NGW = F.G * NWAVES, r32 = F.lane & 31, hi = F.lane >> 5;
    const int ntiles = M.p32[NE] * 32;
    for (int tile = gw; tile < ntiles; tile += NGW) {
        const int blk = tile >> 5, hb = tile & 31;
        int e = 0; while (M.p32[e + 1] <= blk) ++e;
        const int sb = blk - M.p32[e], cnt = M.cnt[e];
        const int rank = sb * 32 + r32;
        const int tok = F.TOKLIST[e * LCAP + (rank < cnt ? rank : cnt - 1)];
        const bf16* ap = F.ABF + (size_t)tok * D + 8 * hi;
        const int hidb = hb * 32 + r32;
        const bf16* bp[2];
        bp[0] = F.W1T + ((size_t)e * 2048 + 256 * (hidb >> 7) + (hidb & 127)) * D + 8 * hi; bp[1] = bp[0] + 128 * D;
        f32x16 acc[2]; acc[0] = f32x16{}; acc[1] = f32x16{};
        smma<2>(ap, bp, D, acc);
        const float bg = F.b1[e * 2048 + 2 * hidb], bl = F.b1[e * 2048 + 2 * hidb + 1];
#pragma unroll
        for (int r = 0; r < 16; ++r) {
            const int rr = crow(r, hi), rk = sb * 32 + rr;
            float gl = acc[0][r] + bg, li = acc[1][r] + bl;
            gl = fminf(gl, 7.f); li = fminf(fmaxf(li, -7.f), 7.f);
            const float act = gl * sigmoidf_(1.702f * gl) * (li + 1.f);
            if (rk < cnt) F.HID[((size_t)256 * M.toff[e] + rk) * DE + hidb] = (bf16)f2bf(act);
        }
    }
}
__device__ __forceinline__ void p7_moe2(const Frame& F) {
    const MoeTab M = moe_tables(F);
    const int gw = blockIdx.x * NWAVES + F.wave, NGW = F.G * NWAVES, r32 = F.lane & 31, hi = F.lane >> 5;
    const int ntiles = M.p32[NE] * 8;
    for (int tile = gw; tile < ntiles; tile += NGW) {
        const int blk = tile >> 3, cg = tile & 7;
        int e = 0; while (M.p32[e + 1] <= blk) ++e;
        const int sb = blk - M.p32[e], cnt = M.cnt[e];
        const size_t rowb = (size_t)256 * M.toff[e] + sb * 32;
        const bf16* ap = F.HID + (rowb + r32) * DE + 8 * hi;
        const bf16* bp[4];
#pragma unroll
        for (int nb = 0; nb < 4; ++nb) bp[nb] = F.W2T + ((size_t)e * D + cg * 128 + 32 * nb + r32) * DE + 8 * hi;
        f32x16 acc[4];
#pragma unroll
        for (int nb = 0; nb < 4; ++nb) acc[nb] = f32x16{};
        smma<4>(ap, bp, DE, acc);
#pragma unroll
        for (int nb = 0; nb < 4; ++nb) { const int col = cg * 128 + 32 * nb + r32; const float bb = F.b2[e * D + col];
#pragma unroll
            for (int r = 0; r < 16; ++r) { const int rr = crow(r, hi); if (sb * 32 + rr < cnt) F.YS[(rowb + rr) * D + col] = (bf16)f2bf(acc[nb][r] + bb); } }
    }
}
__device__ __forceinline__ void p8_combine(const Frame& F) {
    const MoeTab M = moe_tables(F);
    const int gw = blockIdx.x * NWAVES + F.wave, NGW = F.G * NWAVES;
    if (YS8) {
        for (int t0 = 2 * gw; t0 < T; t0 += 2 * NGW) {
            size_t yrow[2][4]; float gk[2][4];
#pragma unroll
            for (int u = 0; u < 2; ++u)
#pragma unroll
                for (int k = 0; k < 4; ++k) { const int sr = F.SLOTREF[(t0 + u) * 4 + k]; yrow[u][k] = (size_t)256 * M.toff[sr >> 16] + (sr & 0xffff); gk[u][k] = F.GATE[(t0 + u) * 4 + k] * (1.0f / SC_Y); }
            u32x4 hv[2][2], yv[2][4];
#pragma unroll
            for (int u = 0; u < 2; ++u) { hv[u][0] = *(const u32x4*)(F.H1 + (size_t)(t0 + u) * D + 16 * F.lane); hv[u][1] = *(const u32x4*)(F.H1 + (size_t)(t0 + u) * D + 16 * F.lane + 8);
#pragma unroll
                for (int k = 0; k < 4; ++k) yv[u][k] = *(const u32x4*)((const unsigned char*)F.YS + yrow[u][k] * D + 16 * F.lane); }
#pragma unroll
            for (int u = 0; u < 2; ++u) {
                float a[16]; { float lo[8], hi8[8]; unpack8(hv[u][0], lo); unpack8(hv[u][1], hi8);
#pragma unroll
                    for (int q = 0; q < 8; ++q) { a[q] = lo[q]; a[8 + q] = hi8[q]; } }
#pragma unroll
                for (int k = 0; k < 4; ++k)
#pragma unroll
                    for (int d = 0; d < 4; ++d) { float y[4]; unpack4_fp8(yv[u][k][d], y);
#pragma unroll
                        for (int q = 0; q < 4; ++q) a[4 * d + q] += gk[u][k] * y[q]; }
                u32x4 o0, o1; o0.x = pk2(a[0], a[1]); o0.y = pk2(a[2], a[3]); o0.z = pk2(a[4], a[5]); o0.w = pk2(a[6], a[7]); o1.x = pk2(a[8], a[9]); o1.y = pk2(a[10], a[11]); o1.z = pk2(a[12], a[13]); o1.w = pk2(a[14], a[15]);
                *(u32x4*)(F.H2 + (size_t)(t0 + u) * D + 16 * F.lane) = o0; *(u32x4*)(F.H2 + (size_t)(t0 + u) * D + 16 * F.lane + 8) = o1;
                float b[8], c[8]; unpack8(o0, b); unpack8(o1, c); float ss = 0.f;
#pragma unroll
                for (int q = 0; q < 8; ++q) ss += b[q] * b[q] + c[q] * c[q];
                ss = wave_sum(ss);
                if (F.lane == 0) F.RSTD2[t0 + u] = rsqrtf(ss * (1.f / D) + EPS);
            }
        }
        return;
    }
    for (int t0 = 2 * gw; t0 < T; t0 += 2 * NGW) {
        size_t yrow[2][4]; float gk[2][4];
#pragma unroll
        for (int u = 0; u < 2; ++u)
#pragma unroll
            for (int k = 0; k < 4; ++k) { const int sr = F.SLOTREF[(t0 + u) * 4 + k]; yrow[u][k] = (size_t)256 * M.toff[sr >> 16] + (sr & 0xffff); gk[u][k] = F.GATE[(t0 + u) * 4 + k]; }
        u32x4 hv[2][2], yv[2][2][4];
#pragma unroll
        for (int u = 0; u < 2; ++u)
#pragma unroll
            for (int j = 0; j < 2; ++j) { const int col = 8 * F.lane + 512 * j; hv[u][j] = *(const u32x4*)(F.H1 + (size_t)(t0 + u) * D + col);
#pragma unroll
                for (int k = 0; k < 4; ++k) yv[u][j][k] = *(const u32x4*)(F.YS + yrow[u][k] * D + col); }
#pragma unroll
        for (int u = 0; u < 2; ++u) {
            float ss = 0.f;
#pragma unroll
            for (int j = 0; j < 2; ++j) {
                float a[8]; unpack8(hv[u][j], a);
#pragma unroll
                for (int k = 0; k < 4; ++k) { float y[8]; unpack8(yv[u][j][k], y);
#pragma unroll
                    for (int q = 0; q < 8; ++q) a[q] += gk[u][k] * y[q]; }
                u32x4 o; o.x = pk2(a[0], a[1]); o.y = pk2(a[2], a[3]); o.z = pk2(a[4], a[5]); o.w = pk2(a[6], a[7]);
                *(u32x4*)(F.H2 + (size_t)(t0 + u) * D + 8 * F.lane + 512 * j) = o;
                float b[8]; unpack8(o, b);
#pragma unroll
                for (int q = 0; q < 8; ++q) ss += b[q] * b[q];
            }
            ss = wave_sum(ss);
            if (F.lane == 0) F.RSTD2[t0 + u] = rsqrtf(ss * (1.f / D) + EPS);
        }
    }
}
__device__ __forceinline__ void p9_ple(const Frame& F) {
    const int gw = blockIdx.x * NWAVES + F.wave, NGW = F.G * NWAVES, r32 = F.lane & 31, hi = F.lane >> 5;
    for (int tile = gw; tile < (T / 32) * (D / 128); tile += NGW) {
        const int mb = tile / (D / 128), cg = tile % (D / 128), m0 = mb * 32, n0 = cg * 128;
        const bf16* ap = F.H2 + (size_t)(m0 + r32) * D + 8 * hi;
        const bf16* bp[4];
#pragma unroll
        for (int nb = 0; nb < 4; ++nb) bp[nb] = F.WPG + (size_t)(n0 + 32 * nb + r32) * D + 8 * hi;
        f32x16 acc[4];
#pragma unroll
        for (int nb = 0; nb < 4; ++nb) acc[nb] = f32x16{};
        smma<4>(ap, bp, D, acc);
#pragma unroll
        for (int r = 0; r < 16; ++r) {
            const size_t row = m0 + crow(r, hi); const float rs = F.RSTD2[row];
#pragma unroll
            for (int nb = 0; nb < 4; ++nb) { const int col = n0 + 32 * nb + r32;
                const float pg = sigmoidf_(rs * acc[nb][r]);
                F.H3[row * D + col] = (bf16)f2bf(bf2f(F.H2[row * D + col]) + pg * bf2f(F.PROJ[row * D + col])); }
        }
    }
}
__device__ __forceinline__ void p10_final(const Frame& F) {
    const int gw = blockIdx.x * NWAVES + F.wave, NGW = F.G * NWAVES;
    for (int t = gw; t < T; t += NGW) {
        float a[2][8]; float ss = 0.f;
#pragma unroll
        for (int j = 0; j < 2; ++j) { unpack8(*(const u32x4*)(F.H3 + (size_t)t * D + 8 * F.lane + 512 * j), a[j]);
#pragma unroll
            for (int q = 0; q < 8; ++q) ss += a[j][q] * a[j][q]; }
        const float rstd = rsqrtf(wave_sum(ss) * (1.f / D) + EPS);
#pragma unroll
        for (int j = 0; j < 2; ++j) { const int col = 8 * F.lane + 512 * j;
            const f32x4 g0 = *(const f32x4*)(F.g_final + col), g1 = *(const f32x4*)(F.g_final + col + 4);
            f32x4 o0, o1; o0.x = a[j][0] * rstd * g0.x; o0.y = a[j][1] * rstd * g0.y; o0.z = a[j][2] * rstd * g0.z; o0.w = a[j][3] * rstd * g0.w;
            o1.x = a[j][4] * rstd * g1.x; o1.y = a[j][5] * rstd * g1.y; o1.z = a[j][6] * rstd * g1.z; o1.w = a[j][7] * rstd * g1.w;
            *(f32x4*)(F.out + (size_t)t * D + col) = o0; *(f32x4*)(F.out + (size_t)t * D + col + 4) = o1; }
    }
}


namespace pg {
constexpr int BM = 256, BK = 64, HALF = 128, HTB = HALF * BK * 2, STAGE_BYTES = 8 * HTB, NXCD = 8, WGM = 8;
__device__ __forceinline__ int lds_byte(int r, int c) { const int st = (r >> 4) * 2 + (c >> 5), rr = r & 15, cc = c & 31, ob = rr * 64 + cc * 2; return st * 1024 + (ob ^ (((ob >> 9) & 1) << 5)); }
__device__ __forceinline__ void stage_rc(int b, int& R, int& C) { const int st = b / 1024, sb = b % 1024, swz = sb ^ (((sb >> 9) & 1) << 5); R = (st >> 1) * 16 + swz / 64; C = (st & 1) * 32 + (swz % 64) / 2; }
__device__ __forceinline__ int perm32(int rho) { const int n = rho >> 4, i = rho & 15; return 8 * (i >> 2) + 4 * n + (i & 3); }
struct Unit { int arow, brow, kofs, x0, x1, x2; };
typedef float f32x2_t __attribute__((ext_vector_type(2))); typedef __bf16 bf16x2_t __attribute__((ext_vector_type(2)));
__device__ __forceinline__ unsigned cvt_pk_bf16(float lo, float hi) { const f32x2_t v = {lo, hi}; const bf16x2_t b = __builtin_convertvector(v, bf16x2_t); return __builtin_bit_cast(unsigned, b); }
typedef f32x4 Acc[2][2][4][2];
typedef int i32x8 __attribute__((ext_vector_type(8)));
typedef int i32x4 __attribute__((ext_vector_type(4)));

__device__ __forceinline__ void dma16(const void* sbase, unsigned voff, unsigned ldsdst) { unsigned keep;
    asm volatile("s_mov_b32 %0, m0\n\ts_mov_b32 m0, %3\n\ts_nop 0\n\tglobal_load_lds_dwordx4 %1, %2\n\ts_mov_b32 m0, %0" : "=&s"(keep) : "v"(voff), "s"(sbase), "s"(ldsdst) : "memory"); }
struct DenseMap { static constexpr bool GATHER = false; int lda; __device__ __forceinline__ unsigned rowoff(const Unit&, int r) const { return (unsigned)r * (unsigned)lda * 2u; }
    __device__ __forceinline__ size_t base(const Unit& u) const { return (size_t)u.arow * lda * 2; } };
template <int SPLIT>
struct DenseOrder {
    int nM, nN, nwg, G, c, khalf;
    __device__ __forceinline__ void init(int M, int N, int G_, int c_, int khalf_ = 0) { nM = M / BM; nN = N / BM; nwg = nM * nN; G = G_; c = c_; khalf = khalf_; }
    __device__ __forceinline__ bool next(int i, Unit& u) const {
        const int j = SPLIT ? (i >> 1) : i;
        const long L = (long)j * G + c; if (L >= nwg) return false;
        int wgid = (int)L; { const int q = nwg / NXCD, r = nwg % NXCD, xcd = wgid % NXCD, off = wgid / NXCD; wgid = (xcd < r ? xcd * (q + 1) : r * (q + 1) + (xcd - r) * q) + off; }
        const int nig = WGM * nN, gid = wgid / nig, fm = gid * WGM, gsz = (nM - fm) < WGM ? (nM - fm) : WGM;
        const int pm = fm + ((wgid % nig) % gsz), pn = (wgid % nig) / gsz;
        u.arow = pm * BM; u.brow = pn * BM; u.x0 = pm; u.x1 = pn; u.x2 = SPLIT ? (i & 1) : 0; u.kofs = SPLIT ? (i & 1) * khalf : 0; return true;
    }
};

template <class Epi, class Sched, class AMap, bool ALIGN_EPI, int PREC = 0>
__device__ __forceinline__ void gemm_run(LAS unsigned char* lds, const bf16* A, const bf16* Bt, const int ldb, const int nt, const Sched& S, const Epi& E, const AMap& AM) {
    const int tid = threadIdx.x, wid = __builtin_amdgcn_readfirstlane(tid >> 6), lane = tid & 63, wr = wid >> 2, wc = wid & 3, fr = lane & 15, fq = lane >> 4;
    int RA[2]; unsigned CA2[2], voffB[2];
#pragma unroll
    for (int i = 0; i < 2; ++i) { int R, C; stage_rc(tid * 16 + i * 8192, R, C); RA[i] = R; CA2[i] = (unsigned)C * 2u; const int Rb = (R & ~31) + perm32(R & 31); voffB[i] = (unsigned)(Rb * ldb + C) * 2u; }
    const size_t kstep = (size_t)(BK * 2);
    const size_t hstepB = (size_t)HALF * ldb * 2;
    const unsigned ldsw = (unsigned)wid * 1024u;
    const unsigned lds32 = (unsigned)(uintptr_t)lds;
    const int aoff = lds_byte(wr * 64 + fr, fq * 8), boff = lds_byte(wc * 32 + fr, fq * 8);
#define PG_SA(b, h) (((b) * 2 + (h)) * HTB)
#define PG_SB(b, h) ((4 + (b) * 2 + (h)) * HTB)
#define PG_DMA(gbase, voff32, ldsdst) do { unsigned _keep; asm volatile("s_mov_b32 %0, m0\n\ts_mov_b32 m0, %3\n\ts_nop 0\n\tglobal_load_lds_dwordx4 %1, %2\n\ts_mov_b32 m0, %0" \
        : "=&s"(_keep) : "v"(voff32), "s"(gbase), "s"(ldsdst) : "memory"); } while (0)
#define PG_STAGE(bufoff, gbase, voff) do { _Pragma("unroll") for (int _i = 0; _i < 2; ++_i) PG_DMA((const char*)(gbase), (voff)[_i], lds32 + (unsigned)((bufoff) + _i * 8192) + ldsw); } while (0)
#define PG_LD8(addr) __builtin_shufflevector(*(const LAS i32x4*)(addr), *(const LAS i32x4*)((addr) + 1024), 0, 1, 2, 3, 4, 5, 6, 7)
#define PG_LDA(dst, b, h) do { if constexpr (PREC == 0) { _Pragma("unroll") for (int m = 0; m < 4; ++m) _Pragma("unroll") for (int k = 0; k < 2; ++k) dst[m][k] = *(const LAS bf16x8*)(lds + PG_SA(b, h) + aoff + m * 2048 + k * 1024); } \
        else { _Pragma("unroll") for (int m = 0; m < 4; ++m) dst##8[m] = PG_LD8(lds + PG_SA(b, h) + aoff + m * 2048); } } while (0)
#define PG_LDB(dst, b, h) do { if constexpr (PREC == 0) { _Pragma("unroll") for (int n = 0; n < 2; ++n) _Pragma("unroll") for (int k = 0; k < 2; ++k) dst[n][k] = *(const LAS bf16x8*)(lds + PG_SB(b, h) + boff + n * 2048 + k * 1024); } \
        else { _Pragma("unroll") for (int n = 0; n < 2; ++n) dst##8[n] = PG_LD8(lds + PG_SB(b, h) + boff + n * 2048); } } while (0)
#define PG_MMA(ai, bj, At, Bt_) do { __builtin_amdgcn_s_setprio(1); _Pragma("unroll") for (int m = 0; m < 4; ++m) _Pragma("unroll") for (int n = 0; n < 2; ++n) { \
        if constexpr (PREC == 0) { _Pragma("unroll") for (int k = 0; k < 2; ++k) acc[ai][bj][m][n] = __builtin_amdgcn_mfma_f32_16x16x32_bf16(Bt_[n][k], At[m][k], acc[ai][bj][m][n], 0, 0, 0); } \
        else { asm volatile("v_mfma_scale_f32_16x16x128_f8f6f4 %0, %1, %2, %0, %3, %3 op_sel_hi:[0,0,0]" : "+v"(acc[ai][bj][m][n]) : "v"(Bt_##8[n]), "v"(At##8[m]), "v"(one_scale)); } } \
        __builtin_amdgcn_s_setprio(0); } while (0)
#define PG_WAIT_V(n) asm volatile("s_waitcnt vmcnt(" #n ")" ::: "memory")
#define PG_WAIT_L(n) asm volatile("s_waitcnt lgkmcnt(" #n ")" ::: "memory")
#define PG_BAR __builtin_amdgcn_s_barrier()
#define PG_SCHED __builtin_amdgcn_sched_barrier(0)
#define PG_ZERO() do { _Pragma("unroll") for (int a = 0; a < 2; ++a) _Pragma("unroll") for (int b = 0; b < 2; ++b) _Pragma("unroll") for (int m = 0; m < 4; ++m) _Pragma("unroll") for (int n = 0; n < 2; ++n) acc[a][b][m][n] = (f32x4){0.f, 0.f, 0.f, 0.f}; } while (0)
#define PG_MKVA(u, va) do { _Pragma("unroll") for (int h = 0; h < 2; ++h) _Pragma("unroll") for (int i = 0; i < 2; ++i) va[h][i] = AM.rowoff(u, h * HALF + RA[i]) + CA2[i]; } while (0)
    Unit cur, nxt; int ui = 0;
    if (!S.next(0, cur)) return;
    Acc acc; PG_ZERO();
    bf16x8 At[4][2], B0[2][2], B1[2][2];
    i32x8 At8[4], B08[2], B18[2];
    unsigned one_scale; asm volatile("v_mov_b32 %0, 0x7f7f7f7f" : "=v"(one_scale));
    unsigned voffA[2]; unsigned vaC[2][2], vaN[2][2];
    const size_t hstepA = AMap::GATHER ? 0 : (size_t)AM.rowoff(cur, HALF);
    if constexpr (AMap::GATHER) { PG_MKVA(cur, vaC); } else {
#pragma unroll
        for (int i = 0; i < 2; ++i) voffA[i] = AM.rowoff(cur, RA[i]) + CA2[i]; }
#define PG_STAGE_A(bufoff, ptr, h, useNext) do { if constexpr (AMap::GATHER) { unsigned _v[2] = {(useNext) ? vaN[h][0] : vaC[h][0], (useNext) ? vaN[h][1] : vaC[h][1]}; PG_STAGE(bufoff, ptr, _v); } \
        else { PG_STAGE(bufoff, (ptr) + (h) * hstepA, voffA); } } while (0)
    const char* cA = (const char*)A + (size_t)cur.kofs * 2 + AM.base(cur); const char* cB = (const char*)Bt + ((size_t)cur.brow * ldb + cur.kofs) * 2;
    PG_STAGE(PG_SB(0, 0), cB, voffB); PG_STAGE(PG_SB(0, 1), cB + hstepB, voffB); PG_STAGE_A(PG_SA(0, 0), cA, 0, false); PG_STAGE_A(PG_SA(0, 1), cA, 1, false);
    if (wr == 1) PG_BAR;
    PG_WAIT_V(2); PG_BAR;
    PG_STAGE(PG_SB(1, 0), cB + kstep, voffB); PG_STAGE_A(PG_SA(1, 0), cA + kstep, 0, false); PG_STAGE(PG_SB(1, 1), cB + hstepB + kstep, voffB);
    PG_WAIT_V(6); PG_BAR;
    for (;;) {
        const bool has_next = S.next(ui + 1, nxt);
        const char* nA = cA; const char* nB = cB;
        if (has_next) { if constexpr (AMap::GATHER) { PG_MKVA(nxt, vaN); } nA = (const char*)A + (size_t)nxt.kofs * 2 + AM.base(nxt); nB = (const char*)Bt + ((size_t)nxt.brow * ldb + nxt.kofs) * 2; }
        else if constexpr (AMap::GATHER) {
#pragma unroll
            for (int h = 0; h < 2; ++h)
#pragma unroll
                for (int i = 0; i < 2; ++i) vaN[h][i] = vaC[h][i]; }
        E.prefetch(cur, ui, wid, lane);
#pragma unroll 1
        for (int t = 0; t < nt; t += 2) {
            const bool last = (t == nt - 2);
            const char* a1 = cA + (size_t)(t + 1) * kstep;
            const char* a2 = last ? nA : cA + (size_t)(t + 2) * kstep; const char* b2 = last ? nB : cB + (size_t)(t + 2) * kstep;
            const char* a3 = a2 + kstep; const char* b3 = b2 + kstep;
            PG_LDB(B0, 0, 0); PG_LDB(B1, 0, 1); PG_SCHED; PG_LDA(At, 0, 0); PG_STAGE_A(PG_SA(1, 1), a1, 1, false);
            PG_WAIT_V(8); PG_WAIT_L(0); PG_BAR; PG_MMA(0, 0, At, B0); PG_MMA(0, 1, At, B1); PG_BAR; PG_SCHED;
            PG_LDA(At, 0, 1); PG_STAGE(PG_SB(0, 0), b2, voffB); PG_STAGE(PG_SB(0, 1), b2 + hstepB, voffB); PG_STAGE_A(PG_SA(0, 0), a2, 0, last);
            PG_WAIT_V(8); PG_WAIT_L(0); PG_BAR; PG_MMA(1, 0, At, B0); PG_MMA(1, 1, At, B1); PG_BAR; PG_SCHED;
            PG_LDB(B0, 1, 0); PG_LDB(B1, 1, 1); PG_SCHED; PG_LDA(At, 1, 0); PG_STAGE_A(PG_SA(0, 1), a2, 1, last);
            PG_WAIT_V(8); PG_WAIT_L(0); PG_BAR; PG_MMA(0, 0, At, B0); PG_MMA(0, 1, At, B1); PG_BAR; PG_SCHED;
            PG_LDA(At, 1, 1); PG_STAGE(PG_SB(1, 0), b3, voffB); PG_STAGE(PG_SB(1, 1), b3 + hstepB, voffB); PG_STAGE_A(PG_SA(1, 0), a3, 0, last);
            PG_WAIT_V(8); PG_WAIT_L(0); PG_BAR; PG_MMA(1, 0, At, B0); PG_MMA(1, 1, At, B1); PG_BAR; PG_SCHED;
        }
        if constexpr (ALIGN_EPI) { if (wr == 0) PG_BAR; }
        if constexpr (PREC == 1) asm volatile("s_nop 15\n\ts_nop 15\n\ts_nop 15\n\ts_nop 15" ::: "memory");
        E(acc, cur, ui, wr, wc, fr, fq);
        if (!has_next) break;
        if (!E.keep(cur)) PG_ZERO();
        cur = nxt; cA = nA; cB = nB; ++ui;
        if constexpr (AMap::GATHER) {
#pragma unroll
            for (int h = 0; h < 2; ++h)
#pragma unroll
                for (int i = 0; i < 2; ++i) vaC[h][i] = vaN[h][i]; }
        if constexpr (ALIGN_EPI) { if (wr == 1) PG_BAR; }
    }
    PG_WAIT_V(0);
    if constexpr (!ALIGN_EPI) { if (wr == 0) PG_BAR; }
    PG_BAR;
#undef PG_SA
#undef PG_SB
#undef PG_STAGE
#undef PG_DMA
#undef PG_LDA
#undef PG_LDB
#undef PG_LD8
#undef PG_MMA
#undef PG_WAIT_V
#undef PG_WAIT_L
#undef PG_BAR
#undef PG_SCHED
#undef PG_ZERO
#undef PG_MKVA
#undef PG_STAGE_A
}

__device__ __forceinline__ float sigm(float x) { return __builtin_amdgcn_rcpf(1.0f + __builtin_amdgcn_exp2f(-LOG2E * x)); }
__device__ __forceinline__ float gelu_t(float x) { const float u = 1.5957691216057308f * (x + 0.044715f * x * x * x); return x * sigm(u); }
template <int KIND> __device__ __forceinline__ float act_k(float x) {
    if (KIND == 2) { const float t = x * (-2.3022082f + (-0.10294324f) * (x * x)); return x * __builtin_amdgcn_rcpf(1.0f + __builtin_amdgcn_exp2f(t)); }
    return __builtin_amdgcn_rcpf(1.0f + __builtin_amdgcn_exp2f(-LOG2E * x));
}
template <int KIND> __device__ __forceinline__ void store_act(const Acc& acc, bf16* base, int ldc) {
#pragma unroll
    for (int ai = 0; ai < 2; ++ai)
#pragma unroll
        for (int m = 0; m < 4; ++m) { bf16* rowp = base + (size_t)(ai * HALF + m * 16) * ldc;
#pragma unroll
            for (int bj = 0; bj < 2; ++bj) { const f32x4 v0 = acc[ai][bj][m][0], v1 = acc[ai][bj][m][1];
                u32x4 w; w.x = cvt_pk_bf16(act_k<KIND>(v0[0]), act_k<KIND>(v0[1])); w.y = cvt_pk_bf16(act_k<KIND>(v0[2]), act_k<KIND>(v0[3]));
                w.z = cvt_pk_bf16(act_k<KIND>(v1[0]), act_k<KIND>(v1[1])); w.w = cvt_pk_bf16(act_k<KIND>(v1[2]), act_k<KIND>(v1[3]));
                *(u32x4*)(rowp + bj * HALF) = w; }
            asm volatile("" ::: "memory"); }
}
__device__ __forceinline__ void store_plain(const Acc& acc, bf16* base, int ldc) {
#pragma unroll
    for (int ai = 0; ai < 2; ++ai)
#pragma unroll
        for (int m = 0; m < 4; ++m) { bf16* rowp = base + (size_t)(ai * HALF + m * 16) * ldc;
#pragma unroll
            for (int bj = 0; bj < 2; ++bj) { const f32x4 v0 = acc[ai][bj][m][0], v1 = acc[ai][bj][m][1];
                u32x4 w; w.x = cvt_pk_bf16(v0[0], v0[1]); w.y = cvt_pk_bf16(v0[2], v0[3]); w.z = cvt_pk_bf16(v1[0], v1[1]); w.w = cvt_pk_bf16(v1[2], v1[3]);
                *(u32x4*)(rowp + bj * HALF) = w; } }
}
struct EpiInproj {
    bf16* ZZ;
    __device__ __forceinline__ bool keep(const Unit&) const { return false; }
    __device__ __forceinline__ void prefetch(const Unit&, int, int, int) const {}
    __device__ __forceinline__ void operator()(const Acc& acc, const Unit& u, int ui, int wr, int wc, int fr, int fq) const {
        bf16* base = ZZ + (size_t)(u.arow + wr * 64 + fr) * INC + u.brow + wc * 32 + 8 * fq;
        const int n0 = u.brow;
        if (n0 < ZU) store_plain(acc, base, INC); else if (n0 < ZGA) store_act<2>(acc, base, INC); else store_act<3>(acc, base, INC);
    }
};
struct EpiPlain {
    bf16* O; int ldc;
    __device__ __forceinline__ bool keep(const Unit&) const { return false; }
    __device__ __forceinline__ void prefetch(const Unit&, int, int, int) const {}
    __device__ __forceinline__ void operator()(const Acc& acc, const Unit& u, int ui, int wr, int wc, int fr, int fq) const {
        store_plain(acc, O + (size_t)(u.arow + wr * 64 + fr) * ldc + u.brow + wc * 32 + 8 * fq, ldc);
    }
};
struct EpiMerge {
    const bf16* ZZ; bf16* O;
    __device__ __forceinline__ bool keep(const Unit& u) const { return u.x2 == 0; }
    __device__ __forceinline__ void prefetch(const Unit&, int, int, int) const {}
    __device__ __forceinline__ void operator()(Acc& acc, const Unit& u, int ui, int wr, int wc, int fr, int fq) const {
        const int row0 = u.arow + wr * 64 + fr, col0 = u.brow + wc * 32 + 8 * fq;
#pragma unroll
        for (int ai = 0; ai < 2; ++ai)
#pragma unroll
            for (int m = 0; m < 4; ++m) { const size_t row = row0 + ai * HALF + m * 16;
#pragma unroll
                for (int bj = 0; bj < 2; ++bj) { const int col = col0 + bj * HALF;
                    float gb[8]; unpack8(*(const u32x4*)(ZZ + row * INC + ZGB + col), gb);
#pragma unroll
                    for (int q = 0; q < 8; ++q) gb[q] = fmaxf(gb[q], 1e-30f);
                    if (u.x2 == 0) { float ga[8]; unpack8(*(const u32x4*)(ZZ + row * INC + ZGA + col), ga);
#pragma unroll
                        for (int q = 0; q < 8; ++q) acc[ai][bj][m][q >> 2][q & 3] *= ga[q] * __builtin_amdgcn_rcpf(gb[q]); }
                    else { const f32x4 v0 = acc[ai][bj][m][0], v1 = acc[ai][bj][m][1];
                        u32x4 w; w.x = cvt_pk_bf16(v0[0] * gb[0], v0[1] * gb[1]); w.y = cvt_pk_bf16(v0[2] * gb[2], v0[3] * gb[3]); w.z = cvt_pk_bf16(v1[0] * gb[4], v1[1] * gb[5]); w.w = cvt_pk_bf16(v1[2] * gb[6], v1[3] * gb[7]);
                        *(u32x4*)(O + row * D + col) = w; } }
                asm volatile("" ::: "memory"); }
    }
};
struct EpiOut {
    const float* x; bf16* O;
    __device__ __forceinline__ bool keep(const Unit&) const { return false; }
    __device__ __forceinline__ void prefetch(const Unit&, int, int, int) const {}
    __device__ __forceinline__ void operator()(const Acc& acc, const Unit& u, int ui, int wr, int wc, int fr, int fq) const {
        const int row0 = u.arow + wr * 64 + fr, col0 = u.brow + wc * 32 + 8 * fq;
#pragma unroll
        for (int ai = 0; ai < 2; ++ai)
#pragma unroll
            for (int m = 0; m < 4; ++m) { const size_t row = row0 + ai * HALF + m * 16;
#pragma unroll
                for (int bj = 0; bj < 2; ++bj) { const int col = col0 + bj * HALF;
                    const f32x4 x0 = *(const f32x4*)(x + row * D + col), x1 = *(const f32x4*)(x + row * D + col + 4);
                    const f32x4 v0 = acc[ai][bj][m][0] + x0, v1 = acc[ai][bj][m][1] + x1;
                    u32x4 w; w.x = cvt_pk_bf16(v0[0], v0[1]); w.y = cvt_pk_bf16(v0[2], v0[3]); w.z = cvt_pk_bf16(v1[0], v1[1]); w.w = cvt_pk_bf16(v1[2], v1[3]);
                    *(u32x4*)(O + row * D + col) = w; }
                asm volatile("" ::: "memory"); }
    }
};
struct EpiPle {
    const bf16* H2; const bf16* PROJ; const float* RSTD2; bf16* O;
    __device__ __forceinline__ bool keep(const Unit&) const { return false; }
    __device__ __forceinline__ void prefetch(const Unit&, int, int, int) const {}
    __device__ __forceinline__ void operator()(const Acc& acc, const Unit& u, int ui, int wr, int wc, int fr, int fq) const {
        const int row0 = u.arow + wr * 64 + fr, col0 = u.brow + wc * 32 + 8 * fq;
#pragma unroll
        for (int ai = 0; ai < 2; ++ai)
#pragma unroll
            for (int m = 0; m < 4; ++m) { const size_t row = row0 + ai * HALF + m * 16; const float rs = RSTD2[row];
#pragma unroll
                for (int bj = 0; bj < 2; ++bj) { const int col = col0 + bj * HALF;
                    float h[8], pj[8]; unpack8(*(const u32x4*)(H2 + row * D + col), h); unpack8(*(const u32x4*)(PROJ + row * D + col), pj);
                    float o[8];
#pragma unroll
                    for (int q = 0; q < 8; ++q) o[q] = h[q] + sigm(rs * acc[ai][bj][m][q >> 2][q & 3]) * pj[q];
                    u32x4 w; w.x = cvt_pk_bf16(o[0], o[1]); w.y = cvt_pk_bf16(o[2], o[3]); w.z = cvt_pk_bf16(o[4], o[5]); w.w = cvt_pk_bf16(o[6], o[7]);
                    *(u32x4*)(O + row * D + col) = w; }
                asm volatile("" ::: "memory"); }
    }
};
}

__device__ __forceinline__ void p1_fast(const Frame& F) {
    { pg::DenseOrder<0> S; S.init(T, INC, F.G, (int)blockIdx.x); pg::EpiInproj E{F.ZZ}; pg::DenseMap AM{D};
      pg::gemm_run<pg::EpiInproj, pg::DenseOrder<0>, pg::DenseMap, true>(F.lds + STAGE_OFF, F.ABF, F.WIN, D, D / 64, S, E, AM); }
    { pg::DenseOrder<0> S; S.init(T, D, F.G, (int)blockIdx.x); pg::EpiPlain E{F.PROJ, D}; pg::DenseMap AM{PLE};
      pg::gemm_run<pg::EpiPlain, pg::DenseOrder<0>, pg::DenseMap, true>(F.lds + STAGE_OFF, F.PBF, F.WPP, PLE, PLE / 64, S, E, AM); }
}
__device__ __forceinline__ void p3_fast(const Frame& F) {
    pg::DenseOrder<1> S; S.init(T, D, F.G, (int)blockIdx.x, 512); pg::EpiMerge E{F.ZZ, F.MERGED}; pg::DenseMap AM{D};
    pg::gemm_run<pg::EpiMerge, pg::DenseOrder<1>, pg::DenseMap, true>(F.lds + STAGE_OFF, F.OAB, F.WAB, D, 512 / 64, S, E, AM);
}
__device__ __forceinline__ void p4_fast(const Frame& F) {
    pg::DenseOrder<0> S; S.init(T, D, F.G, (int)blockIdx.x); pg::EpiOut E{F.x, F.H1}; pg::DenseMap AM{D};
    pg::gemm_run<pg::EpiOut, pg::DenseOrder<0>, pg::DenseMap, true>(F.lds + STAGE_OFF, F.MERGED, F.WOUT, D, D / 64, S, E, AM);
}
__device__ __forceinline__ void p9_fast(const Frame& F) {
    pg::DenseOrder<0> S; S.init(T, D, F.G, (int)blockIdx.x); pg::EpiPle E{F.H2, F.PROJ, F.RSTD2, F.H3}; pg::DenseMap AM{D};
    pg::gemm_run<pg::EpiPle, pg::DenseOrder<0>, pg::DenseMap, true>(F.lds + STAGE_OFF, F.H2, F.WPG, D, D / 64, S, E, AM);
}


namespace pg {
template <int MT, int NT, int NROWS_B>
struct MoeOrder {
    LAS const int* cnt; LAS const int* toff; int c;
    __device__ __forceinline__ bool next(int i, Unit& u) const {
        const int x = c & 7, cl = c >> 3, sb = i * 8 + x, mtg = MT * sb + cl / NT, pn = cl % NT;
        if (mtg >= __builtin_amdgcn_readfirstlane(toff[NE])) return false;
        int e = 0; while (toff[e + 1] <= mtg) ++e;
        e = __builtin_amdgcn_readfirstlane(e);
        const int valid = __builtin_amdgcn_readfirstlane(cnt[e] - 256 * (mtg - toff[e]));
        u.arow = 256 * mtg; u.brow = e * NROWS_B + 256 * pn; u.kofs = 0; u.x0 = e; u.x1 = valid; u.x2 = i; return true;
    }
};
struct GatherMap { static constexpr bool GATHER = true; LAS const unsigned* tab;
    __device__ __forceinline__ unsigned rowoff(const Unit& u, int r) const { return tab[u.x2 * 256 + r]; }
    __device__ __forceinline__ size_t base(const Unit&) const { return 0; } };
struct EpiSwiglu {
    bf16* HID; const float* b1; LAS unsigned char* lds;
    __device__ __forceinline__ bool keep(const Unit&) const { return false; }
    __device__ __forceinline__ void prefetch(const Unit& u, int ui, int wid, int lane) const {
        if (wid == 0) dma16(b1 + u.x0 * 2048 + ((u.brow & 2047) >> 8) * 256, (unsigned)lane * 16u, (unsigned)(uintptr_t)lds + BIAS_OFF + (ui & 1) * 1024); }
    __device__ __forceinline__ void operator()(const Acc& acc, const Unit& u, int ui, int wr, int wc, int fr, int fq) const {
        const int e = u.x0, valid = u.x1, pn = (u.brow & 2047) >> 8, hid0 = 128 * pn + 32 * wc + 8 * fq;
        const LAS f32x4* bp = (const LAS f32x4*)(lds + BIAS_OFF + (ui & 1) * 1024 + (32 * wc + 8 * fq) * 8);
        const f32x4 f0 = bp[0], f1 = bp[1], f2 = bp[2], f3 = bp[3];
        const float bg[8] = {f0[0], f0[2], f1[0], f1[2], f2[0], f2[2], f3[0], f3[2]}, bl[8] = {f0[1], f0[3], f1[1], f1[3], f2[1], f2[3], f3[1], f3[3]};
#pragma unroll
        for (int ai = 0; ai < 2; ++ai)
#pragma unroll
            for (int m = 0; m < 4; ++m) { const int rl = ai * HALF + wr * 64 + m * 16 + fr;
                float o[8];
#pragma unroll
                for (int q = 0; q < 8; ++q) { float g = acc[ai][0][m][q >> 2][q & 3] * (FP8_1 ? SC_INV : 1.0f) + bg[q], l = acc[ai][1][m][q >> 2][q & 3] * (FP8_1 ? SC_INV : 1.0f) + bl[q];
                    g = fminf(g, 7.f); l = __builtin_amdgcn_fmed3f(l, -7.f, 7.f);
                    const float gs = g * __builtin_amdgcn_rcpf(1.0f + __builtin_amdgcn_exp2f(g * (-1.702f * LOG2E))) * (FP8_2 ? SC_ACT : 1.0f);
                    o[q] = gs * l + gs; }
                if (FP8_2) { u32x2 w; w.x = __builtin_amdgcn_cvt_pk_fp8_f32(o[2], o[3], __builtin_amdgcn_cvt_pk_fp8_f32(o[0], o[1], 0, false), true); w.y = __builtin_amdgcn_cvt_pk_fp8_f32(o[6], o[7], __builtin_amdgcn_cvt_pk_fp8_f32(o[4], o[5], 0, false), true);
                    *(u32x2*)((unsigned char*)HID + (size_t)(u.arow + rl) * DE + hid0) = w; }
                else { u32x4 w; w.x = cvt_pk_bf16(o[0], o[1]); w.y = cvt_pk_bf16(o[2], o[3]); w.z = cvt_pk_bf16(o[4], o[5]); w.w = cvt_pk_bf16(o[6], o[7]);
                    *(u32x4*)(HID + (size_t)(u.arow + rl) * DE + hid0) = w; } }
    }
};
struct EpiBias2 {
    bf16* YS; const float* b2; LAS unsigned char* lds;
    __device__ __forceinline__ bool keep(const Unit&) const { return false; }
    __device__ __forceinline__ void prefetch(const Unit& u, int ui, int wid, int lane) const {
        if (wid == 0) dma16(b2 + u.x0 * D + (u.brow & 1023), (unsigned)lane * 16u, (unsigned)(uintptr_t)lds + BIAS_OFF + (ui & 1) * 1024); }
    __device__ __forceinline__ void operator()(const Acc& acc, const Unit& u, int ui, int wr, int wc, int fr, int fq) const {
        const int valid = u.x1, col0 = (u.brow & 1023) + 32 * wc + 8 * fq;
        f32x4 bb[2][2];
#pragma unroll
        for (int bj = 0; bj < 2; ++bj)
#pragma unroll
            for (int n = 0; n < 2; ++n) bb[bj][n] = *(const LAS f32x4*)(lds + BIAS_OFF + (ui & 1) * 1024 + (32 * wc + 8 * fq + bj * HALF + 4 * n) * 4);
#pragma unroll
        for (int ai = 0; ai < 2; ++ai)
#pragma unroll
            for (int m = 0; m < 4; ++m) { const int rl = ai * HALF + wr * 64 + m * 16 + fr;
#pragma unroll
                for (int bj = 0; bj < 2; ++bj) { const f32x4 v0 = acc[ai][bj][m][0] * (FP8_2 ? SC_INV : 1.0f) + bb[bj][0], v1 = acc[ai][bj][m][1] * (FP8_2 ? SC_INV : 1.0f) + bb[bj][1];
                    if (YS8) { u32x2 w; w.x = pk4_fp8(v0[0] * SC_Y, v0[1] * SC_Y, v0[2] * SC_Y, v0[3] * SC_Y); w.y = pk4_fp8(v1[0] * SC_Y, v1[1] * SC_Y, v1[2] * SC_Y, v1[3] * SC_Y);
                        *(u32x2*)((unsigned char*)YS + (size_t)(u.arow + rl) * D + col0 + bj * HALF) = w; }
                    else { u32x4 w; w.x = cvt_pk_bf16(v0[0], v0[1]); w.y = cvt_pk_bf16(v0[2], v0[3]); w.z = cvt_pk_bf16(v1[0], v1[1]); w.w = cvt_pk_bf16(v1[2], v1[3]);
                        *(u32x4*)(YS + (size_t)(u.arow + rl) * D + col0 + bj * HALF) = w; } } }
    }
};
}
__device__ __forceinline__ void p6_fast(const Frame& F) {
    const MoeTab M = moe_tables(F);
    pg::MoeOrder<4, 8, 2048> S{M.cnt, M.toff, (int)blockIdx.x};
    LAS unsigned* tab = (LAS unsigned*)(F.lds + TAB_OFF);
    { pg::Unit u;
      for (int i = 0; i < 18 && S.next(i, u); ++i) { const int e = u.x0, cnt = M.cnt[e], rk0 = cnt - u.x1;
          if (F.tid < 256) { const int rk = rk0 + F.tid; tab[i * 256 + F.tid] = (unsigned)F.TOKLIST[e * LCAP + (rk < cnt ? rk : cnt - 1)] * (unsigned)(FP8_1 ? D : D * 2); } } }
    __syncthreads();
    pg::EpiSwiglu E{F.HID, F.b1, F.lds}; pg::GatherMap AM{tab};
    if (FP8_1) pg::gemm_run<pg::EpiSwiglu, pg::MoeOrder<4, 8, 2048>, pg::GatherMap, true, 1>(F.lds + STAGE_OFF, F.ABF, F.W1T, D / 2, D / 128, S, E, AM);
    else pg::gemm_run<pg::EpiSwiglu, pg::MoeOrder<4, 8, 2048>, pg::GatherMap, true, 0>(F.lds + STAGE_OFF, F.ABF, F.W1T, D, D / 64, S, E, AM);
}
__device__ __forceinline__ void p7_fast(const Frame& F) {
    const MoeTab M = moe_tables(F);
    pg::MoeOrder<8, 4, 1024> S{M.cnt, M.toff, (int)blockIdx.x};
    pg::EpiBias2 E{F.YS, F.b2, F.lds}; pg::DenseMap AM{FP8_2 ? DE / 2 : DE};
    if (FP8_2) pg::gemm_run<pg::EpiBias2, pg::MoeOrder<8, 4, 1024>, pg::DenseMap, true, 1>(F.lds + STAGE_OFF, F.HID, F.W2T, DE / 2, DE / 128, S, E, AM);
    else pg::gemm_run<pg::EpiBias2, pg::MoeOrder<8, 4, 1024>, pg::DenseMap, true, 0>(F.lds + STAGE_OFF, F.HID, F.W2T, DE, DE / 64, S, E, AM);
}


typedef short s16x4 __attribute__((ext_vector_type(4)));
__device__ __forceinline__ s16x4 vtr(LAS const unsigned char* p) { return __builtin_bit_cast(s16x4, __builtin_amdgcn_ds_read_tr16_b64_v4i16((LAS s16x4*)p)); }
__device__ __forceinline__ bf16x8 cat8(s16x4 a, s16x4 b) { return (bf16x8){a[0], a[1], a[2], a[3], b[0], b[1], b[2], b[3]}; }
template <bool EARLY>
__device__ __forceinline__ void p2_attn_fast(const Frame& F, LAS unsigned* cnt_att) {
    const int lane = F.lane, r32 = lane & 31, hi = lane >> 5;
    LAS unsigned char* vl = F.lds + F.wave * 16640;
    LAS const unsigned char* vrd = vl + (4 * hi + ((lane & 15) >> 2)) * 64 + ((lane >> 4) & 1) * 32 + (lane & 3) * 8;
    for (;;) {
        int j = 0; if (lane == 0) j = (int)atomicAdd((unsigned*)cnt_att, 1u);
        j = __builtin_amdgcn_readfirstlane(j);
        if (j >= 32) break;
        const int item = blockIdx.x * NWAVES + (j & 7) + (j >> 3) * (F.G * NWAVES);
        const int qi = item >> 6, bh = item & 63, b = bh >> 3, h = bh & 7;
        const size_t rowbase = (size_t)b * SEQ;
        bf16x8 qf[4];
        { const bf16* qp = F.ZZ + (rowbase + 32 * qi + r32) * INC + ZQ + h * HD + 8 * hi;
#pragma unroll
          for (int d0 = 0; d0 < 4; ++d0) qf[d0] = *(const bf16x8*)(qp + 16 * d0); }
        f32x16 o[2]; o[0] = f32x16{}; o[1] = f32x16{};
        float carry = 1.0f;
        bf16x8 kn[4]; u32x4 vn[4];
#define ATT_LOAD(j) do { const bf16* kp = F.ZZ + (rowbase + 32 * (j) + r32) * INC + ZK + h * HD + 8 * hi; \
            _Pragma("unroll") for (int d0 = 0; d0 < 4; ++d0) kn[d0] = *(const bf16x8*)(kp + 16 * d0); \
            _Pragma("unroll") for (int i = 0; i < 4; ++i) { const int L = i * 64 + lane; \
                vn[i] = *(const u32x4*)(F.ZZ + (rowbase + 32 * (j) + ((L >> 2) & 31)) * INC + ZV + h * HD + (L >> 7) * 32 + (L & 3) * 8); } } while (0)
        ATT_LOAD(qi);
        for (int j = qi; j >= 0; --j) {
            bf16x8 kf[4];
#pragma unroll
            for (int d0 = 0; d0 < 4; ++d0) kf[d0] = kn[d0];
#pragma unroll
            for (int i = 0; i < 4; ++i) *(LAS u32x4*)(vl + (i * 64 + lane) * 16) = vn[i];
            if (j > 0) ATT_LOAD(j - 1);
            f32x16 p = f32x16{};
#pragma unroll
            for (int d0 = 0; d0 < 4; ++d0) p = __builtin_amdgcn_mfma_f32_32x32x16_bf16(kf[d0], qf[d0], p, 0, 0, 0);
            float e[16], sfx[16];
#pragma unroll
            for (int r = 0; r < 16; ++r) { const float z = fminf(p[r], 100.f); e[r] = __builtin_amdgcn_exp2f(z); sfx[r] = __builtin_amdgcn_rcpf(1.0f + e[r]); }
            if (j == qi) {
#pragma unroll
                for (int r = 0; r < 16; ++r) { const bool ok = crow(r, hi) < r32; e[r] = ok ? e[r] : 0.f; sfx[r] = ok ? sfx[r] : 1.f; }
            }
            float TL[4], TH[4];
#pragma unroll
            for (int g = 0; g < 4; ++g) {
                sfx[4 * g + 2] *= sfx[4 * g + 3]; sfx[4 * g + 1] *= sfx[4 * g + 2]; sfx[4 * g] *= sfx[4 * g + 1];
                const auto rr = __builtin_amdgcn_permlane32_swap(__float_as_uint(sfx[4 * g]), __float_as_uint(sfx[4 * g]), false, false);
                TL[g] = __uint_as_float(rr[0]); TH[g] = __uint_as_float(rr[1]); }
            float R[8];
            R[7] = carry; R[6] = R[7] * TH[3]; R[5] = R[6] * TL[3]; R[4] = R[5] * TH[2]; R[3] = R[4] * TL[2]; R[2] = R[3] * TH[1]; R[1] = R[2] * TL[1]; R[0] = R[1] * TH[0]; carry = R[0] * TL[0];
            unsigned pw[8];
#pragma unroll
            for (int g = 0; g < 4; ++g) { const float off = hi ? R[2 * g + 1] : R[2 * g];
                const float w0 = e[4 * g] * (off * sfx[4 * g]), w1 = e[4 * g + 1] * (off * sfx[4 * g + 1]), w2 = e[4 * g + 2] * (off * sfx[4 * g + 2]), w3 = e[4 * g + 3] * (off * sfx[4 * g + 3]);
                pw[2 * g] = pg::cvt_pk_bf16(w0, w1); pw[2 * g + 1] = pg::cvt_pk_bf16(w2, w3); }
            const bf16x8 pa0 = __builtin_bit_cast(bf16x8, (u32x4){pw[0], pw[1], pw[2], pw[3]}), pa1 = __builtin_bit_cast(bf16x8, (u32x4){pw[4], pw[5], pw[6], pw[7]});
            asm volatile("s_waitcnt lgkmcnt(0)" ::: "memory");
#pragma unroll
            for (int d0 = 0; d0 < 2; ++d0) {
                const s16x4 a0 = vtr(vrd + d0 * 2048), a1 = vtr(vrd + d0 * 2048 + 512), b0 = vtr(vrd + d0 * 2048 + 1024), b1 = vtr(vrd + d0 * 2048 + 1536);
                o[d0] = __builtin_amdgcn_mfma_f32_32x32x16_bf16(pa0, cat8(a0, a1), o[d0], 0, 0, 0);
                o[d0] = __builtin_amdgcn_mfma_f32_32x32x16_bf16(pa1, cat8(b0, b1), o[d0], 0, 0, 0);
            }
            asm volatile("s_waitcnt lgkmcnt(0)" ::: "memory");
            if (EARLY && __all(carry == 0.f)) break;
        }
#undef ATT_LOAD
        bf16* op = F.OAB + (rowbase + 32 * qi) * D + h * HD + r32;
#pragma unroll
        for (int d0 = 0; d0 < 2; ++d0)
#pragma unroll
            for (int r = 0; r < 16; ++r) op[(size_t)crow(r, hi) * D + 32 * d0] = (bf16)f2bf(o[d0][r]);
    }
}
__device__ __forceinline__ void p2_sgu_fast(const Frame& F) {
    const int lane = F.lane, r32 = lane & 31, hi = lane >> 5, g = F.wave;
    for (int unit = blockIdx.x; unit < T / 128; unit += F.G) {
        const int row0 = unit * 128;
        __syncthreads();
        {
            u32x4 w[16]; float sm[16], rs[16];
#pragma unroll
            for (int i = 0; i < 16; ++i) w[i] = *(const u32x4*)(F.ZZ + (size_t)(row0 + g * 16 + i) * INC + ZVS + 8 * lane);
#pragma unroll
            for (int i = 0; i < 16; ++i) { float f[8]; unpack8(w[i], f); sm[i] = ((f[0] + f[1]) + (f[2] + f[3])) + ((f[4] + f[5]) + (f[6] + f[7])); }
#pragma unroll
            for (int o = 1; o < 64; o <<= 1)
#pragma unroll
                for (int i = 0; i < 16; ++i) sm[i] += __shfl_xor(sm[i], o);
#pragma unroll
            for (int i = 0; i < 16; ++i) { sm[i] *= (1.f / 512.f); float f[8]; unpack8(w[i], f); float q = 0.f;
#pragma unroll
                for (int j = 0; j < 8; ++j) { const float d = f[j] - sm[i]; q += d * d; }
                rs[i] = q; }
#pragma unroll
            for (int o = 1; o < 64; o <<= 1)
#pragma unroll
                for (int i = 0; i < 16; ++i) rs[i] += __shfl_xor(rs[i], o);
            const f32x4 g0 = *(const f32x4*)(F.sgu_norm + 8 * lane), g1 = *(const f32x4*)(F.sgu_norm + 8 * lane + 4);
#pragma unroll
            for (int i = 0; i < 16; ++i) { const float rstd = rsqrtf(rs[i] * (1.f / 512.f) + EPS), mean = sm[i]; float f[8]; unpack8(w[i], f);
                u32x4 o; o.x = pk2((f[0] - mean) * rstd * g0.x, (f[1] - mean) * rstd * g0.y); o.y = pk2((f[2] - mean) * rstd * g0.z, (f[3] - mean) * rstd * g0.w);
                o.z = pk2((f[4] - mean) * rstd * g1.x, (f[5] - mean) * rstd * g1.y); o.w = pk2((f[6] - mean) * rstd * g1.z, (f[7] - mean) * rstd * g1.w);
                *(LAS u32x4*)(F.lds + (lane >> 2) * 8192 + (g * 16 + i) * 64 + (lane & 3) * 16) = o; }
        }
        __syncthreads();
        LAS const unsigned char* vrd = F.lds + (2 * g) * 8192 + (8 * hi + ((lane & 15) >> 2)) * 64 + ((lane >> 4) & 1) * 32 + (lane & 3) * 8;
        f32x16 acc[4][2];
#pragma unroll
        for (int mt = 0; mt < 4; ++mt) {
            acc[mt][0] = f32x16{}; acc[mt][1] = f32x16{};
            const bf16* ap = F.SGUW + ((size_t)g * 128 + 32 * mt + r32) * 128 + 8 * hi;
            const int nks = (mt < 2) ? 4 : 8;
#pragma unroll 1
            for (int ks = 0; ks < nks; ++ks) {
                const bf16x8 a = *(const bf16x8*)(ap + 16 * ks);
#pragma unroll
                for (int nt = 0; nt < 2; ++nt) {
                    const s16x4 b0 = vtr(vrd + nt * 8192 + ks * 1024), b1 = vtr(vrd + nt * 8192 + ks * 1024 + 256);
                    acc[mt][nt] = __builtin_amdgcn_mfma_f32_32x32x16_bf16(a, cat8(b0, b1), acc[mt][nt], 0, 0, 0);
                }
            }
        }
        asm volatile("s_waitcnt lgkmcnt(0)" ::: "memory");
        LAS bf16* stg = (LAS bf16*)(F.lds + (2 * g) * 8192);
#pragma unroll
        for (int mt = 0; mt < 4; ++mt)
#pragma unroll
            for (int r = 0; r < 16; ++r) { const int tl = 32 * mt + crow(r, hi); const float bs = F.sgu_b[g * 128 + tl];
#pragma unroll
                for (int nt = 0; nt < 2; ++nt) stg[tl * 64 + 32 * nt + r32] = (bf16)f2bf(acc[mt][nt][r] + bs); }
        asm volatile("s_waitcnt lgkmcnt(0)" ::: "memory");
#pragma unroll 4
        for (int i = 0; i < 16; ++i) { const int tl = 8 * i + (lane >> 3), ch8 = (lane & 7) * 8;
            float sv[8], uu[8]; unpack8(*(const LAS u32x4*)(stg + tl * 64 + ch8), sv); unpack8(*(const u32x4*)(F.ZZ + (size_t)(row0 + tl) * INC + ZU + 64 * g + ch8), uu);
            u32x4 o; o.x = pk2(uu[0] * sv[0], uu[1] * sv[1]); o.y = pk2(uu[2] * sv[2], uu[3] * sv[3]); o.z = pk2(uu[4] * sv[4], uu[5] * sv[5]); o.w = pk2(uu[6] * sv[6], uu[7] * sv[7]);
            *(u32x4*)(F.OAB + (size_t)(row0 + tl) * D + 512 + 64 * g + ch8) = o; }
    }
    __syncthreads();
}


__device__ __forceinline__ void p5_fast(const Frame& F) {
    LAS unsigned* hist = (LAS unsigned*)F.lds;
    LAS unsigned* base = hist + 32;
    LAS unsigned* lsel = hist + 64;
    LAS float* lgate = (LAS float*)(hist + 64 + 512);
    LAS float* rsv = lgate + 512;
    LAS float* part = (LAS float*)(F.lds + 8192);
    const int lane = F.lane, r32 = lane & 31, hi = lane >> 5, wg4 = F.wave & 3, kh = F.wave >> 2;
    for (int chunk = blockIdx.x; chunk < T / 128; chunk += F.G) {
        if (F.tid < 32) hist[F.tid] = 0u;
        const int t0 = chunk * 128 + wg4 * 32;
        const bf16* hp = F.H1 + (size_t)(t0 + r32) * D + kh * 512 + 8 * hi;
        const bf16* whp = F.WRHI + r32 * D + kh * 512 + 8 * hi;
        const bf16* wlp = F.WRLO + r32 * D + kh * 512 + 8 * hi;
        f32x16 acc = f32x16{}; float ss = 0.f;
#pragma unroll 8
        for (int k0 = 0; k0 < 512; k0 += 16) {
            const u32x4 hb = *(const u32x4*)(hp + k0);
            const bf16x8 ah = *(const bf16x8*)(whp + k0), al = *(const bf16x8*)(wlp + k0);
            const bf16x8 bb = __builtin_bit_cast(bf16x8, hb);
            acc = __builtin_amdgcn_mfma_f32_32x32x16_bf16(ah, bb, acc, 0, 0, 0);
            acc = __builtin_amdgcn_mfma_f32_32x32x16_bf16(al, bb, acc, 0, 0, 0);
#pragma unroll
            for (int q = 0; q < 4; ++q) { const float lo = __uint_as_float(hb[q] << 16), hh = __uint_as_float(hb[q] & 0xffff0000u); ss += lo * lo + hh * hh; }
        }
        { const auto rr = __builtin_amdgcn_permlane32_swap(__float_as_uint(ss), __float_as_uint(ss), false, false); ss = __uint_as_float(rr[0]) + __uint_as_float(rr[1]); }
        if (kh == 1) {
#pragma unroll
            for (int r = 0; r < 16; ++r) part[(wg4 * 17 + r) * 64 + lane] = acc[r];
            part[(wg4 * 17 + 16) * 64 + lane] = ss;
        }
        __syncthreads();
        if (kh == 0) {
            ss += part[(wg4 * 17 + 16) * 64 + lane];
            const float rstd = rsqrtf(ss * (1.f / D) + EPS);
            float v[16];
#pragma unroll
            for (int r = 0; r < 16; ++r) v[r] = rstd * (acc[r] + part[(wg4 * 17 + r) * 64 + lane]) + F.b_router[crow(r, hi)];
            float cv[8]; int ce[8];
#pragma unroll
            for (int k = 0; k < 4; ++k) {
                float m = v[0];
#pragma unroll
                for (int r = 1; r < 16; ++r) m = fmaxf(m, v[r]);
                int idx = 15;
#pragma unroll
                for (int r = 14; r >= 0; --r) idx = (v[r] == m) ? r : idx;
                cv[k] = m; ce[k] = (idx & 3) + 8 * (idx >> 2) + 4 * hi;
#pragma unroll
                for (int r = 0; r < 16; ++r) v[r] = (r == idx) ? -INFINITY : v[r];
            }
#pragma unroll
            for (int k = 0; k < 4; ++k) {
                const auto rv = __builtin_amdgcn_permlane32_swap(__float_as_uint(cv[k]), __float_as_uint(cv[k]), false, false);
                const auto re = __builtin_amdgcn_permlane32_swap((unsigned)ce[k], (unsigned)ce[k], false, false);
                cv[4 + k] = __uint_as_float(hi ? rv[0] : rv[1]); ce[4 + k] = (int)(hi ? re[0] : re[1]);
            }
            float tv[4]; int te[4];
#pragma unroll
            for (int k = 0; k < 4; ++k) {
                float bv = cv[0]; int be = ce[0];
#pragma unroll
                for (int c = 1; c < 8; ++c) { const bool better = (cv[c] > bv) || (cv[c] == bv && ce[c] < be); bv = better ? cv[c] : bv; be = better ? ce[c] : be; }
                tv[k] = bv; te[k] = be;
#pragma unroll
                for (int c = 0; c < 8; ++c) cv[c] = (ce[c] == be) ? -INFINITY : cv[c];
            }
            float ex[4], sum = 0.f;
#pragma unroll
            for (int k = 0; k < 4; ++k) { ex[k] = __expf(tv[k] - tv[0]); sum += ex[k]; }
            if (hi == 0) { const int tl = wg4 * 32 + r32; rsv[tl] = rstd;
#pragma unroll
                for (int k = 0; k < 4; ++k) { const unsigned loc = atomicAdd((unsigned*)&hist[te[k]], 1u); lsel[tl * 4 + k] = (unsigned)te[k] | (loc << 8); lgate[tl * 4 + k] = ex[k] / sum; } }
        }
        __syncthreads();
        if (F.tid < 32) { const unsigned n = hist[F.tid]; base[F.tid] = n ? __hip_atomic_fetch_add(F.ctl + CW_CNT + 64 * F.tid, n, __ATOMIC_RELAXED, __HIP_MEMORY_SCOPE_AGENT) : 0u; }
        __syncthreads();
        { const int tl = F.tid >> 2, r = F.tid & 3, t = chunk * 128 + tl; const unsigned sl = lsel[tl * 4 + r]; const int ee = sl & 255; const unsigned rank = base[ee] + (sl >> 8);
          F.TOKLIST[ee * LCAP + rank] = t; F.SLOTREF[t * 4 + r] = (ee << 16) | rank; F.GATE[t * 4 + r] = lgate[tl * 4 + r]; }
#pragma unroll 8
        for (int i = 0; i < 16; ++i) {
            const int tl = F.wave * 16 + i, t = chunk * 128 + tl; const float rstd = rsv[tl];
            const u32x4* hr = (const u32x4*)(F.H1 + (size_t)t * D);
            if (FP8_1) {
                float f[8], g[8]; unpack8(hr[2 * lane], f); unpack8(hr[2 * lane + 1], g); const float sc = rstd * SC_ACT;
                u32x4 o; o.x = pk4_fp8(f[0] * sc, f[1] * sc, f[2] * sc, f[3] * sc); o.y = pk4_fp8(f[4] * sc, f[5] * sc, f[6] * sc, f[7] * sc);
                o.z = pk4_fp8(g[0] * sc, g[1] * sc, g[2] * sc, g[3] * sc); o.w = pk4_fp8(g[4] * sc, g[5] * sc, g[6] * sc, g[7] * sc);
                *(u32x4*)((unsigned char*)F.ABF + (size_t)t * D + 16 * lane) = o;
            } else { u32x4* cr = (u32x4*)(F.ABF + (size_t)t * D);
#pragma unroll
            for (int j = 0; j < 2; ++j) { float f[8]; unpack8(hr[lane + 64 * j], f); u32x4 o; o.x = pk2(f[0] * rstd, f[1] * rstd); o.y = pk2(f[2] * rstd, f[3] * rstd); o.z = pk2(f[4] * rstd, f[5] * rstd); o.w = pk2(f[6] * rstd, f[7] * rstd); cr[lane + 64 * j] = o; } }
        }
        __syncthreads();
    }
}

struct Args { const float* in[21]; float* out; unsigned char* ws; int ph_lo, ph_hi; };
__global__ void __launch_bounds__(NTHREADS, 2) fwd(Args args) {
    extern __shared__ __attribute__((aligned(16))) unsigned char lds[];
    Frame F;
    F.lds = (LAS unsigned char*)lds; F.MISC = (volatile LAS unsigned*)(F.lds + MISC_OFF);
    F.tid = threadIdx.x; F.lane = F.tid & 63; F.wave = __builtin_amdgcn_readfirstlane(F.tid >> 6); F.G = gridDim.x;
    unsigned char* ws = args.ws;
    F.ctl = (unsigned*)(ws + WS_CTL);
    F.x = args.in[0]; F.p = args.in[1]; F.g_mix = args.in[2]; F.w_in = args.in[3]; F.w_out_a = args.in[4]; F.w_out_b = args.in[5]; F.w_out = args.in[6];
    F.sgu_norm = args.in[7]; F.sgu_w = args.in[8]; F.sgu_b = args.in[9]; F.g_moe = args.in[10]; F.w_router = args.in[11]; F.b_router = args.in[12];
    F.w1 = args.in[13]; F.b1 = args.in[14]; F.w2 = args.in[15]; F.b2 = args.in[16]; F.g_ple = args.in[17]; F.w_ple_gate = args.in[18]; F.w_ple_proj = args.in[19]; F.g_final = args.in[20];
    F.out = args.out;
    F.WRHI = (bf16*)(ws + WS_WRHI); F.WRLO = (bf16*)(ws + WS_WRLO); F.SGUW = (bf16*)(ws + WS_SGUW); F.WIN = (bf16*)(ws + WS_WIN); F.WAB = (bf16*)(ws + WS_WAB);
    F.WOUT = (bf16*)(ws + WS_WOUT); F.WPG = (bf16*)(ws + WS_WPG); F.WPP = (bf16*)(ws + WS_WPP); F.W1T = (bf16*)(ws + WS_W1); F.W2T = (bf16*)(ws + WS_W2);
    F.PBF = (bf16*)(ws + WS_PBF); F.PROJ = (bf16*)(ws + WS_PROJ); F.H1 = (bf16*)(ws + WS_H1); F.ZZ = (bf16*)(ws + WS_ZZ); F.HID = (bf16*)(ws + WS_HID);
    F.H2 = (bf16*)(ws + WS_H2); F.H3 = (bf16*)(ws + WS_H3); F.ABF = (bf16*)(ws + WS_ABF); F.OAB = (bf16*)(ws + WS_OAB); F.MERGED = (bf16*)(ws + WS_MERGED); F.YS = (bf16*)(ws + WS_YS);
    F.RSTD1 = (float*)(ws + WS_RSTD1); F.RSTD2 = (float*)(ws + WS_RSTD2); F.GATE = (float*)(ws + WS_GATE);
    F.TOKLIST = (int*)(ws + WS_TOKLIST); F.SLOTREF = (int*)(ws + WS_SLOTREF);
    for (int u = F.tid; u < (LDS_BYTES - MISC_OFF) / 4; u += NTHREADS) ((LAS unsigned*)(F.lds + MISC_OFF))[u] = 0u;
    __syncthreads();
    XcdBarrier bar = xcd_barrier_post(F.ctl + CW_BAR, F.MISC + 8);
    const int lo = args.ph_lo, hi = args.ph_hi;
#define IN(k) (lo <= (k) && (k) < hi)
#define SEAM(k) do { if (IN(k) && IN((k) + 1)) xcd_barrier(bar); } while (0)
    if (IN(0)) { p0_prologue(F); } SEAM(0);
    if (IN(1)) { { if (OPT_P1) p1_fast(F); else p1_inproj(F); } } SEAM(1);
    if (IN(2)) {
        const bool sgu_first = (blockIdx.x & 1) != 0;
        if (sgu_first) { if (OPT_SGU) p2_sgu_fast(F); else p2_sgu_simple(F); }
        { LAS unsigned* cnt_att = (LAS unsigned*)(F.lds + MISC_OFF + 64); LAS unsigned* cnt_cv = cnt_att + 1;
          if (OPT_ATT) { if (F.wave < 2) { moe_weight_items(F, cnt_cv); p2_attn_fast<ATT_EARLY>(F, cnt_att); } else { p2_attn_fast<ATT_EARLY>(F, cnt_att); moe_weight_items(F, cnt_cv); } }
          else { moe_weight_items(F, cnt_cv); __syncthreads(); p2_attn_scalar<false>(F); } }
        if (!sgu_first) { __syncthreads(); if (OPT_SGU) p2_sgu_fast(F); else p2_sgu_simple(F); }
    } SEAM(2);
    if (IN(3)) { { if (OPT_P3) p3_fast(F); else p3_merge(F); } } SEAM(3);
    if (IN(4)) { { if (OPT_P4) p4_fast(F); else p4_out(F); } } SEAM(4);
    if (IN(5)) { if (OPT_P5) p5_fast(F); else p5_router(F); } SEAM(5);
    if (IN(6)) { { if (OPT_P6) p6_fast(F); else p6_moe1(F); } } SEAM(6);
    if (IN(7)) { { if (OPT_P7) p7_fast(F); else p7_moe2(F); } } SEAM(7);
    if (IN(8)) { p8_combine(F); } SEAM(8);
    if (IN(9)) { { if (OPT_P9) p9_fast(F); else p9_ple(F); } } SEAM(9);
    if (IN(10)) { p10_final(F); }
#undef IN
#undef SEAM
}

extern "C" void kernel_launch(void* const* d_in, const int* in_sizes, int n_in, void* d_out, int out_size, void* d_ws, size_t ws_size, hipStream_t stream) {
    static int grid = 0;
    if (grid == 0) {
        if (n_in != 21 || out_size != T * D || ws_size < WS_END) { fprintf(stderr, "kernel_launch: unexpected shapes (n_in %d out %d ws %zu)\n", n_in, out_size, ws_size); grid = -1; return; }
        int dev = 0, cus = 0;
        if (hipGetDevice(&dev) != hipSuccess || hipDeviceGetAttribute(&cus, hipDeviceAttributeMultiprocessorCount, dev) != hipSuccess) { grid = -1; return; }
        if (hipFuncSetAttribute((const void*)fwd, hipFuncAttributeMaxDynamicSharedMemorySize, LDS_BYTES) != hipSuccess) { fprintf(stderr, "kernel_launch: hipFuncSetAttribute failed\n"); grid = -1; return; }
        int per_cu = 0;
        if (hipOccupancyMaxActiveBlocksPerMultiprocessor(&per_cu, (const void*)fwd, NTHREADS, LDS_BYTES) != hipSuccess || per_cu < 1) fprintf(stderr, "kernel_launch: occupancy query says %d\n", per_cu);
        (void)hipGetLastError();
        if (cus < 256) { fprintf(stderr, "kernel_launch: needs >= 256 CUs, found %d\n", cus); grid = -1; return; }
        grid = 256;
    }
    if (grid < 0) return;
    (void)hipMemsetAsync((char*)d_ws + WS_CTL, 0, CTL_ZERO_BYTES, stream);
    Args a{};
    for (int i = 0; i < 21; ++i) a.in[i] = (const float*)d_in[i];
    a.out = (float*)d_out; a.ws = (unsigned char*)d_ws; a.ph_lo = 0; a.ph_hi = 11;
    hipLaunchKernelGGL(fwd, dim3(grid), dim3(NTHREADS), LDS_BYTES, stream, a);
}
```
